# Optimizing an MI355X kernel written in HIP

```python
import math
import jax, jax.numpy as jnp
from jax import lax
import numpy as np

D_MODEL = 1024
BATCH = 32
SEQ = 2048
DEPTH = 4
DEC_BATCH = 32
DEC_SEQ = 16
PAST_LEN = 4096

CHUNK = 64
Q_BLOCK = 128
N_MIX_LAYERS = (DEPTH + 1) // 2
N_POOL_LAYERS = DEPTH // 2

A_DK = 128
A_DV = 128
A_HEADS = (D_MODEL // 2) // A_DV
A_W = A_HEADS * A_DK
B_DQK = 64
B_DV = 2 * B_DQK
B_HEADS = (D_MODEL // 2) // B_DV
B_W = B_HEADS * B_DV
IN_COLS = 4 * A_W + 3 * B_W
MIX_W = A_HEADS * A_DV + B_W
POOL_WINDOWS = (2, 4, 8, 16)
POOL_GROUP = D_MODEL // len(POOL_WINDOWS)
POOL_HIST = max(POOL_WINDOWS) - 1
D_FF = 256 * math.ceil(8 * D_MODEL / 3 / 256)
CONV_W = 3
NUM_BUCKETS = 32
MAX_DISTANCE = 128
DN_ALPHA = (2 * DEPTH) ** 0.25
DN_BETA = (8 * DEPTH) ** -0.25
LN_EPS = 1e-5
RMS_EPS = 1e-6

kernel_name = "hgrn2_diffattn_pool_convffn_stream"


def layer_norm(x, g, b):
    xf = x.astype(jnp.float32)
    mu = jnp.mean(xf, -1, keepdims=True)
    var = jnp.mean(jnp.square(xf - mu), -1, keepdims=True)
    return ((xf - mu) * lax.rsqrt(var + LN_EPS) * g.astype(jnp.float32) + b.astype(jnp.float32)).astype(x.dtype)


def rms_norm(x, g):
    xf = x.astype(jnp.float32)
    return (xf * lax.rsqrt(jnp.mean(xf * xf, -1, keepdims=True) + RMS_EPS) * g.astype(jnp.float32)).astype(x.dtype)


def rel_bucket(rel):
    half = NUM_BUCKETS // 2
    max_exact = half // 2
    base = jnp.where(rel > 0, half, 0)
    n = jnp.abs(rel)
    nf = jnp.maximum(n, 1).astype(jnp.float32)
    large = max_exact + (jnp.log(nf / max_exact) / math.log(MAX_DISTANCE / max_exact)
                         * (half - max_exact)).astype(jnp.int32)
    large = jnp.minimum(large, half - 1)
    return base + jnp.where(n < max_exact, n, large)


def diff_attn(q, k, v, q_pos, k_pos, lam, rel_bias):
    scale = B_DQK ** -0.5
    visible = (k_pos[None, :] // CHUNK) <= (q_pos[:, None] // CHUNK)
    bias = jnp.moveaxis(rel_bias[rel_bucket(k_pos[None, :] - q_pos[:, None])], -1, 0).astype(jnp.float32)
    neg = jnp.finfo(jnp.float32).min

    def probs(qa, ka):
        s = jnp.einsum('bqhd,bkhd->bhqk', qa, ka, preferred_element_type=jnp.float32) * scale + bias
        return jax.nn.softmax(jnp.where(visible, s, neg), axis=-1)

    attn = probs(q[..., :B_DQK], k[..., :B_DQK]) - lam * probs(q[..., B_DQK:], k[..., B_DQK:])
    return jnp.einsum('bhqk,bkhd->bqhd', attn.astype(v.dtype), v)


def hgrn2_chunk(S0, q, log_f, k, v):
    L = q.shape[1]
    b = jnp.cumsum(log_f, axis=1)
    causal = jnp.tril(jnp.ones((L, L), bool))[None, :, :, None, None]
    decay = jnp.where(causal, jnp.exp(jnp.minimum(b[:, :, None] - b[:, None, :], 0.0)), 0.0)
    scores = jnp.einsum('bthk,btshk,bshk->bhts', q, decay, k)
    o = (jnp.einsum('bhts,bshv->bthv', scores, v)
         + jnp.einsum('bthk,bhkv->bthv', q * jnp.exp(b), S0))
    b_last = b[:, -1]
    S = S0 * jnp.exp(b_last)[..., None] + jnp.einsum('bshk,bshv->bhkv', k * jnp.exp(b_last[:, None] - b), v)
    return S, o


def hgrn2_scan(S0, q, log_f, k, v):
    Bsz, T = q.shape[:2]
    L = min(T, CHUNK)
    n = T // L
    to_chunks = lambda t: jnp.moveaxis(t.reshape(Bsz, n, L, *t.shape[2:]), 1, 0)
    S, o = lax.scan(lambda S, c: hgrn2_chunk(S, *c), S0, (to_chunks(q), to_chunks(log_f), to_chunks(k), to_chunks(v)))
    return S, jnp.moveaxis(o, 0, 1).reshape(Bsz, T, *o.shape[3:])


def mixer_ab(x, k_hist, v_hist, S0, lb, lam_init, w_in, w_out, a_norm_g, lam_p, b_norm_g, rel_bias):
    Bsz, T, _ = x.shape
    P = k_hist.shape[1]
    h = x @ w_in
    aq, af, ai, ag, bq, bk, bv = jnp.split(h, np.cumsum([A_W] * 4 + [B_W] * 2).tolist(), axis=-1)
    zf = af.astype(jnp.float32)
    log_f = jnp.log(lb + (1.0 - lb) * jax.nn.sigmoid(zf))
    k_in = (1.0 - lb) * jax.nn.sigmoid(-zf)
    ah = lambda t: t.reshape(Bsz, T, A_HEADS, -1)
    S, oa = hgrn2_scan(S0.astype(jnp.float32), ah(aq.astype(jnp.float32)), ah(log_f), ah(k_in),
                       ah(ai.astype(jnp.float32)))
    oa = rms_norm(oa, a_norm_g.reshape(A_HEADS, A_DV)).reshape(Bsz, T, A_W).astype(x.dtype) * jax.nn.silu(ag)
    lp = lam_p.astype(jnp.float32)
    lam = jnp.exp(jnp.sum(lp[0] * lp[1])) - jnp.exp(jnp.sum(lp[2] * lp[3])) + lam_init
    q = bq.reshape(Bsz, T, B_HEADS, 2 * B_DQK)
    k_new = bk.reshape(Bsz, T, B_HEADS, 2 * B_DQK)
    v_new = bv.reshape(Bsz, T, B_HEADS, B_DV)
    k_all = jnp.concatenate([k_hist.astype(x.dtype), k_new], axis=1)
    v_all = jnp.concatenate([v_hist.astype(x.dtype), v_new], axis=1)
    q_pos = P + jnp.arange(T, dtype=jnp.int32)
    k_pos = jnp.arange(P + T, dtype=jnp.int32)
    if T > Q_BLOCK:
        nb = T // Q_BLOCK
        qb = jnp.moveaxis(q.reshape(Bsz, nb, Q_BLOCK, B_HEADS, 2 * B_DQK), 1, 0)
        ob = lax.map(lambda c: diff_attn(c[0], k_all, v_all, c[1], k_pos, lam, rel_bias),
                     (qb, q_pos.reshape(nb, Q_BLOCK)))
        ob = jnp.moveaxis(ob, 0, 1).reshape(Bsz, T, B_HEADS, B_DV)
    else:
        ob = diff_attn(q, k_all, v_all, q_pos, k_pos, lam, rel_bias)
    ob = (rms_norm(ob, b_norm_g) * (1.0 - lam_init)).reshape(Bsz, T, B_W)
    y = jnp.concatenate([oa, ob], axis=-1) @ w_out
    return y, k_new, v_new, S.astype(x.dtype)


def mixer_pool(x, pos0, hist, w_groups, scale):
    Bsz, T, _ = x.shape
    xh = jnp.concatenate([hist.astype(x.dtype), x], axis=1)
    cs = jnp.cumsum(jnp.pad(xh.astype(jnp.float32), ((0, 0), (1, 0), (0, 0))), axis=1)
    pos = pos0 + jnp.arange(T, dtype=jnp.int32)
    outs = []
    for g, w in enumerate(POOL_WINDOWS):
        sl = slice(g * POOL_GROUP, (g + 1) * POOL_GROUP)
        s = cs[:, POOL_HIST + 1:, sl] - cs[:, POOL_HIST + 1 - w:POOL_HIST + 1 - w + T, sl]
        cnt = jnp.minimum(w, pos + 1).astype(jnp.float32)[None, :, None]
        pooled = (s / cnt).astype(x.dtype) - x[..., sl]
        outs.append(pooled @ w_groups[g])
    y = jnp.concatenate(outs, axis=-1) * scale
    return y, xh[:, -POOL_HIST:]


def conv_ffn(x, hist, w_up, conv_w, conv_b, w_down):
    T = x.shape[1]
    a, b = jnp.split(x @ w_up, 2, axis=-1)
    ah = jnp.concatenate([hist.astype(x.dtype), a], axis=1)
    c = conv_b
    for j in range(CONV_W):
        c = c + ah[:, j:j + T] * conv_w[j]
    return (jax.nn.silu(c) * b) @ w_down, ah[:, -(CONV_W - 1):]


def trunk(x, k_hist, v_hist, s_hist, pool_hist, conv_hist, lower_bounds, w_in_ab, w_out_ab, hgrn_norm_g,
          diff_lambda, diff_norm_g, rel_bias, pool_w, pool_scale, ffn_w_up, ffn_conv_w, ffn_conv_b,
          ffn_w_down, ln1_g, ln1_b, ln2_g, ln2_b):
    pos0 = k_hist[0].shape[1]
    ks, vs, ss, ps, cs = [], [], [], [], []
    for l in range(DEPTH):
        if l % 2 == 0:
            m = l // 2
            lam_init = 0.8 - 0.6 * math.exp(-0.3 * l)
            y, kr, vr, S = mixer_ab(x, k_hist[m], v_hist[m], s_hist[m], lower_bounds[m], lam_init,
                                    w_in_ab[m], w_out_ab[m], hgrn_norm_g[m], diff_lambda[m],
                                    diff_norm_g[m], rel_bias)
            ks.append(kr); vs.append(vr); ss.append(S)
        else:
            p = l // 2
            y, ph = mixer_pool(x, pos0, pool_hist[p], pool_w[p], pool_scale[p])
            ps.append(ph)
        x = layer_norm(DN_ALPHA * x + y, ln1_g[l], ln1_b[l])
        f, ch = conv_ffn(x, conv_hist[l], ffn_w_up[l], ffn_conv_w[l], ffn_conv_b[l], ffn_w_down[l])
        cs.append(ch)
        x = layer_norm(DN_ALPHA * x + f, ln2_g[l], ln2_b[l])
    return x, jnp.stack(ks), jnp.stack(vs), jnp.stack(ss), jnp.stack(ps), jnp.stack(cs)


def setup_inputs(seed: int = 0) -> dict:
    key = jax.random.key(seed)
    ks = jax.random.split(key, 24)
    nrm = lambda k, shape, s: jax.random.normal(k, shape, jnp.float32) * s
    return {
        "x_prompt": nrm(ks[0], (BATCH, SEQ, D_MODEL), 1.0),
        "x_sample": nrm(ks[1], (DEC_BATCH, DEC_SEQ, D_MODEL), 1.0),
        "cache_k": nrm(ks[2], (N_MIX_LAYERS, DEC_BATCH, PAST_LEN, B_HEADS, 2 * B_DQK), 1.0),
        "cache_v": nrm(ks[3], (N_MIX_LAYERS, DEC_BATCH, PAST_LEN, B_HEADS, B_DV), 1.0),
        "state_hgrn": nrm(ks[4], (N_MIX_LAYERS, DEC_BATCH, A_HEADS, A_DK, A_DV), 0.5),
        "state_pool": nrm(ks[5], (N_POOL_LAYERS, DEC_BATCH, POOL_HIST, D_MODEL), 1.0),
        "state_ffn_conv": nrm(ks[6], (DEPTH, DEC_BATCH, CONV_W - 1, D_FF), 1.0),
        "w_in_ab": nrm(ks[7], (N_MIX_LAYERS, D_MODEL, IN_COLS), D_MODEL ** -0.5),
        "w_out_ab": nrm(ks[8], (N_MIX_LAYERS, MIX_W, D_MODEL), DN_BETA * MIX_W ** -0.5),
        "lb_logits": nrm(ks[9], (N_MIX_LAYERS, A_W), 0.5),
        "hgrn_norm_g": 1.0 + nrm(ks[10], (N_MIX_LAYERS, A_W), 0.02),
        "diff_lambda": nrm(ks[11], (N_MIX_LAYERS, 4, B_DQK), 0.1),
        "diff_norm_g": 1.0 + nrm(ks[12], (N_MIX_LAYERS, B_DV), 0.02),
        "rel_bias": nrm(ks[13], (NUM_BUCKETS, B_HEADS), 0.2),
        "pool_w": nrm(ks[14], (N_POOL_LAYERS, len(POOL_WINDOWS), POOL_GROUP, POOL_GROUP), DN_BETA * POOL_GROUP ** -0.5),
        "pool_scale": 1.0 + nrm(ks[15], (N_POOL_LAYERS, D_MODEL), 0.02),
        "ffn_w_up": nrm(ks[16], (DEPTH, D_MODEL, 2 * D_FF), D_MODEL ** -0.5),
        "ffn_conv_w": nrm(ks[17], (DEPTH, CONV_W, D_FF), CONV_W ** -0.5),
        "ffn_conv_b": nrm(ks[18], (DEPTH, D_FF), 0.01),
        "ffn_w_down": nrm(ks[19], (DEPTH, D_FF, D_MODEL), DN_BETA * D_FF ** -0.5),
        "ln1_g": 1.0 + nrm(ks[20], (DEPTH, D_MODEL), 0.02),
        "ln1_b": nrm(ks[21], (DEPTH, D_MODEL), 0.01),
        "ln2_g": 1.0 + nrm(ks[22], (DEPTH, D_MODEL), 0.02),
        "ln2_b": nrm(ks[23], (DEPTH, D_MODEL), 0.01),
    }


def reference(x_prompt, x_sample, cache_k, cache_v, state_hgrn, state_pool, state_ffn_conv, w_in_ab, w_out_ab,
              lb_logits, hgrn_norm_g, diff_lambda, diff_norm_g, rel_bias, pool_w, pool_scale, ffn_w_up,
              ffn_conv_w, ffn_conv_b, ffn_w_down, ln1_g, ln1_b, ln2_g, ln2_b):
    sm = jax.nn.softmax(lb_logits.astype(jnp.float32), axis=0)
    lower_bounds = jnp.cumsum(sm, axis=0) - sm[0]
    weights = (lower_bounds, w_in_ab, w_out_ab, hgrn_norm_g, diff_lambda, diff_norm_g, rel_bias, pool_w,
               pool_scale, ffn_w_up, ffn_conv_w, ffn_conv_b, ffn_w_down, ln1_g, ln1_b, ln2_g, ln2_b)
    Bp, dt = x_prompt.shape[0], x_prompt.dtype
    y_prompt, k_p, v_p, s_p, pool_p, conv_p = trunk(
        x_prompt,
        [jnp.zeros((Bp, 0, B_HEADS, 2 * B_DQK), dt)] * N_MIX_LAYERS,
        [jnp.zeros((Bp, 0, B_HEADS, B_DV), dt)] * N_MIX_LAYERS,
        [jnp.zeros((Bp, A_HEADS, A_DK, A_DV), dt)] * N_MIX_LAYERS,
        [jnp.zeros((Bp, POOL_HIST, D_MODEL), dt)] * N_POOL_LAYERS,
        [jnp.zeros((Bp, CONV_W - 1, D_FF), dt)] * DEPTH,
        *weights)
    y_sample, k_s, v_s, s_s, pool_s, conv_s = trunk(
        x_sample, cache_k, cache_v, state_hgrn, state_pool, state_ffn_conv, *weights)
    return (y_prompt, y_sample, k_p, v_p, s_p, pool_p, conv_p, k_s, v_s, s_s, pool_s, conv_s)
```

```cpp
#include <hip/hip_runtime.h>
#include <cstdio>
#include <cstdint>

#ifndef PHM
#define PHM 0xffff
#endif
#ifndef MK_SINGLE
#define MK_SINGLE 1
#endif

#define LAS __attribute__((address_space(3)))
#define GAS __attribute__((address_space(1)))
typedef unsigned short bf16_t;
typedef short bf16x8 __attribute__((ext_vector_type(8)));
typedef short s16x4 __attribute__((ext_vector_type(4)));
typedef float f32x2 __attribute__((ext_vector_type(2)));
typedef float f32x4 __attribute__((ext_vector_type(4)));
typedef float f32x16 __attribute__((ext_vector_type(16)));
typedef unsigned u32x2 __attribute__((ext_vector_type(2)));
typedef unsigned u32x4 __attribute__((ext_vector_type(4)));
typedef __bf16 bf16x2_t __attribute__((ext_vector_type(2)));
typedef GAS unsigned gu32;

constexpr int D = 1024, PB = 32, PT = 2048, SB = 32, ST = 16, PAST = 4096;
constexpr int MP = PB * PT, MS = SB * ST, MT = MP + MS;
constexpr int INC = 3584, DFF = 2816, UPN = 2 * DFF, NH = 4;
constexpr int C_AQ = 0, C_AF = 512, C_AI = 1024, C_AG = 1536, C_BQ = 2048, C_BK = 2560, C_BV = 3072;
constexpr float DN_ALPHA = 1.681792830507429f;
constexpr float LN_EPS = 1e-5f, RMS_EPS = 1e-6f;
constexpr float LOG2E = 1.4426950408889634f;
constexpr int NWAVES = 8, NTHREADS = 512;

constexpr size_t O_YP = 0;
constexpr size_t O_YS = O_YP + (size_t)MP * D;
constexpr size_t O_KP = O_YS + (size_t)MS * D;
constexpr size_t O_VP = O_KP + (size_t)2 * MP * 512;
constexpr size_t O_HP = O_VP + (size_t)2 * MP * 512;
constexpr size_t O_PP = O_HP + (size_t)2 * PB * NH * 128 * 128;
constexpr size_t O_CP = O_PP + (size_t)2 * PB * 15 * D;
constexpr size_t O_KS = O_CP + (size_t)4 * PB * 2 * DFF;
constexpr size_t O_VS = O_KS + (size_t)2 * MS * 512;
constexpr size_t O_HS = O_VS + (size_t)2 * MS * 512;
constexpr size_t O_PS = O_HS + (size_t)2 * SB * NH * 128 * 128;
constexpr size_t O_CS = O_PS + (size_t)2 * SB * 15 * D;
constexpr size_t O_END = O_CS + (size_t)4 * SB * 2 * DFF;
static_assert(O_END == 214695936ull, "d_out size");

constexpr size_t WS_CTL = 0, CTL_ZERO_BYTES = 1u << 20;
constexpr size_t WS_WIN = CTL_ZERO_BYTES;
constexpr size_t WS_WOUT = WS_WIN + (size_t)2 * INC * D * 2;
constexpr size_t WS_WPOOL = WS_WOUT + (size_t)2 * D * D * 2;
constexpr size_t WS_WUP = WS_WPOOL + (size_t)2 * D * 256 * 2;
constexpr size_t WS_WDN = WS_WUP + (size_t)4 * UPN * D * 2;
constexpr size_t WS_TAB = WS_WDN + (size_t)4 * D * DFF * 2;
constexpr size_t WS_XB = WS_TAB + 65536;
constexpr size_t WS_Z = WS_XB + (size_t)MT * D * 2;
constexpr size_t WS_MIX = WS_Z + (size_t)MT * D * 4;
constexpr size_t WS_G = WS_MIX + (size_t)MT * D * 2;
constexpr size_t WS_A = WS_G + (size_t)MT * DFF * 2;
constexpr size_t WS_H = WS_A;
constexpr size_t WS_LF = WS_H + (size_t)MT * INC * 2;
constexpr size_t WS_AB = WS_A;
constexpr size_t WS_END = WS_A + (size_t)MT * UPN * 2;
static_assert(WS_LF + (size_t)MT * 512 * 4 <= WS_END, "H|LF inside region A");
static_assert(WS_END <= 2147483648ull, "workspace");
constexpr int CW_TMO = 0;
constexpr int CW_BAR = 4096;
constexpr int CW_QUEUE = 16384;
constexpr int TB_LB = 0;
constexpr int TB_LAM = 1024;

constexpr int LDS_BYTES = 163840;
constexpr int LDS_CTRL = LDS_BYTES - 512;
constexpr int LDS_TAB = LDS_CTRL - 1024;

__device__ __forceinline__ unsigned pk2(float lo, float hi) { f32x2 v = {lo, hi}; bf16x2_t b = __builtin_convertvector(v, bf16x2_t); return __builtin_bit_cast(unsigned, b); }
__device__ __forceinline__ float bflo(unsigned u) { return __builtin_bit_cast(float, u << 16); }
__device__ __forceinline__ float bfhi(unsigned u) { return __builtin_bit_cast(float, u & 0xffff0000u); }
__device__ __forceinline__ u32x4 pk8(const float* v) { u32x4 w; w.x = pk2(v[0], v[1]); w.y = pk2(v[2], v[3]); w.z = pk2(v[4], v[5]); w.w = pk2(v[6], v[7]); return w; }
__device__ __forceinline__ void unpk8(u32x4 w, float* v) { v[0] = bflo(w.x); v[1] = bfhi(w.x); v[2] = bflo(w.y); v[3] = bfhi(w.y); v[4] = bflo(w.z); v[5] = bfhi(w.z); v[6] = bflo(w.w); v[7] = bfhi(w.w); }
__device__ __forceinline__ float wave_sum(float v) {
#pragma unroll
    for (int o = 1; o < 64; o <<= 1) v += __shfl_xor(v, o);
    return v;
}
__device__ __forceinline__ int opq(int x) { asm volatile("" : "+v"(x)); return x; }
__device__ __forceinline__ int crow(int reg, int h) { return (reg & 3) + 8 * (reg >> 2) + 4 * h; }
__device__ __forceinline__ s16x4 vtr(const LAS unsigned char* p) { return __builtin_bit_cast(s16x4, __builtin_amdgcn_ds_read_tr16_b64_v4i16((LAS s16x4*)p)); }
__device__ __forceinline__ bf16x8 cat8(s16x4 lo, s16x4 hi) { return (bf16x8){lo[0], lo[1], lo[2], lo[3], hi[0], hi[1], hi[2], hi[3]}; }
#define MFMA32(a, b, c) __builtin_amdgcn_mfma_f32_32x32x16_bf16((a), (b), (c), 0, 0, 0)
__device__ __forceinline__ bf16x8 pack_step(const f32x16& x, int s) {
    u32x4 p; p.x = pk2(x[8 * s], x[8 * s + 1]); p.y = pk2(x[8 * s + 2], x[8 * s + 3]); p.z = pk2(x[8 * s + 4], x[8 * s + 5]); p.w = pk2(x[8 * s + 6], x[8 * s + 7]);
    return __builtin_bit_cast(bf16x8, p);
}

namespace pg8 {
constexpr int BM = 256, BK = 64, HALF = 128, HTB = HALF * BK * 2, STAGE_BYTES = 8 * HTB, NXCD = 8, WGM = 8;
__host__ __device__ __forceinline__ int lds_byte(int r, int c) { const int st = (r >> 4) * 2 + (c >> 5), rr = r & 15, cc = c & 31, ob = rr * 64 + cc * 2; return st * 1024 + (ob ^ (((ob >> 9) & 1) << 5)); }
__host__ __device__ __forceinline__ void stage_rc(int b, int& R, int& C) { const int st = b / 1024, sb = b % 1024, swz = sb ^ (((sb >> 9) & 1) << 5); R = (st >> 1) * 16 + swz / 64; C = (st & 1) * 32 + (swz % 64) / 2; }
__host__ __device__ __forceinline__ int perm32(int rho) { const int n = rho >> 4, i = rho & 15; return 8 * (i >> 2) + 4 * n + (i & 3); }
struct Unit { int pm, pn; };
struct Gemm { const bf16_t* A; const bf16_t* Bt; int M, N, K, lda, a_pn_step; };
struct StaticOrder {
    int nM, nN, nwg, G, c;
    __device__ void init(int M, int N, int G_, int c_) { nM = M / BM; nN = N / BM; nwg = nM * nN; G = G_; c = c_; }
    __device__ bool next(int i, Unit& u) const {
        const long L = (long)i * G + c; if (L >= nwg) return false;
        int wgid = (int)L; { const int q = nwg / NXCD, r = nwg % NXCD, xcd = wgid % NXCD, off = wgid / NXCD; wgid = (xcd < r ? xcd * (q + 1) : r * (q + 1) + (xcd - r) * q) + off; }
        const int nig = WGM * nN, gid = wgid / nig, fm = gid * WGM, gsz = (nM - fm) < WGM ? (nM - fm) : WGM;
        u.pm = fm + ((wgid % nig) % gsz); u.pn = (wgid % nig) / gsz; return true;
    }
};
template <class Epi>
__device__ __forceinline__ void gemm_phase(LAS unsigned char* lds, const Gemm g, const StaticOrder& S, const Epi& E, int tid_in) {
    const int tid = tid_in, wid = __builtin_amdgcn_readfirstlane(tid >> 6), lane = tid & 63, wr = wid >> 2, wc = wid & 3, fr = lane & 15, fq = lane >> 4;
    const int K = g.K, nt = K / BK, lda = g.lda;
    unsigned voffA[2], voffB[2];
#pragma unroll
    for (int i = 0; i < 2; ++i) { int R, C; stage_rc(tid * 16 + i * 8192, R, C); const int Rb = (R & ~31) + perm32(R & 31);
        voffA[i] = (unsigned)(R * lda + C) * 2u; voffB[i] = (unsigned)(Rb * K + C) * 2u; }
    const size_t kstep = (size_t)(BK * 2);
    const size_t hstepA = (size_t)HALF * lda * 2, hstepB = (size_t)HALF * K * 2;
    const size_t tstepA = 2 * hstepA, tstepB = 2 * hstepB;
    const size_t pnA = (size_t)g.a_pn_step * 2;
    const unsigned ldsw = (unsigned)wid * 1024u;
    const int aoff = lds_byte(wr * 64 + fr, fq * 8), boff = lds_byte(wc * 32 + fr, fq * 8);
#define PG8_SA(b, h) (((b) * 2 + (h)) * HTB)
#define PG8_SB(b, h) ((4 + (b) * 2 + (h)) * HTB)
#define PG8_STAGE(bufoff, gbase, voff) do { _Pragma("unroll") for (int _i = 0; _i < 2; ++_i) \
        __builtin_amdgcn_global_load_lds((const unsigned*)((const char*)(gbase) + (voff)[_i]), (LAS unsigned*)(lds + (bufoff) + ldsw + _i * 8192), 16, 0, 0); } while (0)
#define PG8_LDA(dst, b, h) do { _Pragma("unroll") for (int m = 0; m < 4; ++m) _Pragma("unroll") for (int k = 0; k < 2; ++k) dst[m][k] = *(const LAS bf16x8*)(lds + PG8_SA(b, h) + aoff + m * 2048 + k * 1024); } while (0)
#define PG8_LDB(dst, b, h) do { _Pragma("unroll") for (int n = 0; n < 2; ++n) _Pragma("unroll") for (int k = 0; k < 2; ++k) dst[n][k] = *(const LAS bf16x8*)(lds + PG8_SB(b, h) + boff + n * 2048 + k * 1024); } while (0)
#define PG8_MMA(ai, bj, At, Bt) do { __builtin_amdgcn_s_setprio(1); _Pragma("unroll") for (int m = 0; m < 4; ++m) _Pragma("unroll") for (int n = 0; n < 2; ++n) _Pragma("unroll") for (int k = 0; k < 2; ++k) \
        acc[ai][bj][m][n] = __builtin_amdgcn_mfma_f32_16x16x32_bf16(Bt[n][k], At[m][k], acc[ai][bj][m][n], 0, 0, 0); __builtin_amdgcn_s_setprio(0); } while (0)
#define PG8_WAIT_V(n) asm volatile("s_waitcnt vmcnt(" #n ")" ::: "memory")
#define PG8_WAIT_L(n) asm volatile("s_waitcnt lgkmcnt(" #n ")" ::: "memory")
#define PG8_BAR __builtin_amdgcn_s_barrier()
#define PG8_SCHED __builtin_amdgcn_sched_barrier(0)
    Unit cur, nxt; int ui = 0;
    if (!S.next(0, cur)) return;
    f32x4 acc[2][2][4][2];
#pragma unroll
    for (int a = 0; a < 2; ++a)
#pragma unroll
        for (int b = 0; b < 2; ++b)
#pragma unroll
            for (int m = 0; m < 4; ++m)
#pragma unroll
                for (int n = 0; n < 2; ++n) acc[a][b][m][n] = (f32x4){0.f, 0.f, 0.f, 0.f};
    bf16x8 At[4][2], B0[2][2], B1[2][2];
    const char* cA = (const char*)g.A + (size_t)cur.pm * tstepA + (size_t)cur.pn * pnA; const char* cB = (const char*)g.Bt + (size_t)cur.pn * tstepB;
    PG8_STAGE(PG8_SB(0, 0), cB, voffB); PG8_STAGE(PG8_SB(0, 1), cB + hstepB, voffB); PG8_STAGE(PG8_SA(0, 0), cA, voffA); PG8_STAGE(PG8_SA(0, 1), cA + hstepA, voffA);
    if (wr == 1) PG8_BAR;
    PG8_WAIT_V(2); PG8_BAR;
    PG8_STAGE(PG8_SB(1, 0), cB + kstep, voffB); PG8_STAGE(PG8_SA(1, 0), cA + kstep, voffA); PG8_STAGE(PG8_SB(1, 1), cB + hstepB + kstep, voffB);
    PG8_WAIT_V(6); PG8_BAR;
    for (;;) {
        const bool has_next = S.next(ui + 1, nxt);
        const char* nA = has_next ? (const char*)g.A + (size_t)nxt.pm * tstepA + (size_t)nxt.pn * pnA : cA; const char* nB = has_next ? (const char*)g.Bt + (size_t)nxt.pn * tstepB : cB;
        for (int t = 0; t < nt; t += 2) {
            const bool last = (t == nt - 2);
            const char* a1 = cA + (size_t)(t + 1) * kstep;
            const char* a2 = last ? nA : cA + (size_t)(t + 2) * kstep; const char* b2 = last ? nB : cB + (size_t)(t + 2) * kstep;
            const char* a3 = a2 + kstep; const char* b3 = b2 + kstep;
            PG8_LDB(B0, 0, 0); PG8_LDB(B1, 0, 1); PG8_SCHED; PG8_LDA(At, 0, 0); PG8_STAGE(PG8_SA(1, 1), a1 + hstepA, voffA);
            PG8_WAIT_V(8); PG8_WAIT_L(0); PG8_BAR; PG8_MMA(0, 0, At, B0); PG8_MMA(0, 1, At, B1); PG8_BAR; PG8_SCHED;
            PG8_LDA(At, 0, 1); PG8_STAGE(PG8_SB(0, 0), b2, voffB); PG8_STAGE(PG8_SB(0, 1), b2 + hstepB, voffB); PG8_STAGE(PG8_SA(0, 0), a2, voffA);
            PG8_WAIT_V(8); PG8_WAIT_L(0); PG8_BAR; PG8_MMA(1, 0, At, B0); PG8_MMA(1, 1, At, B1); PG8_BAR; PG8_SCHED;
            PG8_LDB(B0, 1, 0); PG8_LDB(B1, 1, 1); PG8_SCHED; PG8_LDA(At, 1, 0); PG8_STAGE(PG8_SA(0, 1), a2 + hstepA, voffA);
            PG8_WAIT_V(8); PG8_WAIT_L(0); PG8_BAR; PG8_MMA(0, 0, At, B0); PG8_MMA(0, 1, At, B1); PG8_BAR; PG8_SCHED;
            PG8_LDA(At, 1, 1); PG8_STAGE(PG8_SB(1, 0), b3, voffB); PG8_STAGE(PG8_SB(1, 1), b3 + hstepB, voffB); PG8_STAGE(PG8_SA(1, 0), a3, voffA);
            PG8_WAIT_V(8); PG8_WAIT_L(0); PG8_BAR; PG8_MMA(1, 0, At, B0); PG8_MMA(1, 1, At, B1); PG8_BAR; PG8_SCHED;
        }
        if (wr == 0) PG8_BAR;
        { const int le = opq(lane); E(acc, cur, wr, wc, le & 15, le >> 4); }
        if (!has_next) break;
#pragma unroll
        for (int a = 0; a < 2; ++a)
#pragma unroll
            for (int b = 0; b < 2; ++b)
#pragma unroll
                for (int m = 0; m < 4; ++m)
#pragma unroll
                    for (int n = 0; n < 2; ++n) acc[a][b][m][n] = (f32x4){0.f, 0.f, 0.f, 0.f};
        cur = nxt; cA = nA; cB = nB; ++ui;
        if (wr == 1) PG8_BAR;
    }
    PG8_WAIT_V(0);
    PG8_BAR;
#undef PG8_SA
#undef PG8_SB
#undef PG8_STAGE
#undef PG8_LDA
#undef PG8_LDB
#undef PG8_MMA
#undef PG8_WAIT_V
#undef PG8_WAIT_L
#undef PG8_BAR
#undef PG8_SCHED
}
}

struct EpiBf16 {
    bf16_t* O; int ldc;
    __device__ __forceinline__ void operator()(const f32x4 (&acc)[2][2][4][2], const pg8::Unit& u, int wr, int wc, int fr, int fq) const {
        const int row0 = u.pm * 256 + wr * 64 + fr, col0 = u.pn * 256 + wc * 32 + 8 * fq;
#pragma unroll
        for (int ai = 0; ai < 2; ++ai)
#pragma unroll
            for (int m = 0; m < 4; ++m) { bf16_t* rowp = O + (size_t)(row0 + ai * 128 + m * 16) * ldc + col0;
#pragma unroll
                for (int bj = 0; bj < 2; ++bj) { const f32x4 v0 = acc[ai][bj][m][0], v1 = acc[ai][bj][m][1];
                    u32x4 w; w.x = pk2(v0[0], v0[1]); w.y = pk2(v0[2], v0[3]); w.z = pk2(v1[0], v1[1]); w.w = pk2(v1[2], v1[3]);
                    *(u32x4*)(rowp + bj * 128) = w; } }
    }
};
struct EpiIn {
    bf16_t* H; float* LF; const float* lbv; float* kP; float* vP; float* kS; float* vS;
    __device__ __forceinline__ void operator()(const f32x4 (&acc)[2][2][4][2], const pg8::Unit& u, int wr, int wc, int fr, int fq) const {
        const int row0 = u.pm * 256 + wr * 64 + fr, col0 = u.pn * 256 + wc * 32 + 8 * fq;
        const int kind = u.pn >> 1;
        if (kind == 1) {
#pragma unroll
            for (int bj = 0; bj < 2; ++bj) { const int c = col0 + bj * 128 - C_AF;
                const f32x4 l0 = *(const f32x4*)(lbv + c), l1 = *(const f32x4*)(lbv + c + 4);
#pragma unroll
                for (int ai = 0; ai < 2; ++ai)
#pragma unroll
                    for (int m = 0; m < 4; ++m) { const int row = row0 + ai * 128 + m * 16;
                        f32x4 o0, o1;
#pragma unroll
                        for (int e = 0; e < 4; ++e) {
                            { const float z = acc[ai][bj][m][0][e], ez = __expf(-fabsf(z)), sg = (z >= 0.f ? 1.f : ez) / (1.f + ez), f = l0[e] + (1.f - l0[e]) * sg; o0[e] = fmaxf(__logf(f), -60.f); }
                            { const float z = acc[ai][bj][m][1][e], ez = __expf(-fabsf(z)), sg = (z >= 0.f ? 1.f : ez) / (1.f + ez), f = l1[e] + (1.f - l1[e]) * sg; o1[e] = fmaxf(__logf(f), -60.f); }
                        }
                        float* dst = LF + (size_t)row * 512 + c; *(f32x4*)dst = o0; *(f32x4*)(dst + 4) = o1; } }
            return;
        }
#pragma unroll
        for (int ai = 0; ai < 2; ++ai)
#pragma unroll
            for (int m = 0; m < 4; ++m) { const int row = row0 + ai * 128 + m * 16; bf16_t* rowp = H + (size_t)row * INC + col0;
#pragma unroll
                for (int bj = 0; bj < 2; ++bj) { const f32x4 v0 = acc[ai][bj][m][0], v1 = acc[ai][bj][m][1];
                    u32x4 w; w.x = pk2(v0[0], v0[1]); w.y = pk2(v0[2], v0[3]); w.z = pk2(v1[0], v1[1]); w.w = pk2(v1[2], v1[3]);
                    *(u32x4*)(rowp + bj * 128) = w;
                    if (kind >= 5) { const int c = col0 + bj * 128 - (kind == 5 ? C_BK : C_BV);
                        float* dst = (row < MP) ? ((kind == 5 ? kP : vP) + (size_t)row * 512 + c) : ((kind == 5 ? kS : vS) + (size_t)(row - MP) * 512 + c);
                        *(f32x4*)dst = v0; *(f32x4*)(dst + 4) = v1; } } }
    }
};
struct EpiRes {
    const bf16_t* X; float* Z; const float* scale;
    __device__ __forceinline__ void operator()(const f32x4 (&acc)[2][2][4][2], const pg8::Unit& u, int wr, int wc, int fr, int fq) const {
        const int row0 = u.pm * 256 + wr * 64 + fr, col0 = u.pn * 256 + wc * 32 + 8 * fq;
#pragma unroll
        for (int bj = 0; bj < 2; ++bj) { const int c = col0 + bj * 128;
            f32x4 s0 = {1.f, 1.f, 1.f, 1.f}, s1 = {1.f, 1.f, 1.f, 1.f};
            if (scale) { s0 = *(const f32x4*)(scale + c); s1 = *(const f32x4*)(scale + c + 4); }
#pragma unroll
            for (int ai = 0; ai < 2; ++ai)
#pragma unroll
                for (int m = 0; m < 4; ++m) { const size_t off = (size_t)(row0 + ai * 128 + m * 16) * D + c;
                    const u32x4 xw = *(const u32x4*)(X + off); float xv[8]; unpk8(xw, xv);
                    f32x4 o0, o1;
#pragma unroll
                    for (int e = 0; e < 4; ++e) { o0[e] = DN_ALPHA * xv[e] + acc[ai][bj][m][0][e] * s0[e]; o1[e] = DN_ALPHA * xv[4 + e] + acc[ai][bj][m][1][e] * s1[e]; }
                    *(f32x4*)(Z + off) = o0; *(f32x4*)(Z + off + 4) = o1; } }
    }
};

#define XB_TMO      128
#define XB_XCNT(j)  (256  + 64 * (j))
#define XB_XSUB(j)  (1280 + 64 * (j))
#define XB_XGEN(j)  (2304 + 64 * (j))
#define XB_TOP      3328
#define XB_TOPGEN   3392
#define XCD_BAR_WORDS 3456
#define XB_SPIN_CAP (1u << 22)
__device__ __forceinline__ unsigned xb_ld(unsigned* p)              { return __hip_atomic_load(p, __ATOMIC_RELAXED, __HIP_MEMORY_SCOPE_AGENT); }
__device__ __forceinline__ unsigned xb_add(unsigned* p, unsigned v) { return __hip_atomic_fetch_add(p, v, __ATOMIC_RELAXED, __HIP_MEMORY_SCOPE_AGENT); }
__device__ __forceinline__ unsigned xb_xcc_id() { return (unsigned)__builtin_amdgcn_s_getreg((3 << 11) | 20) & 0xFu; }
#define XB_SPIN(cond, bar) do { unsigned _sp = 0; while (cond) { __builtin_amdgcn_s_sleep(1); \
    if ((++_sp & 255u) == 0u) { if (xb_ld(&(bar)[XB_TMO])) break; if (_sp > XB_SPIN_CAP) { atomicAdd(&(bar)[XB_TMO], 1u); break; } } } } while (0)
struct XcdBarrier { unsigned* bar; unsigned x; volatile LAS unsigned* st; };
__device__ __forceinline__ XcdBarrier xcd_barrier_post(unsigned* bar, volatile LAS unsigned* st) {
    XcdBarrier b; b.bar = bar; b.x = xb_xcc_id(); b.st = st;
    if (threadIdx.x == 0) (void)xb_add(&bar[XB_XCNT(b.x)], 1u);
    return b;
}
__device__ __forceinline__ void xcd_barrier_complete(unsigned* bar, unsigned x, unsigned& nloc, unsigned& nx) {
    const unsigned G = gridDim.x * gridDim.y * gridDim.z;
    unsigned sum, cnt, mine, sp = 0u;
    for (;;) {
        sum = 0u; cnt = 0u; mine = 0u;
#pragma unroll
        for (unsigned j = 0; j < 16; ++j) { const unsigned c = xb_ld(&bar[XB_XCNT(j)]); sum += c; cnt += (c > 0u) ? 1u : 0u; mine = (j == x) ? c : mine; }
        if (sum == G) break;
        __builtin_amdgcn_s_sleep(1);
        if ((++sp & 255u) == 0u) { if (xb_ld(&bar[XB_TMO])) break; if (sp > XB_SPIN_CAP) { atomicAdd(&bar[XB_TMO], 1u); break; } }
    }
    nloc = mine > 0u ? mine : 1u; nx = cnt > 0u ? cnt : 1u;
}
__device__ __forceinline__ void xcd_barrier(const XcdBarrier& b) {
    asm volatile("s_waitcnt vmcnt(0)" ::: "memory");
    __syncthreads();
    if (threadIdx.x == 0) {
        unsigned* bar = b.bar;
        __builtin_amdgcn_s_waitcnt(0);
        unsigned nloc = b.st[0], nx = b.st[1];
        if (nloc == 0u) { xcd_barrier_complete(bar, b.x, nloc, nx); b.st[0] = nloc; b.st[1] = nx; }
        const unsigned old = xb_add(&bar[XB_XSUB(b.x)], 1u);
        const unsigned gen = old / nloc;
        if (old + 1u == (gen + 1u) * nloc) {
            __builtin_amdgcn_fence(__ATOMIC_RELEASE, "agent");
            asm volatile("s_waitcnt vmcnt(0)" ::: "memory");
            const unsigned og = xb_add(&bar[XB_TOP], 1u);
            const unsigned tg = og / nx;
            if (og + 1u == (tg + 1u) * nx) xb_add(&bar[XB_TOPGEN], 1u);
            else XB_SPIN(xb_ld(&bar[XB_TOPGEN]) == tg, bar);
            __builtin_amdgcn_fence(__ATOMIC_ACQUIRE, "agent");
            xb_add(&bar[XB_XGEN(b.x)], 1u);
            asm volatile("s_waitcnt vmcnt(0)" ::: "memory");
        } else {
            XB_SPIN(xb_ld(&bar[XB_XGEN(b.x)]) == gen, bar);
            __builtin_amdgcn_fence(__ATOMIC_ACQUIRE, "agent");
            asm volatile("s_waitcnt vmcnt(0)" ::: "memory");
        }
    }
    __syncthreads();
}

struct Args { const float* in[24]; float* out; unsigned char* ws; int ph_lo, ph_hi, single, pad; };
typedef const float* cfp_t;
typedef const __attribute__((address_space(4))) cfp_t* kin_t;
struct Frame {
    LAS unsigned char* lds;
    int tid, lane, wave, bid, G;
    kin_t in;
    float* out; unsigned char* ws;
};
enum { I_XP = 0, I_XS, I_CK, I_CV, I_SH, I_SP, I_SC, I_WIN, I_WOUT, I_LBL, I_HNG, I_DLAM, I_DNG, I_RB, I_PW, I_PSC, I_WUP, I_CW, I_CB, I_WDN, I_L1G, I_L1B, I_L2G, I_L2B };

__device__ __forceinline__ void p0_transpose_item(const float* W, int K, int N, bf16_t* WT, int dst_row0, LAS float* scr, int k0, int n0, int lane) {
#pragma unroll 8
    for (int i = 0; i < 32; ++i) { const int kk = 2 * i + (lane >> 5); scr[kk * 33 + (lane & 31)] = W[(size_t)(k0 + kk) * N + n0 + (lane & 31)]; }
    asm volatile("s_waitcnt lgkmcnt(0)" ::: "memory");
    const int c = lane & 7;
#pragma unroll
    for (int j = 0; j < 4; ++j) { const int n = (lane >> 3) + 8 * j; const LAS float* s = scr + (8 * c) * 33 + n;
        u32x4 o; o.x = pk2(s[0 * 33], s[1 * 33]); o.y = pk2(s[2 * 33], s[3 * 33]); o.z = pk2(s[4 * 33], s[5 * 33]); o.w = pk2(s[6 * 33], s[7 * 33]);
        *(u32x4*)(WT + (size_t)(dst_row0 + n) * K + k0 + 8 * c) = o; }
    asm volatile("s_waitcnt lgkmcnt(0)" ::: "memory");
}
__device__ __forceinline__ void phase_prologue(Frame& F) {
    LAS float* scr = (LAS float*)(F.lds + F.wave * 16384);
    const int gw = F.bid * NWAVES + F.wave, NGW = F.G * NWAVES;
    constexpr int I_IN = (D / 64) * (INC / 32), I_OUT = (D / 64) * (D / 32), I_POOL = 4 * 8, I_UP = (D / 64) * (UPN / 32), I_DN = (DFF / 64) * (D / 32);
    constexpr int NITEMS = 2 * I_IN + 2 * I_OUT + 8 * I_POOL + 4 * I_UP + 4 * I_DN;
    for (int it = gw; it < NITEMS; it += NGW) {
        int r = it;
        if (r < 2 * I_IN) { const int m = r / I_IN; r %= I_IN; const int kb = r / (INC / 32), nb = r % (INC / 32);
            p0_transpose_item(F.in[I_WIN] + (size_t)m * D * INC, D, INC, (bf16_t*)(F.ws + WS_WIN) + (size_t)m * INC * D, 32 * nb, scr, 64 * kb, 32 * nb, F.lane); continue; } r -= 2 * I_IN;
        if (r < 2 * I_OUT) { const int m = r / I_OUT; r %= I_OUT; const int kb = r / (D / 32), nb = r % (D / 32);
            p0_transpose_item(F.in[I_WOUT] + (size_t)m * D * D, D, D, (bf16_t*)(F.ws + WS_WOUT) + (size_t)m * D * D, 32 * nb, scr, 64 * kb, 32 * nb, F.lane); continue; } r -= 2 * I_OUT;
        if (r < 8 * I_POOL) { const int pg = r / I_POOL; r %= I_POOL; const int kb = r / 8, nb = r % 8;
            p0_transpose_item(F.in[I_PW] + (size_t)pg * 256 * 256, 256, 256, (bf16_t*)(F.ws + WS_WPOOL) + (size_t)pg * 256 * 256, 32 * nb, scr, 64 * kb, 32 * nb, F.lane); continue; } r -= 8 * I_POOL;
        if (r < 4 * I_UP) { const int l = r / I_UP; r %= I_UP; const int kb = r / (UPN / 32), nb = r % (UPN / 32); const int n0 = 32 * nb;
            const int dst = (n0 < DFF) ? (256 * (n0 / 128) + (n0 % 128)) : (256 * ((n0 - DFF) / 128) + 128 + ((n0 - DFF) % 128));
            p0_transpose_item(F.in[I_WUP] + (size_t)l * D * UPN, D, UPN, (bf16_t*)(F.ws + WS_WUP) + (size_t)l * UPN * D, dst, scr, 64 * kb, n0, F.lane); continue; } r -= 4 * I_UP;
        { const int l = r / I_DN; r %= I_DN; const int kb = r / (D / 32), nb = r % (D / 32);
            p0_transpose_item(F.in[I_WDN] + (size_t)l * DFF * D, DFF, D, (bf16_t*)(F.ws + WS_WDN) + (size_t)l * D * DFF, 32 * nb, scr, 64 * kb, 32 * nb, F.lane); }
    }
    bf16_t* XB = (bf16_t*)(F.ws + WS_XB);
    for (int m = gw; m < MT; m += NGW) {
        const float* src = (m < MP) ? F.in[I_XP] + (size_t)m * D : F.in[I_XS] + (size_t)(m - MP) * D;
#pragma unroll
        for (int j = 0; j < 4; ++j) { const f32x4 v = *(const f32x4*)(src + 4 * F.lane + 256 * j);
            u32x2 w; w.x = pk2(v[0], v[1]); w.y = pk2(v[2], v[3]); *(u32x2*)(XB + (size_t)m * D + 4 * F.lane + 256 * j) = w; }
    }
    if (F.bid == 0) {
        float* tab = (float*)(F.ws + WS_TAB);
        { const int c = F.tid; const float a = F.in[I_LBL][c], b = F.in[I_LBL][512 + c], mx = fmaxf(a, b), ea = __expf(a - mx), eb = __expf(b - mx);
          tab[TB_LB + c] = 0.f; tab[TB_LB + 512 + c] = eb / (ea + eb); }
        if (F.wave < 2) { const int m = F.wave; const float* lp = F.in[I_DLAM] + (size_t)m * 4 * 64;
            const float s01 = wave_sum(lp[F.lane] * lp[64 + F.lane]), s23 = wave_sum(lp[128 + F.lane] * lp[192 + F.lane]);
            const float lam_init = (m == 0) ? 0.2f : 0.47071302f;
            if (F.lane == 0) tab[TB_LAM + m] = __expf(s01) - __expf(s23) + lam_init; }
    }
}

__device__ __forceinline__ void phase_ln(Frame& F, const float* g, const float* b, bool final_out) {
    const float* Z = (const float*)(F.ws + WS_Z); bf16_t* XB = (bf16_t*)(F.ws + WS_XB);
    const int gw = F.bid * NWAVES + F.wave, NGW = F.G * NWAVES;
    f32x4 gv[4], bv[4];
#pragma unroll
    for (int j = 0; j < 4; ++j) { gv[j] = *(const f32x4*)(g + 4 * F.lane + 256 * j); bv[j] = *(const f32x4*)(b + 4 * F.lane + 256 * j); }
    for (int m = gw; m < MT; m += NGW) {
        f32x4 v[4]; float s = 0.f;
#pragma unroll
        for (int j = 0; j < 4; ++j) { v[j] = *(const f32x4*)(Z + (size_t)m * D + 4 * F.lane + 256 * j); s += (v[j][0] + v[j][1]) + (v[j][2] + v[j][3]); }
        const float mean = wave_sum(s) * (1.f / D); float s2 = 0.f;
#pragma unroll
        for (int j = 0; j < 4; ++j) { v[j] = v[j] - mean; s2 += (v[j][0] * v[j][0] + v[j][1] * v[j][1]) + (v[j][2] * v[j][2] + v[j][3] * v[j][3]); }
        const float rstd = 1.f / sqrtf(wave_sum(s2) * (1.f / D) + LN_EPS);
        float* outp = final_out ? ((m < MP) ? F.out + O_YP + (size_t)m * D : F.out + O_YS + (size_t)(m - MP) * D) : nullptr;
#pragma unroll
        for (int j = 0; j < 4; ++j) { const f32x4 y = v[j] * rstd * gv[j] + bv[j];
            u32x2 w; w.x = pk2(y[0], y[1]); w.y = pk2(y[2], y[3]); *(u32x2*)(XB + (size_t)m * D + 4 * F.lane + 256 * j) = w;
            if (final_out) *(f32x4*)(outp + 4 * F.lane + 256 * j) = y; }
    }
}

__device__ __forceinline__ void phase_pool_prep(Frame& F, int p) {
    const bf16_t* XB = (const bf16_t*)(F.ws + WS_XB); bf16_t* PO = (bf16_t*)(F.ws + WS_MIX);
    const float* hist = F.in[I_SP] + (size_t)p * SB * 15 * D;
    const int gw = F.bid * NWAVES + F.wave, NGW = F.G * NWAVES;
    for (int m = gw; m < MT; m += NGW) {
        const bool smp = m >= MP; const int b = smp ? (m - MP) / ST : m / PT, t = smp ? (m - MP) % ST : m % PT;
#pragma unroll
        for (int j = 0; j < 4; ++j) { const int w = 2 << j, c = 4 * F.lane + 256 * j;
            float s[4] = {0.f, 0.f, 0.f, 0.f}; float x0[4] = {0.f, 0.f, 0.f, 0.f};
            for (int i = 0; i < w; ++i) { const int tt = t - i;
                if (tt >= 0) { const u32x2 q = *(const u32x2*)(XB + (size_t)(m - i) * D + c); const float a0 = bflo(q.x), a1 = bfhi(q.x), a2 = bflo(q.y), a3 = bfhi(q.y);
                    if (i == 0) { x0[0] = a0; x0[1] = a1; x0[2] = a2; x0[3] = a3; }
                    s[0] += a0; s[1] += a1; s[2] += a2; s[3] += a3; }
                else if (smp) { const f32x4 hv = *(const f32x4*)(hist + ((size_t)b * 15 + (15 + tt)) * D + c); s[0] += hv[0]; s[1] += hv[1]; s[2] += hv[2]; s[3] += hv[3]; } }
            const float inv = 1.f / (float)(smp ? w : (t + 1 < w ? t + 1 : w));
            u32x2 o; o.x = pk2(s[0] * inv - x0[0], s[1] * inv - x0[1]); o.y = pk2(s[2] * inv - x0[2], s[3] * inv - x0[3]);
            *(u32x2*)(PO + (size_t)m * D + c) = o;
            if (!smp && t >= PT - 15) *(f32x4*)(F.out + O_PP + (((size_t)p * PB + b) * 15 + (t - (PT - 15))) * D + c) = (f32x4){x0[0], x0[1], x0[2], x0[3]};
            if (smp && t >= 1) *(f32x4*)(F.out + O_PS + (((size_t)p * SB + b) * 15 + (t - 1)) * D + c) = (f32x4){x0[0], x0[1], x0[2], x0[3]};
        }
    }
}

__device__ __forceinline__ void phase_conv_gate(Frame& F, int l) {
    const bf16_t* AB = (const bf16_t*)(F.ws + WS_AB); bf16_t* Gb = (bf16_t*)(F.ws + WS_G);
    const float* cw = F.in[I_CW] + (size_t)l * 3 * DFF; const float* cb = F.in[I_CB] + (size_t)l * DFF;
    const float* hist = F.in[I_SC] + (size_t)l * SB * 2 * DFF;
    const int gw = F.bid * NWAVES + F.wave, NGW = F.G * NWAVES;
    for (int m = gw; m < MT; m += NGW) {
        const bool smp = m >= MP; const int b = smp ? (m - MP) / ST : m / PT, t = smp ? (m - MP) % ST : m % PT;
        for (int cg = F.lane; cg < DFF / 8; cg += 64) { const int ch = 8 * cg, col = 256 * (ch >> 7) + (ch & 127);
            float a0[8], a1[8], a2[8], bb[8];
            unpk8(*(const u32x4*)(AB + (size_t)m * UPN + col), a2); unpk8(*(const u32x4*)(AB + (size_t)m * UPN + col + 128), bb);
            if (t >= 1) unpk8(*(const u32x4*)(AB + (size_t)(m - 1) * UPN + col), a1);
            else if (smp) { const f32x4 h0 = *(const f32x4*)(hist + ((size_t)b * 2 + 1) * DFF + ch), h1 = *(const f32x4*)(hist + ((size_t)b * 2 + 1) * DFF + ch + 4);
#pragma unroll
                for (int e = 0; e < 4; ++e) { a1[e] = h0[e]; a1[4 + e] = h1[e]; } }
            else {
#pragma unroll
                for (int e = 0; e < 8; ++e) a1[e] = 0.f; }
            if (t >= 2) unpk8(*(const u32x4*)(AB + (size_t)(m - 2) * UPN + col), a0);
            else if (smp) { const int hj = t;
                const f32x4 h0 = *(const f32x4*)(hist + ((size_t)b * 2 + hj) * DFF + ch), h1 = *(const f32x4*)(hist + ((size_t)b * 2 + hj) * DFF + ch + 4);
#pragma unroll
                for (int e = 0; e < 4; ++e) { a0[e] = h0[e]; a0[4 + e] = h1[e]; } }
            else {
#pragma unroll
                for (int e = 0; e < 8; ++e) a0[e] = 0.f; }
            float o[8];
#pragma unroll
            for (int e = 0; e < 8; ++e) { const float c = cb[ch + e] + a0[e] * cw[ch + e] + a1[e] * cw[DFF + ch + e] + a2[e] * cw[2 * DFF + ch + e];
                o[e] = c / (1.f + __expf(-c)) * bb[e]; }
            *(u32x4*)(Gb + (size_t)m * DFF + ch) = pk8(o);
            if (!smp && t >= PT - 2) { float* dst = F.out + O_CP + (((size_t)l * PB + b) * 2 + (t - (PT - 2))) * DFF + ch;
                *(f32x4*)dst = (f32x4){a2[0], a2[1], a2[2], a2[3]}; *(f32x4*)(dst + 4) = (f32x4){a2[4], a2[5], a2[6], a2[7]}; }
            if (smp && t >= ST - 2) { float* dst = F.out + O_CS + (((size_t)l * SB + b) * 2 + (t - (ST - 2))) * DFF + ch;
                *(f32x4*)dst = (f32x4){a2[0], a2[1], a2[2], a2[3]}; *(f32x4*)(dst + 4) = (f32x4){a2[4], a2[5], a2[6], a2[7]}; }
        }
    }
}

constexpr int HG_LF = 0;
constexpr int HG_TOT = HG_LF + 16384;
constexpr int HG_G = HG_TOT + 2048;
constexpr int HG_QT = HG_G + 512;
constexpr int HG_KS = HG_QT + 32 * 272;
constexpr int HG_KT = HG_KS + 32 * 272;
constexpr int HG_V = HG_KT + 128 * 80;
constexpr int HG_PF = HG_V + 32 * 320;
constexpr int HG_OX = HG_PF + 2048;
constexpr int HG_END = HG_OX + 32768;
static_assert(HG_END <= LDS_TAB, "HGRN LDS");

template <bool SMP>
__device__ __forceinline__ void hgrn_unit(Frame& F, int m, int b, int h) {
    LAS unsigned char* L = F.lds;
    const bf16_t* H = (const bf16_t*)(F.ws + WS_H); const float* LFg = (const float*)(F.ws + WS_LF); bf16_t* MIX = (bf16_t*)(F.ws + WS_MIX);
    const float* gn = F.in[I_HNG] + (size_t)m * 512 + h * 128;
    const int tid = opq(F.tid), lane = tid & 63, wave = __builtin_amdgcn_readfirstlane(tid >> 6), r = lane & 31, hh = lane >> 5;
    const int nb = wave & 3, kh = wave >> 2;
    const size_t row0 = SMP ? (size_t)MP + (size_t)b * ST : (size_t)b * PT;
    const int nsteps = SMP ? 1 : PT / 32;
    f32x16 S[2];
    if (SMP) { const float* s0 = F.in[I_SH] + (((size_t)m * SB + b) * NH + h) * 128 * 128 + (size_t)(64 * kh + 4 * hh) * 128 + 32 * nb + r;
#pragma unroll
        for (int kbl = 0; kbl < 2; ++kbl)
#pragma unroll
            for (int i = 0; i < 16; ++i) S[kbl][i] = s0[(32 * kbl + (i & 3) + 8 * (i >> 2)) * 128];
    } else {
#pragma unroll
        for (int kbl = 0; kbl < 2; ++kbl)
#pragma unroll
            for (int i = 0; i < 16; ++i) S[kbl][i] = 0.f;
    }
    const int et = tid >> 4, ek = (tid & 15) * 8;
    for (int step = 0; step < nsteps; ++step) {
        const bool valid = !SMP || et < ST;
        const size_t row = row0 + (size_t)step * 32 + et;
        f32x4 lf0 = {0.f, 0.f, 0.f, 0.f}, lf1 = {0.f, 0.f, 0.f, 0.f}; u32x4 qw = {0u, 0u, 0u, 0u}, vw = {0u, 0u, 0u, 0u}, gw = {0u, 0u, 0u, 0u};
        if (valid) { lf0 = *(const f32x4*)(LFg + row * 512 + h * 128 + ek); lf1 = *(const f32x4*)(LFg + row * 512 + h * 128 + ek + 4);
            qw = *(const u32x4*)(H + row * INC + C_AQ + h * 128 + ek); vw = *(const u32x4*)(H + row * INC + C_AI + h * 128 + ek); gw = *(const u32x4*)(H + row * INC + C_AG + h * 128 + ek); }
        *(LAS f32x4*)(L + HG_LF + (et * 128 + ek) * 4) = lf0; *(LAS f32x4*)(L + HG_LF + (et * 128 + ek + 4) * 4) = lf1;
        __syncthreads();
        { const int k = tid & 127, tq = tid >> 7; LAS float* p = (LAS float*)(L + HG_LF) + (8 * tq) * 128 + k; float run = 0.f;
#pragma unroll
            for (int i = 0; i < 8; ++i) { run += p[i * 128]; p[i * 128] = run; }
            ((LAS float*)(L + HG_TOT))[tq * 128 + k] = run; }
        __syncthreads();
        { float bcum[8];
            { const f32x4 c0 = *(LAS f32x4*)(L + HG_LF + (et * 128 + ek) * 4), c1 = *(LAS f32x4*)(L + HG_LF + (et * 128 + ek + 4) * 4);
#pragma unroll
              for (int e = 0; e < 4; ++e) { bcum[e] = c0[e]; bcum[4 + e] = c1[e]; } }
            for (int gq = 0; gq < (et >> 3); ++gq) { const f32x4 c0 = *(LAS f32x4*)(L + HG_TOT + (gq * 128 + ek) * 4), c1 = *(LAS f32x4*)(L + HG_TOT + (gq * 128 + ek + 4) * 4);
#pragma unroll
                for (int e = 0; e < 4; ++e) { bcum[e] += c0[e]; bcum[4 + e] += c1[e]; } }
            float qv[8]; unpk8(qw, qv);
            float qt[8], kt[8];
#pragma unroll
            for (int e = 0; e < 8; ++e) { const float lfe = e < 4 ? lf0[e] : lf1[e - 4]; const float eb = __expf(bcum[e]);
                qt[e] = qv[e] * eb; kt[e] = (1.f - __expf(lfe)) * __expf(-bcum[e]);
                if (et == 31) ((LAS float*)(L + HG_G))[ek + e] = eb; }
            const u32x4 qp = pk8(qt), kp = pk8(kt);
            *(LAS u32x4*)(L + HG_QT + et * 272 + ek * 2) = qp;
            *(LAS u32x4*)(L + HG_KS + et * 272 + ek * 2) = kp;
            *(LAS u32x4*)(L + HG_V + et * 320 + ek * 2) = vw;
            const unsigned kk[4] = {kp.x, kp.y, kp.z, kp.w};
#pragma unroll
            for (int e = 0; e < 8; ++e) *(LAS bf16_t*)(L + HG_KT + (ek + e) * 80 + et * 2) = (bf16_t)((e & 1) ? (kk[e >> 1] >> 16) : (kk[e >> 1] & 0xffffu));
        }
        __syncthreads();
        if (wave == 0) {
            f32x16 pt;
#pragma unroll
            for (int i = 0; i < 16; ++i) pt[i] = 0.f;
#pragma unroll
            for (int st = 0; st < 8; ++st) { const bf16x8 a = *(const LAS bf16x8*)(L + HG_KS + r * 272 + (16 * st + 8 * hh) * 2), bq = *(const LAS bf16x8*)(L + HG_QT + r * 272 + (16 * st + 8 * hh) * 2);
                pt = MFMA32(a, bq, pt); }
#pragma unroll
            for (int i = 0; i < 16; ++i) if (crow(i, hh) > r) pt[i] = 0.f;
            *(LAS bf16x8*)(L + HG_PF + lane * 16) = pack_step(pt, 0); *(LAS bf16x8*)(L + HG_PF + 1024 + lane * 16) = pack_step(pt, 1);
        }
        f32x16 oacc;
#pragma unroll
        for (int i = 0; i < 16; ++i) oacc[i] = 0.f;
#pragma unroll
        for (int kbl = 0; kbl < 2; ++kbl)
#pragma unroll
            for (int s2 = 0; s2 < 2; ++s2) { const int k0 = 64 * kh + 32 * kbl + 16 * s2 + 4 * hh;
                const s16x4 lo = *(const LAS s16x4*)(L + HG_QT + r * 272 + k0 * 2), hi = *(const LAS s16x4*)(L + HG_QT + r * 272 + (k0 + 8) * 2);
                oacc = MFMA32(pack_step(S[kbl], s2), cat8(lo, hi), oacc); }
        __syncthreads();
        const int i16 = lane & 15, tq = i16 >> 2, tp = i16 & 3, gi = (lane >> 4) & 1;
        if (kh == 0) {
#pragma unroll
            for (int s2 = 0; s2 < 2; ++s2) { const int key0 = 16 * s2 + 4 * hh;
                const s16x4 lo = vtr(L + HG_V + (key0 + tq) * 320 + (32 * nb + 16 * gi + 4 * tp) * 2), hi = vtr(L + HG_V + (key0 + 8 + tq) * 320 + (32 * nb + 16 * gi + 4 * tp) * 2);
                const bf16x8 pf = *(const LAS bf16x8*)(L + HG_PF + s2 * 1024 + lane * 16);
                oacc = MFMA32(cat8(lo, hi), pf, oacc); }
        }
#pragma unroll
        for (int i = 0; i < 16; ++i) ((LAS float*)(L + HG_OX))[(kh * 128 + 32 * nb + crow(i, hh)) * 32 + r] = oacc[i];
#pragma unroll
        for (int kbl = 0; kbl < 2; ++kbl)
#pragma unroll
            for (int s2 = 0; s2 < 2; ++s2) { const int key0 = 16 * s2 + 8 * hh;
                const bf16x8 a = *(const LAS bf16x8*)(L + HG_KT + (64 * kh + 32 * kbl + r) * 80 + key0 * 2);
                const s16x4 lo = vtr(L + HG_V + (key0 + tq) * 320 + (32 * nb + 16 * gi + 4 * tp) * 2), hi = vtr(L + HG_V + (key0 + 4 + tq) * 320 + (32 * nb + 16 * gi + 4 * tp) * 2);
                S[kbl] = MFMA32(a, cat8(lo, hi), S[kbl]); }
#pragma unroll
        for (int kbl = 0; kbl < 2; ++kbl)
#pragma unroll
            for (int i = 0; i < 16; ++i) S[kbl][i] *= ((LAS float*)(L + HG_G))[64 * kh + 32 * kbl + crow(i, hh)];
        __syncthreads();
        { float o[8], ss = 0.f;
#pragma unroll
            for (int e = 0; e < 8; ++e) { o[e] = ((LAS float*)(L + HG_OX))[(ek + e) * 32 + et] + ((LAS float*)(L + HG_OX))[(128 + ek + e) * 32 + et]; ss += o[e] * o[e]; }
            ss += __shfl_xor(ss, 1); ss += __shfl_xor(ss, 2); ss += __shfl_xor(ss, 4); ss += __shfl_xor(ss, 8);
            const float rstd = 1.f / sqrtf(ss * (1.f / 128.f) + RMS_EPS);
            float gv[8]; unpk8(gw, gv);
            const f32x4 g0 = *(const f32x4*)(gn + ek), g1 = *(const f32x4*)(gn + ek + 4);
#pragma unroll
            for (int e = 0; e < 8; ++e) { const float y = o[e] * rstd * (e < 4 ? g0[e] : g1[e - 4]); o[e] = y * (gv[e] / (1.f + __expf(-gv[e]))); }
            if (valid) *(u32x4*)(MIX + row * D + h * 128 + ek) = pk8(o);
        }
    }
    { float* so = (SMP ? F.out + O_HS + (((size_t)m * SB + b) * NH + h) * 128 * 128 : F.out + O_HP + (((size_t)m * PB + b) * NH + h) * 128 * 128);
      const int l2 = opq(lane); float* sp = so + (size_t)(64 * kh + 4 * (l2 >> 5)) * 128 + 32 * nb + (l2 & 31);
#pragma unroll
      for (int kbl = 0; kbl < 2; ++kbl)
#pragma unroll
        for (int i = 0; i < 16; ++i) sp[(32 * kbl + (i & 3) + 8 * (i >> 2)) * 128] = S[kbl][i]; }
    __syncthreads();
}

constexpr int AT_KP = 272, AT_VP = 320;
constexpr int AT_KB = 64 * AT_KP, AT_VB = 64 * AT_VP;
constexpr int AT_TILE = AT_KB + AT_VB;
static_assert(4 * AT_TILE <= LDS_TAB && (8 * 66 * 64 + 64 * 64 + 8 * 64) * 4 <= LDS_TAB, "attention LDS");

__device__ __forceinline__ void attn_build_tab(Frame& F, int h) {
    if (F.tid < 256) { const int rel = F.tid - 128, n = rel < 0 ? -rel : rel;
        int bk = n;
        if (n >= 8) bk = 8 + (n >= 12) + (n >= 16) + (n >= 23) + (n >= 32) + (n >= 46) + (n >= 64) + (n >= 91);
        if (rel > 0) bk += 16;
        ((LAS float*)(F.lds + LDS_TAB))[F.tid] = F.in[I_RB][bk * NH + h] * LOG2E; }
}
struct AttnState { f32x16 o[4]; float m, l; };
template <bool MASK_END>
__device__ __forceinline__ void attn_tile(const LAS unsigned char* Kt, const LAS unsigned char* Vt, int vh, const bf16x8 (&qf)[4], AttnState& A, int kpos0, int qpos, int qpos_min, int kv_end,
                                          const LAS float* tab, int r, int hh, int lane) {
    f32x16 st[2];
#pragma unroll
    for (int kb = 0; kb < 2; ++kb) {
#pragma unroll
        for (int i = 0; i < 16; ++i) st[kb][i] = 0.f;
#pragma unroll
        for (int s = 0; s < 4; ++s) { const bf16x8 a = *(const LAS bf16x8*)(Kt + (32 * kb + r) * AT_KP + (vh * 64 + 16 * s + 8 * hh) * 2); st[kb] = MFMA32(a, qf[s], st[kb]); }
    }
    constexpr float C2 = 0.125f * LOG2E;
    const bool far = (kpos0 + 63) <= (qpos_min - 91);
    if (far) { const float bc = tab[0];
#pragma unroll
        for (int kb = 0; kb < 2; ++kb)
#pragma unroll
            for (int i = 0; i < 16; ++i) st[kb][i] = st[kb][i] * C2 + bc;
    } else {
#pragma unroll
        for (int kb = 0; kb < 2; ++kb)
#pragma unroll
            for (int i = 0; i < 16; ++i) { const int kpos = kpos0 + 32 * kb + crow(i, hh); int rel = kpos - qpos; rel = rel < -128 ? -128 : (rel > 127 ? 127 : rel);
                float x = st[kb][i] * C2 + tab[rel + 128];
                if (MASK_END) x = (kpos < kv_end) ? x : -1e30f;
                st[kb][i] = x; }
    }
    float mx = st[0][0];
#pragma unroll
    for (int kb = 0; kb < 2; ++kb)
#pragma unroll
        for (int i = 0; i < 16; ++i) mx = fmaxf(mx, st[kb][i]);
    mx = fmaxf(mx, __shfl_xor(mx, 32));
    const float mnew = fmaxf(A.m, mx), alpha = __builtin_amdgcn_exp2f(A.m - mnew);
    A.m = mnew;
    float ls = 0.f;
#pragma unroll
    for (int kb = 0; kb < 2; ++kb)
#pragma unroll
        for (int i = 0; i < 16; ++i) { const float p = __builtin_amdgcn_exp2f(st[kb][i] - mnew); st[kb][i] = p; ls += p; }
    A.l = A.l * alpha + ls;
#pragma unroll
    for (int mb = 0; mb < 4; ++mb)
#pragma unroll
        for (int i = 0; i < 16; ++i) A.o[mb][i] *= alpha;
    const int i16 = lane & 15, tq = i16 >> 2, tp = i16 & 3, gi = (lane >> 4) & 1;
#pragma unroll
    for (int kb = 0; kb < 2; ++kb)
#pragma unroll
        for (int s2 = 0; s2 < 2; ++s2) { const bf16x8 pf = pack_step(st[kb], s2); const int key0 = 32 * kb + 16 * s2 + 4 * hh;
#pragma unroll
            for (int mb = 0; mb < 4; ++mb) {
                const s16x4 lo = vtr(Vt + (key0 + tq) * AT_VP + (32 * mb + 16 * gi + 4 * tp) * 2), hi = vtr(Vt + (key0 + 8 + tq) * AT_VP + (32 * mb + 16 * gi + 4 * tp) * 2);
                A.o[mb] = MFMA32(cat8(lo, hi), pf, A.o[mb]); } }
}
__device__ __forceinline__ void attn_store(const f32x16 (&o)[4], const float* gnorm, float post, bf16_t* dst_row  , int hh, bool active) {
    float ss = 0.f;
#pragma unroll
    for (int mb = 0; mb < 4; ++mb)
#pragma unroll
        for (int i = 0; i < 16; ++i) ss += o[mb][i] * o[mb][i];
    ss += __shfl_xor(ss, 32);
    const float rstd = post / sqrtf(ss * (1.f / 128.f) + RMS_EPS);
    if (active) {
#pragma unroll
        for (int mb = 0; mb < 4; ++mb)
#pragma unroll
            for (int g4 = 0; g4 < 4; ++g4) { const int dv = 32 * mb + 8 * g4 + 4 * hh; const f32x4 gv = *(const f32x4*)(gnorm + dv);
                u32x2 w; w.x = pk2(o[mb][4 * g4] * rstd * gv[0], o[mb][4 * g4 + 1] * rstd * gv[1]); w.y = pk2(o[mb][4 * g4 + 2] * rstd * gv[2], o[mb][4 * g4 + 3] * rstd * gv[3]);
                *(u32x2*)(dst_row + dv) = w; }
    }
}

__device__ __forceinline__ void attn_prompt_unit(Frame& F, int m, int b, int h, int qb) {
    LAS unsigned char* L = F.lds; const LAS float* tab = (const LAS float*)(L + LDS_TAB);
    const bf16_t* H = (const bf16_t*)(F.ws + WS_H); bf16_t* MIX = (bf16_t*)(F.ws + WS_MIX);
    const int tid = opq(F.tid), lane = tid & 63, wave = __builtin_amdgcn_readfirstlane(tid >> 6), r = lane & 31, hh = lane >> 5, vh = wave >> 2, wq = wave & 3;
    const size_t rowb = (size_t)b * PT;
    const int q0w = qb * 128 + wq * 32, qc = q0w >> 6, nkt = 2 * qb + 2;
    attn_build_tab(F, h);
    bf16x8 qf[4];
#pragma unroll
    for (int s = 0; s < 4; ++s) qf[s] = *(const bf16x8*)(H + (rowb + q0w + r) * INC + C_BQ + h * 128 + vh * 64 + 16 * s + 8 * hh);
    AttnState A;
#pragma unroll
    for (int mb = 0; mb < 4; ++mb)
#pragma unroll
        for (int i = 0; i < 16; ++i) A.o[mb][i] = 0.f;
    A.m = -1e30f; A.l = 0.f;
    u32x4 kr[2], vr[2];
#define AT_LD(kt) do { _Pragma("unroll") for (int i_ = 0; i_ < 2; ++i_) { const int c_ = tid + 512 * i_, key_ = c_ >> 4, ch_ = c_ & 15; const bf16_t* src_ = H + (rowb + 64 * (kt) + key_) * INC + h * 128 + ch_ * 8; \
        kr[i_] = *(const u32x4*)(src_ + C_BK); vr[i_] = *(const u32x4*)(src_ + C_BV); } } while (0)
#define AT_ST(buf) do { _Pragma("unroll") for (int i_ = 0; i_ < 2; ++i_) { const int c_ = tid + 512 * i_, key_ = c_ >> 4, ch_ = c_ & 15; \
        *(LAS u32x4*)(L + (buf) * AT_TILE + key_ * AT_KP + ch_ * 16) = kr[i_]; *(LAS u32x4*)(L + (buf) * AT_TILE + AT_KB + key_ * AT_VP + ch_ * 16) = vr[i_]; } } while (0)
    AT_LD(0); AT_ST(0);
    if (nkt > 1) AT_LD(1);
    __syncthreads();
    for (int kt = 0; kt < nkt; ++kt) {
        if (kt <= qc) attn_tile<false>(L + (kt & 1) * AT_TILE, L + (kt & 1) * AT_TILE + AT_KB, vh, qf, A, 64 * kt, q0w + r, q0w, 0, tab, r, hh, lane);
        if (kt + 1 < nkt) AT_ST((kt + 1) & 1);
        if (kt + 2 < nkt) AT_LD(kt + 2);
        __syncthreads();
    }
#undef AT_LD
#undef AT_ST
    { const float lt = A.l + __shfl_xor(A.l, 32), inv = 1.f / lt;
#pragma unroll
        for (int mb = 0; mb < 4; ++mb)
#pragma unroll
            for (int i = 0; i < 16; ++i) A.o[mb][i] *= inv; }
    LAS float* X = (LAS float*)L;
    if (vh == 1) {
#pragma unroll
        for (int mb = 0; mb < 4; ++mb)
#pragma unroll
            for (int i = 0; i < 16; ++i) X[(wq * 64 + mb * 16 + i) * 64 + lane] = A.o[mb][i];
    }
    __syncthreads();
    if (vh == 0) {
        const float lam = ((const float*)(F.ws + WS_TAB))[TB_LAM + m];
#pragma unroll
        for (int mb = 0; mb < 4; ++mb)
#pragma unroll
            for (int i = 0; i < 16; ++i) A.o[mb][i] -= lam * X[(wq * 64 + mb * 16 + i) * 64 + lane];
        const float lam_init = (m == 0) ? 0.2f : 0.47071302f;
        attn_store(A.o, F.in[I_DNG] + (size_t)m * 128, 1.f - lam_init, MIX + (rowb + q0w + r) * D + 512 + h * 128, hh, true);
    }
    __syncthreads();
}

__device__ __forceinline__ void attn_sample_unit(Frame& F, int m, int b, int h) {
    LAS unsigned char* L = F.lds; const LAS float* tab = (const LAS float*)(L + LDS_TAB);
    const bf16_t* H = (const bf16_t*)(F.ws + WS_H); bf16_t* MIX = (bf16_t*)(F.ws + WS_MIX);
    const float* ck = F.in[I_CK] + (((size_t)m * SB + b) * PAST) * 512 + h * 128; const float* cv = F.in[I_CV] + (((size_t)m * SB + b) * PAST) * 512 + h * 128;
    const int tid = opq(F.tid), lane = tid & 63, wave = __builtin_amdgcn_readfirstlane(tid >> 6), r = lane & 31, hh = lane >> 5, vh = wave >> 2, ks = wave & 3;
    const size_t rows = (size_t)MP + (size_t)b * ST;
    attn_build_tab(F, h);
    bf16x8 qf[4];
#pragma unroll
    for (int s = 0; s < 4; ++s) qf[s] = *(const bf16x8*)(H + (rows + (r & 15)) * INC + C_BQ + h * 128 + vh * 64 + 16 * s + 8 * hh);
    AttnState A;
#pragma unroll
    for (int mb = 0; mb < 4; ++mb)
#pragma unroll
        for (int i = 0; i < 16; ++i) A.o[mb][i] = 0.f;
    A.m = -1e30f; A.l = 0.f;
    constexpr int NT = PAST / 64 + 1;
    for (int it = 0; it < (NT + 3) / 4; ++it) {
#pragma unroll 1
        for (int j = 0; j < 4; ++j) { const int T = 4 * it + j;
#pragma unroll
            for (int i = 0; i < 2; ++i) { const int c = tid + 512 * i, key = c >> 4, ch = c & 15;
                u32x4 kw = {0u, 0u, 0u, 0u}, vw = {0u, 0u, 0u, 0u};
                if (T < PAST / 64) { const float* pk = ck + (size_t)(64 * T + key) * 512 + ch * 8; const float* pv = cv + (size_t)(64 * T + key) * 512 + ch * 8;
                    const f32x4 k0 = *(const f32x4*)pk, k1 = *(const f32x4*)(pk + 4), v0 = *(const f32x4*)pv, v1 = *(const f32x4*)(pv + 4);
                    kw.x = pk2(k0[0], k0[1]); kw.y = pk2(k0[2], k0[3]); kw.z = pk2(k1[0], k1[1]); kw.w = pk2(k1[2], k1[3]);
                    vw.x = pk2(v0[0], v0[1]); vw.y = pk2(v0[2], v0[3]); vw.z = pk2(v1[0], v1[1]); vw.w = pk2(v1[2], v1[3]); }
                else if (T == PAST / 64 && key < ST) { const bf16_t* src = H + (rows + key) * INC + h * 128 + ch * 8; kw = *(const u32x4*)(src + C_BK); vw = *(const u32x4*)(src + C_BV); }
                *(LAS u32x4*)(L + j * AT_TILE + key * AT_KP + ch * 16) = kw; *(LAS u32x4*)(L + j * AT_TILE + AT_KB + key * AT_VP + ch * 16) = vw; } }
        __syncthreads();
        { const int T = 4 * it + ks;
            if (T < NT - 1) attn_tile<false>(L + ks * AT_TILE, L + ks * AT_TILE + AT_KB, vh, qf, A, 64 * T, PAST + (r & 15), PAST, 0, tab, r, hh, lane);
            else if (T == NT - 1) attn_tile<true>(L + ks * AT_TILE, L + ks * AT_TILE + AT_KB, vh, qf, A, 64 * T, PAST + (r & 15), PAST, PAST + ST, tab, r, hh, lane); }
        __syncthreads();
    }
    const float lt = A.l + __shfl_xor(A.l, 32);
    LAS float* X = (LAS float*)L;
#pragma unroll
    for (int mb = 0; mb < 4; ++mb)
#pragma unroll
        for (int i = 0; i < 16; ++i) X[(wave * 66 + mb * 16 + i) * 64 + lane] = A.o[mb][i];
    X[(wave * 66 + 64) * 64 + lane] = A.m; X[(wave * 66 + 65) * 64 + lane] = lt;
    LAS float* Y = X + 8 * 66 * 64;
    LAS float* SS = Y + 64 * 64;
    __syncthreads();
    {
        const float lam = ((const float*)(F.ws + WS_TAB))[TB_LAM + m];
        float coef[8];
#pragma unroll
        for (int v2 = 0; v2 < 2; ++v2) {
            float M = -1e30f;
#pragma unroll
            for (int k = 0; k < 4; ++k) M = fmaxf(M, X[((v2 * 4 + k) * 66 + 64) * 64 + lane]);
            float Ls = 0.f;
#pragma unroll
            for (int k = 0; k < 4; ++k) { coef[v2 * 4 + k] = __builtin_amdgcn_exp2f(X[((v2 * 4 + k) * 66 + 64) * 64 + lane] - M); Ls += coef[v2 * 4 + k] * X[((v2 * 4 + k) * 66 + 65) * 64 + lane]; }
            const float sc = (v2 == 0 ? 1.f : -lam) / Ls;
#pragma unroll
            for (int k = 0; k < 4; ++k) coef[v2 * 4 + k] *= sc;
        }
        float ss = 0.f;
#pragma unroll
        for (int i8 = 0; i8 < 8; ++i8) { const int row = 8 * wave + i8; float y = 0.f;
#pragma unroll
            for (int p = 0; p < 8; ++p) y += coef[p] * X[(p * 66 + row) * 64 + lane];
            Y[row * 64 + lane] = y; ss += y * y; }
        SS[wave * 64 + lane] = ss;
    }
    __syncthreads();
    if (wave == 0) {
        float ss = 0.f;
#pragma unroll
        for (int w = 0; w < 8; ++w) ss += SS[w * 64 + lane];
        ss += __shfl_xor(ss, 32);
        const float lam_init = (m == 0) ? 0.2f : 0.47071302f;
        const float rstd = (1.f - lam_init) / sqrtf(ss * (1.f / 128.f) + RMS_EPS);
        const float* gnorm = F.in[I_DNG] + (size_t)m * 128;
        bf16_t* dst_row = MIX + (rows + (r & 15)) * D + 512 + h * 128;
        if (r < ST) {
#pragma unroll
            for (int mb = 0; mb < 4; ++mb)
#pragma unroll
                for (int g4 = 0; g4 < 4; ++g4) { const int dv = 32 * mb + 8 * g4 + 4 * hh; const f32x4 gv = *(const f32x4*)(gnorm + dv); const LAS float* yp = Y + (mb * 16 + 4 * g4) * 64 + lane;
                    u32x2 w; w.x = pk2(yp[0] * rstd * gv[0], yp[64] * rstd * gv[1]); w.y = pk2(yp[128] * rstd * gv[2], yp[192] * rstd * gv[3]);
                    *(u32x2*)(dst_row + dv) = w; }
        }
    }
    __syncthreads();
}

__device__ __forceinline__ void phase_mixer(Frame& F, int m) {
    const int G = F.G, bid = F.bid;
    if (PHM & 0x1000) for (int u = bid; u < PB * NH; u += G) hgrn_unit<false>(F, m, u >> 2, u & 3);
    if (PHM & 0x2000) for (int u = (G >= 256 ? (bid >= 128 ? bid - 128 : bid + G - 128) : bid); u < SB * NH; u += G) attn_sample_unit(F, m, u >> 2, u & 3);
    if (PHM & 0x4000) {
        gu32* head = (gu32*)(F.ws + WS_CTL) + CW_QUEUE + 64 * m;
        volatile LAS int* slot = (volatile LAS int*)(F.lds + LDS_CTRL + 64);
        for (;;) {
            if (F.tid == 0) *slot = (int)__hip_atomic_fetch_add(head, 1u, __ATOMIC_RELAXED, __HIP_MEMORY_SCOPE_AGENT);
            __syncthreads();
            const int u = *slot;
            __syncthreads();
            if (u >= PB * NH * 16) break;
            const int qb = 15 - (u >> 7), bh = u & 127;
            attn_prompt_unit(F, m, bh >> 2, bh & 3, qb);
        }
    }
    if (PHM & 0x8000) for (int u = bid; u < SB * NH; u += G) hgrn_unit<true>(F, m, u >> 2, u & 3);
}

__global__ void __launch_bounds__(NTHREADS, 2) mega_fwd(Args args) {
    extern __shared__ __attribute__((aligned(16))) unsigned char lds_raw[];
    Frame F;
    F.lds = (LAS unsigned char*)lds_raw;
    F.tid = threadIdx.x; F.lane = F.tid & 63; F.wave = __builtin_amdgcn_readfirstlane(F.tid >> 6);
    const int wave_s = F.wave;
    F.bid = blockIdx.x; F.G = gridDim.x; F.in = (kin_t)__builtin_amdgcn_kernarg_segment_ptr(); F.out = (float*)F.in[24]; F.ws = (unsigned char*)F.in[25];
    if (F.tid < 128) ((LAS unsigned*)(F.lds + LDS_CTRL))[F.tid] = 0u;
    __syncthreads();
    unsigned* barw = (unsigned*)(F.ws + WS_CTL) + CW_BAR;
    XcdBarrier bar; bar.bar = barw; bar.x = 0; bar.st = nullptr;
    const bool single = args.single != 0;
    if (single) bar = xcd_barrier_post(barw, (volatile LAS unsigned*)(F.lds + LDS_CTRL + 32));
    const int lo = args.ph_lo, hi = args.ph_hi;
#define RUN(p) (lo <= (p) && (p) < hi)
#define SEAM() do { if (single) { XcdBarrier b2_ = bar; asm volatile("" : "+s"(b2_.bar)); xcd_barrier(b2_); } } while (0)
#define REFRESH() do { { int b_ = (int)blockIdx.x, g_ = (int)gridDim.x; asm volatile("" : "+s"(b_), "+s"(g_)); F.bid = b_; F.G = g_; } { kin_t kp_ = (kin_t)__builtin_amdgcn_kernarg_segment_ptr(); asm volatile("" : "+s"(kp_)); F.in = kp_; F.out = (float*)kp_[24]; F.ws = (unsigned char*)kp_[25]; } { int l_; asm volatile("v_mbcnt_lo_u32_b32 %0, -1, 0\n\tv_mbcnt_hi_u32_b32 %0, -1, %0" : "=v"(l_)); F.lane = l_; } F.wave = wave_s; F.tid = wave_s * 64 + F.lane; } while (0)
    int ph = 0;
    if ((PHM & 1) && RUN(ph)) { REFRESH(); phase_prologue(F); SEAM(); } ++ph;
    for (int l = 0; l < 4; ++l) {
        bf16_t* XB = (bf16_t*)(F.ws + WS_XB);
        if ((l & 1) == 0) {
            const int m = l >> 1;
            if ((PHM & 2) && RUN(ph)) {
                REFRESH();
                pg8::Gemm g{XB, (const bf16_t*)(F.ws + WS_WIN) + (size_t)m * INC * D, MT, INC, D, D, 0}; pg8::StaticOrder S; S.init(MT, INC, F.G, F.bid);
                EpiIn E{(bf16_t*)(F.ws + WS_H), (float*)(F.ws + WS_LF), (const float*)(F.ws + WS_TAB) + TB_LB + m * 512,
                        F.out + O_KP + (size_t)m * MP * 512, F.out + O_VP + (size_t)m * MP * 512, F.out + O_KS + (size_t)m * MS * 512, F.out + O_VS + (size_t)m * MS * 512};
                pg8::gemm_phase<EpiIn>(F.lds, g, S, E, F.tid); SEAM(); } ++ph;
            if ((PHM & 4) && RUN(ph)) { REFRESH(); phase_mixer(F, m); SEAM(); } ++ph;
            if ((PHM & 8) && RUN(ph)) {
                REFRESH();
                pg8::Gemm g{(const bf16_t*)(F.ws + WS_MIX), (const bf16_t*)(F.ws + WS_WOUT) + (size_t)m * D * D, MT, D, D, D, 0}; pg8::StaticOrder S; S.init(MT, D, F.G, F.bid);
                EpiRes E{XB, (float*)(F.ws + WS_Z), nullptr};
                pg8::gemm_phase<EpiRes>(F.lds, g, S, E, F.tid); SEAM(); } ++ph;
        } else {
            const int p = l >> 1;
            if ((PHM & 16) && RUN(ph)) { REFRESH(); phase_pool_prep(F, p); SEAM(); } ++ph;
            ++ph;
            if ((PHM & 32) && RUN(ph)) {
                REFRESH();
                pg8::Gemm g{(const bf16_t*)(F.ws + WS_MIX), (const bf16_t*)(F.ws + WS_WPOOL) + (size_t)p * D * 256, MT, D, 256, D, 256}; pg8::StaticOrder S; S.init(MT, D, F.G, F.bid);
                EpiRes E{XB, (float*)(F.ws + WS_Z), F.in[I_PSC] + (size_t)p * D};
                pg8::gemm_phase<EpiRes>(F.lds, g, S, E, F.tid); SEAM(); } ++ph;
        }
        if ((PHM & 64) && RUN(ph)) { REFRESH(); phase_ln(F, F.in[I_L1G] + (size_t)l * D, F.in[I_L1B] + (size_t)l * D, false); SEAM(); } ++ph;
        if ((PHM & 128) && RUN(ph)) {
            REFRESH();
            pg8::Gemm g{XB, (const bf16_t*)(F.ws + WS_WUP) + (size_t)l * UPN * D, MT, UPN, D, D, 0}; pg8::StaticOrder S; S.init(MT, UPN, F.G, F.bid);
            EpiBf16 E{(bf16_t*)(F.ws + WS_AB), UPN};
            pg8::gemm_phase<EpiBf16>(F.lds, g, S, E, F.tid); SEAM(); } ++ph;
        if ((PHM & 256) && RUN(ph)) { REFRESH(); phase_conv_gate(F, l); SEAM(); } ++ph;
        if ((PHM & 512) && RUN(ph)) {
            REFRESH();
            pg8::Gemm g{(const bf16_t*)(F.ws + WS_G), (const bf16_t*)(F.ws + WS_WDN) + (size_t)l * D * DFF, MT, D, DFF, DFF, 0}; pg8::StaticOrder S; S.init(MT, D, F.G, F.bid);
            EpiRes E{XB, (float*)(F.ws + WS_Z), nullptr};
            pg8::gemm_phase<EpiRes>(F.lds, g, S, E, F.tid); SEAM(); } ++ph;
        if ((PHM & 1024) && RUN(ph)) { REFRESH(); phase_ln(F, F.in[I_L2G] + (size_t)l * D, F.in[I_L2B] + (size_t)l * D, l == 3); if (l < 3) SEAM(); } ++ph;
    }
#undef RUN
#undef SEAM
}
constexpr int N_PHASES = 1 + 4 * 8;

extern "C" void kernel_launch(void* const* d_in, const int* in_sizes, int n_in, void* d_out, int out_size, void* d_ws, size_t ws_size, hipStream_t stream) {
    static int grid = 0;
    if (grid == 0) {
        if (n_in != 24 || (size_t)out_size != O_END || ws_size < WS_END) { fprintf(stderr, "kernel_launch: unexpected problem (n_in %d out %d ws %zu)\n", n_in, out_size, ws_size); grid = -1; return; }
        int dev = 0, cus = 0;
        if (hipGetDevice(&dev) != hipSuccess || hipDeviceGetAttribute(&cus, hipDeviceAttributeMultiprocessorCount, dev) != hipSuccess) { grid = -1; return; }
        if (hipFuncSetAttribute((const void*)mega_fwd, hipFuncAttributeMaxDynamicSharedMemorySize, LDS_BYTES) != hipSuccess) { fprintf(stderr, "kernel_launch: hipFuncSetAttribute failed\n"); grid = -1; return; }
        int per_cu = 0;
        if (hipOccupancyMaxActiveBlocksPerMultiprocessor(&per_cu, (const void*)mega_fwd, NTHREADS, LDS_BYTES) != hipSuccess || per_cu < 1) fprintf(stderr, "kernel_launch: occupancy query reports %d\n", per_cu);
        (void)hipGetLastError();
        grid = cus;
    }
    if (grid < 0) return;
    (void)hipMemsetAsync((char*)d_ws + WS_CTL, 0, CTL_ZERO_BYTES, stream);
    Args a{};
    for (int i = 0; i < 24; ++i) a.in[i] = (const float*)d_in[i];
    a.out = (float*)d_out; a.ws = (unsigned char*)d_ws; a.pad = 0;
#if MK_SINGLE
    a.ph_lo = 0; a.ph_hi = N_PHASES; a.single = 1;
    hipLaunchKernelGGL(mega_fwd, dim3(grid), dim3(NTHREADS), LDS_BYTES, stream, a);
#else
    for (int p = 0; p < N_PHASES; ++p) {
        const int k = (p - 1) % 8, l = (p - 1) / 8;
        if (p > 0 && (l & 1) == 1 && k == 1) continue;
        a.ph_lo = p; a.ph_hi = p + 1; a.single = 0;
        hipLaunchKernelGGL(mega_fwd, dim3(grid), dim3(NTHREADS), LDS_BYTES, stream, a);
    }
#endif
}
```

```cpp
#include <hip/hip_runtime.h>
#include <cstdio>
#include <cstdint>

#ifndef PHM
#define PHM 0xffff
#endif
#ifndef PROBE_MIXER
#define PROBE_MIXER 0
#endif
#ifndef EMU_BF16
#define EMU_BF16 0
#endif
#ifndef PROBE_LN
#define PROBE_LN 0
#endif
#ifndef PROBE_PRO
#define PROBE_PRO 0
#endif
#ifndef PROBE_HG
#define PROBE_HG 0
#endif
#ifndef PROBE_SA
#define PROBE_SA 0
#endif
#ifndef PROBE_UP
#define PROBE_UP 0
#endif
#ifndef MK_SINGLE
#define MK_SINGLE 1
#endif

#define LAS __attribute__((address_space(3)))
#define GAS __attribute__((address_space(1)))
typedef unsigned short bf16_t;
typedef short bf16x8 __attribute__((ext_vector_type(8)));
typedef short s16x4 __attribute__((ext_vector_type(4)));
typedef float f32x2 __attribute__((ext_vector_type(2)));
typedef float f32x4 __attribute__((ext_vector_type(4)));
typedef float f32x16 __attribute__((ext_vector_type(16)));
typedef unsigned u32x2 __attribute__((ext_vector_type(2)));
typedef unsigned u32x4 __attribute__((ext_vector_type(4)));
typedef __bf16 bf16x2_t __attribute__((ext_vector_type(2)));
typedef GAS unsigned gu32;

constexpr int D = 1024, PB = 32, PT = 2048, SB = 32, ST = 16, PAST = 4096;
constexpr int MP = PB * PT, MS = SB * ST, MT = MP + MS;
constexpr int INC = 3584, DFF = 2816, UPN = 2 * DFF, NH = 4;
constexpr int C_AQ = 0, C_AF = 512, C_AI = 1024, C_AG = 1536, C_BQ = 2048, C_BK = 2560, C_BV = 3072;
constexpr float DN_ALPHA = 1.681792830507429f;
constexpr float LN_EPS = 1e-5f, RMS_EPS = 1e-6f;
constexpr float LOG2E = 1.4426950408889634f;
constexpr int NWAVES = 8, NTHREADS = 512;

constexpr size_t O_YP = 0;
constexpr size_t O_YS = O_YP + (size_t)MP * D;
constexpr size_t O_KP = O_YS + (size_t)MS * D;
constexpr size_t O_VP = O_KP + (size_t)2 * MP * 512;
constexpr size_t O_HP = O_VP + (size_t)2 * MP * 512;
constexpr size_t O_PP = O_HP + (size_t)2 * PB * NH * 128 * 128;
constexpr size_t O_CP = O_PP + (size_t)2 * PB * 15 * D;
constexpr size_t O_KS = O_CP + (size_t)4 * PB * 2 * DFF;
constexpr size_t O_VS = O_KS + (size_t)2 * MS * 512;
constexpr size_t O_HS = O_VS + (size_t)2 * MS * 512;
constexpr size_t O_PS = O_HS + (size_t)2 * SB * NH * 128 * 128;
constexpr size_t O_CS = O_PS + (size_t)2 * SB * 15 * D;
constexpr size_t O_END = O_CS + (size_t)4 * SB * 2 * DFF;
static_assert(O_END == 214695936ull, "d_out size");

constexpr size_t WS_CTL = 0, CTL_ZERO_BYTES = 8u << 20;
constexpr size_t WS_WIN = CTL_ZERO_BYTES;
constexpr size_t WS_WOUT = WS_WIN + (size_t)2 * INC * D * 2;
constexpr size_t WS_WPOOL = WS_WOUT + (size_t)2 * D * D * 2;
constexpr size_t WS_WUP = WS_WPOOL + (size_t)2 * D * 256 * 2;
constexpr size_t WS_WDN = WS_WUP + (size_t)4 * UPN * D * 2;
constexpr size_t WS_TAB = WS_WDN + (size_t)4 * D * DFF * 2;
constexpr size_t WS_XB = WS_TAB + 65536;
constexpr size_t WS_Z = WS_XB + (size_t)MT * D * 2;
constexpr size_t WS_ZB = WS_Z + (size_t)MT * D * 2;
constexpr size_t WS_MIX = WS_Z + (size_t)MT * D * 4;
constexpr size_t WS_G = WS_MIX + (size_t)MT * D * 2;
constexpr size_t WS_A = WS_G + (size_t)MT * DFF * 2;
constexpr size_t WS_H = WS_A;
constexpr size_t WS_LF = WS_H + (size_t)MT * INC * 2;
constexpr size_t WS_AB = WS_A;
constexpr size_t WS_END = WS_A + (size_t)MT * UPN * 2;
static_assert(WS_LF + (size_t)MT * 512 * 4 <= WS_END, "H|LF inside region A");
constexpr size_t SIDE_BYTES = (size_t)(MT / 256) * 2 * DFF * 4;
constexpr size_t WS_AHEAD = WS_END, WS_BHEAD = WS_AHEAD + SIDE_BYTES, WS_ATAIL = WS_BHEAD + SIDE_BYTES, WS_END2 = WS_ATAIL + SIDE_BYTES;
static_assert(WS_END2 <= 2147483648ull, "workspace");
constexpr int CW_TMO = 0;
constexpr int CW_BAR = 4096;
constexpr int CW_QUEUE = 16384;
constexpr int CW_STATS = 262144;
constexpr int CW_UC = CW_STATS + 8 * MT * 2;
constexpr int UC_UUP = CW_UC, UC_CUP = UC_UUP + 4 * UPN, UC_UIN = UC_CUP + 4 * UPN, UC_CIN = UC_UIN + INC, UC_ZERO = UC_CIN + INC, UC_END = UC_ZERO + INC;
static_assert((size_t)UC_END * 4 <= CTL_ZERO_BYTES, "zeroed region");
constexpr int TB_LB = 0;
constexpr int TB_LAM = 1024;

constexpr int LDS_BYTES = 163840;
constexpr int LDS_CTRL = LDS_BYTES - 512;
constexpr int LDS_TAB = LDS_CTRL - 1024;
constexpr int LDS_STT = 131072 + 4096;
constexpr int LDS_CT = 131072 + 8192;
constexpr int LDS_EX = 131072;

__device__ __forceinline__ unsigned pk2(float lo, float hi) { f32x2 v = {lo, hi}; bf16x2_t b = __builtin_convertvector(v, bf16x2_t); return __builtin_bit_cast(unsigned, b); }
__device__ __forceinline__ float bflo(unsigned u) { return __builtin_bit_cast(float, u << 16); }
__device__ __forceinline__ float bfhi(unsigned u) { return __builtin_bit_cast(float, u & 0xffff0000u); }
__device__ __forceinline__ u32x4 pk8(const float* v) { u32x4 w; w.x = pk2(v[0], v[1]); w.y = pk2(v[2], v[3]); w.z = pk2(v[4], v[5]); w.w = pk2(v[6], v[7]); return w; }
__device__ __forceinline__ void unpk8(u32x4 w, float* v) { v[0] = bflo(w.x); v[1] = bfhi(w.x); v[2] = bflo(w.y); v[3] = bfhi(w.y); v[4] = bflo(w.z); v[5] = bfhi(w.z); v[6] = bflo(w.w); v[7] = bfhi(w.w); }
__device__ __forceinline__ float wave_sum(float v) {
#pragma unroll
    for (int o = 1; o < 64; o <<= 1) v += __shfl_xor(v, o);
    return v;
}
__device__ __forceinline__ int opq(int x) { asm volatile("" : "+v"(x)); return x; }
__device__ __forceinline__ int lane_id_v() { int l_; asm volatile("v_mbcnt_lo_u32_b32 %0, -1, 0\n\tv_mbcnt_hi_u32_b32 %0, -1, %0" : "=v"(l_)); return l_; }
__device__ __forceinline__ float silu_mul(float c, float b) { return c * __builtin_amdgcn_rcpf(1.f + __builtin_amdgcn_exp2f(-LOG2E * c)) * b; }
__device__ __forceinline__ int crow(int reg, int h) { return (reg & 3) + 8 * (reg >> 2) + 4 * h; }
__device__ __forceinline__ s16x4 vtr(const LAS unsigned char* p) { return __builtin_bit_cast(s16x4, __builtin_amdgcn_ds_read_tr16_b64_v4i16((LAS s16x4*)p)); }
__device__ __forceinline__ bf16x8 cat8(s16x4 lo, s16x4 hi) { return (bf16x8){lo[0], lo[1], lo[2], lo[3], hi[0], hi[1], hi[2], hi[3]}; }
#define MFMA32(a, b, c) __builtin_amdgcn_mfma_f32_32x32x16_bf16((a), (b), (c), 0, 0, 0)
__device__ __forceinline__ bf16x8 pack_step(const f32x16& x, int s) {
    u32x4 p; p.x = pk2(x[8 * s], x[8 * s + 1]); p.y = pk2(x[8 * s + 2], x[8 * s + 3]); p.z = pk2(x[8 * s + 4], x[8 * s + 5]); p.w = pk2(x[8 * s + 6], x[8 * s + 7]);
    return __builtin_bit_cast(bf16x8, p);
}

namespace pg8 {
constexpr int BM = 256, BK = 64, HALF = 128, HTB = HALF * BK * 2, STAGE_BYTES = 8 * HTB, NXCD = 8, WGM = 8;
__host__ __device__ __forceinline__ int lds_byte(int r, int c) { const int st = (r >> 4) * 2 + (c >> 5), rr = r & 15, cc = c & 31, ob = rr * 64 + cc * 2; return st * 1024 + (ob ^ (((ob >> 9) & 1) << 5)); }
__host__ __device__ __forceinline__ void stage_rc(int b, int& R, int& C) { const int st = b / 1024, sb = b % 1024, swz = sb ^ (((sb >> 9) & 1) << 5); R = (st >> 1) * 16 + swz / 64; C = (st & 1) * 32 + (swz % 64) / 2; }
__host__ __device__ __forceinline__ int perm32(int rho) { const int n = rho >> 4, i = rho & 15; return 8 * (i >> 2) + 4 * n + (i & 3); }
struct Unit { int pm, pn; };
struct Gemm { const bf16_t* A; const bf16_t* Bt; int M, N, K, lda, a_pn_step; const float* st; };
struct StaticOrder {
    int nM, nN, nwg, G, c;
    __device__ void init(int M, int N, int G_, int c_) { nM = M / BM; nN = N / BM; nwg = nM * nN; G = G_; c = c_; }
    __device__ bool next(int i, Unit& u) const {
        const long L = (long)i * G + c; if (L >= nwg) return false;
        int wgid = (int)L; { const int q = nwg / NXCD, r = nwg % NXCD, xcd = wgid % NXCD, off = wgid / NXCD; wgid = (xcd < r ? xcd * (q + 1) : r * (q + 1) + (xcd - r) * q) + off; }
        const int nig = WGM * nN, gid = wgid / nig, fm = gid * WGM, gsz = (nM - fm) < WGM ? (nM - fm) : WGM;
        u.pm = fm + ((wgid % nig) % gsz); u.pn = (wgid % nig) / gsz; return true;
    }
};
template <class Epi>
__device__ __forceinline__ void gemm_phase(LAS unsigned char* lds, const Gemm g, const StaticOrder& S, const Epi& E, int tid_in) {
    const int tid = tid_in, wid = __builtin_amdgcn_readfirstlane(tid >> 6), lane = tid & 63, wr = wid >> 2, wc = wid & 3, fr = lane & 15, fq = lane >> 4;
    const int K = g.K, nt = K / BK, lda = g.lda;
    unsigned voffA[2], voffB[2];
#define PG8_VOFF() do { const int t_ = wid * 64 + lane_id_v(); _Pragma("unroll") for (int i = 0; i < 2; ++i) { int R, C; stage_rc(t_ * 16 + i * 8192, R, C); const int Rb = (R & ~31) + perm32(R & 31); \
        voffA[i] = (unsigned)(R * lda + C) * 2u; voffB[i] = (unsigned)(Rb * K + C) * 2u; } } while (0)
    PG8_VOFF();
    const size_t kstep = (size_t)(BK * 2);
    const size_t hstepA = (size_t)HALF * lda * 2, hstepB = (size_t)HALF * K * 2;
    const size_t tstepA = 2 * hstepA, tstepB = 2 * hstepB;
    const size_t pnA = (size_t)g.a_pn_step * 2;
    const unsigned ldsw = (unsigned)wid * 1024u;
    const int aoff = lds_byte(wr * 64 + fr, fq * 8), boff = lds_byte(wc * 32 + fr, fq * 8);
#define PG8_SA(b, h) (((b) * 2 + (h)) * HTB)
#define PG8_SB(b, h) ((4 + (b) * 2 + (h)) * HTB)
#define PG8_STAGE(bufoff, gbase, voff) do { _Pragma("unroll") for (int _i = 0; _i < 2; ++_i) \
        __builtin_amdgcn_global_load_lds((const unsigned*)((const char*)(gbase) + (voff)[_i]), (LAS unsigned*)(lds + (bufoff) + ldsw + _i * 8192), 16, 0, 0); } while (0)
#define PG8_LDA(dst, b, h) do { _Pragma("unroll") for (int m = 0; m < 4; ++m) _Pragma("unroll") for (int k = 0; k < 2; ++k) dst[m][k] = *(const LAS bf16x8*)(lds + PG8_SA(b, h) + aoff + m * 2048 + k * 1024); } while (0)
#define PG8_LDB(dst, b, h) do { _Pragma("unroll") for (int n = 0; n < 2; ++n) _Pragma("unroll") for (int k = 0; k < 2; ++k) dst[n][k] = *(const LAS bf16x8*)(lds + PG8_SB(b, h) + boff + n * 2048 + k * 1024); } while (0)
#define PG8_MMA(ai, bj, At, Bt) do { __builtin_amdgcn_s_setprio(1); _Pragma("unroll") for (int m = 0; m < 4; ++m) _Pragma("unroll") for (int n = 0; n < 2; ++n) _Pragma("unroll") for (int k = 0; k < 2; ++k) \
        acc[ai][bj][m][n] = __builtin_amdgcn_mfma_f32_16x16x32_bf16(Bt[n][k], At[m][k], acc[ai][bj][m][n], 0, 0, 0); __builtin_amdgcn_s_setprio(0); } while (0)
#define PG8_WAIT_V(n) asm volatile("s_waitcnt vmcnt(" #n ")" ::: "memory")
#define PG8_WAIT_L(n) asm volatile("s_waitcnt lgkmcnt(" #n ")" ::: "memory")
#define PG8_BAR __builtin_amdgcn_s_barrier()
#define PG8_SCHED __builtin_amdgcn_sched_barrier(0)
    Unit cur, nxt; int ui = 0;
    if (!S.next(0, cur)) return;
#define PG8_STATS(pm_, par_) do { if (g.st) __builtin_amdgcn_global_load_lds((const unsigned*)(g.st + (size_t)(pm_) * 512 + 64 * wid + lane_id_v()), (LAS unsigned*)(lds + LDS_STT + (par_) * 2048 + wid * 256), 4, 0, 0); } while (0)
    PG8_STATS(cur.pm, 0); __builtin_amdgcn_sched_barrier(0); E.prefetch(cur, 0, wid, lds);
    f32x4 acc[2][2][4][2];
#pragma unroll
    for (int a = 0; a < 2; ++a)
#pragma unroll
        for (int b = 0; b < 2; ++b)
#pragma unroll
            for (int m = 0; m < 4; ++m)
#pragma unroll
                for (int n = 0; n < 2; ++n) acc[a][b][m][n] = (f32x4){0.f, 0.f, 0.f, 0.f};
    bf16x8 At[4][2], B0[2][2], B1[2][2];
    const char* cA = (const char*)g.A + (size_t)cur.pm * tstepA + (size_t)cur.pn * pnA; const char* cB = (const char*)g.Bt + (size_t)cur.pn * tstepB;
    PG8_STAGE(PG8_SB(0, 0), cB, voffB); PG8_STAGE(PG8_SB(0, 1), cB + hstepB, voffB); PG8_STAGE(PG8_SA(0, 0), cA, voffA); PG8_STAGE(PG8_SA(0, 1), cA + hstepA, voffA);
    if (wr == 1) PG8_BAR;
    PG8_WAIT_V(2); PG8_BAR;
    PG8_STAGE(PG8_SB(1, 0), cB + kstep, voffB); PG8_STAGE(PG8_SA(1, 0), cA + kstep, voffA); PG8_STAGE(PG8_SB(1, 1), cB + hstepB + kstep, voffB);
    PG8_WAIT_V(6); PG8_BAR;
    for (;;) {
        const bool has_next = S.next(ui + 1, nxt);
        const char* nA = has_next ? (const char*)g.A + (size_t)nxt.pm * tstepA + (size_t)nxt.pn * pnA : cA; const char* nB = has_next ? (const char*)g.Bt + (size_t)nxt.pn * tstepB : cB;
        for (int t = 0; t < nt; t += 2) {
            const bool last = (t == nt - 2);
            const char* a1 = cA + (size_t)(t + 1) * kstep;
            const char* a2 = last ? nA : cA + (size_t)(t + 2) * kstep; const char* b2 = last ? nB : cB + (size_t)(t + 2) * kstep;
            const char* a3 = a2 + kstep; const char* b3 = b2 + kstep;
            PG8_LDB(B0, 0, 0); PG8_LDB(B1, 0, 1); PG8_SCHED; PG8_LDA(At, 0, 0); PG8_STAGE(PG8_SA(1, 1), a1 + hstepA, voffA);
            PG8_WAIT_V(8); PG8_WAIT_L(0); PG8_BAR; PG8_MMA(0, 0, At, B0); PG8_MMA(0, 1, At, B1); PG8_BAR; PG8_SCHED;
            PG8_LDA(At, 0, 1); PG8_STAGE(PG8_SB(0, 0), b2, voffB); PG8_STAGE(PG8_SB(0, 1), b2 + hstepB, voffB); PG8_STAGE(PG8_SA(0, 0), a2, voffA);
            PG8_WAIT_V(8); PG8_WAIT_L(0); PG8_BAR; PG8_MMA(1, 0, At, B0); PG8_MMA(1, 1, At, B1); PG8_BAR; PG8_SCHED;
            PG8_LDB(B0, 1, 0); PG8_LDB(B1, 1, 1); PG8_SCHED; PG8_LDA(At, 1, 0); PG8_STAGE(PG8_SA(0, 1), a2 + hstepA, voffA);
            PG8_WAIT_V(8); PG8_WAIT_L(0); PG8_BAR; PG8_MMA(0, 0, At, B0); PG8_MMA(0, 1, At, B1); PG8_BAR; PG8_SCHED;
            PG8_LDA(At, 1, 1); PG8_STAGE(PG8_SB(1, 0), b3, voffB); PG8_STAGE(PG8_SB(1, 1), b3 + hstepB, voffB); PG8_STAGE(PG8_SA(1, 0), a3, voffA);
            PG8_WAIT_V(8); PG8_WAIT_L(0); PG8_BAR; PG8_MMA(1, 0, At, B0); PG8_MMA(1, 1, At, B1); PG8_BAR; PG8_SCHED;
        }
        if (wr == 0) PG8_BAR;
        { const int le = lane_id_v(); int wr_ = wr, wc_ = wc; asm volatile("" : "+s"(wr_), "+s"(wc_));
          E(acc, cur, wr_, wc_, le & 15, le >> 4, (const LAS float*)(lds + LDS_STT + (ui & 1) * 2048), (const LAS float*)(lds + LDS_CT + (ui & 1) * 4096)); }
        if (!has_next) break;
#pragma unroll
        for (int a = 0; a < 2; ++a)
#pragma unroll
            for (int b = 0; b < 2; ++b)
#pragma unroll
                for (int m = 0; m < 4; ++m)
#pragma unroll
                    for (int n = 0; n < 2; ++n) acc[a][b][m][n] = (f32x4){0.f, 0.f, 0.f, 0.f};
        cur = nxt; cA = nA; cB = nB; ++ui;
        PG8_VOFF();
        PG8_STATS(cur.pm, ui & 1); E.prefetch(cur, ui & 1, wid, lds);
        if (wr == 1) PG8_BAR;
    }
    PG8_WAIT_V(0);
    PG8_BAR;
#undef PG8_STATS
#undef PG8_VOFF
#undef PG8_SA
#undef PG8_SB
#undef PG8_STAGE
#undef PG8_LDA
#undef PG8_LDB
#undef PG8_MMA
#undef PG8_WAIT_V
#undef PG8_WAIT_L
#undef PG8_BAR
#undef PG8_SCHED
}
}

struct LnRef { const bf16_t* Z; const float* st; const float* g; const float* b; int ident; };
__device__ __forceinline__ void ln_row(const float* st, size_t row, int ident, float& mu, float& rstd) {
    mu = 0.f; rstd = 1.f;
    if (!ident) { const f32x2 s = *(const f32x2*)(st + row * 2); mu = s[0] * (1.f / D); rstd = 1.f / sqrtf(fmaxf(s[1] * (1.f / D) - mu * mu, 0.f) + LN_EPS); }
}
__device__ __forceinline__ void ln_row_lds(const LAS float* stt, int rl, int ident, float& mu, float& rstd) {
    mu = 0.f; rstd = 1.f;
    if (!ident) { const f32x2 s = *(const LAS f32x2*)(stt + 2 * rl); mu = s[0] * (1.f / D); rstd = __builtin_amdgcn_rsqf(fmaxf(s[1] * (1.f / D) - mu * mu, 0.f) + LN_EPS); }
}
struct EpiBf16 {
    __device__ __forceinline__ void prefetch(const pg8::Unit&, int, int, LAS unsigned char*) const {}
    bf16_t* O; int ldc;
    __device__ __forceinline__ void operator()(const f32x4 (&acc)[2][2][4][2], const pg8::Unit& u, int wr, int wc, int fr, int fq, const LAS float* stt, const LAS float* ct) const {
        const int row0 = u.pm * 256 + wr * 64 + fr, col0 = u.pn * 256 + wc * 32 + 8 * fq;
#pragma unroll
        for (int ai = 0; ai < 2; ++ai)
#pragma unroll
            for (int m = 0; m < 4; ++m) { bf16_t* rowp = O + (size_t)(row0 + ai * 128 + m * 16) * ldc + col0;
#pragma unroll
                for (int bj = 0; bj < 2; ++bj) { const f32x4 v0 = acc[ai][bj][m][0], v1 = acc[ai][bj][m][1];
                    u32x4 w; w.x = pk2(v0[0], v0[1]); w.y = pk2(v0[2], v0[3]); w.z = pk2(v1[0], v1[1]); w.w = pk2(v1[2], v1[3]);
                    *(u32x4*)(rowp + bj * 128) = w; } }
    }
};
struct EpiIn {
    __device__ __forceinline__ void prefetch(const pg8::Unit&, int, int, LAS unsigned char*) const {}
    bf16_t* H; float* LF; const float* lbv; float* kP; float* vP; float* kS; float* vS; const float* st; const float* uu; const float* cc; int ident;
    __device__ __forceinline__ void operator()(const f32x4 (&acc_in)[2][2][4][2], const pg8::Unit& u, int wr, int wc, int fr, int fq, const LAS float* stt, const LAS float* ct) const {
        f32x4 acc[2][2][4][2];
        { const int r0 = u.pm * 256 + wr * 64 + fr, c0 = u.pn * 256 + wc * 32 + 8 * fq;
#pragma unroll
          for (int bj = 0; bj < 2; ++bj) { const f32x4 u0 = *(const f32x4*)(uu + c0 + bj * 128), u1 = *(const f32x4*)(uu + c0 + bj * 128 + 4), k0 = *(const f32x4*)(cc + c0 + bj * 128), k1 = *(const f32x4*)(cc + c0 + bj * 128 + 4);
#pragma unroll
            for (int ai = 0; ai < 2; ++ai)
#pragma unroll
                for (int m = 0; m < 4; ++m) { float mu, rstd; ln_row_lds(stt, wr * 64 + fr + ai * 128 + m * 16, ident, mu, rstd);
                    const float nb = -mu * rstd; acc[ai][bj][m][0] = acc_in[ai][bj][m][0] * rstd + (u0 * nb + k0); acc[ai][bj][m][1] = acc_in[ai][bj][m][1] * rstd + (u1 * nb + k1); } } }
        const int row0 = u.pm * 256 + wr * 64 + fr, col0 = u.pn * 256 + wc * 32 + 8 * fq;
        const int kind = u.pn >> 1;
        if (kind == 1) {
#pragma unroll
            for (int bj = 0; bj < 2; ++bj) { const int c = col0 + bj * 128 - C_AF;
                const f32x4 l0 = *(const f32x4*)(lbv + c), l1 = *(const f32x4*)(lbv + c + 4);
#pragma unroll
                for (int ai = 0; ai < 2; ++ai)
#pragma unroll
                    for (int m = 0; m < 4; ++m) { const int row = row0 + ai * 128 + m * 16;
                        f32x4 o0, o1;
#pragma unroll
                        for (int e = 0; e < 4; ++e) {
                            { const float z = acc[ai][bj][m][0][e], ez = __builtin_amdgcn_exp2f(-LOG2E * fabsf(z)), sg = (z >= 0.f ? 1.f : ez) * __builtin_amdgcn_rcpf(1.f + ez), f = l0[e] + (1.f - l0[e]) * sg; o0[e] = fmaxf(__builtin_amdgcn_logf(f) * 0.6931471805599453f, -60.f); }
                            { const float z = acc[ai][bj][m][1][e], ez = __builtin_amdgcn_exp2f(-LOG2E * fabsf(z)), sg = (z >= 0.f ? 1.f : ez) * __builtin_amdgcn_rcpf(1.f + ez), f = l1[e] + (1.f - l1[e]) * sg; o1[e] = fmaxf(__builtin_amdgcn_logf(f) * 0.6931471805599453f, -60.f); }
                        }
                        float* dst = LF + (size_t)row * 512 + c; *(f32x4*)dst = o0; *(f32x4*)(dst + 4) = o1; } }
            return;
        }
#pragma unroll
        for (int ai = 0; ai < 2; ++ai)
#pragma unroll
            for (int m = 0; m < 4; ++m) { const int row = row0 + ai * 128 + m * 16; bf16_t* rowp = H + (size_t)row * INC + col0;
#pragma unroll
                for (int bj = 0; bj < 2; ++bj) { const f32x4 v0 = acc[ai][bj][m][0], v1 = acc[ai][bj][m][1];
                    u32x4 w; w.x = pk2(v0[0], v0[1]); w.y = pk2(v0[2], v0[3]); w.z = pk2(v1[0], v1[1]); w.w = pk2(v1[2], v1[3]);
                    *(u32x4*)(rowp + bj * 128) = w;
                    if (kind >= 5) { const int c = col0 + bj * 128 - (kind == 5 ? C_BK : C_BV);
                        float* dst = (row < MP) ? ((kind == 5 ? kP : vP) + (size_t)row * 512 + c) : ((kind == 5 ? kS : vS) + (size_t)(row - MP) * 512 + c);
                        *(f32x4*)dst = v0; *(f32x4*)(dst + 4) = v1; } } }
    }
};
struct EpiRes {
    __device__ __forceinline__ void prefetch(const pg8::Unit&, int, int, LAS unsigned char*) const {}
    LnRef P; bf16_t* Z; float* st_out; const float* scale;
    __device__ __forceinline__ void operator()(const f32x4 (&acc)[2][2][4][2], const pg8::Unit& u, int wr, int wc, int fr, int fq, const LAS float* stt, const LAS float* ct) const {
        const int row0 = u.pm * 256 + wr * 64 + fr, col0 = u.pn * 256 + wc * 32 + 8 * fq;
        float s1[8], s2[8];
#pragma unroll
        for (int i = 0; i < 8; ++i) { s1[i] = 0.f; s2[i] = 0.f; }
#pragma unroll
        for (int bj = 0; bj < 2; ++bj) { const int c = col0 + bj * 128;
            float sc[8], gg[8], bb[8];
#pragma unroll
            for (int e = 0; e < 8; ++e) { sc[e] = 1.f; gg[e] = 1.f; bb[e] = 0.f; }
            if (scale) { const f32x4 a0 = *(const f32x4*)(scale + c), a1 = *(const f32x4*)(scale + c + 4);
#pragma unroll
                for (int e = 0; e < 4; ++e) { sc[e] = a0[e]; sc[4 + e] = a1[e]; } }
            if (!P.ident) { const f32x4 a0 = *(const f32x4*)(P.g + c), a1 = *(const f32x4*)(P.g + c + 4), b0 = *(const f32x4*)(P.b + c), b1 = *(const f32x4*)(P.b + c + 4);
#pragma unroll
                for (int e = 0; e < 4; ++e) { gg[e] = a0[e]; gg[4 + e] = a1[e]; bb[e] = b0[e]; bb[4 + e] = b1[e]; } }
#pragma unroll
            for (int ai = 0; ai < 2; ++ai)
#pragma unroll
                for (int m = 0; m < 4; ++m) { const size_t row = (size_t)(row0 + ai * 128 + m * 16), off = row * D + c;
                    float mu, rstd; ln_row_lds(stt, wr * 64 + fr + ai * 128 + m * 16, P.ident, mu, rstd);
                    const u32x4 xw = *(const u32x4*)(P.Z + off); float xv[8]; unpk8(xw, xv);
                    float o[8];
#pragma unroll
                    for (int e = 0; e < 8; ++e) { const float t = rstd * gg[e], x = fmaf(xv[e], t, fmaf(-mu, t, bb[e])); o[e] = fmaf(DN_ALPHA, x, (e < 4 ? acc[ai][bj][m][0][e] : acc[ai][bj][m][1][e - 4]) * sc[e]); }
                    const u32x4 w = pk8(o); *(u32x4*)(Z + off) = w;
                    float ov[8]; unpk8(w, ov);
#pragma unroll
                    for (int e = 0; e < 8; ++e) { s1[ai * 4 + m] += ov[e]; s2[ai * 4 + m] += ov[e] * ov[e]; } } }
#pragma unroll
        for (int i = 0; i < 8; ++i) { s1[i] += __shfl_xor(s1[i], 16); s1[i] += __shfl_xor(s1[i], 32); s2[i] += __shfl_xor(s2[i], 16); s2[i] += __shfl_xor(s2[i], 32); }
        {
#pragma unroll
            for (int k = 0; k < 2; ++k) { const float a1 = fq == 0 ? s1[k] : fq == 1 ? s1[2 + k] : fq == 2 ? s1[4 + k] : s1[6 + k], a2 = fq == 0 ? s2[k] : fq == 1 ? s2[2 + k] : fq == 2 ? s2[4 + k] : s2[6 + k];
                const int i = 2 * fq + k; float* p = st_out + (size_t)(row0 + (i >> 2) * 128 + (i & 3) * 16) * 2; atomicAdd(p, a1); atomicAdd(p + 1, a2); } }
    }
};

template <int CTRL> __device__ __forceinline__ float dpp_f(float v) { return __builtin_bit_cast(float, __builtin_amdgcn_update_dpp(0, __builtin_bit_cast(int, v), CTRL, 0xf, 0xf, false)); }
struct EpiUpConv {
    bf16_t* G; const float* cw; const float* cb; const float* hist; float* ahead; float* bhead; float* atail; float* outP; float* outS; LAS float* ex; const float* st; const float* uu; const float* cc;
    __device__ __forceinline__ void prefetch(const pg8::Unit& u, int par, int wid, LAS unsigned char* lds) const {
        const int l = lane_id_v();
#pragma unroll
        for (int j = 0; j < 2; ++j) { const int arr = j * 4 + (wid >> 1), off = (wid & 1) * 64 + l;
            const float* src = (arr < 3) ? cw + (size_t)arr * DFF + 128 * u.pn : (arr == 3) ? cb + 128 * u.pn : (arr == 4) ? uu + 256 * u.pn : (arr == 5) ? cc + 256 * u.pn : (arr == 6) ? uu + 256 * u.pn + 128 : cc + 256 * u.pn + 128;
            __builtin_amdgcn_global_load_lds((const unsigned*)(src + off), (LAS unsigned*)(lds + LDS_CT + par * 4096 + (j * 512 + wid * 64) * 4), 4, 0, 0); __builtin_amdgcn_sched_barrier(0); }
    }
    __device__ __forceinline__ void corr(const f32x4& a0, const f32x4& a1, const LAS float* up, const LAS float* kp, float mu, float rstd, float* o) const {
        const f32x4 u0 = *(const LAS f32x4*)up, u1 = *(const LAS f32x4*)(up + 4), k0 = *(const LAS f32x4*)kp, k1 = *(const LAS f32x4*)(kp + 4);
        const float nb = -mu * rstd;
#pragma unroll
        for (int e = 0; e < 4; ++e) { o[e] = fmaf(a0[e], rstd, fmaf(u0[e], nb, k0[e])); o[4 + e] = fmaf(a1[e], rstd, fmaf(u1[e], nb, k1[e])); }
    }
    __device__ __forceinline__ void operator()(const f32x4 (&acc)[2][2][4][2], const pg8::Unit& u, int wr, int wc, int fr, int fq, const LAS float* stt, const LAS float* ct) const {
        const int chl = 32 * wc + 8 * fq, ch = 128 * u.pn + chl;
        const LAS float* T = ct + chl;
        if (fr >= 14) {
#pragma unroll
            for (int ai = 0; ai < 2; ++ai) { float mu, rstd, t[8]; ln_row_lds(stt, wr * 64 + fr + ai * 128 + 48, 0, mu, rstd); corr(acc[ai][0][3][0], acc[ai][0][3][1], T + 4 * 128, T + 5 * 128, mu, rstd, t);
                LAS float* p = ex + ((ai * 2 + wr) * 2 + (fr - 14)) * 128 + chl; *(LAS f32x4*)p = (f32x4){t[0], t[1], t[2], t[3]}; *(LAS f32x4*)(p + 4) = (f32x4){t[4], t[5], t[6], t[7]}; }
        }
        asm volatile("s_waitcnt lgkmcnt(0)" ::: "memory"); __builtin_amdgcn_s_barrier(); asm volatile("" ::: "memory");
        const bool smp = u.pm >= MP / 256;
        const int seq_first = (u.pm & 7) == 0;
#pragma unroll
        for (int ai = 0; ai < 2; ++ai) {
            float h1[8], h2[8];
#pragma unroll
            for (int e = 0; e < 8; ++e) { h1[e] = 0.f; h2[e] = 0.f; }
            bool top_missing = false;
            if (!smp) {
                if (wr == 1 || ai == 1) { const int sa = (wr == 1) ? ai : 0, sw = (wr == 1) ? 0 : 1; const LAS float* p = ex + ((sa * 2 + sw) * 2) * 128 + chl;
                    const f32x4 a0 = *(const LAS f32x4*)p, a1 = *(const LAS f32x4*)(p + 4), b0 = *(const LAS f32x4*)(p + 128), b1 = *(const LAS f32x4*)(p + 132);
#pragma unroll
                    for (int e = 0; e < 4; ++e) { h2[e] = a0[e]; h2[4 + e] = a1[e]; h1[e] = b0[e]; h1[4 + e] = b1[e]; } }
                else top_missing = !seq_first;
            }
            float r1p[8], r2p[8];
#pragma unroll
            for (int e = 0; e < 8; ++e) { r1p[e] = 0.f; r2p[e] = 0.f; }
#pragma unroll
            for (int m = 0; m < 4; ++m) {
                const int rloc = 128 * ai + 64 * wr + 16 * m + fr;
                float cur[8], bb[8], r1[8], r2[8], p1[8], p2[8], o[8];
                const LAS float* Tm = T; asm volatile("" : "+v"(Tm));
                { float mu, rstd; ln_row_lds(stt, rloc, 0, mu, rstd);
                  corr(acc[ai][0][m][0], acc[ai][0][m][1], Tm + 4 * 128, Tm + 5 * 128, mu, rstd, cur); corr(acc[ai][1][m][0], acc[ai][1][m][1], Tm + 6 * 128, Tm + 7 * 128, mu, rstd, bb); }
#pragma unroll
                for (int e = 0; e < 8; ++e) { r1[e] = dpp_f<0x121>(cur[e]); r2[e] = dpp_f<0x122>(cur[e]); }
                if (smp) { const int sb = ((u.pm - MP / 256) * 256 + 128 * ai + 64 * wr + 16 * m) >> 4; const float* hp = hist + (size_t)sb * 2 * DFF + ch;
                    const f32x4 a0 = *(const f32x4*)hp, a1 = *(const f32x4*)(hp + 4), b0 = *(const f32x4*)(hp + DFF), b1 = *(const f32x4*)(hp + DFF + 4);
#pragma unroll
                    for (int e = 0; e < 8; ++e) { const float hh0 = e < 4 ? a0[e & 3] : a1[e & 3], hh1 = e < 4 ? b0[e & 3] : b1[e & 3];
                        p1[e] = fr >= 1 ? r1[e] : hh1; p2[e] = fr >= 2 ? r2[e] : (fr == 1 ? hh1 : hh0); } }
                else if (m == 0) {
#pragma unroll
                    for (int e = 0; e < 8; ++e) { p1[e] = fr >= 1 ? r1[e] : h1[e]; p2[e] = fr >= 2 ? r2[e] : (fr == 1 ? h1[e] : h2[e]); } }
                else {
#pragma unroll
                    for (int e = 0; e < 8; ++e) { p1[e] = fr >= 1 ? r1[e] : r1p[e]; p2[e] = fr >= 2 ? r2[e] : r2p[e]; } }
#pragma unroll
                for (int h2i = 0; h2i < 2; ++h2i) { const f32x4 x0 = *(const LAS f32x4*)(Tm + 0 * 128 + 4 * h2i), x1 = *(const LAS f32x4*)(Tm + 1 * 128 + 4 * h2i), x2 = *(const LAS f32x4*)(Tm + 2 * 128 + 4 * h2i), xb = *(const LAS f32x4*)(Tm + 3 * 128 + 4 * h2i);
#pragma unroll
                    for (int e = 0; e < 4; ++e) { const int q = 4 * h2i + e; const float c = fmaf(cur[q], x2[e], fmaf(p1[q], x1[e], fmaf(p2[q], x0[e], xb[e]))); o[q] = silu_mul(c, bb[q]); r1p[q] = r1[q]; r2p[q] = r2[q]; } }
                if (!(top_missing && m == 0 && fr < 2)) *(u32x4*)(G + (size_t)(u.pm * 256 + rloc) * DFF + ch) = pk8(o);
                const f32x4 ca0 = {cur[0], cur[1], cur[2], cur[3]}, ca1 = {cur[4], cur[5], cur[6], cur[7]};
                if (ai == 0 && m == 0 && wr == 0 && fr < 2) { float* pa = ahead + ((size_t)u.pm * 2 + fr) * DFF + ch; float* pb = bhead + ((size_t)u.pm * 2 + fr) * DFF + ch;
                    *(f32x4*)pa = ca0; *(f32x4*)(pa + 4) = ca1; *(f32x4*)pb = (f32x4){bb[0], bb[1], bb[2], bb[3]}; *(f32x4*)(pb + 4) = (f32x4){bb[4], bb[5], bb[6], bb[7]}; }
                if (ai == 1 && m == 3 && wr == 1 && fr >= 14) { float* pt = atail + ((size_t)u.pm * 2 + (fr - 14)) * DFF + ch; *(f32x4*)pt = ca0; *(f32x4*)(pt + 4) = ca1;
                    if (!smp && (u.pm & 7) == 7) { float* po = outP + ((size_t)(u.pm >> 3) * 2 + (fr - 14)) * DFF + ch; *(f32x4*)po = ca0; *(f32x4*)(po + 4) = ca1; } }
                if (smp && fr >= 14) { const int sb = ((u.pm - MP / 256) * 256 + 128 * ai + 64 * wr + 16 * m) >> 4; float* po = outS + ((size_t)sb * 2 + (fr - 14)) * DFF + ch;
                    *(f32x4*)po = ca0; *(f32x4*)(po + 4) = ca1; }
            }
        }
    }
};


template <int KW  >
__device__ __forceinline__ void sgemm_res_phase(LAS unsigned char* lds, const bf16_t* A, int lda, int a_grp_step, const bf16_t* Bt, int K, int bid, int G, int tid, const LnRef& P, bf16_t* Z, float* st_out, const float* scale) {
    const int lane = tid & 63, wave = __builtin_amdgcn_readfirstlane(tid >> 6), fr = lane & 15, fq = lane >> 4;
    LAS f32x4* red = (LAS f32x4*)lds;
    for (int t = bid; t < 256; t += G) {
        const int rt = t >> 5, ct = t & 31;
        const GAS bf16_t* ap = (const GAS bf16_t*)(A + (size_t)(rt * 64 + fr) * lda + (size_t)((ct * 32) >> 8) * a_grp_step + wave * KW + 8 * fq);
        const GAS bf16_t* bp = (const GAS bf16_t*)(Bt + (size_t)(ct * 32 + fr) * K + wave * KW + 8 * fq);
        f32x4 acc[4][2];
#pragma unroll
        for (int i = 0; i < 4; ++i) { acc[i][0] = (f32x4){0.f, 0.f, 0.f, 0.f}; acc[i][1] = (f32x4){0.f, 0.f, 0.f, 0.f}; }
#pragma unroll
        for (int k0 = 0; k0 < KW; k0 += 32) {
            bf16x8 af[4], bf[2];
#pragma unroll
            for (int i = 0; i < 4; ++i) af[i] = *(const GAS bf16x8*)(ap + (size_t)(16 * i) * lda + k0);
#pragma unroll
            for (int j = 0; j < 2; ++j) bf[j] = *(const GAS bf16x8*)(bp + (size_t)(16 * j) * K + k0);
#pragma unroll
            for (int i = 0; i < 4; ++i)
#pragma unroll
                for (int j = 0; j < 2; ++j) acc[i][j] = __builtin_amdgcn_mfma_f32_16x16x32_bf16(bf[j], af[i], acc[i][j], 0, 0, 0);
        }
#pragma unroll
        for (int i = 0; i < 4; ++i)
#pragma unroll
            for (int j = 0; j < 2; ++j) red[(wave * 8 + i * 2 + j) * 64 + lane] = acc[i][j];
        __syncthreads();
        f32x4 v = red[(0 * 8 + wave) * 64 + lane];
#pragma unroll
        for (int w = 1; w < 8; ++w) v += red[(w * 8 + wave) * 64 + lane];
        __syncthreads();
        const int row = rt * 64 + 16 * (wave >> 1) + fr, n = ct * 32 + 16 * (wave & 1) + 4 * fq; const size_t grow = (size_t)MP + row, off = grow * D + n;
        float mu, rstd; ln_row(P.st, grow, P.ident, mu, rstd);
        f32x4 gg = {1.f, 1.f, 1.f, 1.f}, bb = {0.f, 0.f, 0.f, 0.f}, sc = {1.f, 1.f, 1.f, 1.f};
        if (!P.ident) { gg = *(const f32x4*)(P.g + n); bb = *(const f32x4*)(P.b + n); }
        if (scale) sc = *(const f32x4*)(scale + n);
        const u32x2 xw = *(const u32x2*)(P.Z + off); const float xv[4] = {bflo(xw.x), bfhi(xw.x), bflo(xw.y), bfhi(xw.y)};
        float o[4];
#pragma unroll
        for (int e = 0; e < 4; ++e) { const float tt = rstd * gg[e], x = fmaf(xv[e], tt, fmaf(-mu, tt, bb[e])); o[e] = fmaf(DN_ALPHA, x, v[e] * sc[e]); }
        u32x2 w; w.x = pk2(o[0], o[1]); w.y = pk2(o[2], o[3]); *(u32x2*)(Z + off) = w;
        float s1 = (bflo(w.x) + bfhi(w.x)) + (bflo(w.y) + bfhi(w.y)), s2 = (bflo(w.x) * bflo(w.x) + bfhi(w.x) * bfhi(w.x)) + (bflo(w.y) * bflo(w.y) + bfhi(w.y) * bfhi(w.y));
        s1 += __shfl_xor(s1, 16); s1 += __shfl_xor(s1, 32); s2 += __shfl_xor(s2, 16); s2 += __shfl_xor(s2, 32);
        if (fq == 0) { atomicAdd(st_out + grow * 2, s1); atomicAdd(st_out + grow * 2 + 1, s2); }
    }
}

__device__ __forceinline__ void sgemm_in_phase(LAS unsigned char* lds, const bf16_t* A, const bf16_t* Bt, int bid, int G, int tid, const EpiIn& E) {
    constexpr int K = D, KW = K / 8;
    const int lane = tid & 63, wave = __builtin_amdgcn_readfirstlane(tid >> 6), fr = lane & 15, fq = lane >> 4;
    LAS f32x4* red = (LAS f32x4*)lds;
    for (int t = bid; t < 256; t += G) {
        const int rt = t >> 5, ct = t & 31;
        const GAS bf16_t* ap = (const GAS bf16_t*)(A + (size_t)(rt * 64 + fr) * K + wave * KW + 8 * fq);
        const GAS bf16_t* bp = (const GAS bf16_t*)(Bt + (size_t)(ct * 112 + fr) * K + wave * KW + 8 * fq);
        f32x4 acc[4][7];
#pragma unroll
        for (int i = 0; i < 4; ++i)
#pragma unroll
            for (int j = 0; j < 7; ++j) acc[i][j] = (f32x4){0.f, 0.f, 0.f, 0.f};
#pragma unroll
        for (int k0 = 0; k0 < KW; k0 += 32) {
            bf16x8 af[4], bf[7];
#pragma unroll
            for (int i = 0; i < 4; ++i) af[i] = *(const GAS bf16x8*)(ap + (size_t)(16 * i) * K + k0);
#pragma unroll
            for (int j = 0; j < 7; ++j) bf[j] = *(const GAS bf16x8*)(bp + (size_t)(16 * j) * K + k0);
#pragma unroll
            for (int i = 0; i < 4; ++i)
#pragma unroll
                for (int j = 0; j < 7; ++j) acc[i][j] = __builtin_amdgcn_mfma_f32_16x16x32_bf16(bf[j], af[i], acc[i][j], 0, 0, 0);
        }
#pragma unroll
        for (int i = 0; i < 4; ++i) {
#pragma unroll
            for (int j = 0; j < 7; ++j) red[(wave * 7 + j) * 64 + lane] = acc[i][j];
            __syncthreads();
            if (wave < 7) {
                f32x4 v = red[(0 * 7 + wave) * 64 + lane];
#pragma unroll
                for (int w = 1; w < 8; ++w) v += red[(w * 7 + wave) * 64 + lane];
                const int m = rt * 64 + 16 * i + fr, n = ct * 112 + 16 * wave + 4 * fq; const size_t row = (size_t)MP + m;
                float mu, rstd; ln_row(E.st, row, E.ident, mu, rstd);
                const f32x4 u0 = *(const f32x4*)(E.uu + n), k0v = *(const f32x4*)(E.cc + n);
                const float nb = -mu * rstd; v = v * rstd + (u0 * nb + k0v);
                const int kind = n >> 9;
                if (kind == 1) { const int c = n - C_AF; const f32x4 l0 = *(const f32x4*)(E.lbv + c); f32x4 o;
#pragma unroll
                    for (int e = 0; e < 4; ++e) { const float z = v[e], ez = __builtin_amdgcn_exp2f(-LOG2E * fabsf(z)), sg = (z >= 0.f ? 1.f : ez) * __builtin_amdgcn_rcpf(1.f + ez), f = l0[e] + (1.f - l0[e]) * sg; o[e] = fmaxf(__builtin_amdgcn_logf(f) * 0.6931471805599453f, -60.f); }
                    *(f32x4*)(E.LF + row * 512 + c) = o; }
                else { u32x2 w; w.x = pk2(v[0], v[1]); w.y = pk2(v[2], v[3]); *(u32x2*)(E.H + row * INC + n) = w;
                    if (kind == 5) *(f32x4*)(E.kS + (size_t)m * 512 + (n - C_BK)) = v;
                    if (kind == 6) *(f32x4*)(E.vS + (size_t)m * 512 + (n - C_BV)) = v; }
            }
            __syncthreads();
        }
    }
}

#define XB_TMO      128
#define XB_XCNT(j)  (256  + 64 * (j))
#define XB_XSUB(j)  (1280 + 64 * (j))
#define XB_XGEN(j)  (2304 + 64 * (j))
#define XB_TOP      3328
#define XB_TOPGEN   3392
#define XCD_BAR_WORDS 3456
#define XB_SPIN_CAP (1u << 22)
__device__ __forceinline__ unsigned xb_ld(unsigned* p)              { return __hip_atomic_load(p, __ATOMIC_RELAXED, __HIP_MEMORY_SCOPE_AGENT); }
__device__ __forceinline__ unsigned xb_add(unsigned* p, unsigned v) { return __hip_atomic_fetch_add(p, v, __ATOMIC_RELAXED, __HIP_MEMORY_SCOPE_AGENT); }
__device__ __forceinline__ unsigned xb_xcc_id() { return (unsigned)__builtin_amdgcn_s_getreg((3 << 11) | 20) & 0xFu; }
#define XB_SPIN(cond, bar) do { unsigned _sp = 0; while (cond) { __builtin_amdgcn_s_sleep(1); \
    if ((++_sp & 255u) == 0u) { if (xb_ld(&(bar)[XB_TMO])) break; if (_sp > XB_SPIN_CAP) { atomicAdd(&(bar)[XB_TMO], 1u); break; } } } } while (0)
struct XcdBarrier { unsigned* bar; unsigned x; volatile LAS unsigned* st; };
__device__ __forceinline__ XcdBarrier xcd_barrier_post(unsigned* bar, volatile LAS unsigned* st) {
    XcdBarrier b; b.bar = bar; b.x = xb_xcc_id(); b.st = st;
    if (threadIdx.x == 0) (void)xb_add(&bar[XB_XCNT(b.x)], 1u);
    return b;
}
__device__ __forceinline__ void xcd_barrier_complete(unsigned* bar, unsigned x, unsigned& nloc, unsigned& nx) {
    const unsigned G = gridDim.x * gridDim.y * gridDim.z;
    unsigned sum, cnt, mine, sp = 0u;
    for (;;) {
        sum = 0u; cnt = 0u; mine = 0u;
#pragma unroll
        for (unsigned j = 0; j < 16; ++j) { const unsigned c = xb_ld(&bar[XB_XCNT(j)]); sum += c; cnt += (c > 0u) ? 1u : 0u; mine = (j == x) ? c : mine; }
        if (sum == G) break;
        __builtin_amdgcn_s_sleep(1);
        if ((++sp & 255u) == 0u) { if (xb_ld(&bar[XB_TMO])) break; if (sp > XB_SPIN_CAP) { atomicAdd(&bar[XB_TMO], 1u); break; } }
    }
    nloc = mine > 0u ? mine : 1u; nx = cnt > 0u ? cnt : 1u;
}
__device__ __forceinline__ void xcd_barrier(const XcdBarrier& b) {
    asm volatile("s_waitcnt vmcnt(0)" ::: "memory");
    __syncthreads();
    if (threadIdx.x == 0) {
        unsigned* bar = b.bar;
        __builtin_amdgcn_s_waitcnt(0);
        unsigned nloc = b.st[0], nx = b.st[1];
        if (nloc == 0u) { xcd_barrier_complete(bar, b.x, nloc, nx); b.st[0] = nloc; b.st[1] = nx; }
        const unsigned old = xb_add(&bar[XB_XSUB(b.x)], 1u);
        const unsigned gen = old / nloc;
        if (old + 1u == (gen + 1u) * nloc) {
            __builtin_amdgcn_fence(__ATOMIC_RELEASE, "agent");
            asm volatile("s_waitcnt vmcnt(0)" ::: "memory");
            const unsigned og = xb_add(&bar[XB_TOP], 1u);
            const unsigned tg = og / nx;
            if (og + 1u == (tg + 1u) * nx) xb_add(&bar[XB_TOPGEN], 1u);
            else XB_SPIN(xb_ld(&bar[XB_TOPGEN]) == tg, bar);
            __builtin_amdgcn_fence(__ATOMIC_ACQUIRE, "agent");
            xb_add(&bar[XB_XGEN(b.x)], 1u);
            asm volatile("s_waitcnt vmcnt(0)" ::: "memory");
        } else {
            XB_SPIN(xb_ld(&bar[XB_XGEN(b.x)]) == gen, bar);
            __builtin_amdgcn_fence(__ATOMIC_ACQUIRE, "agent");
            asm volatile("s_waitcnt vmcnt(0)" ::: "memory");
        }
    }
    __syncthreads();
}

struct Args { const float* in[24]; float* out; unsigned char* ws; int ph_lo, ph_hi, single, pad; };
typedef const float* cfp_t;
typedef const __attribute__((address_space(4))) cfp_t* kin_t;
struct Frame {
    LAS unsigned char* lds;
    int tid, lane, wave, bid, G;
    kin_t in;
    float* out; unsigned char* ws;
};
enum { I_XP = 0, I_XS, I_CK, I_CV, I_SH, I_SP, I_SC, I_WIN, I_WOUT, I_LBL, I_HNG, I_DLAM, I_DNG, I_RB, I_PW, I_PSC, I_WUP, I_CW, I_CB, I_WDN, I_L1G, I_L1B, I_L2G, I_L2B };

__device__ __forceinline__ void p0_transpose_item(const float* W, int K, int N, bf16_t* WT, int dst_row0, LAS float* scr, int k0, int n0, int lane, const float* gk, const float* bk, float* uo, float* co) {
#pragma unroll 8
    for (int i = 0; i < 32; ++i) { const int kk = 2 * i + (lane >> 5); scr[kk * 33 + (lane & 31)] = W[(size_t)(k0 + kk) * N + n0 + (lane & 31)]; }
    asm volatile("s_waitcnt lgkmcnt(0)" ::: "memory");
    const int c = lane & 7;
    float gv[8], bv[8];
#pragma unroll
    for (int e = 0; e < 8; ++e) { gv[e] = 1.f; bv[e] = 0.f; }
    if (gk) {
#pragma unroll
        for (int e = 0; e < 8; ++e) { gv[e] = gk[k0 + 8 * c + e]; bv[e] = bk[k0 + 8 * c + e]; } }
#pragma unroll
    for (int j = 0; j < 4; ++j) { const int n = (lane >> 3) + 8 * j; const LAS float* sp = scr + (8 * c) * 33 + n;
        float wv[8]; float cs = 0.f;
#pragma unroll
        for (int e = 0; e < 8; ++e) { const float w = sp[e * 33]; wv[e] = w * gv[e]; cs += w * bv[e]; }
        const u32x4 o = pk8(wv);
        *(u32x4*)(WT + (size_t)(dst_row0 + n) * K + k0 + 8 * c) = o;
        if (gk) { float rv[8]; unpk8(o, rv); float us = 0.f;
#pragma unroll
            for (int e = 0; e < 8; ++e) us += rv[e];
            us += __shfl_xor(us, 1); us += __shfl_xor(us, 2); us += __shfl_xor(us, 4); cs += __shfl_xor(cs, 1); cs += __shfl_xor(cs, 2); cs += __shfl_xor(cs, 4);
            if (c == 0) { atomicAdd(uo + dst_row0 + n, us); atomicAdd(co + dst_row0 + n, cs); } } }
    asm volatile("s_waitcnt lgkmcnt(0)" ::: "memory");
}
__device__ __forceinline__ void phase_prologue(Frame& F) {
    LAS float* scr = (LAS float*)(F.lds + F.wave * 16384);
    const int gw = F.bid * NWAVES + F.wave, NGW = F.G * NWAVES;
    constexpr int I_IN = (D / 64) * (INC / 32), I_OUT = (D / 64) * (D / 32), I_POOL = 4 * 8, I_UP = (D / 64) * (UPN / 32), I_DN = (DFF / 64) * (D / 32);
    constexpr int NITEMS = 2 * I_IN + 2 * I_OUT + 8 * I_POOL + 4 * I_UP + 4 * I_DN;
    for (int it = gw; it < NITEMS; it += NGW) {
        int r = it;
        if (r < 2 * I_IN) { const int m = r / I_IN; r %= I_IN; const int kb = r / (INC / 32), nb = r % (INC / 32);
            float* ctlf = (float*)(F.ws + WS_CTL);
            p0_transpose_item(F.in[I_WIN] + (size_t)m * D * INC, D, INC, (bf16_t*)(F.ws + WS_WIN) + (size_t)m * INC * D, 32 * nb, scr, 64 * kb, 32 * nb, F.lane,
                              m == 1 ? F.in[I_L2G] + 1 * D : nullptr, F.in[I_L2B] + 1 * D, ctlf + UC_UIN, ctlf + UC_CIN); continue; } r -= 2 * I_IN;
        if (r < 2 * I_OUT) { const int m = r / I_OUT; r %= I_OUT; const int kb = r / (D / 32), nb = r % (D / 32);
            p0_transpose_item(F.in[I_WOUT] + (size_t)m * D * D, D, D, (bf16_t*)(F.ws + WS_WOUT) + (size_t)m * D * D, 32 * nb, scr, 64 * kb, 32 * nb, F.lane, nullptr, nullptr, nullptr, nullptr); continue; } r -= 2 * I_OUT;
        if (r < 8 * I_POOL) { const int pg = r / I_POOL; r %= I_POOL; const int kb = r / 8, nb = r % 8;
            p0_transpose_item(F.in[I_PW] + (size_t)pg * 256 * 256, 256, 256, (bf16_t*)(F.ws + WS_WPOOL) + (size_t)pg * 256 * 256, 32 * nb, scr, 64 * kb, 32 * nb, F.lane, nullptr, nullptr, nullptr, nullptr); continue; } r -= 8 * I_POOL;
        if (r < 4 * I_UP) { const int l = r / I_UP; r %= I_UP; const int kb = r / (UPN / 32), nb = r % (UPN / 32); const int n0 = 32 * nb;
            const int dst = (n0 < DFF) ? (256 * (n0 / 128) + (n0 % 128)) : (256 * ((n0 - DFF) / 128) + 128 + ((n0 - DFF) % 128));
            float* ctlf = (float*)(F.ws + WS_CTL);
            p0_transpose_item(F.in[I_WUP] + (size_t)l * D * UPN, D, UPN, (bf16_t*)(F.ws + WS_WUP) + (size_t)l * UPN * D, dst, scr, 64 * kb, n0, F.lane,
                              F.in[I_L1G] + (size_t)l * D, F.in[I_L1B] + (size_t)l * D, ctlf + UC_UUP + l * UPN, ctlf + UC_CUP + l * UPN); continue; } r -= 4 * I_UP;
        { const int l = r / I_DN; r %= I_DN; const int kb = r / (D / 32), nb = r % (D / 32);
            p0_transpose_item(F.in[I_WDN] + (size_t)l * DFF * D, DFF, D, (bf16_t*)(F.ws + WS_WDN) + (size_t)l * D * DFF, 32 * nb, scr, 64 * kb, 32 * nb, F.lane, nullptr, nullptr, nullptr, nullptr); }
    }
    bf16_t* XB = (bf16_t*)(F.ws + WS_XB);
    for (int m0 = gw; m0 < MT; m0 += 4 * NGW) {
        f32x4 v[4][4];
#pragma unroll
        for (int q = 0; q < 4; ++q) { const int m = m0 + q * NGW;
            if (m < MT) { const float* src = (m < MP) ? F.in[I_XP] + (size_t)m * D : F.in[I_XS] + (size_t)(m - MP) * D;
#pragma unroll
                for (int j = 0; j < 4; ++j) v[q][j] = *(const f32x4*)(src + 4 * F.lane + 256 * j); } }
#pragma unroll
        for (int q = 0; q < 4; ++q) { const int m = m0 + q * NGW;
            if (m < MT) {
#pragma unroll
                for (int j = 0; j < 4; ++j) { u32x2 w; w.x = pk2(v[q][j][0], v[q][j][1]); w.y = pk2(v[q][j][2], v[q][j][3]); *(u32x2*)(XB + (size_t)m * D + 4 * F.lane + 256 * j) = w; } } }
    }
    if (F.bid == 0) {
        float* tab = (float*)(F.ws + WS_TAB);
        { const int c = F.tid; const float a = F.in[I_LBL][c], b = F.in[I_LBL][512 + c], mx = fmaxf(a, b), ea = __expf(a - mx), eb = __expf(b - mx);
          tab[TB_LB + c] = 0.f; tab[TB_LB + 512 + c] = eb / (ea + eb); }
        if (F.wave < 2) { const int m = F.wave; const float* lp = F.in[I_DLAM] + (size_t)m * 4 * 64;
            const float s01 = wave_sum(lp[F.lane] * lp[64 + F.lane]), s23 = wave_sum(lp[128 + F.lane] * lp[192 + F.lane]);
            const float lam_init = (m == 0) ? 0.2f : 0.47071302f;
            if (F.lane == 0) tab[TB_LAM + m] = __expf(s01) - __expf(s23) + lam_init; }
    }
}

__device__ __forceinline__ void phase_ln_final(Frame& F, const bf16_t* Z, const float* g, const float* b) {
    const int gw = F.bid * NWAVES + F.wave, NGW = F.G * NWAVES;
    f32x4 gv[4], bv[4];
#pragma unroll
    for (int j = 0; j < 4; ++j) { const int c = 8 * F.lane + 512 * (j >> 1) + 4 * (j & 1); gv[j] = *(const f32x4*)(g + c); bv[j] = *(const f32x4*)(b + c); }
    for (int m = gw; m < MT; m += NGW) {
        f32x4 v[4]; float s = 0.f;
#pragma unroll
        for (int j2 = 0; j2 < 2; ++j2) { const u32x4 w = *(const u32x4*)(Z + (size_t)m * D + 8 * F.lane + 512 * j2);
            v[2 * j2] = (f32x4){bflo(w.x), bfhi(w.x), bflo(w.y), bfhi(w.y)}; v[2 * j2 + 1] = (f32x4){bflo(w.z), bfhi(w.z), bflo(w.w), bfhi(w.w)}; }
#pragma unroll
        for (int j = 0; j < 4; ++j) s += (v[j][0] + v[j][1]) + (v[j][2] + v[j][3]);
        const float mean = wave_sum(s) * (1.f / D); float s2 = 0.f;
#pragma unroll
        for (int j = 0; j < 4; ++j) { v[j] = v[j] - mean; s2 += (v[j][0] * v[j][0] + v[j][1] * v[j][1]) + (v[j][2] * v[j][2] + v[j][3] * v[j][3]); }
        const float rstd = 1.f / sqrtf(wave_sum(s2) * (1.f / D) + LN_EPS);
        float* outp = (m < MP) ? F.out + O_YP + (size_t)m * D : F.out + O_YS + (size_t)(m - MP) * D;
#pragma unroll
        for (int j2 = 0; j2 < 2; ++j2) { const f32x4 y0 = v[2 * j2] * rstd * gv[2 * j2] + bv[2 * j2], y1 = v[2 * j2 + 1] * rstd * gv[2 * j2 + 1] + bv[2 * j2 + 1];
            *(f32x4*)(outp + 8 * F.lane + 512 * j2) = y0; *(f32x4*)(outp + 8 * F.lane + 512 * j2 + 4) = y1; }
    }
}

template <int J>
__device__ __forceinline__ void pool_item(Frame& F, const LnRef& R, int p, int rb, int c) {
    constexpr int W = 2 << J;
    bf16_t* PO = (bf16_t*)(F.ws + WS_MIX);
    const f32x4 g4 = *(const f32x4*)(R.g + c), b4 = *(const f32x4*)(R.b + c);
    const int m0 = rb * 16; const bool smp = m0 >= MP; const int b = smp ? (m0 - MP) / ST : m0 / PT, t0 = smp ? 0 : m0 % PT;
    f32x4 ring[W]; f32x4 s = {0.f, 0.f, 0.f, 0.f};
#pragma unroll
    for (int i = 0; i < W; ++i) {
        const int tt = t0 - W + i; f32x4 v = {0.f, 0.f, 0.f, 0.f};
        if (tt >= 0) { const size_t rr = (size_t)(m0 - W + i); const u32x2 q = *(const u32x2*)(R.Z + rr * D + c); float mu, rstd; ln_row(R.st, rr, 0, mu, rstd);
            v = ((f32x4){bflo(q.x), bfhi(q.x), bflo(q.y), bfhi(q.y)} - mu) * rstd * g4 + b4; }
        else if (smp && tt >= -15) v = *(const f32x4*)(F.in[I_SP] + (((size_t)p * SB + b) * 15 + (15 + tt)) * D + c);
        ring[i] = v; s += v; }
#pragma unroll
    for (int i = 0; i < 16; ++i) { const int t = t0 + i;
        const size_t rr = (size_t)(m0 + i); const u32x2 q = *(const u32x2*)(R.Z + rr * D + c); float mu, rstd; ln_row(R.st, rr, 0, mu, rstd);
        const f32x4 x = ((f32x4){bflo(q.x), bfhi(q.x), bflo(q.y), bfhi(q.y)} - mu) * rstd * g4 + b4;
        s += x - ring[i % W]; ring[i % W] = x;
        const float inv = 1.f / (float)(smp ? W : (t + 1 < W ? t + 1 : W));
        const f32x4 o = s * inv - x;
        u32x2 w; w.x = pk2(o[0], o[1]); w.y = pk2(o[2], o[3]); *(u32x2*)(PO + (size_t)(m0 + i) * D + c) = w;
        if (!smp && t >= PT - 15) *(f32x4*)(F.out + O_PP + (((size_t)p * PB + b) * 15 + (t - (PT - 15))) * D + c) = x;
        if (smp && t >= 1) *(f32x4*)(F.out + O_PS + (((size_t)p * SB + b) * 15 + (t - 1)) * D + c) = x; }
}
__device__ __forceinline__ void phase_pool_prep(Frame& F, const LnRef& R, int p) {
    const int gt = F.bid * NTHREADS + F.tid, NGT = F.G * NTHREADS;
    for (int it = gt; it < (MT / 16) * 256; it += NGT) { const int rb = it >> 8, cq = it & 255, c = 4 * cq;
        const int j = cq >> 6;
        if (j == 0) pool_item<0>(F, R, p, rb, c); else if (j == 1) pool_item<1>(F, R, p, rb, c); else if (j == 2) pool_item<2>(F, R, p, rb, c); else pool_item<3>(F, R, p, rb, c); }
}

__device__ __forceinline__ void conv_fix_item(Frame& F, int l, int pm, int ch) {
    bf16_t* Gb = (bf16_t*)(F.ws + WS_G);
    const float* cw = F.in[I_CW] + (size_t)l * 3 * DFF; const float* cb = F.in[I_CB] + (size_t)l * DFF;
    const float* ahead = (const float*)(F.ws + WS_AHEAD); const float* bhead = (const float*)(F.ws + WS_BHEAD); const float* atail = (const float*)(F.ws + WS_ATAIL);
    float t0[8], t1[8], a0[8], a1[8], b0[8], b1[8], o[8];
#pragma unroll
    for (int h2 = 0; h2 < 2; ++h2) {
        const f32x4 x0 = *(const f32x4*)(atail + ((size_t)(pm - 1) * 2 + 0) * DFF + ch + 4 * h2), x1 = *(const f32x4*)(atail + ((size_t)(pm - 1) * 2 + 1) * DFF + ch + 4 * h2);
        const f32x4 y0 = *(const f32x4*)(ahead + ((size_t)pm * 2 + 0) * DFF + ch + 4 * h2), y1 = *(const f32x4*)(ahead + ((size_t)pm * 2 + 1) * DFF + ch + 4 * h2);
        const f32x4 z0 = *(const f32x4*)(bhead + ((size_t)pm * 2 + 0) * DFF + ch + 4 * h2), z1 = *(const f32x4*)(bhead + ((size_t)pm * 2 + 1) * DFF + ch + 4 * h2);
#pragma unroll
        for (int e = 0; e < 4; ++e) { t0[4 * h2 + e] = x0[e]; t1[4 * h2 + e] = x1[e]; a0[4 * h2 + e] = y0[e]; a1[4 * h2 + e] = y1[e]; b0[4 * h2 + e] = z0[e]; b1[4 * h2 + e] = z1[e]; } }
#pragma unroll
    for (int e = 0; e < 8; ++e) { const float c = cb[ch + e] + t0[e] * cw[ch + e] + t1[e] * cw[DFF + ch + e] + a0[e] * cw[2 * DFF + ch + e]; o[e] = silu_mul(c, b0[e]); }
    *(u32x4*)(Gb + (size_t)(pm * 256) * DFF + ch) = pk8(o);
#pragma unroll
    for (int e = 0; e < 8; ++e) { const float c = cb[ch + e] + t1[e] * cw[ch + e] + a0[e] * cw[DFF + ch + e] + a1[e] * cw[2 * DFF + ch + e]; o[e] = silu_mul(c, b1[e]); }
    *(u32x4*)(Gb + (size_t)(pm * 256 + 1) * DFF + ch) = pk8(o);
}
__device__ __forceinline__ void conv_fix_local(Frame& F, int l, const pg8::StaticOrder& S) {
    pg8::Unit u;
    for (int i = 0; S.next(i, u); ++i)
        if (u.pm < MP / 256 && (u.pm & 7) != 0)
            for (int it = F.tid; it < DFF / 8; it += NTHREADS) conv_fix_item(F, l, u.pm, 8 * it);
    asm volatile("s_waitcnt vmcnt(0)" ::: "memory");
    __syncthreads();
}

constexpr int HG_LF = 0;
constexpr int HG_TOT = HG_LF + 16384;
constexpr int HG_G = HG_TOT + 2048;
constexpr int HG_QT = HG_G + 512;
constexpr int HG_KS = HG_QT + 32 * 272;
constexpr int HG_V = HG_KS + 32 * 320;
constexpr int HG_PF = HG_V + 32 * 320;
constexpr int HG_OX = HG_PF + 2048;
constexpr int HG_END = HG_OX + 32768;
static_assert(HG_END <= LDS_TAB, "HGRN LDS");

template <bool SMP>
__device__ __forceinline__ void hgrn_unit(Frame& F, int m, int b, int h) {
    LAS unsigned char* L = F.lds;
    const bf16_t* H = (const bf16_t*)(F.ws + WS_H); const float* LFg = (const float*)(F.ws + WS_LF); bf16_t* MIX = (bf16_t*)(F.ws + WS_MIX);
    const float* gn = F.in[I_HNG] + (size_t)m * 512 + h * 128;
    const int tid = opq(F.tid), lane = tid & 63, wave = __builtin_amdgcn_readfirstlane(tid >> 6), r = lane & 31, hh = lane >> 5;
    const int nb = wave & 3, kh = wave >> 2;
    const size_t row0 = SMP ? (size_t)MP + (size_t)b * ST : (size_t)b * PT;
    const int nsteps = SMP ? 1 : PT / 32;
    f32x16 S[2];
    if (SMP) { const float* s0 = F.in[I_SH] + (((size_t)m * SB + b) * NH + h) * 128 * 128 + (size_t)(64 * kh + 4 * hh) * 128 + 32 * nb + r;
#pragma unroll
        for (int kbl = 0; kbl < 2; ++kbl)
#pragma unroll
            for (int i = 0; i < 16; ++i) S[kbl][i] = s0[(32 * kbl + (i & 3) + 8 * (i >> 2)) * 128];
    } else {
#pragma unroll
        for (int kbl = 0; kbl < 2; ++kbl)
#pragma unroll
            for (int i = 0; i < 16; ++i) S[kbl][i] = 0.f;
    }
    const int et = tid >> 4, ek = (tid & 15) * 8;
    const bool valid = !SMP || et < ST;
    f32x4 lf0 = {0.f, 0.f, 0.f, 0.f}, lf1 = {0.f, 0.f, 0.f, 0.f}; u32x4 qw = {0u, 0u, 0u, 0u}, vw = {0u, 0u, 0u, 0u}, gw = {0u, 0u, 0u, 0u};
    if (valid) { const size_t row = row0 + et;
        lf0 = *(const f32x4*)(LFg + row * 512 + h * 128 + ek); lf1 = *(const f32x4*)(LFg + row * 512 + h * 128 + ek + 4);
        qw = *(const u32x4*)(H + row * INC + C_AQ + h * 128 + ek); vw = *(const u32x4*)(H + row * INC + C_AI + h * 128 + ek); gw = *(const u32x4*)(H + row * INC + C_AG + h * 128 + ek); }
    for (int step = 0; step < nsteps; ++step) {
        const size_t row = row0 + (size_t)step * 32 + et;
        *(LAS f32x4*)(L + HG_LF + (et * 128 + ek) * 4) = lf0; *(LAS f32x4*)(L + HG_LF + (et * 128 + ek + 4) * 4) = lf1;
        f32x4 nlf0 = lf0, nlf1 = lf1; u32x4 nqw = qw, nvw = vw, ngw = gw;
        if (!SMP && step + 1 < nsteps) { const size_t rn = row + 32;
            nlf0 = *(const f32x4*)(LFg + rn * 512 + h * 128 + ek); nlf1 = *(const f32x4*)(LFg + rn * 512 + h * 128 + ek + 4);
            nqw = *(const u32x4*)(H + rn * INC + C_AQ + h * 128 + ek); nvw = *(const u32x4*)(H + rn * INC + C_AI + h * 128 + ek); ngw = *(const u32x4*)(H + rn * INC + C_AG + h * 128 + ek); }
        __syncthreads();
        { const int k = tid & 127, tq = tid >> 7; LAS float* p = (LAS float*)(L + HG_LF) + (8 * tq) * 128 + k; float vs[8];
#pragma unroll
            for (int i = 0; i < 8; ++i) vs[i] = p[i * 128];
#pragma unroll
            for (int i = 1; i < 8; ++i) vs[i] += vs[i - 1];
#pragma unroll
            for (int i = 0; i < 8; ++i) p[i * 128] = vs[i];
            ((LAS float*)(L + HG_TOT))[tq * 128 + k] = vs[7]; }
        __syncthreads();
        { float bcum[8];
            { const f32x4 c0 = *(LAS f32x4*)(L + HG_LF + (et * 128 + ek) * 4), c1 = *(LAS f32x4*)(L + HG_LF + (et * 128 + ek + 4) * 4);
#pragma unroll
              for (int e = 0; e < 4; ++e) { bcum[e] = c0[e]; bcum[4 + e] = c1[e]; } }
            for (int gq = 0; gq < (et >> 3); ++gq) { const f32x4 c0 = *(LAS f32x4*)(L + HG_TOT + (gq * 128 + ek) * 4), c1 = *(LAS f32x4*)(L + HG_TOT + (gq * 128 + ek + 4) * 4);
#pragma unroll
                for (int e = 0; e < 4; ++e) { bcum[e] += c0[e]; bcum[4 + e] += c1[e]; } }
            float qv[8]; unpk8(qw, qv);
            float qt[8], kt[8];
#pragma unroll
            for (int e = 0; e < 8; ++e) { const float lfe = e < 4 ? lf0[e] : lf1[e - 4]; const float eb = __expf(bcum[e]);
                qt[e] = qv[e] * eb; kt[e] = (1.f - __expf(lfe)) * __expf(-bcum[e]);
                if (et == 31) ((LAS float*)(L + HG_G))[ek + e] = eb; }
            const u32x4 qp = pk8(qt), kp = pk8(kt);
            *(LAS u32x4*)(L + HG_QT + et * 272 + ek * 2) = qp;
            *(LAS u32x4*)(L + HG_KS + et * 320 + ek * 2) = kp;
            *(LAS u32x4*)(L + HG_V + et * 320 + ek * 2) = vw;
        }
        __syncthreads();
        if (wave == 0) {
            f32x16 pt;
#pragma unroll
            for (int i = 0; i < 16; ++i) pt[i] = 0.f;
#pragma unroll
            for (int st = 0; st < 8; ++st) { const bf16x8 a = *(const LAS bf16x8*)(L + HG_KS + r * 320 + (16 * st + 8 * hh) * 2), bq = *(const LAS bf16x8*)(L + HG_QT + r * 272 + (16 * st + 8 * hh) * 2);
                pt = MFMA32(a, bq, pt); }
#pragma unroll
            for (int i = 0; i < 16; ++i) if (crow(i, hh) > r) pt[i] = 0.f;
            *(LAS bf16x8*)(L + HG_PF + lane * 16) = pack_step(pt, 0); *(LAS bf16x8*)(L + HG_PF + 1024 + lane * 16) = pack_step(pt, 1);
        }
        f32x16 oacc;
#pragma unroll
        for (int i = 0; i < 16; ++i) oacc[i] = 0.f;
#pragma unroll
        for (int kbl = 0; kbl < 2; ++kbl)
#pragma unroll
            for (int s2 = 0; s2 < 2; ++s2) { const int k0 = 64 * kh + 32 * kbl + 16 * s2 + 4 * hh;
                const s16x4 lo = *(const LAS s16x4*)(L + HG_QT + r * 272 + k0 * 2), hi = *(const LAS s16x4*)(L + HG_QT + r * 272 + (k0 + 8) * 2);
                oacc = MFMA32(pack_step(S[kbl], s2), cat8(lo, hi), oacc); }
        __syncthreads();
        const int i16 = lane & 15, tq = i16 >> 2, tp = i16 & 3, gi = (lane >> 4) & 1;
        if (kh == 0) {
#pragma unroll
            for (int s2 = 0; s2 < 2; ++s2) { const int key0 = 16 * s2 + 4 * hh;
                const s16x4 lo = vtr(L + HG_V + (key0 + tq) * 320 + (32 * nb + 16 * gi + 4 * tp) * 2), hi = vtr(L + HG_V + (key0 + 8 + tq) * 320 + (32 * nb + 16 * gi + 4 * tp) * 2);
                const bf16x8 pf = *(const LAS bf16x8*)(L + HG_PF + s2 * 1024 + lane * 16);
                oacc = MFMA32(cat8(lo, hi), pf, oacc); }
        }
#pragma unroll
        for (int i = 0; i < 16; ++i) ((LAS float*)(L + HG_OX))[(kh * 128 + 32 * nb + crow(i, hh)) * 32 + r] = oacc[i];
#pragma unroll
        for (int kbl = 0; kbl < 2; ++kbl)
#pragma unroll
            for (int s2 = 0; s2 < 2; ++s2) { const int key0 = 16 * s2 + 8 * hh;
                const s16x4 alo = vtr(L + HG_KS + (key0 + tq) * 320 + (64 * kh + 32 * kbl + 16 * gi + 4 * tp) * 2), ahi = vtr(L + HG_KS + (key0 + 4 + tq) * 320 + (64 * kh + 32 * kbl + 16 * gi + 4 * tp) * 2);
                const s16x4 lo = vtr(L + HG_V + (key0 + tq) * 320 + (32 * nb + 16 * gi + 4 * tp) * 2), hi = vtr(L + HG_V + (key0 + 4 + tq) * 320 + (32 * nb + 16 * gi + 4 * tp) * 2);
                S[kbl] = MFMA32(cat8(alo, ahi), cat8(lo, hi), S[kbl]); }
#pragma unroll
        for (int kbl = 0; kbl < 2; ++kbl)
#pragma unroll
            for (int i = 0; i < 16; ++i) S[kbl][i] *= ((LAS float*)(L + HG_G))[64 * kh + 32 * kbl + crow(i, hh)];
        __syncthreads();
        { float o[8], ss = 0.f;
#pragma unroll
            for (int e = 0; e < 8; ++e) { o[e] = ((LAS float*)(L + HG_OX))[(ek + e) * 32 + et] + ((LAS float*)(L + HG_OX))[(128 + ek + e) * 32 + et]; ss += o[e] * o[e]; }
            ss += __shfl_xor(ss, 1); ss += __shfl_xor(ss, 2); ss += __shfl_xor(ss, 4); ss += __shfl_xor(ss, 8);
            const float rstd = 1.f / sqrtf(ss * (1.f / 128.f) + RMS_EPS);
            float gv[8]; unpk8(gw, gv);
            const f32x4 g0 = *(const f32x4*)(gn + ek), g1 = *(const f32x4*)(gn + ek + 4);
#pragma unroll
            for (int e = 0; e < 8; ++e) { const float y = o[e] * rstd * (e < 4 ? g0[e] : g1[e - 4]); o[e] = y * (gv[e] / (1.f + __expf(-gv[e]))); }
            if (valid) *(u32x4*)(MIX + row * D + h * 128 + ek) = pk8(o);
        }
        lf0 = nlf0; lf1 = nlf1; qw = nqw; vw = nvw; gw = ngw;
    }
    { float* so = (SMP ? F.out + O_HS + (((size_t)m * SB + b) * NH + h) * 128 * 128 : F.out + O_HP + (((size_t)m * PB + b) * NH + h) * 128 * 128);
      const int l2 = opq(lane); float* sp = so + (size_t)(64 * kh + 4 * (l2 >> 5)) * 128 + 32 * nb + (l2 & 31);
#pragma unroll
      for (int kbl = 0; kbl < 2; ++kbl)
#pragma unroll
        for (int i = 0; i < 16; ++i) sp[(32 * kbl + (i & 3) + 8 * (i >> 2)) * 128] = S[kbl][i]; }
    __syncthreads();
}

constexpr int AT_KP = 272, AT_VP = 320;
constexpr int AT_KB = 64 * AT_KP, AT_VB = 64 * AT_VP;
constexpr int AT_TILE = AT_KB + AT_VB;
static_assert(4 * AT_TILE <= LDS_TAB && (8 * 66 * 64 + 64 * 64 + 8 * 64) * 4 <= LDS_TAB && 2 * AT_TILE + 8 * 2 * 32 * 144 <= LDS_TAB, "attention LDS");

__device__ __forceinline__ void attn_build_tab(Frame& F, int h) {
    if (F.tid < 256) { const int rel = F.tid - 128, n = rel < 0 ? -rel : rel;
        int bk = n;
        if (n >= 8) bk = 8 + (n >= 12) + (n >= 16) + (n >= 23) + (n >= 32) + (n >= 46) + (n >= 64) + (n >= 91);
        if (rel > 0) bk += 16;
        ((LAS float*)(F.lds + LDS_TAB))[F.tid] = F.in[I_RB][bk * NH + h] * LOG2E; }
}
struct AttnState { f32x16 o[4]; float m, l; };
template <bool MASK_END>
__device__ __forceinline__ void attn_tile(const LAS unsigned char* Kt, const LAS unsigned char* Vt, int vh, const bf16x8 (&qf)[4], AttnState& A, int kpos0, int qpos, int qpos_min, int kv_end,
                                          const LAS float* tab, int r, int hh, int lane) {
    f32x16 st[2];
#pragma unroll
    for (int kb = 0; kb < 2; ++kb) {
#pragma unroll
        for (int i = 0; i < 16; ++i) st[kb][i] = 0.f;
#pragma unroll
        for (int s = 0; s < 4; ++s) { const bf16x8 a = *(const LAS bf16x8*)(Kt + (32 * kb + r) * AT_KP + (vh * 64 + 16 * s + 8 * hh) * 2); st[kb] = MFMA32(a, qf[s], st[kb]); }
    }
    constexpr float C2 = 0.125f * LOG2E;
    const bool far = (kpos0 + 63) <= (qpos_min - 91);
    if (far) { const float bc = tab[0];
#pragma unroll
        for (int kb = 0; kb < 2; ++kb)
#pragma unroll
            for (int i = 0; i < 16; ++i) st[kb][i] = st[kb][i] * C2 + bc;
    } else {
#pragma unroll
        for (int kb = 0; kb < 2; ++kb)
#pragma unroll
            for (int i = 0; i < 16; ++i) { const int kpos = kpos0 + 32 * kb + crow(i, hh); int rel = kpos - qpos; rel = rel < -128 ? -128 : (rel > 127 ? 127 : rel);
                float x = st[kb][i] * C2 + tab[rel + 128];
                if (MASK_END) x = (kpos < kv_end) ? x : -1e30f;
                st[kb][i] = x; }
    }
    float mx = st[0][0];
#pragma unroll
    for (int kb = 0; kb < 2; ++kb)
#pragma unroll
        for (int i = 0; i < 16; ++i) mx = fmaxf(mx, st[kb][i]);
    mx = fmaxf(mx, __shfl_xor(mx, 32));
    if (__any(mx > A.m + 8.f)) {
        const float mnew = fmaxf(A.m, mx), alpha = __builtin_amdgcn_exp2f(A.m - mnew);
        A.m = mnew; A.l *= alpha;
#pragma unroll
        for (int mb = 0; mb < 4; ++mb)
#pragma unroll
            for (int i = 0; i < 16; ++i) A.o[mb][i] *= alpha;
    }
    const float mref = A.m;
    float ls = 0.f;
#pragma unroll
    for (int kb = 0; kb < 2; ++kb)
#pragma unroll
        for (int i = 0; i < 16; ++i) { const float p = __builtin_amdgcn_exp2f(st[kb][i] - mref); st[kb][i] = p; ls += p; }
    A.l += ls;
    const int i16 = lane & 15, tq = i16 >> 2, tp = i16 & 3, gi = (lane >> 4) & 1;
#pragma unroll
    for (int kb = 0; kb < 2; ++kb)
#pragma unroll
        for (int s2 = 0; s2 < 2; ++s2) { const bf16x8 pf = pack_step(st[kb], s2); const int key0 = 32 * kb + 16 * s2 + 4 * hh;
#pragma unroll
            for (int mb = 0; mb < 4; ++mb) {
                const s16x4 lo = vtr(Vt + (key0 + tq) * AT_VP + (32 * mb + 16 * gi + 4 * tp) * 2), hi = vtr(Vt + (key0 + 8 + tq) * AT_VP + (32 * mb + 16 * gi + 4 * tp) * 2);
                A.o[mb] = MFMA32(cat8(lo, hi), pf, A.o[mb]); } }
}
__device__ __forceinline__ void attn_store(const f32x16 (&o)[4], const float* gnorm, float post, bf16_t* dst_row  , int hh, bool active) {
    float ss = 0.f;
#pragma unroll
    for (int mb = 0; mb < 4; ++mb)
#pragma unroll
        for (int i = 0; i < 16; ++i) ss += o[mb][i] * o[mb][i];
    ss += __shfl_xor(ss, 32);
    const float rstd = post / sqrtf(ss * (1.f / 128.f) + RMS_EPS);
    if (active) {
#pragma unroll
        for (int mb = 0; mb < 4; ++mb)
#pragma unroll
            for (int g4 = 0; g4 < 4; ++g4) { const int dv = 32 * mb + 8 * g4 + 4 * hh; const f32x4 gv = *(const f32x4*)(gnorm + dv);
                u32x2 w; w.x = pk2(o[mb][4 * g4] * rstd * gv[0], o[mb][4 * g4 + 1] * rstd * gv[1]); w.y = pk2(o[mb][4 * g4 + 2] * rstd * gv[2], o[mb][4 * g4 + 3] * rstd * gv[3]);
                *(u32x2*)(dst_row + dv) = w; }
    }
}

__device__ __forceinline__ void attn_prompt_unit(Frame& F, int m, int b, int h, int qb) {
    LAS unsigned char* L = F.lds; const LAS float* tab = (const LAS float*)(L + LDS_TAB);
    const bf16_t* H = (const bf16_t*)(F.ws + WS_H); bf16_t* MIX = (bf16_t*)(F.ws + WS_MIX);
    const int tid = opq(F.tid), lane = tid & 63, wave = __builtin_amdgcn_readfirstlane(tid >> 6), r = lane & 31, hh = lane >> 5, vh = wave >> 2, wq = wave & 3;
    const size_t rowb = (size_t)b * PT;
    const int q0a = qb * 256 + wq * 32, q0b = q0a + 128, qca = q0a >> 6, qcb = q0b >> 6, nkt = 4 * qb + 4;
    attn_build_tab(F, h);
    LAS unsigned char* qs = L + 2 * AT_TILE + wave * (2 * 32 * 144) + r * 144 + 16 * hh;
#pragma unroll
    for (int s = 0; s < 4; ++s) { *(LAS bf16x8*)(qs + 32 * s) = *(const bf16x8*)(H + (rowb + q0a + r) * INC + C_BQ + h * 128 + vh * 64 + 16 * s + 8 * hh);
        *(LAS bf16x8*)(qs + 32 * 144 + 32 * s) = *(const bf16x8*)(H + (rowb + q0b + r) * INC + C_BQ + h * 128 + vh * 64 + 16 * s + 8 * hh); }
    AttnState A0, A1;
#pragma unroll
    for (int mb = 0; mb < 4; ++mb)
#pragma unroll
        for (int i = 0; i < 16; ++i) { A0.o[mb][i] = 0.f; A1.o[mb][i] = 0.f; }
    A0.m = -1e30f; A0.l = 0.f; A1.m = -1e30f; A1.l = 0.f;
    u32x4 kr[2], vr[2];
#define AT_LD(kt) do { _Pragma("unroll") for (int i_ = 0; i_ < 2; ++i_) { const int c_ = tid + 512 * i_, key_ = c_ >> 4, ch_ = c_ & 15; const bf16_t* src_ = H + (rowb + 64 * (kt) + key_) * INC + h * 128 + ch_ * 8; \
        kr[i_] = *(const u32x4*)(src_ + C_BK); vr[i_] = *(const u32x4*)(src_ + C_BV); } } while (0)
#define AT_ST(buf) do { _Pragma("unroll") for (int i_ = 0; i_ < 2; ++i_) { const int c_ = tid + 512 * i_, key_ = c_ >> 4, ch_ = c_ & 15; \
        *(LAS u32x4*)(L + (buf) * AT_TILE + key_ * AT_KP + ch_ * 16) = kr[i_]; *(LAS u32x4*)(L + (buf) * AT_TILE + AT_KB + key_ * AT_VP + ch_ * 16) = vr[i_]; } } while (0)
    AT_LD(0); AT_ST(0);
    AT_LD(1);
    __syncthreads();
    for (int kt = 0; kt < nkt; ++kt) {
        if (kt <= qca) { bf16x8 qf[4];
#pragma unroll
            for (int s = 0; s < 4; ++s) qf[s] = *(const LAS bf16x8*)(qs + 32 * s);
            attn_tile<false>(L + (kt & 1) * AT_TILE, L + (kt & 1) * AT_TILE + AT_KB, vh, qf, A0, 64 * kt, q0a + r, q0a, 0, tab, r, hh, lane); }
        if (kt <= qcb) { bf16x8 qf[4];
#pragma unroll
            for (int s = 0; s < 4; ++s) qf[s] = *(const LAS bf16x8*)(qs + 32 * 144 + 32 * s);
            attn_tile<false>(L + (kt & 1) * AT_TILE, L + (kt & 1) * AT_TILE + AT_KB, vh, qf, A1, 64 * kt, q0b + r, q0b, 0, tab, r, hh, lane); }
        if (kt + 1 < nkt) AT_ST((kt + 1) & 1);
        if (kt + 2 < nkt) AT_LD(kt + 2);
        __syncthreads();
    }
#undef AT_LD
#undef AT_ST
    { const float l0 = A0.l + __shfl_xor(A0.l, 32), i0 = 1.f / l0, l1 = A1.l + __shfl_xor(A1.l, 32), i1 = 1.f / l1;
#pragma unroll
        for (int mb = 0; mb < 4; ++mb)
#pragma unroll
            for (int i = 0; i < 16; ++i) { A0.o[mb][i] *= i0; A1.o[mb][i] *= i1; } }
    LAS float* X = (LAS float*)L;
    if (vh == 1) {
#pragma unroll
        for (int mb = 0; mb < 4; ++mb)
#pragma unroll
            for (int i = 0; i < 16; ++i) { X[(wq * 64 + mb * 16 + i) * 64 + lane] = A0.o[mb][i]; X[((4 + wq) * 64 + mb * 16 + i) * 64 + lane] = A1.o[mb][i]; }
    }
    __syncthreads();
    if (vh == 0) {
        const float lam = ((const float*)(F.ws + WS_TAB))[TB_LAM + m];
        const float lam_init = (m == 0) ? 0.2f : 0.47071302f;
#pragma unroll
        for (int mb = 0; mb < 4; ++mb)
#pragma unroll
            for (int i = 0; i < 16; ++i) A0.o[mb][i] -= lam * X[(wq * 64 + mb * 16 + i) * 64 + lane];
        attn_store(A0.o, F.in[I_DNG] + (size_t)m * 128, 1.f - lam_init, MIX + (rowb + q0a + r) * D + 512 + h * 128, hh, true);
#pragma unroll
        for (int mb = 0; mb < 4; ++mb)
#pragma unroll
            for (int i = 0; i < 16; ++i) A1.o[mb][i] -= lam * X[((4 + wq) * 64 + mb * 16 + i) * 64 + lane];
        attn_store(A1.o, F.in[I_DNG] + (size_t)m * 128, 1.f - lam_init, MIX + (rowb + q0b + r) * D + 512 + h * 128, hh, true);
    }
    __syncthreads();
}

__device__ __forceinline__ void attn_sample_unit(Frame& F, int m, int b, int h) {
    LAS unsigned char* L = F.lds; const LAS float* tab = (const LAS float*)(L + LDS_TAB);
    const bf16_t* H = (const bf16_t*)(F.ws + WS_H); bf16_t* MIX = (bf16_t*)(F.ws + WS_MIX);
    const float* ck = F.in[I_CK] + (((size_t)m * SB + b) * PAST) * 512 + h * 128; const float* cv = F.in[I_CV] + (((size_t)m * SB + b) * PAST) * 512 + h * 128;
    const int tid = opq(F.tid), lane = tid & 63, wave = __builtin_amdgcn_readfirstlane(tid >> 6), r = lane & 31, hh = lane >> 5, vh = wave >> 2, ks = wave & 3;
    const size_t rows = (size_t)MP + (size_t)b * ST;
    attn_build_tab(F, h);
    bf16x8 qf[4];
#pragma unroll
    for (int s = 0; s < 4; ++s) qf[s] = *(const bf16x8*)(H + (rows + (r & 15)) * INC + C_BQ + h * 128 + vh * 64 + 16 * s + 8 * hh);
    AttnState A;
#pragma unroll
    for (int mb = 0; mb < 4; ++mb)
#pragma unroll
        for (int i = 0; i < 16; ++i) A.o[mb][i] = 0.f;
    A.m = -1e30f; A.l = 0.f;
    constexpr int NT = PAST / 64 + 1;
    for (int it = 0; it < (NT + 3) / 4; ++it) {
#pragma unroll 1
        for (int j = 0; j < 4; ++j) { const int T = 4 * it + j;
#pragma unroll
            for (int i = 0; i < 2; ++i) { const int c = tid + 512 * i, key = c >> 4, ch = c & 15;
                u32x4 kw = {0u, 0u, 0u, 0u}, vw = {0u, 0u, 0u, 0u};
                if (T < PAST / 64) { const float* pk = ck + (size_t)(64 * T + key) * 512 + ch * 8; const float* pv = cv + (size_t)(64 * T + key) * 512 + ch * 8;
                    const f32x4 k0 = *(const f32x4*)pk, k1 = *(const f32x4*)(pk + 4), v0 = *(const f32x4*)pv, v1 = *(const f32x4*)(pv + 4);
                    kw.x = pk2(k0[0], k0[1]); kw.y = pk2(k0[2], k0[3]); kw.z = pk2(k1[0], k1[1]); kw.w = pk2(k1[2], k1[3]);
                    vw.x = pk2(v0[0], v0[1]); vw.y = pk2(v0[2], v0[3]); vw.z = pk2(v1[0], v1[1]); vw.w = pk2(v1[2], v1[3]); }
                else if (T == PAST / 64 && key < ST) { const bf16_t* src = H + (rows + key) * INC + h * 128 + ch * 8; kw = *(const u32x4*)(src + C_BK); vw = *(const u32x4*)(src + C_BV); }
                *(LAS u32x4*)(L + j * AT_TILE + key * AT_KP + ch * 16) = kw; *(LAS u32x4*)(L + j * AT_TILE + AT_KB + key * AT_VP + ch * 16) = vw; } }
        __syncthreads();
        { const int T = 4 * it + ks;
            if (T < NT - 1) attn_tile<false>(L + ks * AT_TILE, L + ks * AT_TILE + AT_KB, vh, qf, A, 64 * T, PAST + (r & 15), PAST, 0, tab, r, hh, lane);
            else if (T == NT - 1) attn_tile<true>(L + ks * AT_TILE, L + ks * AT_TILE + AT_KB, vh, qf, A, 64 * T, PAST + (r & 15), PAST, PAST + ST, tab, r, hh, lane); }
        __syncthreads();
    }
    const float lt = A.l + __shfl_xor(A.l, 32);
    LAS float* X = (LAS float*)L;
#pragma unroll
    for (int mb = 0; mb < 4; ++mb)
#pragma unroll
        for (int i = 0; i < 16; ++i) X[(wave * 66 + mb * 16 + i) * 64 + lane] = A.o[mb][i];
    X[(wave * 66 + 64) * 64 + lane] = A.m; X[(wave * 66 + 65) * 64 + lane] = lt;
    LAS float* Y = X + 8 * 66 * 64;
    LAS float* SS = Y + 64 * 64;
    __syncthreads();
    {
        const float lam = ((const float*)(F.ws + WS_TAB))[TB_LAM + m];
        float coef[8];
#pragma unroll
        for (int v2 = 0; v2 < 2; ++v2) {
            float M = -1e30f;
#pragma unroll
            for (int k = 0; k < 4; ++k) M = fmaxf(M, X[((v2 * 4 + k) * 66 + 64) * 64 + lane]);
            float Ls = 0.f;
#pragma unroll
            for (int k = 0; k < 4; ++k) { coef[v2 * 4 + k] = __builtin_amdgcn_exp2f(X[((v2 * 4 + k) * 66 + 64) * 64 + lane] - M); Ls += coef[v2 * 4 + k] * X[((v2 * 4 + k) * 66 + 65) * 64 + lane]; }
            const float sc = (v2 == 0 ? 1.f : -lam) / Ls;
#pragma unroll
            for (int k = 0; k < 4; ++k) coef[v2 * 4 + k] *= sc;
        }
        float ss = 0.f;
#pragma unroll
        for (int i8 = 0; i8 < 8; ++i8) { const int row = 8 * wave + i8; float y = 0.f;
#pragma unroll
            for (int p = 0; p < 8; ++p) y += coef[p] * X[(p * 66 + row) * 64 + lane];
            Y[row * 64 + lane] = y; ss += y * y; }
        SS[wave * 64 + lane] = ss;
    }
    __syncthreads();
    if (wave == 0) {
        float ss = 0.f;
#pragma unroll
        for (int w = 0; w < 8; ++w) ss += SS[w * 64 + lane];
        ss += __shfl_xor(ss, 32);
        const float lam_init = (m == 0) ? 0.2f : 0.47071302f;
        const float rstd = (1.f - lam_init) / sqrtf(ss * (1.f / 128.f) + RMS_EPS);
        const float* gnorm = F.in[I_DNG] + (size_t)m * 128;
        bf16_t* dst_row = MIX + (rows + (r & 15)) * D + 512 + h * 128;
        if (r < ST) {
#pragma unroll
            for (int mb = 0; mb < 4; ++mb)
#pragma unroll
                for (int g4 = 0; g4 < 4; ++g4) { const int dv = 32 * mb + 8 * g4 + 4 * hh; const f32x4 gv = *(const f32x4*)(gnorm + dv); const LAS float* yp = Y + (mb * 16 + 4 * g4) * 64 + lane;
                    u32x2 w; w.x = pk2(yp[0] * rstd * gv[0], yp[64] * rstd * gv[1]); w.y = pk2(yp[128] * rstd * gv[2], yp[192] * rstd * gv[3]);
                    *(u32x2*)(dst_row + dv) = w; }
        }
    }
    __syncthreads();
}

__device__ __forceinline__ void phase_mixer(Frame& F, int m, int qsel = 0) {
    const int G = F.G, bid = F.bid;
    if (PHM & 0x1000) for (int u = bid; u < PB * NH; u += G) hgrn_unit<false>(F, m, u >> 2, u & 3);
#if PROBE_HG
    for (int u = bid; u < PB * NH; u += G) hgrn_unit<false>(F, m, u >> 2, u & 3);
#endif
    if (PHM & 0x2000) for (int u = (G >= 256 ? (bid >= 128 ? bid - 128 : bid + G - 128) : bid); u < SB * NH; u += G) attn_sample_unit(F, m, u >> 2, u & 3);
#if PROBE_SA
    for (int u = (G >= 256 ? (bid >= 128 ? bid - 128 : bid + G - 128) : bid); u < SB * NH; u += G) attn_sample_unit(F, m, u >> 2, u & 3);
#endif
    if (PHM & 0x4000) {
        gu32* head = (gu32*)(F.ws + WS_CTL) + CW_QUEUE + 64 * m + 128 * qsel;
        volatile LAS int* slot = (volatile LAS int*)(F.lds + LDS_CTRL + 64);
        for (;;) {
            if (F.tid == 0) *slot = (int)__hip_atomic_fetch_add(head, 1u, __ATOMIC_RELAXED, __HIP_MEMORY_SCOPE_AGENT);
            __syncthreads();
            const int u = *slot;
            __syncthreads();
            if (u >= PB * NH * 8) break;
            const int qb = 7 - (u >> 7), bh = u & 127;
            attn_prompt_unit(F, m, bh >> 2, bh & 3, qb);
        }
    }
    if (PHM & 0x8000) for (int u = bid; u < SB * NH; u += G) hgrn_unit<true>(F, m, u >> 2, u & 3);
}

__global__ void __launch_bounds__(NTHREADS, 2) mega_fwd(Args args) {
    extern __shared__ __attribute__((aligned(16))) unsigned char lds_raw[];
    Frame F;
    F.lds = (LAS unsigned char*)lds_raw;
    F.tid = threadIdx.x; F.lane = F.tid & 63; F.wave = __builtin_amdgcn_readfirstlane(F.tid >> 6);
    const int wave_s = F.wave;
    F.bid = blockIdx.x; F.G = gridDim.x; F.in = (kin_t)__builtin_amdgcn_kernarg_segment_ptr(); F.out = (float*)F.in[24]; F.ws = (unsigned char*)F.in[25];
    if (F.tid < 128) ((LAS unsigned*)(F.lds + LDS_CTRL))[F.tid] = 0u;
    __syncthreads();
    unsigned* barw = (unsigned*)(F.ws + WS_CTL) + CW_BAR;
    XcdBarrier bar; bar.bar = barw; bar.x = 0; bar.st = nullptr;
    const bool single = args.single != 0;
    if (single) bar = xcd_barrier_post(barw, (volatile LAS unsigned*)(F.lds + LDS_CTRL + 32));
    const int lo = args.ph_lo, hi = args.ph_hi;
#define RUN(p) (lo <= (p) && (p) < hi)
#define SEAM() do { if (single) { XcdBarrier b2_ = bar; asm volatile("" : "+s"(b2_.bar)); xcd_barrier(b2_); } } while (0)
#define REFRESH() do { { int b_ = (int)blockIdx.x, g_ = (int)gridDim.x; asm volatile("" : "+s"(b_), "+s"(g_)); F.bid = b_; F.G = g_; } { kin_t kp_ = (kin_t)__builtin_amdgcn_kernarg_segment_ptr(); asm volatile("" : "+s"(kp_)); F.in = kp_; F.out = (float*)kp_[24]; F.ws = (unsigned char*)kp_[25]; } { int l_; asm volatile("v_mbcnt_lo_u32_b32 %0, -1, 0\n\tv_mbcnt_hi_u32_b32 %0, -1, %0" : "=v"(l_)); F.lane = l_; } F.wave = wave_s; F.tid = wave_s * 64 + F.lane; } while (0)
    int ph = 0;
    if ((PHM & 1) && RUN(ph)) { REFRESH(); phase_prologue(F); SEAM();
#if PROBE_PRO
        REFRESH(); phase_prologue(F); SEAM();
#endif
    } ++ph;
    for (int l = 0; l < 4; ++l) {
#define WSB(off) ((bf16_t*)(F.ws + (off)))
#define STATS(k) ((float*)(F.ws + WS_CTL) + CW_STATS + (size_t)(k) * MT * 2)
#define LN1REF(ll) LnRef{WSB(WS_Z), STATS(2 * (ll)), F.in[I_L1G] + (size_t)(ll) * D, F.in[I_L1B] + (size_t)(ll) * D, 0}
#define LN2REF(ll) LnRef{WSB(WS_ZB), STATS(2 * (ll) + 1), F.in[I_L2G] + (size_t)(ll) * D, F.in[I_L2B] + (size_t)(ll) * D, 0}
        if ((l & 1) == 0) {
            const int m = l >> 1;
            if ((PHM & 2) && RUN(ph)) {
                REFRESH();
                const float* ctlf = (const float*)(F.ws + WS_CTL);
                pg8::Gemm g{l == 0 ? WSB(WS_XB) : WSB(WS_ZB), (const bf16_t*)(F.ws + WS_WIN) + (size_t)m * INC * D, MP, INC, D, D, 0, l == 0 ? nullptr : STATS(2 * (l - 1) + 1)}; pg8::StaticOrder S; S.init(MP, INC, F.G, F.bid);
                EpiIn E{(bf16_t*)(F.ws + WS_H), (float*)(F.ws + WS_LF), (const float*)(F.ws + WS_TAB) + TB_LB + m * 512,
                        F.out + O_KP + (size_t)m * MP * 512, F.out + O_VP + (size_t)m * MP * 512, F.out + O_KS + (size_t)m * MS * 512, F.out + O_VS + (size_t)m * MS * 512,
                        STATS(l == 0 ? 0 : 2 * (l - 1) + 1), ctlf + (l == 0 ? UC_ZERO : UC_UIN), ctlf + (l == 0 ? UC_ZERO : UC_CIN), l == 0 ? 1 : 0};
                pg8::gemm_phase<EpiIn>(F.lds, g, S, E, F.tid);
                REFRESH(); sgemm_in_phase(F.lds, g.A + (size_t)MP * D, g.Bt, F.bid, F.G, F.tid, E);
                SEAM(); } ++ph;
            if ((PHM & 4) && RUN(ph)) { REFRESH(); phase_mixer(F, m); SEAM();
#if PROBE_MIXER
                REFRESH(); phase_mixer(F, m, 1); SEAM();
#endif
            } ++ph;
            if ((PHM & 8) && RUN(ph)) {
                REFRESH();
                pg8::Gemm g{(const bf16_t*)(F.ws + WS_MIX), (const bf16_t*)(F.ws + WS_WOUT) + (size_t)m * D * D, MP, D, D, D, 0, l == 0 ? nullptr : STATS(2 * (l - 1) + 1)}; pg8::StaticOrder S; S.init(MP, D, F.G, F.bid);
                LnRef P = LN2REF(l == 0 ? 0 : l - 1); if (l == 0) { P.Z = WSB(WS_XB); P.ident = 1; }
                EpiRes E{P, WSB(WS_Z), STATS(2 * l), nullptr};
                pg8::gemm_phase<EpiRes>(F.lds, g, S, E, F.tid);
                REFRESH(); sgemm_res_phase<128>(F.lds, g.A + (size_t)MP * D, D, 0, g.Bt, D, F.bid, F.G, F.tid, P, WSB(WS_Z), STATS(2 * l), nullptr);
                SEAM(); } ++ph;
        } else {
            const int p = l >> 1;
            if ((PHM & 16) && RUN(ph)) { REFRESH(); const LnRef R = LN2REF(l - 1); phase_pool_prep(F, R, p); SEAM(); } ++ph;
            ++ph;
            if ((PHM & 32) && RUN(ph)) {
                REFRESH();
                pg8::Gemm g{(const bf16_t*)(F.ws + WS_MIX), (const bf16_t*)(F.ws + WS_WPOOL) + (size_t)p * D * 256, MP, D, 256, D, 256, STATS(2 * (l - 1) + 1)}; pg8::StaticOrder S; S.init(MP, D, F.G, F.bid);
                EpiRes E{LN2REF(l - 1), WSB(WS_Z), STATS(2 * l), F.in[I_PSC] + (size_t)p * D};
                pg8::gemm_phase<EpiRes>(F.lds, g, S, E, F.tid);
                REFRESH(); { const LnRef P2 = LN2REF(l - 1); sgemm_res_phase<32>(F.lds, g.A + (size_t)MP * D, D, 256, g.Bt, 256, F.bid, F.G, F.tid, P2, WSB(WS_Z), STATS(2 * l), E.scale); }
                SEAM(); } ++ph;
        }
        ++ph;
        if ((PHM & 128) && RUN(ph)) {
            REFRESH();
            const float* ctlf = (const float*)(F.ws + WS_CTL);
            pg8::Gemm g{WSB(WS_Z), (const bf16_t*)(F.ws + WS_WUP) + (size_t)l * UPN * D, MT, UPN, D, D, 0, STATS(2 * l)}; pg8::StaticOrder S; S.init(MT, UPN, F.G, F.bid);
            EpiUpConv E{(bf16_t*)(F.ws + WS_G), F.in[I_CW] + (size_t)l * 3 * DFF, F.in[I_CB] + (size_t)l * DFF, F.in[I_SC] + (size_t)l * SB * 2 * DFF,
                        (float*)(F.ws + WS_AHEAD), (float*)(F.ws + WS_BHEAD), (float*)(F.ws + WS_ATAIL), F.out + O_CP + (size_t)l * PB * 2 * DFF, F.out + O_CS + (size_t)l * SB * 2 * DFF, (LAS float*)(F.lds + LDS_EX),
                        STATS(2 * l), ctlf + UC_UUP + (size_t)l * UPN, ctlf + UC_CUP + (size_t)l * UPN};
            pg8::gemm_phase<EpiUpConv>(F.lds, g, S, E, F.tid); SEAM();
#if PROBE_UP
            REFRESH(); pg8::gemm_phase<EpiUpConv>(F.lds, g, S, E, F.tid); SEAM();
#endif
            } ++ph;
        ++ph;
        if ((PHM & 512) && RUN(ph)) {
            REFRESH();
            pg8::Gemm g{(const bf16_t*)(F.ws + WS_G), (const bf16_t*)(F.ws + WS_WDN) + (size_t)l * D * DFF, MP, D, DFF, DFF, 0, STATS(2 * l)}; pg8::StaticOrder S; S.init(MP, D, F.G, F.bid);
            conv_fix_local(F, l, S); REFRESH();
            EpiRes E{LN1REF(l), WSB(WS_ZB), STATS(2 * l + 1), nullptr};
            pg8::gemm_phase<EpiRes>(F.lds, g, S, E, F.tid);
            REFRESH(); { const LnRef P1 = LN1REF(l); sgemm_res_phase<352>(F.lds, g.A + (size_t)MP * DFF, DFF, 0, g.Bt, DFF, F.bid, F.G, F.tid, P1, WSB(WS_ZB), STATS(2 * l + 1), nullptr); }
            SEAM(); } ++ph;
        if ((PHM & 1024) && RUN(ph) && l == 3) { REFRESH(); phase_ln_final(F, WSB(WS_ZB), F.in[I_L2G] + (size_t)3 * D, F.in[I_L2B] + (size_t)3 * D); } ++ph;
    }
#undef RUN
#undef SEAM
}
constexpr int N_PHASES = 1 + 4 * 8;

extern "C" void kernel_launch(void* const* d_in, const int* in_sizes, int n_in, void* d_out, int out_size, void* d_ws, size_t ws_size, hipStream_t stream) {
    static int grid = 0;
    if (grid == 0) {
        if (n_in != 24 || (size_t)out_size != O_END || ws_size < WS_END2) { fprintf(stderr, "kernel_launch: unexpected problem (n_in %d out %d ws %zu)\n", n_in, out_size, ws_size); grid = -1; return; }
        int dev = 0, cus = 0;
        if (hipGetDevice(&dev) != hipSuccess || hipDeviceGetAttribute(&cus, hipDeviceAttributeMultiprocessorCount, dev) != hipSuccess) { grid = -1; return; }
        if (hipFuncSetAttribute((const void*)mega_fwd, hipFuncAttributeMaxDynamicSharedMemorySize, LDS_BYTES) != hipSuccess) { fprintf(stderr, "kernel_launch: hipFuncSetAttribute failed\n"); grid = -1; return; }
        int per_cu = 0;
        if (hipOccupancyMaxActiveBlocksPerMultiprocessor(&per_cu, (const void*)mega_fwd, NTHREADS, LDS_BYTES) != hipSuccess || per_cu < 1) fprintf(stderr, "kernel_launch: occupancy query reports %d\n", per_cu);
        (void)hipGetLastError();
        grid = cus;
    }
    if (grid < 0) return;
    (void)hipMemsetAsync((char*)d_ws + WS_CTL, 0, CTL_ZERO_BYTES, stream);
    Args a{};
    for (int i = 0; i < 24; ++i) a.in[i] = (const float*)d_in[i];
    a.out = (float*)d_out; a.ws = (unsigned char*)d_ws; a.pad = 0;
#if MK_SINGLE
    a.ph_lo = 0; a.ph_hi = N_PHASES; a.single = 1;
    hipLaunchKernelGGL(mega_fwd, dim3(grid), dim3(NTHREADS), LDS_BYTES, stream, a);
#else
    for (int p = 0; p < N_PHASES; ++p) {
        const int k = (p - 1) % 8, l = (p - 1) / 8;
        if (p > 0 && (l & 1) == 1 && k == 1) continue;
        a.ph_lo = p; a.ph_hi = p + 1; a.single = 0;
        hipLaunchKernelGGL(mega_fwd, dim3(grid), dim3(NTHREADS), LDS_BYTES, stream, a);
    }
#endif
}
```

```cpp
#include <hip/hip_runtime.h>
#include <cstdio>
#include <cstdint>

#ifndef PHM
#define PHM 0xffff
#endif
#ifndef PROBE_MIXER
#define PROBE_MIXER 0
#endif
#ifndef EMU_BF16
#define EMU_BF16 0
#endif
#ifndef PROBE_LN
#define PROBE_LN 0
#endif
#ifndef PROBE_PRO
#define PROBE_PRO 0
#endif
#ifndef PROBE_HG
#define PROBE_HG 0
#endif
#ifndef PROBE_SA
#define PROBE_SA 0
#endif
#ifndef PROBE_UP
#define PROBE_UP 0
#endif
#ifndef MK_SINGLE
#define MK_SINGLE 1
#endif

#define LAS __attribute__((address_space(3)))
#define GAS __attribute__((address_space(1)))
typedef unsigned short bf16_t;
typedef short bf16x8 __attribute__((ext_vector_type(8)));
typedef short s16x4 __attribute__((ext_vector_type(4)));
typedef float f32x2 __attribute__((ext_vector_type(2)));
typedef float f32x4 __attribute__((ext_vector_type(4)));
typedef float f32x16 __attribute__((ext_vector_type(16)));
typedef unsigned u32x2 __attribute__((ext_vector_type(2)));
typedef unsigned u32x4 __attribute__((ext_vector_type(4)));
typedef __bf16 bf16x2_t __attribute__((ext_vector_type(2)));
typedef GAS unsigned gu32;

constexpr int D = 1024, PB = 32, PT = 2048, SB = 32, ST = 16, PAST = 4096;
constexpr int MP = PB * PT, MS = SB * ST, MT = MP + MS;
constexpr int INC = 3584, DFF = 2816, UPN = 2 * DFF, NH = 4;
constexpr int C_AQ = 0, C_AF = 512, C_AI = 1024, C_AG = 1536, C_BQ = 2048, C_BK = 2560, C_BV = 3072;
constexpr float DN_ALPHA = 1.681792830507429f;
constexpr float LN_EPS = 1e-5f, RMS_EPS = 1e-6f;
constexpr float LOG2E = 1.4426950408889634f;
constexpr int NWAVES = 8, NTHREADS = 512;

constexpr size_t O_YP = 0;
constexpr size_t O_YS = O_YP + (size_t)MP * D;
constexpr size_t O_KP = O_YS + (size_t)MS * D;
constexpr size_t O_VP = O_KP + (size_t)2 * MP * 512;
constexpr size_t O_HP = O_VP + (size_t)2 * MP * 512;
constexpr size_t O_PP = O_HP + (size_t)2 * PB * NH * 128 * 128;
constexpr size_t O_CP = O_PP + (size_t)2 * PB * 15 * D;
constexpr size_t O_KS = O_CP + (size_t)4 * PB * 2 * DFF;
constexpr size_t O_VS = O_KS + (size_t)2 * MS * 512;
constexpr size_t O_HS = O_VS + (size_t)2 * MS * 512;
constexpr size_t O_PS = O_HS + (size_t)2 * SB * NH * 128 * 128;
constexpr size_t O_CS = O_PS + (size_t)2 * SB * 15 * D;
constexpr size_t O_END = O_CS + (size_t)4 * SB * 2 * DFF;
static_assert(O_END == 214695936ull, "d_out size");

constexpr size_t WS_CTL = 0, CTL_ZERO_BYTES = 8u << 20;
constexpr size_t WS_WIN = CTL_ZERO_BYTES;
constexpr size_t WS_WOUT = WS_WIN + (size_t)2 * INC * D * 2;
constexpr size_t WS_WPOOL = WS_WOUT + (size_t)2 * D * D * 2;
constexpr size_t WS_WUP = WS_WPOOL + (size_t)2 * D * 256 * 2;
constexpr size_t WS_WDN = WS_WUP + (size_t)4 * UPN * D * 2;
constexpr size_t WS_TAB = WS_WDN + (size_t)4 * D * DFF * 2;
constexpr size_t WS_XB = WS_TAB + 65536;
constexpr size_t WS_Z = WS_XB + (size_t)MT * D * 2;
constexpr size_t WS_ZB = WS_Z + (size_t)MT * D * 2;
constexpr size_t WS_MIX = WS_Z + (size_t)MT * D * 4;
constexpr size_t WS_G = WS_MIX + (size_t)MT * D * 2;
constexpr size_t WS_A = WS_G + (size_t)MT * DFF * 2;
constexpr size_t WS_H = WS_A;
constexpr size_t WS_LF = WS_H + (size_t)MT * INC * 2;
constexpr size_t WS_AB = WS_A;
constexpr size_t WS_END = WS_A + (size_t)MT * UPN * 2;
static_assert(WS_LF + (size_t)MT * 512 * 4 <= WS_END, "H|LF inside region A");
constexpr size_t SIDE_BYTES = (size_t)(MT / 256) * 2 * DFF * 4;
constexpr size_t WS_AHEAD = WS_END, WS_BHEAD = WS_AHEAD + SIDE_BYTES, WS_ATAIL = WS_BHEAD + SIDE_BYTES, WS_END2 = WS_ATAIL + SIDE_BYTES;
static_assert(WS_END2 <= 2147483648ull, "workspace");
constexpr int CW_TMO = 0;
constexpr int CW_BAR = 4096;
constexpr int CW_QUEUE = 16384;
constexpr int CW_STATS = 262144;
constexpr int CW_UC = CW_STATS + 8 * MT * 2;
constexpr int UC_UUP = CW_UC, UC_CUP = UC_UUP + 4 * UPN, UC_UIN = UC_CUP + 4 * UPN, UC_CIN = UC_UIN + INC, UC_ZERO = UC_CIN + INC, UC_END = UC_ZERO + INC;
static_assert((size_t)UC_END * 4 <= CTL_ZERO_BYTES, "zeroed region");
constexpr int TB_LB = 0;
constexpr int TB_LAM = 1024;

constexpr int LDS_BYTES = 163840;
constexpr int LDS_CTRL = LDS_BYTES - 512;
constexpr int LDS_TAB = LDS_CTRL - 1024;
constexpr int LDS_STT = 131072 + 4096;
constexpr int LDS_CT = 131072 + 8192;
constexpr int LDS_EX = 131072;

__device__ __forceinline__ unsigned pk2(float lo, float hi) { f32x2 v = {lo, hi}; bf16x2_t b = __builtin_convertvector(v, bf16x2_t); return __builtin_bit_cast(unsigned, b); }
__device__ __forceinline__ float bflo(unsigned u) { return __builtin_bit_cast(float, u << 16); }
__device__ __forceinline__ float bfhi(unsigned u) { return __builtin_bit_cast(float, u & 0xffff0000u); }
__device__ __forceinline__ u32x4 pk8(const float* v) { u32x4 w; w.x = pk2(v[0], v[1]); w.y = pk2(v[2], v[3]); w.z = pk2(v[4], v[5]); w.w = pk2(v[6], v[7]); return w; }
__device__ __forceinline__ void unpk8(u32x4 w, float* v) { v[0] = bflo(w.x); v[1] = bfhi(w.x); v[2] = bflo(w.y); v[3] = bfhi(w.y); v[4] = bflo(w.z); v[5] = bfhi(w.z); v[6] = bflo(w.w); v[7] = bfhi(w.w); }
__device__ __forceinline__ float wave_sum(float v) {
#pragma unroll
    for (int o = 1; o < 64; o <<= 1) v += __shfl_xor(v, o);
    return v;
}
__device__ __forceinline__ int opq(int x) { asm volatile("" : "+v"(x)); return x; }
__device__ __forceinline__ int lane_id_v() { int l_; asm volatile("v_mbcnt_lo_u32_b32 %0, -1, 0\n\tv_mbcnt_hi_u32_b32 %0, -1, %0" : "=v"(l_)); return l_; }
__device__ __forceinline__ float silu_mul(float c, float b) { return c * __builtin_amdgcn_rcpf(1.f + __builtin_amdgcn_exp2f(-LOG2E * c)) * b; }
__device__ __forceinline__ int crow(int reg, int h) { return (reg & 3) + 8 * (reg >> 2) + 4 * h; }
__device__ __forceinline__ s16x4 vtr(const LAS unsigned char* p) { return __builtin_bit_cast(s16x4, __builtin_amdgcn_ds_read_tr16_b64_v4i16((LAS s16x4*)p)); }
__device__ __forceinline__ bf16x8 cat8(s16x4 lo, s16x4 hi) { return (bf16x8){lo[0], lo[1], lo[2], lo[3], hi[0], hi[1], hi[2], hi[3]}; }
#define MFMA32(a, b, c) __builtin_amdgcn_mfma_f32_32x32x16_bf16((a), (b), (c), 0, 0, 0)
__device__ __forceinline__ bf16x8 pack_step(const f32x16& x, int s) {
    u32x4 p; p.x = pk2(x[8 * s], x[8 * s + 1]); p.y = pk2(x[8 * s + 2], x[8 * s + 3]); p.z = pk2(x[8 * s + 4], x[8 * s + 5]); p.w = pk2(x[8 * s + 6], x[8 * s + 7]);
    return __builtin_bit_cast(bf16x8, p);
}

namespace pg8 {
constexpr int BM = 256, BK = 64, HALF = 128, HTB = HALF * BK * 2, STAGE_BYTES = 8 * HTB, NXCD = 8, WGM = 8;
__host__ __device__ __forceinline__ int lds_byte(int r, int c) { const int st = (r >> 4) * 2 + (c >> 5), rr = r & 15, cc = c & 31, ob = rr * 64 + cc * 2; return st * 1024 + (ob ^ (((ob >> 9) & 1) << 5)); }
__host__ __device__ __forceinline__ void stage_rc(int b, int& R, int& C) { const int st = b / 1024, sb = b % 1024, swz = sb ^ (((sb >> 9) & 1) << 5); R = (st >> 1) * 16 + swz / 64; C = (st & 1) * 32 + (swz % 64) / 2; }
__host__ __device__ __forceinline__ int perm32(int rho) { const int n = rho >> 4, i = rho & 15; return 8 * (i >> 2) + 4 * n + (i & 3); }
struct Unit { int pm, pn; };
struct Gemm { const bf16_t* A; const bf16_t* Bt; int M, N, K, lda, a_pn_step; const float* st; };
struct StaticOrder {
    int nM, nN, nwg, G, c;
    __device__ void init(int M, int N, int G_, int c_) { nM = M / BM; nN = N / BM; nwg = nM * nN; G = G_; c = c_; }
    __device__ bool next(int i, Unit& u) const {
        const long L = (long)i * G + c; if (L >= nwg) return false;
        int wgid = (int)L; { const int q = nwg / NXCD, r = nwg % NXCD, xcd = wgid % NXCD, off = wgid / NXCD; wgid = (xcd < r ? xcd * (q + 1) : r * (q + 1) + (xcd - r) * q) + off; }
        const int nig = WGM * nN, gid = wgid / nig, fm = gid * WGM, gsz = (nM - fm) < WGM ? (nM - fm) : WGM;
        u.pm = fm + ((wgid % nig) % gsz); u.pn = (wgid % nig) / gsz; return true;
    }
};
template <class Epi>
__device__ __forceinline__ void gemm_phase(LAS unsigned char* lds, const Gemm g, const StaticOrder& S, const Epi& E, int tid_in) {
    const int tid = tid_in, wid = __builtin_amdgcn_readfirstlane(tid >> 6), lane = tid & 63, wr = wid >> 2, wc = wid & 3, fr = lane & 15, fq = lane >> 4;
    const int K = g.K, nt = K / BK, lda = g.lda;
    unsigned voffA[2], voffB[2];
#define PG8_VOFF() do { const int t_ = wid * 64 + lane_id_v(); _Pragma("unroll") for (int i = 0; i < 2; ++i) { int R, C; stage_rc(t_ * 16 + i * 8192, R, C); const int Rb = (R & ~31) + perm32(R & 31); \
        voffA[i] = (unsigned)(R * lda + C) * 2u; voffB[i] = (unsigned)(Rb * K + C) * 2u; } } while (0)
    PG8_VOFF();
    const size_t kstep = (size_t)(BK * 2);
    const size_t hstepA = (size_t)HALF * lda * 2, hstepB = (size_t)HALF * K * 2;
    const size_t tstepA = 2 * hstepA, tstepB = 2 * hstepB;
    const size_t pnA = (size_t)g.a_pn_step * 2;
    const unsigned ldsw = (unsigned)wid * 1024u;
    const int aoff = lds_byte(wr * 64 + fr, fq * 8), boff = lds_byte(wc * 32 + fr, fq * 8);
#define PG8_SA(b, h) (((b) * 2 + (h)) * HTB)
#define PG8_SB(b, h) ((4 + (b) * 2 + (h)) * HTB)
#define PG8_STAGE(bufoff, gbase, voff) do { _Pragma("unroll") for (int _i = 0; _i < 2; ++_i) \
        __builtin_amdgcn_global_load_lds((const unsigned*)((const char*)(gbase) + (voff)[_i]), (LAS unsigned*)(lds + (bufoff) + ldsw + _i * 8192), 16, 0, 0); } while (0)
#define PG8_LDA(dst, b, h) do { _Pragma("unroll") for (int m = 0; m < 4; ++m) _Pragma("unroll") for (int k = 0; k < 2; ++k) dst[m][k] = *(const LAS bf16x8*)(lds + PG8_SA(b, h) + aoff + m * 2048 + k * 1024); } while (0)
#define PG8_LDB(dst, b, h) do { _Pragma("unroll") for (int n = 0; n < 2; ++n) _Pragma("unroll") for (int k = 0; k < 2; ++k) dst[n][k] = *(const LAS bf16x8*)(lds + PG8_SB(b, h) + boff + n * 2048 + k * 1024); } while (0)
#define PG8_MMA(ai, bj, At, Bt) do { __builtin_amdgcn_s_setprio(1); _Pragma("unroll") for (int m = 0; m < 4; ++m) _Pragma("unroll") for (int n = 0; n < 2; ++n) _Pragma("unroll") for (int k = 0; k < 2; ++k) \
        acc[ai][bj][m][n] = __builtin_amdgcn_mfma_f32_16x16x32_bf16(Bt[n][k], At[m][k], acc[ai][bj][m][n], 0, 0, 0); __builtin_amdgcn_s_setprio(0); } while (0)
#define PG8_WAIT_V(n) asm volatile("s_waitcnt vmcnt(" #n ")" ::: "memory")
#define PG8_WAIT_L(n) asm volatile("s_waitcnt lgkmcnt(" #n ")" ::: "memory")
#define PG8_BAR __builtin_amdgcn_s_barrier()
#define PG8_SCHED __builtin_amdgcn_sched_barrier(0)
    Unit cur, nxt; int ui = 0;
    if (!S.next(0, cur)) return;
#define PG8_STATS(pm_, par_) do { if (g.st) __builtin_amdgcn_global_load_lds((const unsigned*)(g.st + (size_t)(pm_) * 512 + 64 * wid + lane_id_v()), (LAS unsigned*)(lds + LDS_STT + (par_) * 2048 + wid * 256), 4, 0, 0); } while (0)
    PG8_STATS(cur.pm, 0); __builtin_amdgcn_sched_barrier(0); E.prefetch(cur, 0, wid, lds);
    f32x4 acc[2][2][4][2];
#pragma unroll
    for (int a = 0; a < 2; ++a)
#pragma unroll
        for (int b = 0; b < 2; ++b)
#pragma unroll
            for (int m = 0; m < 4; ++m)
#pragma unroll
                for (int n = 0; n < 2; ++n) acc[a][b][m][n] = (f32x4){0.f, 0.f, 0.f, 0.f};
    bf16x8 At[4][2], B0[2][2], B1[2][2];
    const char* cA = (const char*)g.A + (size_t)cur.pm * tstepA + (size_t)cur.pn * pnA; const char* cB = (const char*)g.Bt + (size_t)cur.pn * tstepB;
    PG8_STAGE(PG8_SB(0, 0), cB, voffB); PG8_STAGE(PG8_SB(0, 1), cB + hstepB, voffB); PG8_STAGE(PG8_SA(0, 0), cA, voffA); PG8_STAGE(PG8_SA(0, 1), cA + hstepA, voffA);
    if (wr == 1) PG8_BAR;
    PG8_WAIT_V(2); PG8_BAR;
    PG8_STAGE(PG8_SB(1, 0), cB + kstep, voffB); PG8_STAGE(PG8_SA(1, 0), cA + kstep, voffA); PG8_STAGE(PG8_SB(1, 1), cB + hstepB + kstep, voffB);
    PG8_WAIT_V(6); PG8_BAR;
    for (;;) {
        const bool has_next = S.next(ui + 1, nxt);
        const char* nA = has_next ? (const char*)g.A + (size_t)nxt.pm * tstepA + (size_t)nxt.pn * pnA : cA; const char* nB = has_next ? (const char*)g.Bt + (size_t)nxt.pn * tstepB : cB;
        for (int t = 0; t < nt; t += 2) {
            const bool last = (t == nt - 2);
            const char* a1 = cA + (size_t)(t + 1) * kstep;
            const char* a2 = last ? nA : cA + (size_t)(t + 2) * kstep; const char* b2 = last ? nB : cB + (size_t)(t + 2) * kstep;
            const char* a3 = a2 + kstep; const char* b3 = b2 + kstep;
            PG8_LDB(B0, 0, 0); PG8_LDB(B1, 0, 1); PG8_SCHED; PG8_LDA(At, 0, 0); PG8_STAGE(PG8_SA(1, 1), a1 + hstepA, voffA);
            PG8_WAIT_V(8); PG8_WAIT_L(0); PG8_BAR; PG8_MMA(0, 0, At, B0); PG8_MMA(0, 1, At, B1); PG8_BAR; PG8_SCHED;
            PG8_LDA(At, 0, 1); PG8_STAGE(PG8_SB(0, 0), b2, voffB); PG8_STAGE(PG8_SB(0, 1), b2 + hstepB, voffB); PG8_STAGE(PG8_SA(0, 0), a2, voffA);
            PG8_WAIT_V(8); PG8_WAIT_L(0); PG8_BAR; PG8_MMA(1, 0, At, B0); PG8_MMA(1, 1, At, B1); PG8_BAR; PG8_SCHED;
            PG8_LDB(B0, 1, 0); PG8_LDB(B1, 1, 1); PG8_SCHED; PG8_LDA(At, 1, 0); PG8_STAGE(PG8_SA(0, 1), a2 + hstepA, voffA);
            PG8_WAIT_V(8); PG8_WAIT_L(0); PG8_BAR; PG8_MMA(0, 0, At, B0); PG8_MMA(0, 1, At, B1); PG8_BAR; PG8_SCHED;
            PG8_LDA(At, 1, 1); PG8_STAGE(PG8_SB(1, 0), b3, voffB); PG8_STAGE(PG8_SB(1, 1), b3 + hstepB, voffB); PG8_STAGE(PG8_SA(1, 0), a3, voffA);
            PG8_WAIT_V(8); PG8_WAIT_L(0); PG8_BAR; PG8_MMA(1, 0, At, B0); PG8_MMA(1, 1, At, B1); PG8_BAR; PG8_SCHED;
        }
        if (wr == 0) PG8_BAR;
        { const int le = lane_id_v(); int wr_ = wr, wc_ = wc; asm volatile("" : "+s"(wr_), "+s"(wc_));
          E(acc, cur, wr_, wc_, le & 15, le >> 4, (const LAS float*)(lds + LDS_STT + (ui & 1) * 2048), (const LAS float*)(lds + LDS_CT + (ui & 1) * 4096)); }
        if (!has_next) break;
#pragma unroll
        for (int a = 0; a < 2; ++a)
#pragma unroll
            for (int b = 0; b < 2; ++b)
#pragma unroll
                for (int m = 0; m < 4; ++m)
#pragma unroll
                    for (int n = 0; n < 2; ++n) acc[a][b][m][n] = (f32x4){0.f, 0.f, 0.f, 0.f};
        cur = nxt; cA = nA; cB = nB; ++ui;
        PG8_VOFF();
        PG8_STATS(cur.pm, ui & 1); E.prefetch(cur, ui & 1, wid, lds);
        if (wr == 1) PG8_BAR;
    }
    PG8_WAIT_V(0);
    PG8_BAR;
#undef PG8_STATS
#undef PG8_VOFF
#undef PG8_SA
#undef PG8_SB
#undef PG8_STAGE
#undef PG8_LDA
#undef PG8_LDB
#undef PG8_MMA
#undef PG8_WAIT_V
#undef PG8_WAIT_L
#undef PG8_BAR
#undef PG8_SCHED
}
}

struct LnRef { const bf16_t* Z; const float* st; const float* g; const float* b; int ident; };
__device__ __forceinline__ void ln_row(const float* st, size_t row, int ident, float& mu, float& rstd) {
    mu = 0.f; rstd = 1.f;
    if (!ident) { const f32x2 s = *(const f32x2*)(st + row * 2); mu = s[0] * (1.f / D); rstd = 1.f / sqrtf(fmaxf(s[1] * (1.f / D) - mu * mu, 0.f) + LN_EPS); }
}
__device__ __forceinline__ void ln_row_lds(const LAS float* stt, int rl, int ident, float& mu, float& rstd) {
    mu = 0.f; rstd = 1.f;
    if (!ident) { const f32x2 s = *(const LAS f32x2*)(stt + 2 * rl); mu = s[0] * (1.f / D); rstd = __builtin_amdgcn_rsqf(fmaxf(s[1] * (1.f / D) - mu * mu, 0.f) + LN_EPS); }
}
struct EpiBf16 {
    __device__ __forceinline__ void prefetch(const pg8::Unit&, int, int, LAS unsigned char*) const {}
    bf16_t* O; int ldc;
    __device__ __forceinline__ void operator()(const f32x4 (&acc)[2][2][4][2], const pg8::Unit& u, int wr, int wc, int fr, int fq, const LAS float* stt, const LAS float* ct) const {
        const int row0 = u.pm * 256 + wr * 64 + fr, col0 = u.pn * 256 + wc * 32 + 8 * fq;
#pragma unroll
        for (int ai = 0; ai < 2; ++ai)
#pragma unroll
            for (int m = 0; m < 4; ++m) { bf16_t* rowp = O + (size_t)(row0 + ai * 128 + m * 16) * ldc + col0;
#pragma unroll
                for (int bj = 0; bj < 2; ++bj) { const f32x4 v0 = acc[ai][bj][m][0], v1 = acc[ai][bj][m][1];
                    u32x4 w; w.x = pk2(v0[0], v0[1]); w.y = pk2(v0[2], v0[3]); w.z = pk2(v1[0], v1[1]); w.w = pk2(v1[2], v1[3]);
                    *(u32x4*)(rowp + bj * 128) = w; } }
    }
};
struct EpiIn {
    __device__ __forceinline__ void prefetch(const pg8::Unit&, int, int, LAS unsigned char*) const {}
    bf16_t* H; float* LF; const float* lbv; float* kP; float* vP; float* kS; float* vS; const float* st; const float* uu; const float* cc; int ident;
    __device__ __forceinline__ void operator()(const f32x4 (&acc_in)[2][2][4][2], const pg8::Unit& u, int wr, int wc, int fr, int fq, const LAS float* stt, const LAS float* ct) const {
        f32x4 acc[2][2][4][2];
        { const int r0 = u.pm * 256 + wr * 64 + fr, c0 = u.pn * 256 + wc * 32 + 8 * fq;
#pragma unroll
          for (int bj = 0; bj < 2; ++bj) { const f32x4 u0 = *(const f32x4*)(uu + c0 + bj * 128), u1 = *(const f32x4*)(uu + c0 + bj * 128 + 4), k0 = *(const f32x4*)(cc + c0 + bj * 128), k1 = *(const f32x4*)(cc + c0 + bj * 128 + 4);
#pragma unroll
            for (int ai = 0; ai < 2; ++ai)
#pragma unroll
                for (int m = 0; m < 4; ++m) { float mu, rstd; ln_row_lds(stt, wr * 64 + fr + ai * 128 + m * 16, ident, mu, rstd);
                    const float nb = -mu * rstd; acc[ai][bj][m][0] = acc_in[ai][bj][m][0] * rstd + (u0 * nb + k0); acc[ai][bj][m][1] = acc_in[ai][bj][m][1] * rstd + (u1 * nb + k1); } } }
        const int row0 = u.pm * 256 + wr * 64 + fr, col0 = u.pn * 256 + wc * 32 + 8 * fq;
        const int kind = u.pn >> 1;
        if (kind == 1) {
#pragma unroll
            for (int bj = 0; bj < 2; ++bj) { const int c = col0 + bj * 128 - C_AF;
                const f32x4 l0 = *(const f32x4*)(lbv + c), l1 = *(const f32x4*)(lbv + c + 4);
#pragma unroll
                for (int ai = 0; ai < 2; ++ai)
#pragma unroll
                    for (int m = 0; m < 4; ++m) { const int row = row0 + ai * 128 + m * 16;
                        f32x4 o0, o1;
#pragma unroll
                        for (int e = 0; e < 4; ++e) {
                            { const float z = acc[ai][bj][m][0][e], ez = __builtin_amdgcn_exp2f(-LOG2E * fabsf(z)), sg = (z >= 0.f ? 1.f : ez) * __builtin_amdgcn_rcpf(1.f + ez), f = l0[e] + (1.f - l0[e]) * sg; o0[e] = fmaxf(__builtin_amdgcn_logf(f) * 0.6931471805599453f, -60.f); }
                            { const float z = acc[ai][bj][m][1][e], ez = __builtin_amdgcn_exp2f(-LOG2E * fabsf(z)), sg = (z >= 0.f ? 1.f : ez) * __builtin_amdgcn_rcpf(1.f + ez), f = l1[e] + (1.f - l1[e]) * sg; o1[e] = fmaxf(__builtin_amdgcn_logf(f) * 0.6931471805599453f, -60.f); }
                        }
                        float* dst = LF + (size_t)row * 512 + c; *(f32x4*)dst = o0; *(f32x4*)(dst + 4) = o1; } }
            return;
        }
#pragma unroll
        for (int ai = 0; ai < 2; ++ai)
#pragma unroll
            for (int m = 0; m < 4; ++m) { const int row = row0 + ai * 128 + m * 16; bf16_t* rowp = H + (size_t)row * INC + col0;
#pragma unroll
                for (int bj = 0; bj < 2; ++bj) { const f32x4 v0 = acc[ai][bj][m][0], v1 = acc[ai][bj][m][1];
                    u32x4 w; w.x = pk2(v0[0], v0[1]); w.y = pk2(v0[2], v0[3]); w.z = pk2(v1[0], v1[1]); w.w = pk2(v1[2], v1[3]);
                    *(u32x4*)(rowp + bj * 128) = w;
                    if (kind >= 5) { const int c = col0 + bj * 128 - (kind == 5 ? C_BK : C_BV);
                        float* dst = (row < MP) ? ((kind == 5 ? kP : vP) + (size_t)row * 512 + c) : ((kind == 5 ? kS : vS) + (size_t)(row - MP) * 512 + c);
                        *(f32x4*)dst = v0; *(f32x4*)(dst + 4) = v1; } } }
    }
};
struct EpiRes {
    __device__ __forceinline__ void prefetch(const pg8::Unit&, int, int, LAS unsigned char*) const {}
    LnRef P; bf16_t* Z; float* st_out; const float* scale;
    __device__ __forceinline__ void operator()(const f32x4 (&acc)[2][2][4][2], const pg8::Unit& u, int wr, int wc, int fr, int fq, const LAS float* stt, const LAS float* ct) const {
        const int row0 = u.pm * 256 + wr * 64 + fr, col0 = u.pn * 256 + wc * 32 + 8 * fq;
        float s1[8], s2[8];
#pragma unroll
        for (int i = 0; i < 8; ++i) { s1[i] = 0.f; s2[i] = 0.f; }
#pragma unroll
        for (int bj = 0; bj < 2; ++bj) { const int c = col0 + bj * 128;
            float sc[8], gg[8], bb[8];
#pragma unroll
            for (int e = 0; e < 8; ++e) { sc[e] = 1.f; gg[e] = 1.f; bb[e] = 0.f; }
            if (scale) { const f32x4 a0 = *(const f32x4*)(scale + c), a1 = *(const f32x4*)(scale + c + 4);
#pragma unroll
                for (int e = 0; e < 4; ++e) { sc[e] = a0[e]; sc[4 + e] = a1[e]; } }
            if (!P.ident) { const f32x4 a0 = *(const f32x4*)(P.g + c), a1 = *(const f32x4*)(P.g + c + 4), b0 = *(const f32x4*)(P.b + c), b1 = *(const f32x4*)(P.b + c + 4);
#pragma unroll
                for (int e = 0; e < 4; ++e) { gg[e] = a0[e]; gg[4 + e] = a1[e]; bb[e] = b0[e]; bb[4 + e] = b1[e]; } }
#pragma unroll
            for (int ai = 0; ai < 2; ++ai)
#pragma unroll
                for (int m = 0; m < 4; ++m) { const size_t row = (size_t)(row0 + ai * 128 + m * 16), off = row * D + c;
                    float mu, rstd; ln_row_lds(stt, wr * 64 + fr + ai * 128 + m * 16, P.ident, mu, rstd);
                    const u32x4 xw = *(const u32x4*)(P.Z + off); float xv[8]; unpk8(xw, xv);
                    float o[8];
#pragma unroll
                    for (int e = 0; e < 8; ++e) { const float t = rstd * gg[e], x = fmaf(xv[e], t, fmaf(-mu, t, bb[e])); o[e] = fmaf(DN_ALPHA, x, (e < 4 ? acc[ai][bj][m][0][e] : acc[ai][bj][m][1][e - 4]) * sc[e]); }
                    const u32x4 w = pk8(o); *(u32x4*)(Z + off) = w;
                    float ov[8]; unpk8(w, ov);
#pragma unroll
                    for (int e = 0; e < 8; ++e) { s1[ai * 4 + m] += ov[e]; s2[ai * 4 + m] += ov[e] * ov[e]; } } }
#pragma unroll
        for (int i = 0; i < 8; ++i) { s1[i] += __shfl_xor(s1[i], 16); s1[i] += __shfl_xor(s1[i], 32); s2[i] += __shfl_xor(s2[i], 16); s2[i] += __shfl_xor(s2[i], 32); }
        if (fq == 0) {
#pragma unroll
            for (int i = 0; i < 8; ++i) { float* p = st_out + (size_t)(row0 + (i >> 2) * 128 + (i & 3) * 16) * 2; atomicAdd(p, s1[i]); atomicAdd(p + 1, s2[i]); } }
    }
};

template <int CTRL> __device__ __forceinline__ float dpp_f(float v) { return __builtin_bit_cast(float, __builtin_amdgcn_update_dpp(0, __builtin_bit_cast(int, v), CTRL, 0xf, 0xf, false)); }
struct EpiUpConv {
    bf16_t* G; const float* cw; const float* cb; const float* hist; float* ahead; float* bhead; float* atail; float* outP; float* outS; LAS float* ex; const float* st; const float* uu; const float* cc;
    __device__ __forceinline__ void prefetch(const pg8::Unit& u, int par, int wid, LAS unsigned char* lds) const {
        const int l = lane_id_v();
#pragma unroll
        for (int j = 0; j < 2; ++j) { const int arr = j * 4 + (wid >> 1), off = (wid & 1) * 64 + l;
            const float* src = (arr < 3) ? cw + (size_t)arr * DFF + 128 * u.pn : (arr == 3) ? cb + 128 * u.pn : (arr == 4) ? uu + 256 * u.pn : (arr == 5) ? cc + 256 * u.pn : (arr == 6) ? uu + 256 * u.pn + 128 : cc + 256 * u.pn + 128;
            __builtin_amdgcn_global_load_lds((const unsigned*)(src + off), (LAS unsigned*)(lds + LDS_CT + par * 4096 + (j * 512 + wid * 64) * 4), 4, 0, 0); __builtin_amdgcn_sched_barrier(0); }
    }
    __device__ __forceinline__ void corr(const f32x4& a0, const f32x4& a1, const LAS float* up, const LAS float* kp, float mu, float rstd, float* o) const {
        const f32x4 u0 = *(const LAS f32x4*)up, u1 = *(const LAS f32x4*)(up + 4), k0 = *(const LAS f32x4*)kp, k1 = *(const LAS f32x4*)(kp + 4);
        const float nb = -mu * rstd;
#pragma unroll
        for (int e = 0; e < 4; ++e) { o[e] = fmaf(a0[e], rstd, fmaf(u0[e], nb, k0[e])); o[4 + e] = fmaf(a1[e], rstd, fmaf(u1[e], nb, k1[e])); }
    }
    __device__ __forceinline__ void operator()(const f32x4 (&acc)[2][2][4][2], const pg8::Unit& u, int wr, int wc, int fr, int fq, const LAS float* stt, const LAS float* ct) const {
        const int chl = 32 * wc + 8 * fq, ch = 128 * u.pn + chl;
        const LAS float* T = ct + chl;
        if (fr >= 14) {
#pragma unroll
            for (int ai = 0; ai < 2; ++ai) { float mu, rstd, t[8]; ln_row_lds(stt, wr * 64 + fr + ai * 128 + 48, 0, mu, rstd); corr(acc[ai][0][3][0], acc[ai][0][3][1], T + 4 * 128, T + 5 * 128, mu, rstd, t);
                LAS float* p = ex + ((ai * 2 + wr) * 2 + (fr - 14)) * 128 + chl; *(LAS f32x4*)p = (f32x4){t[0], t[1], t[2], t[3]}; *(LAS f32x4*)(p + 4) = (f32x4){t[4], t[5], t[6], t[7]}; }
        }
        asm volatile("s_waitcnt lgkmcnt(0)" ::: "memory"); __builtin_amdgcn_s_barrier(); asm volatile("" ::: "memory");
        const bool smp = u.pm >= MP / 256;
        const int seq_first = (u.pm & 7) == 0;
#pragma unroll
        for (int ai = 0; ai < 2; ++ai) {
            float h1[8], h2[8];
#pragma unroll
            for (int e = 0; e < 8; ++e) { h1[e] = 0.f; h2[e] = 0.f; }
            bool top_missing = false;
            if (!smp) {
                if (wr == 1 || ai == 1) { const int sa = (wr == 1) ? ai : 0, sw = (wr == 1) ? 0 : 1; const LAS float* p = ex + ((sa * 2 + sw) * 2) * 128 + chl;
                    const f32x4 a0 = *(const LAS f32x4*)p, a1 = *(const LAS f32x4*)(p + 4), b0 = *(const LAS f32x4*)(p + 128), b1 = *(const LAS f32x4*)(p + 132);
#pragma unroll
                    for (int e = 0; e < 4; ++e) { h2[e] = a0[e]; h2[4 + e] = a1[e]; h1[e] = b0[e]; h1[4 + e] = b1[e]; } }
                else top_missing = !seq_first;
            }
            float r1p[8], r2p[8];
#pragma unroll
            for (int e = 0; e < 8; ++e) { r1p[e] = 0.f; r2p[e] = 0.f; }
#pragma unroll
            for (int m = 0; m < 4; ++m) {
                const int rloc = 128 * ai + 64 * wr + 16 * m + fr;
                float cur[8], bb[8], r1[8], r2[8], p1[8], p2[8], o[8];
                const LAS float* Tm = T; asm volatile("" : "+v"(Tm));
                { float mu, rstd; ln_row_lds(stt, rloc, 0, mu, rstd);
                  corr(acc[ai][0][m][0], acc[ai][0][m][1], Tm + 4 * 128, Tm + 5 * 128, mu, rstd, cur); corr(acc[ai][1][m][0], acc[ai][1][m][1], Tm + 6 * 128, Tm + 7 * 128, mu, rstd, bb); }
#pragma unroll
                for (int e = 0; e < 8; ++e) { r1[e] = dpp_f<0x121>(cur[e]); r2[e] = dpp_f<0x122>(cur[e]); }
                if (smp) { const int sb = ((u.pm - MP / 256) * 256 + 128 * ai + 64 * wr + 16 * m) >> 4; const float* hp = hist + (size_t)sb * 2 * DFF + ch;
                    const f32x4 a0 = *(const f32x4*)hp, a1 = *(const f32x4*)(hp + 4), b0 = *(const f32x4*)(hp + DFF), b1 = *(const f32x4*)(hp + DFF + 4);
#pragma unroll
                    for (int e = 0; e < 8; ++e) { const float hh0 = e < 4 ? a0[e & 3] : a1[e & 3], hh1 = e < 4 ? b0[e & 3] : b1[e & 3];
                        p1[e] = fr >= 1 ? r1[e] : hh1; p2[e] = fr >= 2 ? r2[e] : (fr == 1 ? hh1 : hh0); } }
                else if (m == 0) {
#pragma unroll
                    for (int e = 0; e < 8; ++e) { p1[e] = fr >= 1 ? r1[e] : h1[e]; p2[e] = fr >= 2 ? r2[e] : (fr == 1 ? h1[e] : h2[e]); } }
                else {
#pragma unroll
                    for (int e = 0; e < 8; ++e) { p1[e] = fr >= 1 ? r1[e] : r1p[e]; p2[e] = fr >= 2 ? r2[e] : r2p[e]; } }
#pragma unroll
                for (int h2i = 0; h2i < 2; ++h2i) { const f32x4 x0 = *(const LAS f32x4*)(Tm + 0 * 128 + 4 * h2i), x1 = *(const LAS f32x4*)(Tm + 1 * 128 + 4 * h2i), x2 = *(const LAS f32x4*)(Tm + 2 * 128 + 4 * h2i), xb = *(const LAS f32x4*)(Tm + 3 * 128 + 4 * h2i);
#pragma unroll
                    for (int e = 0; e < 4; ++e) { const int q = 4 * h2i + e; const float c = fmaf(cur[q], x2[e], fmaf(p1[q], x1[e], fmaf(p2[q], x0[e], xb[e]))); o[q] = silu_mul(c, bb[q]); r1p[q] = r1[q]; r2p[q] = r2[q]; } }
                if (!(top_missing && m == 0 && fr < 2)) *(u32x4*)(G + (size_t)(u.pm * 256 + rloc) * DFF + ch) = pk8(o);
                const f32x4 ca0 = {cur[0], cur[1], cur[2], cur[3]}, ca1 = {cur[4], cur[5], cur[6], cur[7]};
                if (ai == 0 && m == 0 && wr == 0 && fr < 2) { float* pa = ahead + ((size_t)u.pm * 2 + fr) * DFF + ch; float* pb = bhead + ((size_t)u.pm * 2 + fr) * DFF + ch;
                    *(f32x4*)pa = ca0; *(f32x4*)(pa + 4) = ca1; *(f32x4*)pb = (f32x4){bb[0], bb[1], bb[2], bb[3]}; *(f32x4*)(pb + 4) = (f32x4){bb[4], bb[5], bb[6], bb[7]}; }
                if (ai == 1 && m == 3 && wr == 1 && fr >= 14) { float* pt = atail + ((size_t)u.pm * 2 + (fr - 14)) * DFF + ch; *(f32x4*)pt = ca0; *(f32x4*)(pt + 4) = ca1;
                    if (!smp && (u.pm & 7) == 7) { float* po = outP + ((size_t)(u.pm >> 3) * 2 + (fr - 14)) * DFF + ch; *(f32x4*)po = ca0; *(f32x4*)(po + 4) = ca1; } }
                if (smp && fr >= 14) { const int sb = ((u.pm - MP / 256) * 256 + 128 * ai + 64 * wr + 16 * m) >> 4; float* po = outS + ((size_t)sb * 2 + (fr - 14)) * DFF + ch;
                    *(f32x4*)po = ca0; *(f32x4*)(po + 4) = ca1; }
            }
        }
    }
};


template <int KW  >
__device__ __forceinline__ void sgemm_res_phase(LAS unsigned char* lds, const bf16_t* A, int lda, int a_grp_step, const bf16_t* Bt, int K, int bid, int G, int tid, const LnRef& P, bf16_t* Z, float* st_out, const float* scale) {
    const int lane = tid & 63, wave = __builtin_amdgcn_readfirstlane(tid >> 6), fr = lane & 15, fq = lane >> 4;
    LAS f32x4* red = (LAS f32x4*)lds;
    for (int t = bid; t < 256; t += G) {
        const int rt = t >> 5, ct = t & 31;
        const GAS bf16_t* ap = (const GAS bf16_t*)(A + (size_t)(rt * 64 + fr) * lda + (size_t)((ct * 32) >> 8) * a_grp_step + wave * KW + 8 * fq);
        const GAS bf16_t* bp = (const GAS bf16_t*)(Bt + (size_t)(ct * 32 + fr) * K + wave * KW + 8 * fq);
        f32x4 acc[4][2];
#pragma unroll
        for (int i = 0; i < 4; ++i) { acc[i][0] = (f32x4){0.f, 0.f, 0.f, 0.f}; acc[i][1] = (f32x4){0.f, 0.f, 0.f, 0.f}; }
#pragma unroll
        for (int k0 = 0; k0 < KW; k0 += 32) {
            bf16x8 af[4], bf[2];
#pragma unroll
            for (int i = 0; i < 4; ++i) af[i] = *(const GAS bf16x8*)(ap + (size_t)(16 * i) * lda + k0);
#pragma unroll
            for (int j = 0; j < 2; ++j) bf[j] = *(const GAS bf16x8*)(bp + (size_t)(16 * j) * K + k0);
#pragma unroll
            for (int i = 0; i < 4; ++i)
#pragma unroll
                for (int j = 0; j < 2; ++j) acc[i][j] = __builtin_amdgcn_mfma_f32_16x16x32_bf16(bf[j], af[i], acc[i][j], 0, 0, 0);
        }
#pragma unroll
        for (int i = 0; i < 4; ++i)
#pragma unroll
            for (int j = 0; j < 2; ++j) red[(wave * 8 + i * 2 + j) * 64 + lane] = acc[i][j];
        __syncthreads();
        f32x4 v = red[(0 * 8 + wave) * 64 + lane];
#pragma unroll
        for (int w = 1; w < 8; ++w) v += red[(w * 8 + wave) * 64 + lane];
        __syncthreads();
        const int row = rt * 64 + 16 * (wave >> 1) + fr, n = ct * 32 + 16 * (wave & 1) + 4 * fq; const size_t grow = (size_t)MP + row, off = grow * D + n;
        float mu, rstd; ln_row(P.st, grow, P.ident, mu, rstd);
        f32x4 gg = {1.f, 1.f, 1.f, 1.f}, bb = {0.f, 0.f, 0.f, 0.f}, sc = {1.f, 1.f, 1.f, 1.f};
        if (!P.ident) { gg = *(const f32x4*)(P.g + n); bb = *(const f32x4*)(P.b + n); }
        if (scale) sc = *(const f32x4*)(scale + n);
        const u32x2 xw = *(const u32x2*)(P.Z + off); const float xv[4] = {bflo(xw.x), bfhi(xw.x), bflo(xw.y), bfhi(xw.y)};
        float o[4];
#pragma unroll
        for (int e = 0; e < 4; ++e) { const float tt = rstd * gg[e], x = fmaf(xv[e], tt, fmaf(-mu, tt, bb[e])); o[e] = fmaf(DN_ALPHA, x, v[e] * sc[e]); }
        u32x2 w; w.x = pk2(o[0], o[1]); w.y = pk2(o[2], o[3]); *(u32x2*)(Z + off) = w;
        float s1 = (bflo(w.x) + bfhi(w.x)) + (bflo(w.y) + bfhi(w.y)), s2 = (bflo(w.x) * bflo(w.x) + bfhi(w.x) * bfhi(w.x)) + (bflo(w.y) * bflo(w.y) + bfhi(w.y) * bfhi(w.y));
        s1 += __shfl_xor(s1, 16); s1 += __shfl_xor(s1, 32); s2 += __shfl_xor(s2, 16); s2 += __shfl_xor(s2, 32);
        if (fq == 0) { atomicAdd(st_out + grow * 2, s1); atomicAdd(st_out + grow * 2 + 1, s2); }
    }
}

__device__ __forceinline__ void sgemm_in_phase(LAS unsigned char* lds, const bf16_t* A, const bf16_t* Bt, int bid, int G, int tid, const EpiIn& E) {
    constexpr int K = D, KW = K / 8;
    const int lane = tid & 63, wave = __builtin_amdgcn_readfirstlane(tid >> 6), fr = lane & 15, fq = lane >> 4;
    LAS f32x4* red = (LAS f32x4*)lds;
    for (int t = bid; t < 256; t += G) {
        const int rt = t >> 5, ct = t & 31;
        const GAS bf16_t* ap = (const GAS bf16_t*)(A + (size_t)(rt * 64 + fr) * K + wave * KW + 8 * fq);
        const GAS bf16_t* bp = (const GAS bf16_t*)(Bt + (size_t)(ct * 112 + fr) * K + wave * KW + 8 * fq);
        f32x4 acc[4][7];
#pragma unroll
        for (int i = 0; i < 4; ++i)
#pragma unroll
            for (int j = 0; j < 7; ++j) acc[i][j] = (f32x4){0.f, 0.f, 0.f, 0.f};
#pragma unroll
        for (int k0 = 0; k0 < KW; k0 += 32) {
            bf16x8 af[4], bf[7];
#pragma unroll
            for (int i = 0; i < 4; ++i) af[i] = *(const GAS bf16x8*)(ap + (size_t)(16 * i) * K + k0);
#pragma unroll
            for (int j = 0; j < 7; ++j) bf[j] = *(const GAS bf16x8*)(bp + (size_t)(16 * j) * K + k0);
#pragma unroll
            for (int i = 0; i < 4; ++i)
#pragma unroll
                for (int j = 0; j < 7; ++j) acc[i][j] = __builtin_amdgcn_mfma_f32_16x16x32_bf16(bf[j], af[i], acc[i][j], 0, 0, 0);
        }
#pragma unroll
        for (int i = 0; i < 4; ++i) {
#pragma unroll
            for (int j = 0; j < 7; ++j) red[(wave * 7 + j) * 64 + lane] = acc[i][j];
            __syncthreads();
            if (wave < 7) {
                f32x4 v = red[(0 * 7 + wave) * 64 + lane];
#pragma unroll
                for (int w = 1; w < 8; ++w) v += red[(w * 7 + wave) * 64 + lane];
                const int m = rt * 64 + 16 * i + fr, n = ct * 112 + 16 * wave + 4 * fq; const size_t row = (size_t)MP + m;
                float mu, rstd; ln_row(E.st, row, E.ident, mu, rstd);
                const f32x4 u0 = *(const f32x4*)(E.uu + n), k0v = *(const f32x4*)(E.cc + n);
                const float nb = -mu * rstd; v = v * rstd + (u0 * nb + k0v);
                const int kind = n >> 9;
                if (kind == 1) { const int c = n - C_AF; const f32x4 l0 = *(const f32x4*)(E.lbv + c); f32x4 o;
#pragma unroll
                    for (int e = 0; e < 4; ++e) { const float z = v[e], ez = __builtin_amdgcn_exp2f(-LOG2E * fabsf(z)), sg = (z >= 0.f ? 1.f : ez) * __builtin_amdgcn_rcpf(1.f + ez), f = l0[e] + (1.f - l0[e]) * sg; o[e] = fmaxf(__builtin_amdgcn_logf(f) * 0.6931471805599453f, -60.f); }
                    *(f32x4*)(E.LF + row * 512 + c) = o; }
                else { u32x2 w; w.x = pk2(v[0], v[1]); w.y = pk2(v[2], v[3]); *(u32x2*)(E.H + row * INC + n) = w;
                    if (kind == 5) *(f32x4*)(E.kS + (size_t)m * 512 + (n - C_BK)) = v;
                    if (kind == 6) *(f32x4*)(E.vS + (size_t)m * 512 + (n - C_BV)) = v; }
            }
            __syncthreads();
        }
    }
}

#define XB_TMO      128
#define XB_XCNT(j)  (256  + 64 * (j))
#define XB_XSUB(j)  (1280 + 64 * (j))
#define XB_XGEN(j)  (2304 + 64 * (j))
#define XB_TOP      3328
#define XB_TOPGEN   3392
#define XCD_BAR_WORDS 3456
#define XB_SPIN_CAP (1u << 22)
__device__ __forceinline__ unsigned xb_ld(unsigned* p)              { return __hip_atomic_load(p, __ATOMIC_RELAXED, __HIP_MEMORY_SCOPE_AGENT); }
__device__ __forceinline__ unsigned xb_add(unsigned* p, unsigned v) { return __hip_atomic_fetch_add(p, v, __ATOMIC_RELAXED, __HIP_MEMORY_SCOPE_AGENT); }
__device__ __forceinline__ unsigned xb_xcc_id() { return (unsigned)__builtin_amdgcn_s_getreg((3 << 11) | 20) & 0xFu; }
#define XB_SPIN(cond, bar) do { unsigned _sp = 0; while (cond) { __builtin_amdgcn_s_sleep(1); \
    if ((++_sp & 255u) == 0u) { if (xb_ld(&(bar)[XB_TMO])) break; if (_sp > XB_SPIN_CAP) { atomicAdd(&(bar)[XB_TMO], 1u); break; } } } } while (0)
struct XcdBarrier { unsigned* bar; unsigned x; volatile LAS unsigned* st; };
__device__ __forceinline__ XcdBarrier xcd_barrier_post(unsigned* bar, volatile LAS unsigned* st) {
    XcdBarrier b; b.bar = bar; b.x = xb_xcc_id(); b.st = st;
    if (threadIdx.x == 0) (void)xb_add(&bar[XB_XCNT(b.x)], 1u);
    return b;
}
__device__ __forceinline__ void xcd_barrier_complete(unsigned* bar, unsigned x, unsigned& nloc, unsigned& nx) {
    const unsigned G = gridDim.x * gridDim.y * gridDim.z;
    unsigned sum, cnt, mine, sp = 0u;
    for (;;) {
        sum = 0u; cnt = 0u; mine = 0u;
#pragma unroll
        for (unsigned j = 0; j < 16; ++j) { const unsigned c = xb_ld(&bar[XB_XCNT(j)]); sum += c; cnt += (c > 0u) ? 1u : 0u; mine = (j == x) ? c : mine; }
        if (sum == G) break;
        __builtin_amdgcn_s_sleep(1);
        if ((++sp & 255u) == 0u) { if (xb_ld(&bar[XB_TMO])) break; if (sp > XB_SPIN_CAP) { atomicAdd(&bar[XB_TMO], 1u); break; } }
    }
    nloc = mine > 0u ? mine : 1u; nx = cnt > 0u ? cnt : 1u;
}
__device__ __forceinline__ void xcd_barrier(const XcdBarrier& b) {
    asm volatile("s_waitcnt vmcnt(0)" ::: "memory");
    __syncthreads();
    if (threadIdx.x == 0) {
        unsigned* bar = b.bar;
        __builtin_amdgcn_s_waitcnt(0);
        unsigned nloc = b.st[0], nx = b.st[1];
        if (nloc == 0u) { xcd_barrier_complete(bar, b.x, nloc, nx); b.st[0] = nloc; b.st[1] = nx; }
        const unsigned old = xb_add(&bar[XB_XSUB(b.x)], 1u);
        const unsigned gen = old / nloc;
        if (old + 1u == (gen + 1u) * nloc) {
            __builtin_amdgcn_fence(__ATOMIC_RELEASE, "agent");
            asm volatile("s_waitcnt vmcnt(0)" ::: "memory");
            const unsigned og = xb_add(&bar[XB_TOP], 1u);
            const unsigned tg = og / nx;
            if (og + 1u == (tg + 1u) * nx) xb_add(&bar[XB_TOPGEN], 1u);
            else XB_SPIN(xb_ld(&bar[XB_TOPGEN]) == tg, bar);
            __builtin_amdgcn_fence(__ATOMIC_ACQUIRE, "agent");
            xb_add(&bar[XB_XGEN(b.x)], 1u);
            asm volatile("s_waitcnt vmcnt(0)" ::: "memory");
        } else {
            XB_SPIN(xb_ld(&bar[XB_XGEN(b.x)]) == gen, bar);
            __builtin_amdgcn_fence(__ATOMIC_ACQUIRE, "agent");
            asm volatile("s_waitcnt vmcnt(0)" ::: "memory");
        }
    }
    __syncthreads();
}

struct Args { const float* in[24]; float* out; unsigned char* ws; int ph_lo, ph_hi, single, pad; };
typedef const float* cfp_t;
typedef const __attribute__((address_space(4))) cfp_t* kin_t;
struct Frame {
    LAS unsigned char* lds;
    int tid, lane, wave, bid, G;
    kin_t in;
    float* out; unsigned char* ws;
};
enum { I_XP = 0, I_XS, I_CK, I_CV, I_SH, I_SP, I_SC, I_WIN, I_WOUT, I_LBL, I_HNG, I_DLAM, I_DNG, I_RB, I_PW, I_PSC, I_WUP, I_CW, I_CB, I_WDN, I_L1G, I_L1B, I_L2G, I_L2B };

__device__ __forceinline__ void p0_transpose_item(const float* W, int K, int N, bf16_t* WT, int dst_row0, LAS float* scr, int k0, int n0, int lane, const float* gk, const float* bk, float* uo, float* co) {
#pragma unroll 8
    for (int i = 0; i < 32; ++i) { const int kk = 2 * i + (lane >> 5); scr[kk * 33 + (lane & 31)] = W[(size_t)(k0 + kk) * N + n0 + (lane & 31)]; }
    asm volatile("s_waitcnt lgkmcnt(0)" ::: "memory");
    const int c = lane & 7;
    float gv[8], bv[8];
#pragma unroll
    for (int e = 0; e < 8; ++e) { gv[e] = 1.f; bv[e] = 0.f; }
    if (gk) {
#pragma unroll
        for (int e = 0; e < 8; ++e) { gv[e] = gk[k0 + 8 * c + e]; bv[e] = bk[k0 + 8 * c + e]; } }
#pragma unroll
    for (int j = 0; j < 4; ++j) { const int n = (lane >> 3) + 8 * j; const LAS float* sp = scr + (8 * c) * 33 + n;
        float wv[8]; float cs = 0.f;
#pragma unroll
        for (int e = 0; e < 8; ++e) { const float w = sp[e * 33]; wv[e] = w * gv[e]; cs += w * bv[e]; }
        const u32x4 o = pk8(wv);
        *(u32x4*)(WT + (size_t)(dst_row0 + n) * K + k0 + 8 * c) = o;
        if (gk) { float rv[8]; unpk8(o, rv); float us = 0.f;
#pragma unroll
            for (int e = 0; e < 8; ++e) us += rv[e];
            us += __shfl_xor(us, 1); us += __shfl_xor(us, 2); us += __shfl_xor(us, 4); cs += __shfl_xor(cs, 1); cs += __shfl_xor(cs, 2); cs += __shfl_xor(cs, 4);
            if (c == 0) { atomicAdd(uo + dst_row0 + n, us); atomicAdd(co + dst_row0 + n, cs); } } }
    asm volatile("s_waitcnt lgkmcnt(0)" ::: "memory");
}
__device__ __forceinline__ void phase_prologue(Frame& F) {
    LAS float* scr = (LAS float*)(F.lds + F.wave * 16384);
    const int gw = F.bid * NWAVES + F.wave, NGW = F.G * NWAVES;
    constexpr int I_IN = (D / 64) * (INC / 32), I_OUT = (D / 64) * (D / 32), I_POOL = 4 * 8, I_UP = (D / 64) * (UPN / 32), I_DN = (DFF / 64) * (D / 32);
    constexpr int NITEMS = 2 * I_IN + 2 * I_OUT + 8 * I_POOL + 4 * I_UP + 4 * I_DN;
    for (int it = gw; it < NITEMS; it += NGW) {
        int r = it;
        if (r < 2 * I_IN) { const int m = r / I_IN; r %= I_IN; const int kb = r / (INC / 32), nb = r % (INC / 32);
            float* ctlf = (float*)(F.ws + WS_CTL);
            p0_transpose_item(F.in[I_WIN] + (size_t)m * D * INC, D, INC, (bf16_t*)(F.ws + WS_WIN) + (size_t)m * INC * D, 32 * nb, scr, 64 * kb, 32 * nb, F.lane,
                              m == 1 ? F.in[I_L2G] + 1 * D : nullptr, F.in[I_L2B] + 1 * D, ctlf + UC_UIN, ctlf + UC_CIN); continue; } r -= 2 * I_IN;
        if (r < 2 * I_OUT) { const int m = r / I_OUT; r %= I_OUT; const int kb = r / (D / 32), nb = r % (D / 32);
            p0_transpose_item(F.in[I_WOUT] + (size_t)m * D * D, D, D, (bf16_t*)(F.ws + WS_WOUT) + (size_t)m * D * D, 32 * nb, scr, 64 * kb, 32 * nb, F.lane, nullptr, nullptr, nullptr, nullptr); continue; } r -= 2 * I_OUT;
        if (r < 8 * I_POOL) { const int pg = r / I_POOL; r %= I_POOL; const int kb = r / 8, nb = r % 8;
            p0_transpose_item(F.in[I_PW] + (size_t)pg * 256 * 256, 256, 256, (bf16_t*)(F.ws + WS_WPOOL) + (size_t)pg * 256 * 256, 32 * nb, scr, 64 * kb, 32 * nb, F.lane, nullptr, nullptr, nullptr, nullptr); continue; } r -= 8 * I_POOL;
        if (r < 4 * I_UP) { const int l = r / I_UP; r %= I_UP; const int kb = r / (UPN / 32), nb = r % (UPN / 32); const int n0 = 32 * nb;
            const int dst = (n0 < DFF) ? (256 * (n0 / 128) + (n0 % 128)) : (256 * ((n0 - DFF) / 128) + 128 + ((n0 - DFF) % 128));
            float* ctlf = (float*)(F.ws + WS_CTL);
            p0_transpose_item(F.in[I_WUP] + (size_t)l * D * UPN, D, UPN, (bf16_t*)(F.ws + WS_WUP) + (size_t)l * UPN * D, dst, scr, 64 * kb, n0, F.lane,
                              F.in[I_L1G] + (size_t)l * D, F.in[I_L1B] + (size_t)l * D, ctlf + UC_UUP + l * UPN, ctlf + UC_CUP + l * UPN); continue; } r -= 4 * I_UP;
        { const int l = r / I_DN; r %= I_DN; const int kb = r / (D / 32), nb = r % (D / 32);
            p0_transpose_item(F.in[I_WDN] + (size_t)l * DFF * D, DFF, D, (bf16_t*)(F.ws + WS_WDN) + (size_t)l * D * DFF, 32 * nb, scr, 64 * kb, 32 * nb, F.lane, nullptr, nullptr, nullptr, nullptr); }
    }
    bf16_t* XB = (bf16_t*)(F.ws + WS_XB);
    for (int m0 = gw; m0 < MT; m0 += 4 * NGW) {
        f32x4 v[4][4];
#pragma unroll
        for (int q = 0; q < 4; ++q) { const int m = m0 + q * NGW;
            if (m < MT) { const float* src = (m < MP) ? F.in[I_XP] + (size_t)m * D : F.in[I_XS] + (size_t)(m - MP) * D;
#pragma unroll
                for (int j = 0; j < 4; ++j) v[q][j] = *(const f32x4*)(src + 4 * F.lane + 256 * j); } }
#pragma unroll
        for (int q = 0; q < 4; ++q) { const int m = m0 + q * NGW;
            if (m < MT) {
#pragma unroll
                for (int j = 0; j < 4; ++j) { u32x2 w; w.x = pk2(v[q][j][0], v[q][j][1]); w.y = pk2(v[q][j][2], v[q][j][3]); *(u32x2*)(XB + (size_t)m * D + 4 * F.lane + 256 * j) = w; } } }
    }
    if (F.bid == 0) {
        float* tab = (float*)(F.ws + WS_TAB);
        { const int c = F.tid; const float a = F.in[I_LBL][c], b = F.in[I_LBL][512 + c], mx = fmaxf(a, b), ea = __expf(a - mx), eb = __expf(b - mx);
          tab[TB_LB + c] = 0.f; tab[TB_LB + 512 + c] = eb / (ea + eb); }
        if (F.wave < 2) { const int m = F.wave; const float* lp = F.in[I_DLAM] + (size_t)m * 4 * 64;
            const float s01 = wave_sum(lp[F.lane] * lp[64 + F.lane]), s23 = wave_sum(lp[128 + F.lane] * lp[192 + F.lane]);
            const float lam_init = (m == 0) ? 0.2f : 0.47071302f;
            if (F.lane == 0) tab[TB_LAM + m] = __expf(s01) - __expf(s23) + lam_init; }
    }
}

__device__ __forceinline__ void phase_ln_final(Frame& F, const bf16_t* Z, const float* g, const float* b) {
    const int gw = F.bid * NWAVES + F.wave, NGW = F.G * NWAVES;
    f32x4 gv[4], bv[4];
#pragma unroll
    for (int j = 0; j < 4; ++j) { const int c = 8 * F.lane + 512 * (j >> 1) + 4 * (j & 1); gv[j] = *(const f32x4*)(g + c); bv[j] = *(const f32x4*)(b + c); }
    for (int m = gw; m < MT; m += NGW) {
        f32x4 v[4]; float s = 0.f;
#pragma unroll
        for (int j2 = 0; j2 < 2; ++j2) { const u32x4 w = *(const u32x4*)(Z + (size_t)m * D + 8 * F.lane + 512 * j2);
            v[2 * j2] = (f32x4){bflo(w.x), bfhi(w.x), bflo(w.y), bfhi(w.y)}; v[2 * j2 + 1] = (f32x4){bflo(w.z), bfhi(w.z), bflo(w.w), bfhi(w.w)}; }
#pragma unroll
        for (int j = 0; j < 4; ++j) s += (v[j][0] + v[j][1]) + (v[j][2] + v[j][3]);
        const float mean = wave_sum(s) * (1.f / D); float s2 = 0.f;
#pragma unroll
        for (int j = 0; j < 4; ++j) { v[j] = v[j] - mean; s2 += (v[j][0] * v[j][0] + v[j][1] * v[j][1]) + (v[j][2] * v[j][2] + v[j][3] * v[j][3]); }
        const float rstd = 1.f / sqrtf(wave_sum(s2) * (1.f / D) + LN_EPS);
        float* outp = (m < MP) ? F.out + O_YP + (size_t)m * D : F.out + O_YS + (size_t)(m - MP) * D;
#pragma unroll
        for (int j2 = 0; j2 < 2; ++j2) { const f32x4 y0 = v[2 * j2] * rstd * gv[2 * j2] + bv[2 * j2], y1 = v[2 * j2 + 1] * rstd * gv[2 * j2 + 1] + bv[2 * j2 + 1];
            *(f32x4*)(outp + 8 * F.lane + 512 * j2) = y0; *(f32x4*)(outp + 8 * F.lane + 512 * j2 + 4) = y1; }
    }
}

template <int J>
__device__ __forceinline__ void pool_item(Frame& F, const LnRef& R, int p, int rb, int c) {
    constexpr int W = 2 << J;
    bf16_t* PO = (bf16_t*)(F.ws + WS_MIX);
    const f32x4 g0 = *(const f32x4*)(R.g + c), g1 = *(const f32x4*)(R.g + c + 4), b0 = *(const f32x4*)(R.b + c), b1 = *(const f32x4*)(R.b + c + 4);
    const int m0 = rb * 16; const bool smp = m0 >= MP; const int b = smp ? (m0 - MP) / ST : m0 / PT, t0 = smp ? 0 : m0 % PT;
    f32x4 ring[W][2]; f32x4 s0 = {0.f, 0.f, 0.f, 0.f}, s1 = {0.f, 0.f, 0.f, 0.f};
#pragma unroll
    for (int i = 0; i < W; ++i) {
        const int tt = t0 - W + i; f32x4 v0 = {0.f, 0.f, 0.f, 0.f}, v1 = {0.f, 0.f, 0.f, 0.f};
        if (tt >= 0) { const size_t rr = (size_t)(m0 - W + i); const u32x4 q = *(const u32x4*)(R.Z + rr * D + c); float mu, rstd; ln_row(R.st, rr, 0, mu, rstd);
            v0 = ((f32x4){bflo(q.x), bfhi(q.x), bflo(q.y), bfhi(q.y)} - mu) * rstd * g0 + b0; v1 = ((f32x4){bflo(q.z), bfhi(q.z), bflo(q.w), bfhi(q.w)} - mu) * rstd * g1 + b1; }
        else if (smp && tt >= -15) { const float* hp = F.in[I_SP] + (((size_t)p * SB + b) * 15 + (15 + tt)) * D + c; v0 = *(const f32x4*)hp; v1 = *(const f32x4*)(hp + 4); }
        ring[i][0] = v0; ring[i][1] = v1; s0 += v0; s1 += v1; }
#pragma unroll
    for (int i = 0; i < 16; ++i) { const int t = t0 + i;
        const size_t rr = (size_t)(m0 + i); const u32x4 q = *(const u32x4*)(R.Z + rr * D + c); float mu, rstd; ln_row(R.st, rr, 0, mu, rstd);
        const f32x4 x0 = ((f32x4){bflo(q.x), bfhi(q.x), bflo(q.y), bfhi(q.y)} - mu) * rstd * g0 + b0, x1 = ((f32x4){bflo(q.z), bfhi(q.z), bflo(q.w), bfhi(q.w)} - mu) * rstd * g1 + b1;
        s0 += x0 - ring[i % W][0]; s1 += x1 - ring[i % W][1]; ring[i % W][0] = x0; ring[i % W][1] = x1;
        const float inv = 1.f / (float)(smp ? W : (t + 1 < W ? t + 1 : W));
        const f32x4 o0 = s0 * inv - x0, o1 = s1 * inv - x1;
        u32x4 w; w.x = pk2(o0[0], o0[1]); w.y = pk2(o0[2], o0[3]); w.z = pk2(o1[0], o1[1]); w.w = pk2(o1[2], o1[3]); *(u32x4*)(PO + (size_t)(m0 + i) * D + c) = w;
        if (!smp && t >= PT - 15) { float* op = F.out + O_PP + (((size_t)p * PB + b) * 15 + (t - (PT - 15))) * D + c; *(f32x4*)op = x0; *(f32x4*)(op + 4) = x1; }
        if (smp && t >= 1) { float* op = F.out + O_PS + (((size_t)p * SB + b) * 15 + (t - 1)) * D + c; *(f32x4*)op = x0; *(f32x4*)(op + 4) = x1; } }
}
__device__ __forceinline__ void phase_pool_prep(Frame& F, const LnRef& R, int p) {
    const int gwv = F.bid * NWAVES + F.wave, NGW = F.G * NWAVES;
    for (int wi = gwv; wi < (MT / 32) * 4; wi += NGW) { const int j = wi & 3, rb = 2 * (wi >> 2) + (F.lane >> 5), c = 256 * j + 8 * (F.lane & 31);
        if (j == 0) pool_item<0>(F, R, p, rb, c); else if (j == 1) pool_item<1>(F, R, p, rb, c); else if (j == 2) pool_item<2>(F, R, p, rb, c); else pool_item<3>(F, R, p, rb, c); }
}

__device__ __forceinline__ void conv_fix_item(Frame& F, int l, int pm, int ch) {
    bf16_t* Gb = (bf16_t*)(F.ws + WS_G);
    const float* cw = F.in[I_CW] + (size_t)l * 3 * DFF; const float* cb = F.in[I_CB] + (size_t)l * DFF;
    const float* ahead = (const float*)(F.ws + WS_AHEAD); const float* bhead = (const float*)(F.ws + WS_BHEAD); const float* atail = (const float*)(F.ws + WS_ATAIL);
    float t0[8], t1[8], a0[8], a1[8], b0[8], b1[8], o[8];
#pragma unroll
    for (int h2 = 0; h2 < 2; ++h2) {
        const f32x4 x0 = *(const f32x4*)(atail + ((size_t)(pm - 1) * 2 + 0) * DFF + ch + 4 * h2), x1 = *(const f32x4*)(atail + ((size_t)(pm - 1) * 2 + 1) * DFF + ch + 4 * h2);
        const f32x4 y0 = *(const f32x4*)(ahead + ((size_t)pm * 2 + 0) * DFF + ch + 4 * h2), y1 = *(const f32x4*)(ahead + ((size_t)pm * 2 + 1) * DFF + ch + 4 * h2);
        const f32x4 z0 = *(const f32x4*)(bhead + ((size_t)pm * 2 + 0) * DFF + ch + 4 * h2), z1 = *(const f32x4*)(bhead + ((size_t)pm * 2 + 1) * DFF + ch + 4 * h2);
#pragma unroll
        for (int e = 0; e < 4; ++e) { t0[4 * h2 + e] = x0[e]; t1[4 * h2 + e] = x1[e]; a0[4 * h2 + e] = y0[e]; a1[4 * h2 + e] = y1[e]; b0[4 * h2 + e] = z0[e]; b1[4 * h2 + e] = z1[e]; } }
#pragma unroll
    for (int e = 0; e < 8; ++e) { const float c = cb[ch + e] + t0[e] * cw[ch + e] + t1[e] * cw[DFF + ch + e] + a0[e] * cw[2 * DFF + ch + e]; o[e] = silu_mul(c, b0[e]); }
    *(u32x4*)(Gb + (size_t)(pm * 256) * DFF + ch) = pk8(o);
#pragma unroll
    for (int e = 0; e < 8; ++e) { const float c = cb[ch + e] + t1[e] * cw[ch + e] + a0[e] * cw[DFF + ch + e] + a1[e] * cw[2 * DFF + ch + e]; o[e] = silu_mul(c, b1[e]); }
    *(u32x4*)(Gb + (size_t)(pm * 256 + 1) * DFF + ch) = pk8(o);
}
__device__ __forceinline__ void conv_fix_local(Frame& F, int l, const pg8::StaticOrder& S) {
    pg8::Unit u;
    for (int i = 0; S.next(i, u); ++i)
        if (u.pm < MP / 256 && (u.pm & 7) != 0)
            for (int it = F.tid; it < DFF / 8; it += NTHREADS) conv_fix_item(F, l, u.pm, 8 * it);
    asm volatile("s_waitcnt vmcnt(0)" ::: "memory");
    __syncthreads();
}

constexpr int HG_LF = 0;
constexpr int HG_TOT = HG_LF + 16384;
constexpr int HG_G = HG_TOT + 2048;
constexpr int HG_QT = HG_G + 512;
constexpr int HG_KS = HG_QT + 32 * 272;
constexpr int HG_V = HG_KS + 32 * 320;
constexpr int HG_PF = HG_V + 32 * 320;
constexpr int HG_OX = HG_PF + 2048;
constexpr int HG_END = HG_OX + 32768;
static_assert(HG_END <= LDS_TAB, "HGRN LDS");

template <bool SMP>
__device__ __forceinline__ void hgrn_unit(Frame& F, int m, int b, int h) {
    LAS unsigned char* L = F.lds;
    const bf16_t* H = (const bf16_t*)(F.ws + WS_H); const float* LFg = (const float*)(F.ws + WS_LF); bf16_t* MIX = (bf16_t*)(F.ws + WS_MIX);
    const float* gn = F.in[I_HNG] + (size_t)m * 512 + h * 128;
    const int tid = opq(F.tid), lane = tid & 63, wave = __builtin_amdgcn_readfirstlane(tid >> 6), r = lane & 31, hh = lane >> 5;
    const int nb = wave & 3, kh = wave >> 2;
    const size_t row0 = SMP ? (size_t)MP + (size_t)b * ST : (size_t)b * PT;
    const int nsteps = SMP ? 1 : PT / 32;
    f32x16 S[2];
    if (SMP) { const float* s0 = F.in[I_SH] + (((size_t)m * SB + b) * NH + h) * 128 * 128 + (size_t)(64 * kh + 4 * hh) * 128 + 32 * nb + r;
#pragma unroll
        for (int kbl = 0; kbl < 2; ++kbl)
#pragma unroll
            for (int i = 0; i < 16; ++i) S[kbl][i] = s0[(32 * kbl + (i & 3) + 8 * (i >> 2)) * 128];
    } else {
#pragma unroll
        for (int kbl = 0; kbl < 2; ++kbl)
#pragma unroll
            for (int i = 0; i < 16; ++i) S[kbl][i] = 0.f;
    }
    const int et = tid >> 4, ek = (tid & 15) * 8;
    const bool valid = !SMP || et < ST;
    f32x4 lf0 = {0.f, 0.f, 0.f, 0.f}, lf1 = {0.f, 0.f, 0.f, 0.f}; u32x4 qw = {0u, 0u, 0u, 0u}, vw = {0u, 0u, 0u, 0u}, gw = {0u, 0u, 0u, 0u};
    if (valid) { const size_t row = row0 + et;
        lf0 = *(const f32x4*)(LFg + row * 512 + h * 128 + ek); lf1 = *(const f32x4*)(LFg + row * 512 + h * 128 + ek + 4);
        qw = *(const u32x4*)(H + row * INC + C_AQ + h * 128 + ek); vw = *(const u32x4*)(H + row * INC + C_AI + h * 128 + ek); gw = *(const u32x4*)(H + row * INC + C_AG + h * 128 + ek); }
    for (int step = 0; step < nsteps; ++step) {
        const size_t row = row0 + (size_t)step * 32 + et;
        *(LAS f32x4*)(L + HG_LF + (et * 128 + ek) * 4) = lf0; *(LAS f32x4*)(L + HG_LF + (et * 128 + ek + 4) * 4) = lf1;
        f32x4 nlf0 = lf0, nlf1 = lf1; u32x4 nqw = qw, nvw = vw, ngw = gw;
        if (!SMP && step + 1 < nsteps) { const size_t rn = row + 32;
            nlf0 = *(const f32x4*)(LFg + rn * 512 + h * 128 + ek); nlf1 = *(const f32x4*)(LFg + rn * 512 + h * 128 + ek + 4);
            nqw = *(const u32x4*)(H + rn * INC + C_AQ + h * 128 + ek); nvw = *(const u32x4*)(H + rn * INC + C_AI + h * 128 + ek); ngw = *(const u32x4*)(H + rn * INC + C_AG + h * 128 + ek); }
        __syncthreads();
        { const int k = tid & 127, tq = tid >> 7; LAS float* p = (LAS float*)(L + HG_LF) + (8 * tq) * 128 + k; float vs[8];
#pragma unroll
            for (int i = 0; i < 8; ++i) vs[i] = p[i * 128];
#pragma unroll
            for (int i = 1; i < 8; ++i) vs[i] += vs[i - 1];
#pragma unroll
            for (int i = 0; i < 8; ++i) p[i * 128] = vs[i];
            ((LAS float*)(L + HG_TOT))[tq * 128 + k] = vs[7]; }
        __syncthreads();
        { float bcum[8];
            { const f32x4 c0 = *(LAS f32x4*)(L + HG_LF + (et * 128 + ek) * 4), c1 = *(LAS f32x4*)(L + HG_LF + (et * 128 + ek + 4) * 4);
#pragma unroll
              for (int e = 0; e < 4; ++e) { bcum[e] = c0[e]; bcum[4 + e] = c1[e]; } }
            for (int gq = 0; gq < (et >> 3); ++gq) { const f32x4 c0 = *(LAS f32x4*)(L + HG_TOT + (gq * 128 + ek) * 4), c1 = *(LAS f32x4*)(L + HG_TOT + (gq * 128 + ek + 4) * 4);
#pragma unroll
                for (int e = 0; e < 4; ++e) { bcum[e] += c0[e]; bcum[4 + e] += c1[e]; } }
            float qv[8]; unpk8(qw, qv);
            float qt[8], kt[8];
#pragma unroll
            for (int e = 0; e < 8; ++e) { const float lfe = e < 4 ? lf0[e] : lf1[e - 4]; const float eb = __expf(bcum[e]);
                qt[e] = qv[e] * eb; kt[e] = (1.f - __expf(lfe)) * __expf(-bcum[e]);
                if (et == 31) ((LAS float*)(L + HG_G))[ek + e] = eb; }
            const u32x4 qp = pk8(qt), kp = pk8(kt);
            *(LAS u32x4*)(L + HG_QT + et * 272 + ek * 2) = qp;
            *(LAS u32x4*)(L + HG_KS + et * 320 + ek * 2) = kp;
            *(LAS u32x4*)(L + HG_V + et * 320 + ek * 2) = vw;
        }
        __syncthreads();
        if (wave == 0) {
            f32x16 pt;
#pragma unroll
            for (int i = 0; i < 16; ++i) pt[i] = 0.f;
#pragma unroll
            for (int st = 0; st < 8; ++st) { const bf16x8 a = *(const LAS bf16x8*)(L + HG_KS + r * 320 + (16 * st + 8 * hh) * 2), bq = *(const LAS bf16x8*)(L + HG_QT + r * 272 + (16 * st + 8 * hh) * 2);
                pt = MFMA32(a, bq, pt); }
#pragma unroll
            for (int i = 0; i < 16; ++i) if (crow(i, hh) > r) pt[i] = 0.f;
            *(LAS bf16x8*)(L + HG_PF + lane * 16) = pack_step(pt, 0); *(LAS bf16x8*)(L + HG_PF + 1024 + lane * 16) = pack_step(pt, 1);
        }
        f32x16 oacc;
#pragma unroll
        for (int i = 0; i < 16; ++i) oacc[i] = 0.f;
#pragma unroll
        for (int kbl = 0; kbl < 2; ++kbl)
#pragma unroll
            for (int s2 = 0; s2 < 2; ++s2) { const int k0 = 64 * kh + 32 * kbl + 16 * s2 + 4 * hh;
                const s16x4 lo = *(const LAS s16x4*)(L + HG_QT + r * 272 + k0 * 2), hi = *(const LAS s16x4*)(L + HG_QT + r * 272 + (k0 + 8) * 2);
                oacc = MFMA32(pack_step(S[kbl], s2), cat8(lo, hi), oacc); }
        __syncthreads();
        const int i16 = lane & 15, tq = i16 >> 2, tp = i16 & 3, gi = (lane >> 4) & 1;
        if (kh == 0) {
#pragma unroll
            for (int s2 = 0; s2 < 2; ++s2) { const int key0 = 16 * s2 + 4 * hh;
                const s16x4 lo = vtr(L + HG_V + (key0 + tq) * 320 + (32 * nb + 16 * gi + 4 * tp) * 2), hi = vtr(L + HG_V + (key0 + 8 + tq) * 320 + (32 * nb + 16 * gi + 4 * tp) * 2);
                const bf16x8 pf = *(const LAS bf16x8*)(L + HG_PF + s2 * 1024 + lane * 16);
                oacc = MFMA32(cat8(lo, hi), pf, oacc); }
        }
#pragma unroll
        for (int i = 0; i < 16; ++i) ((LAS float*)(L + HG_OX))[(kh * 128 + 32 * nb + crow(i, hh)) * 32 + r] = oacc[i];
#pragma unroll
        for (int kbl = 0; kbl < 2; ++kbl)
#pragma unroll
            for (int s2 = 0; s2 < 2; ++s2) { const int key0 = 16 * s2 + 8 * hh;
                const s16x4 alo = vtr(L + HG_KS + (key0 + tq) * 320 + (64 * kh + 32 * kbl + 16 * gi + 4 * tp) * 2), ahi = vtr(L + HG_KS + (key0 + 4 + tq) * 320 + (64 * kh + 32 * kbl + 16 * gi + 4 * tp) * 2);
                const s16x4 lo = vtr(L + HG_V + (key0 + tq) * 320 + (32 * nb + 16 * gi + 4 * tp) * 2), hi = vtr(L + HG_V + (key0 + 4 + tq) * 320 + (32 * nb + 16 * gi + 4 * tp) * 2);
                S[kbl] = MFMA32(cat8(alo, ahi), cat8(lo, hi), S[kbl]); }
#pragma unroll
        for (int kbl = 0; kbl < 2; ++kbl)
#pragma unroll
            for (int i = 0; i < 16; ++i) S[kbl][i] *= ((LAS float*)(L + HG_G))[64 * kh + 32 * kbl + crow(i, hh)];
        __syncthreads();
        { float o[8], ss = 0.f;
#pragma unroll
            for (int e = 0; e < 8; ++e) { o[e] = ((LAS float*)(L + HG_OX))[(ek + e) * 32 + et] + ((LAS float*)(L + HG_OX))[(128 + ek + e) * 32 + et]; ss += o[e] * o[e]; }
            ss += __shfl_xor(ss, 1); ss += __shfl_xor(ss, 2); ss += __shfl_xor(ss, 4); ss += __shfl_xor(ss, 8);
            const float rstd = 1.f / sqrtf(ss * (1.f / 128.f) + RMS_EPS);
            float gv[8]; unpk8(gw, gv);
            const f32x4 g0 = *(const f32x4*)(gn + ek), g1 = *(const f32x4*)(gn + ek + 4);
#pragma unroll
            for (int e = 0; e < 8; ++e) { const float y = o[e] * rstd * (e < 4 ? g0[e] : g1[e - 4]); o[e] = y * (gv[e] / (1.f + __expf(-gv[e]))); }
            if (valid) *(u32x4*)(MIX + row * D + h * 128 + ek) = pk8(o);
        }
        lf0 = nlf0; lf1 = nlf1; qw = nqw; vw = nvw; gw = ngw;
    }
    { float* so = (SMP ? F.out + O_HS + (((size_t)m * SB + b) * NH + h) * 128 * 128 : F.out + O_HP + (((size_t)m * PB + b) * NH + h) * 128 * 128);
      const int l2 = opq(lane); float* sp = so + (size_t)(64 * kh + 4 * (l2 >> 5)) * 128 + 32 * nb + (l2 & 31);
#pragma unroll
      for (int kbl = 0; kbl < 2; ++kbl)
#pragma unroll
        for (int i = 0; i < 16; ++i) sp[(32 * kbl + (i & 3) + 8 * (i >> 2)) * 128] = S[kbl][i]; }
    __syncthreads();
}

constexpr int AT_KP = 272, AT_VP = 320;
constexpr int AT_KB = 64 * AT_KP, AT_VB = 64 * AT_VP;
constexpr int AT_TILE = AT_KB + AT_VB;
static_assert(4 * AT_TILE <= LDS_TAB && (8 * 66 * 64 + 64 * 64 + 8 * 64) * 4 <= LDS_TAB && 2 * AT_TILE + 8 * 2 * 32 * 144 <= LDS_TAB, "attention LDS");

__device__ __forceinline__ void attn_build_tab(Frame& F, int h) {
    if (F.tid < 256) { const int rel = F.tid - 128, n = rel < 0 ? -rel : rel;
        int bk = n;
        if (n >= 8) bk = 8 + (n >= 12) + (n >= 16) + (n >= 23) + (n >= 32) + (n >= 46) + (n >= 64) + (n >= 91);
        if (rel > 0) bk += 16;
        ((LAS float*)(F.lds + LDS_TAB))[F.tid] = F.in[I_RB][bk * NH + h] * LOG2E; }
}
struct AttnState { f32x16 o[4]; float m, l; };
template <bool MASK_END>
__device__ __forceinline__ void attn_tile(const LAS unsigned char* Kt, const LAS unsigned char* Vt, int vh, const bf16x8 (&qf)[4], AttnState& A, int kpos0, int qpos, int qpos_min, int kv_end,
                                          const LAS float* tab, int r, int hh, int lane) {
    f32x16 st[2];
#pragma unroll
    for (int kb = 0; kb < 2; ++kb) {
#pragma unroll
        for (int i = 0; i < 16; ++i) st[kb][i] = 0.f;
#pragma unroll
        for (int s = 0; s < 4; ++s) { const bf16x8 a = *(const LAS bf16x8*)(Kt + (32 * kb + r) * AT_KP + (vh * 64 + 16 * s + 8 * hh) * 2); st[kb] = MFMA32(a, qf[s], st[kb]); }
    }
    constexpr float C2 = 0.125f * LOG2E;
    const bool far = (kpos0 + 63) <= (qpos_min - 91);
    if (far) { const float bc = tab[0];
#pragma unroll
        for (int kb = 0; kb < 2; ++kb)
#pragma unroll
            for (int i = 0; i < 16; ++i) st[kb][i] = st[kb][i] * C2 + bc;
    } else {
#pragma unroll
        for (int kb = 0; kb < 2; ++kb)
#pragma unroll
            for (int i = 0; i < 16; ++i) { const int kpos = kpos0 + 32 * kb + crow(i, hh); int rel = kpos - qpos; rel = rel < -128 ? -128 : (rel > 127 ? 127 : rel);
                float x = st[kb][i] * C2 + tab[rel + 128];
                if (MASK_END) x = (kpos < kv_end) ? x : -1e30f;
                st[kb][i] = x; }
    }
    float mx = st[0][0];
#pragma unroll
    for (int kb = 0; kb < 2; ++kb)
#pragma unroll
        for (int i = 0; i < 16; ++i) mx = fmaxf(mx, st[kb][i]);
    mx = fmaxf(mx, __shfl_xor(mx, 32));
    if (__any(mx > A.m + 8.f)) {
        const float mnew = fmaxf(A.m, mx), alpha = __builtin_amdgcn_exp2f(A.m - mnew);
        A.m = mnew; A.l *= alpha;
#pragma unroll
        for (int mb = 0; mb < 4; ++mb)
#pragma unroll
            for (int i = 0; i < 16; ++i) A.o[mb][i] *= alpha;
    }
    const float mref = A.m;
    float ls = 0.f;
#pragma unroll
    for (int kb = 0; kb < 2; ++kb)
#pragma unroll
        for (int i = 0; i < 16; ++i) { const float p = __builtin_amdgcn_exp2f(st[kb][i] - mref); st[kb][i] = p; ls += p; }
    A.l += ls;
    const int i16 = lane & 15, tq = i16 >> 2, tp = i16 & 3, gi = (lane >> 4) & 1;
#pragma unroll
    for (int kb = 0; kb < 2; ++kb)
#pragma unroll
        for (int s2 = 0; s2 < 2; ++s2) { const bf16x8 pf = pack_step(st[kb], s2); const int key0 = 32 * kb + 16 * s2 + 4 * hh;
#pragma unroll
            for (int mb = 0; mb < 4; ++mb) {
                const s16x4 lo = vtr(Vt + (key0 + tq) * AT_VP + (32 * mb + 16 * gi + 4 * tp) * 2), hi = vtr(Vt + (key0 + 8 + tq) * AT_VP + (32 * mb + 16 * gi + 4 * tp) * 2);
                A.o[mb] = MFMA32(cat8(lo, hi), pf, A.o[mb]); } }
}
__device__ __forceinline__ void attn_store(const f32x16 (&o)[4], const float* gnorm, float post, bf16_t* dst_row  , int hh, bool active) {
    float ss = 0.f;
#pragma unroll
    for (int mb = 0; mb < 4; ++mb)
#pragma unroll
        for (int i = 0; i < 16; ++i) ss += o[mb][i] * o[mb][i];
    ss += __shfl_xor(ss, 32);
    const float rstd = post / sqrtf(ss * (1.f / 128.f) + RMS_EPS);
    if (active) {
#pragma unroll
        for (int mb = 0; mb < 4; ++mb)
#pragma unroll
            for (int g4 = 0; g4 < 4; ++g4) { const int dv = 32 * mb + 8 * g4 + 4 * hh; const f32x4 gv = *(const f32x4*)(gnorm + dv);
                u32x2 w; w.x = pk2(o[mb][4 * g4] * rstd * gv[0], o[mb][4 * g4 + 1] * rstd * gv[1]); w.y = pk2(o[mb][4 * g4 + 2] * rstd * gv[2], o[mb][4 * g4 + 3] * rstd * gv[3]);
                *(u32x2*)(dst_row + dv) = w; }
    }
}

__device__ __forceinline__ void attn_prompt_unit(Frame& F, int m, int b, int h, int qb) {
    LAS unsigned char* L = F.lds; const LAS float* tab = (const LAS float*)(L + LDS_TAB);
    const bf16_t* H = (const bf16_t*)(F.ws + WS_H); bf16_t* MIX = (bf16_t*)(F.ws + WS_MIX);
    const int tid = opq(F.tid), lane = tid & 63, wave = __builtin_amdgcn_readfirstlane(tid >> 6), r = lane & 31, hh = lane >> 5, vh = wave >> 2, wq = wave & 3;
    const size_t rowb = (size_t)b * PT;
    const int q0a = qb * 256 + wq * 32, q0b = q0a + 128, qca = q0a >> 6, qcb = q0b >> 6, nkt = 4 * qb + 4;
    attn_build_tab(F, h);
    LAS unsigned char* qs = L + 2 * AT_TILE + wave * (2 * 32 * 144) + r * 144 + 16 * hh;
#pragma unroll
    for (int s = 0; s < 4; ++s) { *(LAS bf16x8*)(qs + 32 * s) = *(const bf16x8*)(H + (rowb + q0a + r) * INC + C_BQ + h * 128 + vh * 64 + 16 * s + 8 * hh);
        *(LAS bf16x8*)(qs + 32 * 144 + 32 * s) = *(const bf16x8*)(H + (rowb + q0b + r) * INC + C_BQ + h * 128 + vh * 64 + 16 * s + 8 * hh); }
    AttnState A0, A1;
#pragma unroll
    for (int mb = 0; mb < 4; ++mb)
#pragma unroll
        for (int i = 0; i < 16; ++i) { A0.o[mb][i] = 0.f; A1.o[mb][i] = 0.f; }
    A0.m = -1e30f; A0.l = 0.f; A1.m = -1e30f; A1.l = 0.f;
    u32x4 kr[2], vr[2];
#define AT_LD(kt) do { _Pragma("unroll") for (int i_ = 0; i_ < 2; ++i_) { const int c_ = tid + 512 * i_, key_ = c_ >> 4, ch_ = c_ & 15; const bf16_t* src_ = H + (rowb + 64 * (kt) + key_) * INC + h * 128 + ch_ * 8; \
        kr[i_] = *(const u32x4*)(src_ + C_BK); vr[i_] = *(const u32x4*)(src_ + C_BV); } } while (0)
#define AT_ST(buf) do { _Pragma("unroll") for (int i_ = 0; i_ < 2; ++i_) { const int c_ = tid + 512 * i_, key_ = c_ >> 4, ch_ = c_ & 15; \
        *(LAS u32x4*)(L + (buf) * AT_TILE + key_ * AT_KP + ch_ * 16) = kr[i_]; *(LAS u32x4*)(L + (buf) * AT_TILE + AT_KB + key_ * AT_VP + ch_ * 16) = vr[i_]; } } while (0)
    AT_LD(0); AT_ST(0);
    AT_LD(1);
    __syncthreads();
    for (int kt = 0; kt < nkt; ++kt) {
        if (kt <= qca) { bf16x8 qf[4];
#pragma unroll
            for (int s = 0; s < 4; ++s) qf[s] = *(const LAS bf16x8*)(qs + 32 * s);
            attn_tile<false>(L + (kt & 1) * AT_TILE, L + (kt & 1) * AT_TILE + AT_KB, vh, qf, A0, 64 * kt, q0a + r, q0a, 0, tab, r, hh, lane); }
        if (kt <= qcb) { bf16x8 qf[4];
#pragma unroll
            for (int s = 0; s < 4; ++s) qf[s] = *(const LAS bf16x8*)(qs + 32 * 144 + 32 * s);
            attn_tile<false>(L + (kt & 1) * AT_TILE, L + (kt & 1) * AT_TILE + AT_KB, vh, qf, A1, 64 * kt, q0b + r, q0b, 0, tab, r, hh, lane); }
        if (kt + 1 < nkt) AT_ST((kt + 1) & 1);
        if (kt + 2 < nkt) AT_LD(kt + 2);
        __syncthreads();
    }
#undef AT_LD
#undef AT_ST
    { const float l0 = A0.l + __shfl_xor(A0.l, 32), i0 = 1.f / l0, l1 = A1.l + __shfl_xor(A1.l, 32), i1 = 1.f / l1;
#pragma unroll
        for (int mb = 0; mb < 4; ++mb)
#pragma unroll
            for (int i = 0; i < 16; ++i) { A0.o[mb][i] *= i0; A1.o[mb][i] *= i1; } }
    LAS float* X = (LAS float*)L;
    if (vh == 1) {
#pragma unroll
        for (int mb = 0; mb < 4; ++mb)
#pragma unroll
            for (int i = 0; i < 16; ++i) { X[(wq * 64 + mb * 16 + i) * 64 + lane] = A0.o[mb][i]; X[((4 + wq) * 64 + mb * 16 + i) * 64 + lane] = A1.o[mb][i]; }
    }
    __syncthreads();
    if (vh == 0) {
        const float lam = ((const float*)(F.ws + WS_TAB))[TB_LAM + m];
        const float lam_init = (m == 0) ? 0.2f : 0.47071302f;
#pragma unroll
        for (int mb = 0; mb < 4; ++mb)
#pragma unroll
            for (int i = 0; i < 16; ++i) A0.o[mb][i] -= lam * X[(wq * 64 + mb * 16 + i) * 64 + lane];
        attn_store(A0.o, F.in[I_DNG] + (size_t)m * 128, 1.f - lam_init, MIX + (rowb + q0a + r) * D + 512 + h * 128, hh, true);
#pragma unroll
        for (int mb = 0; mb < 4; ++mb)
#pragma unroll
            for (int i = 0; i < 16; ++i) A1.o[mb][i] -= lam * X[((4 + wq) * 64 + mb * 16 + i) * 64 + lane];
        attn_store(A1.o, F.in[I_DNG] + (size_t)m * 128, 1.f - lam_init, MIX + (rowb + q0b + r) * D + 512 + h * 128, hh, true);
    }
    __syncthreads();
}

__device__ __forceinline__ void attn_sample_unit(Frame& F, int m, int b, int h) {
    LAS unsigned char* L = F.lds; const LAS float* tab = (const LAS float*)(L + LDS_TAB);
    const bf16_t* H = (const bf16_t*)(F.ws + WS_H); bf16_t* MIX = (bf16_t*)(F.ws + WS_MIX);
    const float* ck = F.in[I_CK] + (((size_t)m * SB + b) * PAST) * 512 + h * 128; const float* cv = F.in[I_CV] + (((size_t)m * SB + b) * PAST) * 512 + h * 128;
    const int tid = opq(F.tid), lane = tid & 63, wave = __builtin_amdgcn_readfirstlane(tid >> 6), r = lane & 31, hh = lane >> 5, vh = wave >> 2, ks = wave & 3;
    const size_t rows = (size_t)MP + (size_t)b * ST;
    attn_build_tab(F, h);
    bf16x8 qf[4];
#pragma unroll
    for (int s = 0; s < 4; ++s) qf[s] = *(const bf16x8*)(H + (rows + (r & 15)) * INC + C_BQ + h * 128 + vh * 64 + 16 * s + 8 * hh);
    AttnState A;
#pragma unroll
    for (int mb = 0; mb < 4; ++mb)
#pragma unroll
        for (int i = 0; i < 16; ++i) A.o[mb][i] = 0.f;
    A.m = -1e30f; A.l = 0.f;
    constexpr int NT = PAST / 64 + 1;
    for (int it = 0; it < (NT + 3) / 4; ++it) {
#pragma unroll 1
        for (int j = 0; j < 4; ++j) { const int T = 4 * it + j;
#pragma unroll
            for (int i = 0; i < 2; ++i) { const int c = tid + 512 * i, key = c >> 4, ch = c & 15;
                u32x4 kw = {0u, 0u, 0u, 0u}, vw = {0u, 0u, 0u, 0u};
                if (T < PAST / 64) { const float* pk = ck + (size_t)(64 * T + key) * 512 + ch * 8; const float* pv = cv + (size_t)(64 * T + key) * 512 + ch * 8;
                    const f32x4 k0 = *(const f32x4*)pk, k1 = *(const f32x4*)(pk + 4), v0 = *(const f32x4*)pv, v1 = *(const f32x4*)(pv + 4);
                    kw.x = pk2(k0[0], k0[1]); kw.y = pk2(k0[2], k0[3]); kw.z = pk2(k1[0], k1[1]); kw.w = pk2(k1[2], k1[3]);
                    vw.x = pk2(v0[0], v0[1]); vw.y = pk2(v0[2], v0[3]); vw.z = pk2(v1[0], v1[1]); vw.w = pk2(v1[2], v1[3]); }
                else if (T == PAST / 64 && key < ST) { const bf16_t* src = H + (rows + key) * INC + h * 128 + ch * 8; kw = *(const u32x4*)(src + C_BK); vw = *(const u32x4*)(src + C_BV); }
                *(LAS u32x4*)(L + j * AT_TILE + key * AT_KP + ch * 16) = kw; *(LAS u32x4*)(L + j * AT_TILE + AT_KB + key * AT_VP + ch * 16) = vw; } }
        __syncthreads();
        { const int T = 4 * it + ks;
            if (T < NT - 1) attn_tile<false>(L + ks * AT_TILE, L + ks * AT_TILE + AT_KB, vh, qf, A, 64 * T, PAST + (r & 15), PAST, 0, tab, r, hh, lane);
            else if (T == NT - 1) attn_tile<true>(L + ks * AT_TILE, L + ks * AT_TILE + AT_KB, vh, qf, A, 64 * T, PAST + (r & 15), PAST, PAST + ST, tab, r, hh, lane); }
        __syncthreads();
    }
    const float lt = A.l + __shfl_xor(A.l, 32);
    LAS float* X = (LAS float*)L;
#pragma unroll
    for (int mb = 0; mb < 4; ++mb)
#pragma unroll
        for (int i = 0; i < 16; ++i) X[(wave * 66 + mb * 16 + i) * 64 + lane] = A.o[mb][i];
    X[(wave * 66 + 64) * 64 + lane] = A.m; X[(wave * 66 + 65) * 64 + lane] = lt;
    LAS float* Y = X + 8 * 66 * 64;
    LAS float* SS = Y + 64 * 64;
    __syncthreads();
    {
        const float lam = ((const float*)(F.ws + WS_TAB))[TB_LAM + m];
        float coef[8];
#pragma unroll
        for (int v2 = 0; v2 < 2; ++v2) {
            float M = -1e30f;
#pragma unroll
            for (int k = 0; k < 4; ++k) M = fmaxf(M, X[((v2 * 4 + k) * 66 + 64) * 64 + lane]);
            float Ls = 0.f;
#pragma unroll
            for (int k = 0; k < 4; ++k) { coef[v2 * 4 + k] = __builtin_amdgcn_exp2f(X[((v2 * 4 + k) * 66 + 64) * 64 + lane] - M); Ls += coef[v2 * 4 + k] * X[((v2 * 4 + k) * 66 + 65) * 64 + lane]; }
            const float sc = (v2 == 0 ? 1.f : -lam) / Ls;
#pragma unroll
            for (int k = 0; k < 4; ++k) coef[v2 * 4 + k] *= sc;
        }
        float ss = 0.f;
#pragma unroll
        for (int i8 = 0; i8 < 8; ++i8) { const int row = 8 * wave + i8; float y = 0.f;
#pragma unroll
            for (int p = 0; p < 8; ++p) y += coef[p] * X[(p * 66 + row) * 64 + lane];
            Y[row * 64 + lane] = y; ss += y * y; }
        SS[wave * 64 + lane] = ss;
    }
    __syncthreads();
    if (wave == 0) {
        float ss = 0.f;
#pragma unroll
        for (int w = 0; w < 8; ++w) ss += SS[w * 64 + lane];
        ss += __shfl_xor(ss, 32);
        const float lam_init = (m == 0) ? 0.2f : 0.47071302f;
        const float rstd = (1.f - lam_init) / sqrtf(ss * (1.f / 128.f) + RMS_EPS);
        const float* gnorm = F.in[I_DNG] + (size_t)m * 128;
        bf16_t* dst_row = MIX + (rows + (r & 15)) * D + 512 + h * 128;
        if (r < ST) {
#pragma unroll
            for (int mb = 0; mb < 4; ++mb)
#pragma unroll
                for (int g4 = 0; g4 < 4; ++g4) { const int dv = 32 * mb + 8 * g4 + 4 * hh; const f32x4 gv = *(const f32x4*)(gnorm + dv); const LAS float* yp = Y + (mb * 16 + 4 * g4) * 64 + lane;
                    u32x2 w; w.x = pk2(yp[0] * rstd * gv[0], yp[64] * rstd * gv[1]); w.y = pk2(yp[128] * rstd * gv[2], yp[192] * rstd * gv[3]);
                    *(u32x2*)(dst_row + dv) = w; }
        }
    }
    __syncthreads();
}

__device__ __forceinline__ void phase_mixer(Frame& F, int m, int qsel = 0) {
    const int G = F.G, bid = F.bid;
    if (PHM & 0x1000) for (int u = bid; u < PB * NH; u += G) hgrn_unit<false>(F, m, u >> 2, u & 3);
#if PROBE_HG
    for (int u = bid; u < PB * NH; u += G) hgrn_unit<false>(F, m, u >> 2, u & 3);
#endif
    if (PHM & 0x2000) for (int u = (G >= 256 ? (bid >= 128 ? bid - 128 : bid + G - 128) : bid); u < SB * NH; u += G) attn_sample_unit(F, m, u >> 2, u & 3);
#if PROBE_SA
    for (int u = (G >= 256 ? (bid >= 128 ? bid - 128 : bid + G - 128) : bid); u < SB * NH; u += G) attn_sample_unit(F, m, u >> 2, u & 3);
#endif
    if (PHM & 0x4000) {
        gu32* head = (gu32*)(F.ws + WS_CTL) + CW_QUEUE + 64 * m + 128 * qsel;
        volatile LAS int* slot = (volatile LAS int*)(F.lds + LDS_CTRL + 64);
        for (;;) {
            if (F.tid == 0) *slot = (int)__hip_atomic_fetch_add(head, 1u, __ATOMIC_RELAXED, __HIP_MEMORY_SCOPE_AGENT);
            __syncthreads();
            const int u = *slot;
            __syncthreads();
            if (u >= PB * NH * 8) break;
            const int qb = 7 - (u >> 7), bh = u & 127;
            attn_prompt_unit(F, m, bh >> 2, bh & 3, qb);
        }
    }
    if (PHM & 0x8000) for (int u = bid; u < SB * NH; u += G) hgrn_unit<true>(F, m, u >> 2, u & 3);
}

__global__ void __launch_bounds__(NTHREADS, 2) mega_fwd(Args args) {
    extern __shared__ __attribute__((aligned(16))) unsigned char lds_raw[];
    Frame F;
    F.lds = (LAS unsigned char*)lds_raw;
    F.tid = threadIdx.x; F.lane = F.tid & 63; F.wave = __builtin_amdgcn_readfirstlane(F.tid >> 6);
    const int wave_s = F.wave;
    F.bid = blockIdx.x; F.G = gridDim.x; F.in = (kin_t)__builtin_amdgcn_kernarg_segment_ptr(); F.out = (float*)F.in[24]; F.ws = (unsigned char*)F.in[25];
    if (F.tid < 128) ((LAS unsigned*)(F.lds + LDS_CTRL))[F.tid] = 0u;
    __syncthreads();
    unsigned* barw = (unsigned*)(F.ws + WS_CTL) + CW_BAR;
    XcdBarrier bar; bar.bar = barw; bar.x = 0; bar.st = nullptr;
    const bool single = args.single != 0;
    if (single) bar = xcd_barrier_post(barw, (volatile LAS unsigned*)(F.lds + LDS_CTRL + 32));
    const int lo = args.ph_lo, hi = args.ph_hi;
#define RUN(p) (lo <= (p) && (p) < hi)
#define SEAM() do { if (single) { XcdBarrier b2_ = bar; asm volatile("" : "+s"(b2_.bar)); xcd_barrier(b2_); } } while (0)
#define REFRESH() do { { int b_ = (int)blockIdx.x, g_ = (int)gridDim.x; asm volatile("" : "+s"(b_), "+s"(g_)); F.bid = b_; F.G = g_; } { kin_t kp_ = (kin_t)__builtin_amdgcn_kernarg_segment_ptr(); asm volatile("" : "+s"(kp_)); F.in = kp_; F.out = (float*)kp_[24]; F.ws = (unsigned char*)kp_[25]; } { int l_; asm volatile("v_mbcnt_lo_u32_b32 %0, -1, 0\n\tv_mbcnt_hi_u32_b32 %0, -1, %0" : "=v"(l_)); F.lane = l_; } F.wave = wave_s; F.tid = wave_s * 64 + F.lane; } while (0)
    int ph = 0;
    if ((PHM & 1) && RUN(ph)) { REFRESH(); phase_prologue(F); SEAM();
#if PROBE_PRO
        REFRESH(); phase_prologue(F); SEAM();
#endif
    } ++ph;
    for (int l = 0; l < 4; ++l) {
#define WSB(off) ((bf16_t*)(F.ws + (off)))
#define STATS(k) ((float*)(F.ws + WS_CTL) + CW_STATS + (size_t)(k) * MT * 2)
#define LN1REF(ll) LnRef{WSB(WS_Z), STATS(2 * (ll)), F.in[I_L1G] + (size_t)(ll) * D, F.in[I_L1B] + (size_t)(ll) * D, 0}
#define LN2REF(ll) LnRef{WSB(WS_ZB), STATS(2 * (ll) + 1), F.in[I_L2G] + (size_t)(ll) * D, F.in[I_L2B] + (size_t)(ll) * D, 0}
        if ((l & 1) == 0) {
            const int m = l >> 1;
            if ((PHM & 2) && RUN(ph)) {
                REFRESH();
                const float* ctlf = (const float*)(F.ws + WS_CTL);
                pg8::Gemm g{l == 0 ? WSB(WS_XB) : WSB(WS_ZB), (const bf16_t*)(F.ws + WS_WIN) + (size_t)m * INC * D, MP, INC, D, D, 0, l == 0 ? nullptr : STATS(2 * (l - 1) + 1)}; pg8::StaticOrder S; S.init(MP, INC, F.G, F.bid);
                EpiIn E{(bf16_t*)(F.ws + WS_H), (float*)(F.ws + WS_LF), (const float*)(F.ws + WS_TAB) + TB_LB + m * 512,
                        F.out + O_KP + (size_t)m * MP * 512, F.out + O_VP + (size_t)m * MP * 512, F.out + O_KS + (size_t)m * MS * 512, F.out + O_VS + (size_t)m * MS * 512,
                        STATS(l == 0 ? 0 : 2 * (l - 1) + 1), ctlf + (l == 0 ? UC_ZERO : UC_UIN), ctlf + (l == 0 ? UC_ZERO : UC_CIN), l == 0 ? 1 : 0};
                pg8::gemm_phase<EpiIn>(F.lds, g, S, E, F.tid);
                REFRESH(); sgemm_in_phase(F.lds, g.A + (size_t)MP * D, g.Bt, F.bid, F.G, F.tid, E);
                SEAM(); } ++ph;
            if ((PHM & 4) && RUN(ph)) { REFRESH(); phase_mixer(F, m); SEAM();
#if PROBE_MIXER
                REFRESH(); phase_mixer(F, m, 1); SEAM();
#endif
            } ++ph;
            if ((PHM & 8) && RUN(ph)) {
                REFRESH();
                pg8::Gemm g{(const bf16_t*)(F.ws + WS_MIX), (const bf16_t*)(F.ws + WS_WOUT) + (size_t)m * D * D, MP, D, D, D, 0, l == 0 ? nullptr : STATS(2 * (l - 1) + 1)}; pg8::StaticOrder S; S.init(MP, D, F.G, F.bid);
                LnRef P = LN2REF(l == 0 ? 0 : l - 1); if (l == 0) { P.Z = WSB(WS_XB); P.ident = 1; }
                EpiRes E{P, WSB(WS_Z), STATS(2 * l), nullptr};
                pg8::gemm_phase<EpiRes>(F.lds, g, S, E, F.tid);
                REFRESH(); sgemm_res_phase<128>(F.lds, g.A + (size_t)MP * D, D, 0, g.Bt, D, F.bid, F.G, F.tid, P, WSB(WS_Z), STATS(2 * l), nullptr);
                SEAM(); } ++ph;
        } else {
            const int p = l >> 1;
            if ((PHM & 16) && RUN(ph)) { REFRESH(); const LnRef R = LN2REF(l - 1); phase_pool_prep(F, R, p); SEAM(); } ++ph;
            ++ph;
            if ((PHM & 32) && RUN(ph)) {
                REFRESH();
                pg8::Gemm g{(const bf16_t*)(F.ws + WS_MIX), (const bf16_t*)(F.ws + WS_WPOOL) + (size_t)p * D * 256, MP, D, 256, D, 256, STATS(2 * (l - 1) + 1)}; pg8::StaticOrder S; S.init(MP, D, F.G, F.bid);
                EpiRes E{LN2REF(l - 1), WSB(WS_Z), STATS(2 * l), F.in[I_PSC] + (size_t)p * D};
                pg8::gemm_phase<EpiRes>(F.lds, g, S, E, F.tid);
                REFRESH(); { const LnRef P2 = LN2REF(l - 1); sgemm_res_phase<32>(F.lds, g.A + (size_t)MP * D, D, 256, g.Bt, 256, F.bid, F.G, F.tid, P2, WSB(WS_Z), STATS(2 * l), E.scale); }
                SEAM(); } ++ph;
        }
        ++ph;
        if ((PHM & 128) && RUN(ph)) {
            REFRESH();
            const float* ctlf = (const float*)(F.ws + WS_CTL);
            pg8::Gemm g{WSB(WS_Z), (const bf16_t*)(F.ws + WS_WUP) + (size_t)l * UPN * D, MT, UPN, D, D, 0, STATS(2 * l)}; pg8::StaticOrder S; S.init(MT, UPN, F.G, F.bid);
            EpiUpConv E{(bf16_t*)(F.ws + WS_G), F.in[I_CW] + (size_t)l * 3 * DFF, F.in[I_CB] + (size_t)l * DFF, F.in[I_SC] + (size_t)l * SB * 2 * DFF,
                        (float*)(F.ws + WS_AHEAD), (float*)(F.ws + WS_BHEAD), (float*)(F.ws + WS_ATAIL), F.out + O_CP + (size_t)l * PB * 2 * DFF, F.out + O_CS + (size_t)l * SB * 2 * DFF, (LAS float*)(F.lds + LDS_EX),
                        STATS(2 * l), ctlf + UC_UUP + (size_t)l * UPN, ctlf + UC_CUP + (size_t)l * UPN};
            pg8::gemm_phase<EpiUpConv>(F.lds, g, S, E, F.tid); SEAM();
#if PROBE_UP
            REFRESH(); pg8::gemm_phase<EpiUpConv>(F.lds, g, S, E, F.tid); SEAM();
#endif
            } ++ph;
        ++ph;
        if ((PHM & 512) && RUN(ph)) {
            REFRESH();
            pg8::Gemm g{(const bf16_t*)(F.ws + WS_G), (const bf16_t*)(F.ws + WS_WDN) + (size_t)l * D * DFF, MP, D, DFF, DFF, 0, STATS(2 * l)}; pg8::StaticOrder S; S.init(MP, D, F.G, F.bid);
            conv_fix_local(F, l, S); REFRESH();
            EpiRes E{LN1REF(l), WSB(WS_ZB), STATS(2 * l + 1), nullptr};
            pg8::gemm_phase<EpiRes>(F.lds, g, S, E, F.tid);
            REFRESH(); { const LnRef P1 = LN1REF(l); sgemm_res_phase<352>(F.lds, g.A + (size_t)MP * DFF, DFF, 0, g.Bt, DFF, F.bid, F.G, F.tid, P1, WSB(WS_ZB), STATS(2 * l + 1), nullptr); }
            SEAM(); } ++ph;
        if ((PHM & 1024) && RUN(ph) && l == 3) { REFRESH(); phase_ln_final(F, WSB(WS_ZB), F.in[I_L2G] + (size_t)3 * D, F.in[I_L2B] + (size_t)3 * D); } ++ph;
    }
#undef RUN
#undef SEAM
}
constexpr int N_PHASES = 1 + 4 * 8;

extern "C" void kernel_launch(void* const* d_in, const int* in_sizes, int n_in, void* d_out, int out_size, void* d_ws, size_t ws_size, hipStream_t stream) {
    static int grid = 0;
    if (grid == 0) {
        if (n_in != 24 || (size_t)out_size != O_END || ws_size < WS_END2) { fprintf(stderr, "kernel_launch: unexpected problem (n_in %d out %d ws %zu)\n", n_in, out_size, ws_size); grid = -1; return; }
        int dev = 0, cus = 0;
        if (hipGetDevice(&dev) != hipSuccess || hipDeviceGetAttribute(&cus, hipDeviceAttributeMultiprocessorCount, dev) != hipSuccess) { grid = -1; return; }
        if (hipFuncSetAttribute((const void*)mega_fwd, hipFuncAttributeMaxDynamicSharedMemorySize, LDS_BYTES) != hipSuccess) { fprintf(stderr, "kernel_launch: hipFuncSetAttribute failed\n"); grid = -1; return; }
        int per_cu = 0;
        if (hipOccupancyMaxActiveBlocksPerMultiprocessor(&per_cu, (const void*)mega_fwd, NTHREADS, LDS_BYTES) != hipSuccess || per_cu < 1) fprintf(stderr, "kernel_launch: occupancy query reports %d\n", per_cu);
        (void)hipGetLastError();
        grid = cus;
    }
    if (grid < 0) return;
    (void)hipMemsetAsync((char*)d_ws + WS_CTL, 0, CTL_ZERO_BYTES, stream);
    Args a{};
    for (int i = 0; i < 24; ++i) a.in[i] = (const float*)d_in[i];
    a.out = (float*)d_out; a.ws = (unsigned char*)d_ws; a.pad = 0;
#if MK_SINGLE
    a.ph_lo = 0; a.ph_hi = N_PHASES; a.single = 1;
    hipLaunchKernelGGL(mega_fwd, dim3(grid), dim3(NTHREADS), LDS_BYTES, stream, a);
#else
    for (int p = 0; p < N_PHASES; ++p) {
        const int k = (p - 1) % 8, l = (p - 1) / 8;
        if (p > 0 && (l & 1) == 1 && k == 1) continue;
        a.ph_lo = p; a.ph_hi = p + 1; a.single = 0;
        hipLaunchKernelGGL(mega_fwd, dim3(grid), dim3(NTHREADS), LDS_BYTES, stream, a);
    }
#endif
}
```

```cpp
#include <hip/hip_runtime.h>
#include <cstdio>
#include <cstdint>

#ifndef PHM
#define PHM 0xffff
#endif
#ifndef PROBE_MIXER
#define PROBE_MIXER 0
#endif
#ifndef EMU_BF16
#define EMU_BF16 0
#endif
#ifndef PROBE_LN
#define PROBE_LN 0
#endif
#ifndef PROBE_PRO
#define PROBE_PRO 0
#endif
#ifndef PROBE_HG
#define PROBE_HG 0
#endif
#ifndef PROBE_SA
#define PROBE_SA 0
#endif
#ifndef PROBE_UP
#define PROBE_UP 0
#endif
#ifndef MK_SINGLE
#define MK_SINGLE 1
#endif

#define LAS __attribute__((address_space(3)))
#define GAS __attribute__((address_space(1)))
typedef unsigned short bf16_t;
typedef short bf16x8 __attribute__((ext_vector_type(8)));
typedef short s16x4 __attribute__((ext_vector_type(4)));
typedef float f32x2 __attribute__((ext_vector_type(2)));
typedef float f32x4 __attribute__((ext_vector_type(4)));
typedef float f32x16 __attribute__((ext_vector_type(16)));
typedef unsigned u32x2 __attribute__((ext_vector_type(2)));
typedef unsigned u32x4 __attribute__((ext_vector_type(4)));
typedef __bf16 bf16x2_t __attribute__((ext_vector_type(2)));
typedef GAS unsigned gu32;

constexpr int D = 1024, PB = 32, PT = 2048, SB = 32, ST = 16, PAST = 4096;
constexpr int MP = PB * PT, MS = SB * ST, MT = MP + MS;
constexpr int INC = 3584, DFF = 2816, UPN = 2 * DFF, NH = 4;
constexpr int C_AQ = 0, C_AF = 512, C_AI = 1024, C_AG = 1536, C_BQ = 2048, C_BK = 2560, C_BV = 3072;
constexpr float DN_ALPHA = 1.681792830507429f;
constexpr float LN_EPS = 1e-5f, RMS_EPS = 1e-6f;
constexpr float LOG2E = 1.4426950408889634f;
constexpr int NWAVES = 8, NTHREADS = 512;

constexpr size_t O_YP = 0;
constexpr size_t O_YS = O_YP + (size_t)MP * D;
constexpr size_t O_KP = O_YS + (size_t)MS * D;
constexpr size_t O_VP = O_KP + (size_t)2 * MP * 512;
constexpr size_t O_HP = O_VP + (size_t)2 * MP * 512;
constexpr size_t O_PP = O_HP + (size_t)2 * PB * NH * 128 * 128;
constexpr size_t O_CP = O_PP + (size_t)2 * PB * 15 * D;
constexpr size_t O_KS = O_CP + (size_t)4 * PB * 2 * DFF;
constexpr size_t O_VS = O_KS + (size_t)2 * MS * 512;
constexpr size_t O_HS = O_VS + (size_t)2 * MS * 512;
constexpr size_t O_PS = O_HS + (size_t)2 * SB * NH * 128 * 128;
constexpr size_t O_CS = O_PS + (size_t)2 * SB * 15 * D;
constexpr size_t O_END = O_CS + (size_t)4 * SB * 2 * DFF;
static_assert(O_END == 214695936ull, "d_out size");

constexpr size_t WS_CTL = 0, CTL_ZERO_BYTES = 8u << 20;
constexpr size_t WS_WIN = CTL_ZERO_BYTES;
constexpr size_t WS_WOUT = WS_WIN + (size_t)2 * INC * D * 2;
constexpr size_t WS_WPOOL = WS_WOUT + (size_t)2 * D * D * 2;
constexpr size_t WS_WUP = WS_WPOOL + (size_t)2 * D * 256 * 2;
constexpr size_t WS_WDN = WS_WUP + (size_t)4 * UPN * D * 2;
constexpr size_t WS_TAB = WS_WDN + (size_t)4 * D * DFF * 2;
constexpr size_t WS_XB = WS_TAB + 65536;
constexpr size_t WS_Z = WS_XB + (size_t)MT * D * 2;
constexpr size_t WS_ZB = WS_Z + (size_t)MT * D * 2;
constexpr size_t WS_MIX = WS_Z + (size_t)MT * D * 4;
constexpr size_t WS_G = WS_MIX + (size_t)MT * D * 2;
constexpr size_t WS_A = WS_G + (size_t)MT * DFF * 2;
constexpr size_t WS_H = WS_A;
constexpr size_t WS_LF = WS_H + (size_t)MT * INC * 2;
constexpr size_t WS_AB = WS_A;
constexpr size_t WS_END = WS_A + (size_t)MT * UPN * 2;
static_assert(WS_LF + (size_t)MT * 512 * 4 <= WS_END, "H|LF inside region A");
constexpr size_t SIDE_BYTES = (size_t)(MT / 256) * 2 * DFF * 4;
constexpr size_t WS_AHEAD = WS_END, WS_BHEAD = WS_AHEAD + SIDE_BYTES, WS_ATAIL = WS_BHEAD + SIDE_BYTES, WS_END2 = WS_ATAIL + SIDE_BYTES;
static_assert(WS_END2 <= 2147483648ull, "workspace");
constexpr int CW_TMO = 0;
constexpr int CW_BAR = 4096;
constexpr int CW_QUEUE = 16384;
constexpr int CW_STATS = 262144;
constexpr int CW_UC = CW_STATS + 8 * MT * 2;
constexpr int UC_UUP = CW_UC, UC_CUP = UC_UUP + 4 * UPN, UC_UIN = UC_CUP + 4 * UPN, UC_CIN = UC_UIN + INC, UC_ZERO = UC_CIN + INC, UC_END = UC_ZERO + INC;
static_assert((size_t)UC_END * 4 <= CTL_ZERO_BYTES, "zeroed region");
constexpr int TB_LB = 0;
constexpr int TB_LAM = 1024;

constexpr int LDS_BYTES = 163840;
constexpr int LDS_CTRL = LDS_BYTES - 512;
constexpr int LDS_TAB = LDS_CTRL - 1024;
constexpr int LDS_STT = 131072 + 4096;
constexpr int LDS_CT = 131072 + 8192;
constexpr int LDS_EX = 131072;

__device__ __forceinline__ unsigned pk2(float lo, float hi) { f32x2 v = {lo, hi}; bf16x2_t b = __builtin_convertvector(v, bf16x2_t); return __builtin_bit_cast(unsigned, b); }
__device__ __forceinline__ float bflo(unsigned u) { return __builtin_bit_cast(float, u << 16); }
__device__ __forceinline__ float bfhi(unsigned u) { return __builtin_bit_cast(float, u & 0xffff0000u); }
__device__ __forceinline__ u32x4 pk8(const float* v) { u32x4 w; w.x = pk2(v[0], v[1]); w.y = pk2(v[2], v[3]); w.z = pk2(v[4], v[5]); w.w = pk2(v[6], v[7]); return w; }
__device__ __forceinline__ void unpk8(u32x4 w, float* v) { v[0] = bflo(w.x); v[1] = bfhi(w.x); v[2] = bflo(w.y); v[3] = bfhi(w.y); v[4] = bflo(w.z); v[5] = bfhi(w.z); v[6] = bflo(w.w); v[7] = bfhi(w.w); }
__device__ __forceinline__ float wave_sum(float v) {
#pragma unroll
    for (int o = 1; o < 64; o <<= 1) v += __shfl_xor(v, o);
    return v;
}
__device__ __forceinline__ int opq(int x) { asm volatile("" : "+v"(x)); return x; }
__device__ __forceinline__ int lane_id_v() { int l_; asm volatile("v_mbcnt_lo_u32_b32 %0, -1, 0\n\tv_mbcnt_hi_u32_b32 %0, -1, %0" : "=v"(l_)); return l_; }
__device__ __forceinline__ float silu_mul(float c, float b) { return c * __builtin_amdgcn_rcpf(1.f + __builtin_amdgcn_exp2f(-LOG2E * c)) * b; }
__device__ __forceinline__ int crow(int reg, int h) { return (reg & 3) + 8 * (reg >> 2) + 4 * h; }
__device__ __forceinline__ s16x4 vtr(const LAS unsigned char* p) { return __builtin_bit_cast(s16x4, __builtin_amdgcn_ds_read_tr16_b64_v4i16((LAS s16x4*)p)); }
__device__ __forceinline__ bf16x8 cat8(s16x4 lo, s16x4 hi) { return (bf16x8){lo[0], lo[1], lo[2], lo[3], hi[0], hi[1], hi[2], hi[3]}; }
#define MFMA32(a, b, c) __builtin_amdgcn_mfma_f32_32x32x16_bf16((a), (b), (c), 0, 0, 0)
__device__ __forceinline__ bf16x8 pack_step(const f32x16& x, int s) {
    u32x4 p; p.x = pk2(x[8 * s], x[8 * s + 1]); p.y = pk2(x[8 * s + 2], x[8 * s + 3]); p.z = pk2(x[8 * s + 4], x[8 * s + 5]); p.w = pk2(x[8 * s + 6], x[8 * s + 7]);
    return __builtin_bit_cast(bf16x8, p);
}

namespace pg8 {
constexpr int BM = 256, BK = 64, HALF = 128, HTB = HALF * BK * 2, STAGE_BYTES = 8 * HTB, NXCD = 8, WGM = 8;
__host__ __device__ __forceinline__ int lds_byte(int r, int c) { const int st = (r >> 4) * 2 + (c >> 5), rr = r & 15, cc = c & 31, ob = rr * 64 + cc * 2; return st * 1024 + (ob ^ (((ob >> 9) & 1) << 5)); }
__host__ __device__ __forceinline__ void stage_rc(int b, int& R, int& C) { const int st = b / 1024, sb = b % 1024, swz = sb ^ (((sb >> 9) & 1) << 5); R = (st >> 1) * 16 + swz / 64; C = (st & 1) * 32 + (swz % 64) / 2; }
__host__ __device__ __forceinline__ int perm32(int rho) { const int n = rho >> 4, i = rho & 15; return 8 * (i >> 2) + 4 * n + (i & 3); }
struct Unit { int pm, pn; };
struct Gemm { const bf16_t* A; const bf16_t* Bt; int M, N, K, lda, a_pn_step; const float* st; };
struct StaticOrder {
    int nM, nN, nwg, G, c;
    __device__ void init(int M, int N, int G_, int c_) { nM = M / BM; nN = N / BM; nwg = nM * nN; G = G_; c = c_; }
    __device__ bool next(int i, Unit& u) const {
        const long L = (long)i * G + c; if (L >= nwg) return false;
        int wgid = (int)L; { const int q = nwg / NXCD, r = nwg % NXCD, xcd = wgid % NXCD, off = wgid / NXCD; wgid = (xcd < r ? xcd * (q + 1) : r * (q + 1) + (xcd - r) * q) + off; }
        const int nig = WGM * nN, gid = wgid / nig, fm = gid * WGM, gsz = (nM - fm) < WGM ? (nM - fm) : WGM;
        u.pm = fm + ((wgid % nig) % gsz); u.pn = (wgid % nig) / gsz; return true;
    }
};
template <class Epi>
__device__ __forceinline__ void gemm_phase(LAS unsigned char* lds, const Gemm g, const StaticOrder& S, const Epi& E, int tid_in) {
    const int tid = tid_in, wid = __builtin_amdgcn_readfirstlane(tid >> 6), lane = tid & 63, wr = wid >> 2, wc = wid & 3, fr = lane & 15, fq = lane >> 4;
    const int K = g.K, nt = K / BK, lda = g.lda;
    unsigned voffA[2], voffB[2];
#define PG8_VOFF() do { const int t_ = wid * 64 + lane_id_v(); _Pragma("unroll") for (int i = 0; i < 2; ++i) { int R, C; stage_rc(t_ * 16 + i * 8192, R, C); const int Rb = (R & ~31) + perm32(R & 31); \
        voffA[i] = (unsigned)(R * lda + C) * 2u; voffB[i] = (unsigned)(Rb * K + C) * 2u; } } while (0)
    PG8_VOFF();
    const size_t kstep = (size_t)(BK * 2);
    const size_t hstepA = (size_t)HALF * lda * 2, hstepB = (size_t)HALF * K * 2;
    const size_t tstepA = 2 * hstepA, tstepB = 2 * hstepB;
    const size_t pnA = (size_t)g.a_pn_step * 2;
    const unsigned ldsw = (unsigned)wid * 1024u;
    const int aoff = lds_byte(wr * 64 + fr, fq * 8), boff = lds_byte(wc * 32 + fr, fq * 8);
#define PG8_SA(b, h) (((b) * 2 + (h)) * HTB)
#define PG8_SB(b, h) ((4 + (b) * 2 + (h)) * HTB)
#define PG8_STAGE(bufoff, gbase, voff) do { _Pragma("unroll") for (int _i = 0; _i < 2; ++_i) \
        __builtin_amdgcn_global_load_lds((const unsigned*)((const char*)(gbase) + (voff)[_i]), (LAS unsigned*)(lds + (bufoff) + ldsw + _i * 8192), 16, 0, 0); } while (0)
#define PG8_LDA(dst, b, h) do { _Pragma("unroll") for (int m = 0; m < 4; ++m) _Pragma("unroll") for (int k = 0; k < 2; ++k) dst[m][k] = *(const LAS bf16x8*)(lds + PG8_SA(b, h) + aoff + m * 2048 + k * 1024); } while (0)
#define PG8_LDB(dst, b, h) do { _Pragma("unroll") for (int n = 0; n < 2; ++n) _Pragma("unroll") for (int k = 0; k < 2; ++k) dst[n][k] = *(const LAS bf16x8*)(lds + PG8_SB(b, h) + boff + n * 2048 + k * 1024); } while (0)
#define PG8_MMA(ai, bj, At, Bt) do { __builtin_amdgcn_s_setprio(1); _Pragma("unroll") for (int m = 0; m < 4; ++m) _Pragma("unroll") for (int n = 0; n < 2; ++n) _Pragma("unroll") for (int k = 0; k < 2; ++k) \
        acc[ai][bj][m][n] = __builtin_amdgcn_mfma_f32_16x16x32_bf16(Bt[n][k], At[m][k], acc[ai][bj][m][n], 0, 0, 0); __builtin_amdgcn_s_setprio(0); } while (0)
#define PG8_WAIT_V(n) asm volatile("s_waitcnt vmcnt(" #n ")" ::: "memory")
#define PG8_WAIT_L(n) asm volatile("s_waitcnt lgkmcnt(" #n ")" ::: "memory")
#define PG8_BAR __builtin_amdgcn_s_barrier()
#define PG8_SCHED __builtin_amdgcn_sched_barrier(0)
    Unit cur, nxt; int ui = 0;
    if (!S.next(0, cur)) return;
#define PG8_STATS(pm_, par_) do { if (g.st) __builtin_amdgcn_global_load_lds((const unsigned*)(g.st + (size_t)(pm_) * 512 + 64 * wid + lane_id_v()), (LAS unsigned*)(lds + LDS_STT + (par_) * 2048 + wid * 256), 4, 0, 0); } while (0)
    PG8_STATS(cur.pm, 0); __builtin_amdgcn_sched_barrier(0); E.prefetch(cur, 0, wid, lds);
    f32x4 acc[2][2][4][2];
#pragma unroll
    for (int a = 0; a < 2; ++a)
#pragma unroll
        for (int b = 0; b < 2; ++b)
#pragma unroll
            for (int m = 0; m < 4; ++m)
#pragma unroll
                for (int n = 0; n < 2; ++n) acc[a][b][m][n] = (f32x4){0.f, 0.f, 0.f, 0.f};
    bf16x8 At[4][2], B0[2][2], B1[2][2];
    const char* cA = (const char*)g.A + (size_t)cur.pm * tstepA + (size_t)cur.pn * pnA; const char* cB = (const char*)g.Bt + (size_t)cur.pn * tstepB;
    PG8_STAGE(PG8_SB(0, 0), cB, voffB); PG8_STAGE(PG8_SB(0, 1), cB + hstepB, voffB); PG8_STAGE(PG8_SA(0, 0), cA, voffA); PG8_STAGE(PG8_SA(0, 1), cA + hstepA, voffA);
    if (wr == 1) PG8_BAR;
    PG8_WAIT_V(2); PG8_BAR;
    PG8_STAGE(PG8_SB(1, 0), cB + kstep, voffB); PG8_STAGE(PG8_SA(1, 0), cA + kstep, voffA); PG8_STAGE(PG8_SB(1, 1), cB + hstepB + kstep, voffB);
    PG8_WAIT_V(6); PG8_BAR;
    for (;;) {
        const bool has_next = S.next(ui + 1, nxt);
        const char* nA = has_next ? (const char*)g.A + (size_t)nxt.pm * tstepA + (size_t)nxt.pn * pnA : cA; const char* nB = has_next ? (const char*)g.Bt + (size_t)nxt.pn * tstepB : cB;
        for (int t = 0; t < nt; t += 2) {
            const bool last = (t == nt - 2);
            const char* a1 = cA + (size_t)(t + 1) * kstep;
            const char* a2 = last ? nA : cA + (size_t)(t + 2) * kstep; const char* b2 = last ? nB : cB + (size_t)(t + 2) * kstep;
            const char* a3 = a2 + kstep; const char* b3 = b2 + kstep;
            PG8_LDB(B0, 0, 0); PG8_LDB(B1, 0, 1); PG8_SCHED; PG8_LDA(At, 0, 0); PG8_STAGE(PG8_SA(1, 1), a1 + hstepA, voffA);
            PG8_WAIT_V(8); PG8_WAIT_L(0); PG8_BAR; PG8_MMA(0, 0, At, B0); PG8_MMA(0, 1, At, B1); PG8_BAR; PG8_SCHED;
            PG8_LDA(At, 0, 1); PG8_STAGE(PG8_SB(0, 0), b2, voffB); PG8_STAGE(PG8_SB(0, 1), b2 + hstepB, voffB); PG8_STAGE(PG8_SA(0, 0), a2, voffA);
            PG8_WAIT_V(8); PG8_WAIT_L(0); PG8_BAR; PG8_MMA(1, 0, At, B0); PG8_MMA(1, 1, At, B1); PG8_BAR; PG8_SCHED;
            PG8_LDB(B0, 1, 0); PG8_LDB(B1, 1, 1); PG8_SCHED; PG8_LDA(At, 1, 0); PG8_STAGE(PG8_SA(0, 1), a2 + hstepA, voffA);
            PG8_WAIT_V(8); PG8_WAIT_L(0); PG8_BAR; PG8_MMA(0, 0, At, B0); PG8_MMA(0, 1, At, B1); PG8_BAR; PG8_SCHED;
            PG8_LDA(At, 1, 1); PG8_STAGE(PG8_SB(1, 0), b3, voffB); PG8_STAGE(PG8_SB(1, 1), b3 + hstepB, voffB); PG8_STAGE(PG8_SA(1, 0), a3, voffA);
            PG8_WAIT_V(8); PG8_WAIT_L(0); PG8_BAR; PG8_MMA(1, 0, At, B0); PG8_MMA(1, 1, At, B1); PG8_BAR; PG8_SCHED;
        }
        if (wr == 0) PG8_BAR;
        { const int le = lane_id_v(); int wr_ = wr, wc_ = wc; asm volatile("" : "+s"(wr_), "+s"(wc_));
          E(acc, cur, wr_, wc_, le & 15, le >> 4, (const LAS float*)(lds + LDS_STT + (ui & 1) * 2048), (const LAS float*)(lds + LDS_CT + (ui & 1) * 4096)); }
        if (!has_next) break;
#pragma unroll
        for (int a = 0; a < 2; ++a)
#pragma unroll
            for (int b = 0; b < 2; ++b)
#pragma unroll
                for (int m = 0; m < 4; ++m)
#pragma unroll
                    for (int n = 0; n < 2; ++n) acc[a][b][m][n] = (f32x4){0.f, 0.f, 0.f, 0.f};
        cur = nxt; cA = nA; cB = nB; ++ui;
        PG8_VOFF();
        PG8_STATS(cur.pm, ui & 1); E.prefetch(cur, ui & 1, wid, lds);
        if (wr == 1) PG8_BAR;
    }
    PG8_WAIT_V(0);
    PG8_BAR;
#undef PG8_STATS
#undef PG8_VOFF
#undef PG8_SA
#undef PG8_SB
#undef PG8_STAGE
#undef PG8_LDA
#undef PG8_LDB
#undef PG8_MMA
#undef PG8_WAIT_V
#undef PG8_WAIT_L
#undef PG8_BAR
#undef PG8_SCHED
}
}

struct LnRef { const bf16_t* Z; const float* st; const float* g; const float* b; int ident; };
__device__ __forceinline__ void ln_row(const float* st, size_t row, int ident, float& mu, float& rstd) {
    mu = 0.f; rstd = 1.f;
    if (!ident) { const f32x2 s = *(const f32x2*)(st + row * 2); mu = s[0] * (1.f / D); rstd = 1.f / sqrtf(fmaxf(s[1] * (1.f / D) - mu * mu, 0.f) + LN_EPS); }
}
__device__ __forceinline__ void ln_row_lds(const LAS float* stt, int rl, int ident, float& mu, float& rstd) {
    mu = 0.f; rstd = 1.f;
    if (!ident) { const f32x2 s = *(const LAS f32x2*)(stt + 2 * rl); mu = s[0] * (1.f / D); rstd = __builtin_amdgcn_rsqf(fmaxf(s[1] * (1.f / D) - mu * mu, 0.f) + LN_EPS); }
}
struct EpiBf16 {
    __device__ __forceinline__ void prefetch(const pg8::Unit&, int, int, LAS unsigned char*) const {}
    bf16_t* O; int ldc;
    __device__ __forceinline__ void operator()(const f32x4 (&acc)[2][2][4][2], const pg8::Unit& u, int wr, int wc, int fr, int fq, const LAS float* stt, const LAS float* ct) const {
        const int row0 = u.pm * 256 + wr * 64 + fr, col0 = u.pn * 256 + wc * 32 + 8 * fq;
#pragma unroll
        for (int ai = 0; ai < 2; ++ai)
#pragma unroll
            for (int m = 0; m < 4; ++m) { bf16_t* rowp = O + (size_t)(row0 + ai * 128 + m * 16) * ldc + col0;
#pragma unroll
                for (int bj = 0; bj < 2; ++bj) { const f32x4 v0 = acc[ai][bj][m][0], v1 = acc[ai][bj][m][1];
                    u32x4 w; w.x = pk2(v0[0], v0[1]); w.y = pk2(v0[2], v0[3]); w.z = pk2(v1[0], v1[1]); w.w = pk2(v1[2], v1[3]);
                    *(u32x4*)(rowp + bj * 128) = w; } }
    }
};
struct EpiIn {
    __device__ __forceinline__ void prefetch(const pg8::Unit&, int, int, LAS unsigned char*) const {}
    bf16_t* H; float* LF; const float* lbv; float* kP; float* vP; float* kS; float* vS; const float* st; const float* uu; const float* cc; int ident;
    __device__ __forceinline__ void operator()(const f32x4 (&acc_in)[2][2][4][2], const pg8::Unit& u, int wr, int wc, int fr, int fq, const LAS float* stt, const LAS float* ct) const {
        f32x4 acc[2][2][4][2];
        { const int r0 = u.pm * 256 + wr * 64 + fr, c0 = u.pn * 256 + wc * 32 + 8 * fq;
#pragma unroll
          for (int bj = 0; bj < 2; ++bj) { const f32x4 u0 = *(const f32x4*)(uu + c0 + bj * 128), u1 = *(const f32x4*)(uu + c0 + bj * 128 + 4), k0 = *(const f32x4*)(cc + c0 + bj * 128), k1 = *(const f32x4*)(cc + c0 + bj * 128 + 4);
#pragma unroll
            for (int ai = 0; ai < 2; ++ai)
#pragma unroll
                for (int m = 0; m < 4; ++m) { float mu, rstd; ln_row_lds(stt, wr * 64 + fr + ai * 128 + m * 16, ident, mu, rstd);
                    const float nb = -mu * rstd; acc[ai][bj][m][0] = acc_in[ai][bj][m][0] * rstd + (u0 * nb + k0); acc[ai][bj][m][1] = acc_in[ai][bj][m][1] * rstd + (u1 * nb + k1); } } }
        const int row0 = u.pm * 256 + wr * 64 + fr, col0 = u.pn * 256 + wc * 32 + 8 * fq;
        const int kind = u.pn >> 1;
        if (kind == 1) {
#pragma unroll
            for (int bj = 0; bj < 2; ++bj) { const int c = col0 + bj * 128 - C_AF;
                const f32x4 l0 = *(const f32x4*)(lbv + c), l1 = *(const f32x4*)(lbv + c + 4);
#pragma unroll
                for (int ai = 0; ai < 2; ++ai)
#pragma unroll
                    for (int m = 0; m < 4; ++m) { const int row = row0 + ai * 128 + m * 16;
                        f32x4 o0, o1;
#pragma unroll
                        for (int e = 0; e < 4; ++e) {
                            { const float z = acc[ai][bj][m][0][e], ez = __builtin_amdgcn_exp2f(-LOG2E * fabsf(z)), sg = (z >= 0.f ? 1.f : ez) * __builtin_amdgcn_rcpf(1.f + ez), f = l0[e] + (1.f - l0[e]) * sg; o0[e] = fmaxf(__builtin_amdgcn_logf(f) * 0.6931471805599453f, -60.f); }
                            { const float z = acc[ai][bj][m][1][e], ez = __builtin_amdgcn_exp2f(-LOG2E * fabsf(z)), sg = (z >= 0.f ? 1.f : ez) * __builtin_amdgcn_rcpf(1.f + ez), f = l1[e] + (1.f - l1[e]) * sg; o1[e] = fmaxf(__builtin_amdgcn_logf(f) * 0.6931471805599453f, -60.f); }
                        }
                        float* dst = LF + (size_t)row * 512 + c; *(f32x4*)dst = o0; *(f32x4*)(dst + 4) = o1; } }
            return;
        }
#pragma unroll
        for (int ai = 0; ai < 2; ++ai)
#pragma unroll
            for (int m = 0; m < 4; ++m) { const int row = row0 + ai * 128 + m * 16; bf16_t* rowp = H + (size_t)row * INC + col0;
#pragma unroll
                for (int bj = 0; bj < 2; ++bj) { const f32x4 v0 = acc[ai][bj][m][0], v1 = acc[ai][bj][m][1];
                    u32x4 w; w.x = pk2(v0[0], v0[1]); w.y = pk2(v0[2], v0[3]); w.z = pk2(v1[0], v1[1]); w.w = pk2(v1[2], v1[3]);
                    *(u32x4*)(rowp + bj * 128) = w;
                    if (kind >= 5) { const int c = col0 + bj * 128 - (kind == 5 ? C_BK : C_BV);
                        float* dst = (row < MP) ? ((kind == 5 ? kP : vP) + (size_t)row * 512 + c) : ((kind == 5 ? kS : vS) + (size_t)(row - MP) * 512 + c);
                        *(f32x4*)dst = v0; *(f32x4*)(dst + 4) = v1; } } }
    }
};
struct EpiRes {
    __device__ __forceinline__ void prefetch(const pg8::Unit&, int, int, LAS unsigned char*) const {}
    LnRef P; bf16_t* Z; float* st_out; const float* scale;
    __device__ __forceinline__ void operator()(const f32x4 (&acc)[2][2][4][2], const pg8::Unit& u, int wr, int wc, int fr, int fq, const LAS float* stt, const LAS float* ct) const {
        const int row0 = u.pm * 256 + wr * 64 + fr, col0 = u.pn * 256 + wc * 32 + 8 * fq;
        float s1[8], s2[8];
#pragma unroll
        for (int i = 0; i < 8; ++i) { s1[i] = 0.f; s2[i] = 0.f; }
#pragma unroll
        for (int bj = 0; bj < 2; ++bj) { const int c = col0 + bj * 128;
            float sc[8], gg[8], bb[8];
#pragma unroll
            for (int e = 0; e < 8; ++e) { sc[e] = 1.f; gg[e] = 1.f; bb[e] = 0.f; }
            if (scale) { const f32x4 a0 = *(const f32x4*)(scale + c), a1 = *(const f32x4*)(scale + c + 4);
#pragma unroll
                for (int e = 0; e < 4; ++e) { sc[e] = a0[e]; sc[4 + e] = a1[e]; } }
            if (!P.ident) { const f32x4 a0 = *(const f32x4*)(P.g + c), a1 = *(const f32x4*)(P.g + c + 4), b0 = *(const f32x4*)(P.b + c), b1 = *(const f32x4*)(P.b + c + 4);
#pragma unroll
                for (int e = 0; e < 4; ++e) { gg[e] = a0[e]; gg[4 + e] = a1[e]; bb[e] = b0[e]; bb[4 + e] = b1[e]; } }
#pragma unroll
            for (int ai = 0; ai < 2; ++ai)
#pragma unroll
                for (int m = 0; m < 4; ++m) { const size_t row = (size_t)(row0 + ai * 128 + m * 16), off = row * D + c;
                    float mu, rstd; ln_row_lds(stt, wr * 64 + fr + ai * 128 + m * 16, P.ident, mu, rstd);
                    const u32x4 xw = *(const u32x4*)(P.Z + off); float xv[8]; unpk8(xw, xv);
                    float o[8];
#pragma unroll
                    for (int e = 0; e < 8; ++e) { const float t = rstd * gg[e], x = fmaf(xv[e], t, fmaf(-mu, t, bb[e])); o[e] = fmaf(DN_ALPHA, x, (e < 4 ? acc[ai][bj][m][0][e] : acc[ai][bj][m][1][e - 4]) * sc[e]); }
                    const u32x4 w = pk8(o); *(u32x4*)(Z + off) = w;
                    float ov[8]; unpk8(w, ov);
#pragma unroll
                    for (int e = 0; e < 8; ++e) { s1[ai * 4 + m] += ov[e]; s2[ai * 4 + m] += ov[e] * ov[e]; } } }
#pragma unroll
        for (int i = 0; i < 8; ++i) { s1[i] += __shfl_xor(s1[i], 16); s1[i] += __shfl_xor(s1[i], 32); s2[i] += __shfl_xor(s2[i], 16); s2[i] += __shfl_xor(s2[i], 32); }
        if (fq == 0) {
#pragma unroll
            for (int i = 0; i < 8; ++i) { float* p = st_out + (size_t)(row0 + (i >> 2) * 128 + (i & 3) * 16) * 2; atomicAdd(p, s1[i]); atomicAdd(p + 1, s2[i]); } }
    }
};

template <int CTRL> __device__ __forceinline__ float dpp_f(float v) { return __builtin_bit_cast(float, __builtin_amdgcn_update_dpp(0, __builtin_bit_cast(int, v), CTRL, 0xf, 0xf, false)); }
struct EpiUpConv {
    bf16_t* G; const float* cw; const float* cb; const float* hist; float* ahead; float* bhead; float* atail; float* outP; float* outS; LAS float* ex; const float* st; const float* uu; const float* cc;
    __device__ __forceinline__ void prefetch(const pg8::Unit& u, int par, int wid, LAS unsigned char* lds) const {
        const int l = lane_id_v();
#pragma unroll
        for (int j = 0; j < 2; ++j) { const int arr = j * 4 + (wid >> 1), off = (wid & 1) * 64 + l;
            const float* src = (arr < 3) ? cw + (size_t)arr * DFF + 128 * u.pn : (arr == 3) ? cb + 128 * u.pn : (arr == 4) ? uu + 256 * u.pn : (arr == 5) ? cc + 256 * u.pn : (arr == 6) ? uu + 256 * u.pn + 128 : cc + 256 * u.pn + 128;
            __builtin_amdgcn_global_load_lds((const unsigned*)(src + off), (LAS unsigned*)(lds + LDS_CT + par * 4096 + (j * 512 + wid * 64) * 4), 4, 0, 0); __builtin_amdgcn_sched_barrier(0); }
    }
    __device__ __forceinline__ void corr2(const f32x4& a0, const f32x4& a1, const LAS float* up, const LAS float* kp, float mu, float rstd, f32x2 (&o)[4]) const {
        const f32x4 u0 = *(const LAS f32x4*)up, u1 = *(const LAS f32x4*)(up + 4), k0 = *(const LAS f32x4*)kp, k1 = *(const LAS f32x4*)(kp + 4);
        const float nb = -mu * rstd; const f32x2 r2 = {rstd, rstd}, n2 = {nb, nb};
        o[0] = (f32x2){a0[0], a0[1]} * r2 + ((f32x2){u0[0], u0[1]} * n2 + (f32x2){k0[0], k0[1]});
        o[1] = (f32x2){a0[2], a0[3]} * r2 + ((f32x2){u0[2], u0[3]} * n2 + (f32x2){k0[2], k0[3]});
        o[2] = (f32x2){a1[0], a1[1]} * r2 + ((f32x2){u1[0], u1[1]} * n2 + (f32x2){k1[0], k1[1]});
        o[3] = (f32x2){a1[2], a1[3]} * r2 + ((f32x2){u1[2], u1[3]} * n2 + (f32x2){k1[2], k1[3]});
    }
    template <bool SMP>
    __device__ __forceinline__ void body(const f32x4 (&acc)[2][2][4][2], const pg8::Unit& u, int wr, int fr, int chl, int ch, const LAS float* stt, const LAS float* T) const {
        const int seq_first = (u.pm & 7) == 0;
#pragma unroll
        for (int ai = 0; ai < 2; ++ai) {
            f32x2 h1[4], h2[4];
#pragma unroll
            for (int e = 0; e < 4; ++e) { h1[e] = (f32x2){0.f, 0.f}; h2[e] = (f32x2){0.f, 0.f}; }
            bool top_missing = false;
            if (!SMP) {
                if (wr == 1 || ai == 1) { const int sa = (wr == 1) ? ai : 0, sw = (wr == 1) ? 0 : 1; const LAS float* p = ex + ((sa * 2 + sw) * 2) * 128 + chl;
                    const f32x4 a0 = *(const LAS f32x4*)p, a1 = *(const LAS f32x4*)(p + 4), b0 = *(const LAS f32x4*)(p + 128), b1 = *(const LAS f32x4*)(p + 132);
                    h2[0] = (f32x2){a0[0], a0[1]}; h2[1] = (f32x2){a0[2], a0[3]}; h2[2] = (f32x2){a1[0], a1[1]}; h2[3] = (f32x2){a1[2], a1[3]};
                    h1[0] = (f32x2){b0[0], b0[1]}; h1[1] = (f32x2){b0[2], b0[3]}; h1[2] = (f32x2){b1[0], b1[1]}; h1[3] = (f32x2){b1[2], b1[3]}; }
                else top_missing = !seq_first;
            }
            f32x2 r1p[4], r2p[4];
#pragma unroll
            for (int e = 0; e < 4; ++e) { r1p[e] = (f32x2){0.f, 0.f}; r2p[e] = (f32x2){0.f, 0.f}; }
#pragma unroll
            for (int m = 0; m < 4; ++m) {
                const int rloc = 128 * ai + 64 * wr + 16 * m + fr;
                f32x2 cur[4], bb[4], r1[4], r2[4], p1[4], p2[4], o[4];
                const LAS float* Tm = T; asm volatile("" : "+v"(Tm));
                { float mu, rstd; ln_row_lds(stt, rloc, 0, mu, rstd);
                  corr2(acc[ai][0][m][0], acc[ai][0][m][1], Tm + 4 * 128, Tm + 5 * 128, mu, rstd, cur); corr2(acc[ai][1][m][0], acc[ai][1][m][1], Tm + 6 * 128, Tm + 7 * 128, mu, rstd, bb); }
#pragma unroll
                for (int e = 0; e < 4; ++e) { r1[e] = (f32x2){dpp_f<0x121>(cur[e][0]), dpp_f<0x121>(cur[e][1])}; r2[e] = (f32x2){dpp_f<0x122>(cur[e][0]), dpp_f<0x122>(cur[e][1])}; }
                if (SMP) { const int sb = ((u.pm - MP / 256) * 256 + 128 * ai + 64 * wr + 16 * m) >> 4; const float* hp = hist + (size_t)sb * 2 * DFF + ch;
                    const f32x4 a0 = *(const f32x4*)hp, a1 = *(const f32x4*)(hp + 4), b0 = *(const f32x4*)(hp + DFF), b1 = *(const f32x4*)(hp + DFF + 4);
                    const f32x2 hh0[4] = {{a0[0], a0[1]}, {a0[2], a0[3]}, {a1[0], a1[1]}, {a1[2], a1[3]}}, hh1[4] = {{b0[0], b0[1]}, {b0[2], b0[3]}, {b1[0], b1[1]}, {b1[2], b1[3]}};
#pragma unroll
                    for (int e = 0; e < 4; ++e) { p1[e] = fr >= 1 ? r1[e] : hh1[e]; p2[e] = fr >= 2 ? r2[e] : (fr == 1 ? hh1[e] : hh0[e]); } }
                else if (m == 0) {
#pragma unroll
                    for (int e = 0; e < 4; ++e) { p1[e] = fr >= 1 ? r1[e] : h1[e]; p2[e] = fr >= 2 ? r2[e] : (fr == 1 ? h1[e] : h2[e]); } }
                else {
#pragma unroll
                    for (int e = 0; e < 4; ++e) { p1[e] = fr >= 1 ? r1[e] : r1p[e]; p2[e] = fr >= 2 ? r2[e] : r2p[e]; } }
                { const f32x4 x0a = *(const LAS f32x4*)(Tm + 0 * 128), x0b = *(const LAS f32x4*)(Tm + 0 * 128 + 4), x1a = *(const LAS f32x4*)(Tm + 1 * 128), x1b = *(const LAS f32x4*)(Tm + 1 * 128 + 4);
                  const f32x4 x2a = *(const LAS f32x4*)(Tm + 2 * 128), x2b = *(const LAS f32x4*)(Tm + 2 * 128 + 4), xba = *(const LAS f32x4*)(Tm + 3 * 128), xbb = *(const LAS f32x4*)(Tm + 3 * 128 + 4);
                  const f32x2 w0[4] = {{x0a[0], x0a[1]}, {x0a[2], x0a[3]}, {x0b[0], x0b[1]}, {x0b[2], x0b[3]}}, w1[4] = {{x1a[0], x1a[1]}, {x1a[2], x1a[3]}, {x1b[0], x1b[1]}, {x1b[2], x1b[3]}};
                  const f32x2 w2[4] = {{x2a[0], x2a[1]}, {x2a[2], x2a[3]}, {x2b[0], x2b[1]}, {x2b[2], x2b[3]}}, wb[4] = {{xba[0], xba[1]}, {xba[2], xba[3]}, {xbb[0], xbb[1]}, {xbb[2], xbb[3]}};
#pragma unroll
                  for (int e = 0; e < 4; ++e) { const f32x2 c = cur[e] * w2[e] + (p1[e] * w1[e] + (p2[e] * w0[e] + wb[e]));
                      const f32x2 t = c * (f32x2){-LOG2E, -LOG2E}; const f32x2 d = (f32x2){__builtin_amdgcn_exp2f(t[0]), __builtin_amdgcn_exp2f(t[1])} + (f32x2){1.f, 1.f};
                      o[e] = (c * bb[e]) * (f32x2){__builtin_amdgcn_rcpf(d[0]), __builtin_amdgcn_rcpf(d[1])}; r1p[e] = r1[e]; r2p[e] = r2[e]; } }
                if (!(top_missing && m == 0 && fr < 2)) { u32x4 w; w.x = pk2(o[0][0], o[0][1]); w.y = pk2(o[1][0], o[1][1]); w.z = pk2(o[2][0], o[2][1]); w.w = pk2(o[3][0], o[3][1]);
                    *(u32x4*)(G + (size_t)(u.pm * 256 + rloc) * DFF + ch) = w; }
                const f32x4 ca0 = {cur[0][0], cur[0][1], cur[1][0], cur[1][1]}, ca1 = {cur[2][0], cur[2][1], cur[3][0], cur[3][1]};
                if (ai == 0 && m == 0 && wr == 0 && fr < 2) { float* pa = ahead + ((size_t)u.pm * 2 + fr) * DFF + ch; float* pb = bhead + ((size_t)u.pm * 2 + fr) * DFF + ch;
                    *(f32x4*)pa = ca0; *(f32x4*)(pa + 4) = ca1; *(f32x4*)pb = (f32x4){bb[0][0], bb[0][1], bb[1][0], bb[1][1]}; *(f32x4*)(pb + 4) = (f32x4){bb[2][0], bb[2][1], bb[3][0], bb[3][1]}; }
                if (ai == 1 && m == 3 && wr == 1 && fr >= 14) { float* pt = atail + ((size_t)u.pm * 2 + (fr - 14)) * DFF + ch; *(f32x4*)pt = ca0; *(f32x4*)(pt + 4) = ca1;
                    if (!SMP && (u.pm & 7) == 7) { float* po = outP + ((size_t)(u.pm >> 3) * 2 + (fr - 14)) * DFF + ch; *(f32x4*)po = ca0; *(f32x4*)(po + 4) = ca1; } }
                if (SMP && fr >= 14) { const int sb = ((u.pm - MP / 256) * 256 + 128 * ai + 64 * wr + 16 * m) >> 4; float* po = outS + ((size_t)sb * 2 + (fr - 14)) * DFF + ch;
                    *(f32x4*)po = ca0; *(f32x4*)(po + 4) = ca1; }
            }
        }
    }
    __device__ __forceinline__ void operator()(const f32x4 (&acc)[2][2][4][2], const pg8::Unit& u, int wr, int wc, int fr, int fq, const LAS float* stt, const LAS float* ct) const {
        const int chl = 32 * wc + 8 * fq, ch = 128 * u.pn + chl;
        const LAS float* T = ct + chl;
        if (fr >= 14) {
#pragma unroll
            for (int ai = 0; ai < 2; ++ai) { float mu, rstd; f32x2 t[4]; ln_row_lds(stt, wr * 64 + fr + ai * 128 + 48, 0, mu, rstd); corr2(acc[ai][0][3][0], acc[ai][0][3][1], T + 4 * 128, T + 5 * 128, mu, rstd, t);
                LAS float* p = ex + ((ai * 2 + wr) * 2 + (fr - 14)) * 128 + chl; *(LAS f32x4*)p = (f32x4){t[0][0], t[0][1], t[1][0], t[1][1]}; *(LAS f32x4*)(p + 4) = (f32x4){t[2][0], t[2][1], t[3][0], t[3][1]}; }
        }
        asm volatile("s_waitcnt lgkmcnt(0)" ::: "memory"); __builtin_amdgcn_s_barrier(); asm volatile("" ::: "memory");
        if (u.pm >= MP / 256) body<true>(acc, u, wr, fr, chl, ch, stt, T); else body<false>(acc, u, wr, fr, chl, ch, stt, T);
    }
};


template <int KW  >
__device__ __forceinline__ void sgemm_res_phase(LAS unsigned char* lds, const bf16_t* A, int lda, int a_grp_step, const bf16_t* Bt, int K, int bid, int G, int tid, const LnRef& P, bf16_t* Z, float* st_out, const float* scale) {
    const int lane = tid & 63, wave = __builtin_amdgcn_readfirstlane(tid >> 6), fr = lane & 15, fq = lane >> 4;
    LAS f32x4* red = (LAS f32x4*)lds;
    for (int t = bid; t < 256; t += G) {
        const int rt = t >> 5, ct = t & 31;
        const GAS bf16_t* ap = (const GAS bf16_t*)(A + (size_t)(rt * 64 + fr) * lda + (size_t)((ct * 32) >> 8) * a_grp_step + wave * KW + 8 * fq);
        const GAS bf16_t* bp = (const GAS bf16_t*)(Bt + (size_t)(ct * 32 + fr) * K + wave * KW + 8 * fq);
        f32x4 acc[4][2];
#pragma unroll
        for (int i = 0; i < 4; ++i) { acc[i][0] = (f32x4){0.f, 0.f, 0.f, 0.f}; acc[i][1] = (f32x4){0.f, 0.f, 0.f, 0.f}; }
#pragma unroll
        for (int k0 = 0; k0 < KW; k0 += 32) {
            bf16x8 af[4], bf[2];
#pragma unroll
            for (int i = 0; i < 4; ++i) af[i] = *(const GAS bf16x8*)(ap + (size_t)(16 * i) * lda + k0);
#pragma unroll
            for (int j = 0; j < 2; ++j) bf[j] = *(const GAS bf16x8*)(bp + (size_t)(16 * j) * K + k0);
#pragma unroll
            for (int i = 0; i < 4; ++i)
#pragma unroll
                for (int j = 0; j < 2; ++j) acc[i][j] = __builtin_amdgcn_mfma_f32_16x16x32_bf16(bf[j], af[i], acc[i][j], 0, 0, 0);
        }
#pragma unroll
        for (int i = 0; i < 4; ++i)
#pragma unroll
            for (int j = 0; j < 2; ++j) red[(wave * 8 + i * 2 + j) * 64 + lane] = acc[i][j];
        __syncthreads();
        f32x4 v = red[(0 * 8 + wave) * 64 + lane];
#pragma unroll
        for (int w = 1; w < 8; ++w) v += red[(w * 8 + wave) * 64 + lane];
        __syncthreads();
        const int row = rt * 64 + 16 * (wave >> 1) + fr, n = ct * 32 + 16 * (wave & 1) + 4 * fq; const size_t grow = (size_t)MP + row, off = grow * D + n;
        float mu, rstd; ln_row(P.st, grow, P.ident, mu, rstd);
        f32x4 gg = {1.f, 1.f, 1.f, 1.f}, bb = {0.f, 0.f, 0.f, 0.f}, sc = {1.f, 1.f, 1.f, 1.f};
        if (!P.ident) { gg = *(const f32x4*)(P.g + n); bb = *(const f32x4*)(P.b + n); }
        if (scale) sc = *(const f32x4*)(scale + n);
        const u32x2 xw = *(const u32x2*)(P.Z + off); const float xv[4] = {bflo(xw.x), bfhi(xw.x), bflo(xw.y), bfhi(xw.y)};
        float o[4];
#pragma unroll
        for (int e = 0; e < 4; ++e) { const float tt = rstd * gg[e], x = fmaf(xv[e], tt, fmaf(-mu, tt, bb[e])); o[e] = fmaf(DN_ALPHA, x, v[e] * sc[e]); }
        u32x2 w; w.x = pk2(o[0], o[1]); w.y = pk2(o[2], o[3]); *(u32x2*)(Z + off) = w;
        float s1 = (bflo(w.x) + bfhi(w.x)) + (bflo(w.y) + bfhi(w.y)), s2 = (bflo(w.x) * bflo(w.x) + bfhi(w.x) * bfhi(w.x)) + (bflo(w.y) * bflo(w.y) + bfhi(w.y) * bfhi(w.y));
        s1 += __shfl_xor(s1, 16); s1 += __shfl_xor(s1, 32); s2 += __shfl_xor(s2, 16); s2 += __shfl_xor(s2, 32);
        if (fq == 0) { atomicAdd(st_out + grow * 2, s1); atomicAdd(st_out + grow * 2 + 1, s2); }
    }
}

__device__ __forceinline__ void sgemm_in_phase(LAS unsigned char* lds, const bf16_t* A, const bf16_t* Bt, int bid, int G, int tid, const EpiIn& E) {
    constexpr int K = D, KW = K / 8;
    const int lane = tid & 63, wave = __builtin_amdgcn_readfirstlane(tid >> 6), fr = lane & 15, fq = lane >> 4;
    LAS f32x4* red = (LAS f32x4*)lds;
    for (int t = bid; t < 256; t += G) {
        const int rt = t >> 5, ct = t & 31;
        const GAS bf16_t* ap = (const GAS bf16_t*)(A + (size_t)(rt * 64 + fr) * K + wave * KW + 8 * fq);
        const GAS bf16_t* bp = (const GAS bf16_t*)(Bt + (size_t)(ct * 112 + fr) * K + wave * KW + 8 * fq);
        f32x4 acc[4][7];
#pragma unroll
        for (int i = 0; i < 4; ++i)
#pragma unroll
            for (int j = 0; j < 7; ++j) acc[i][j] = (f32x4){0.f, 0.f, 0.f, 0.f};
#pragma unroll
        for (int k0 = 0; k0 < KW; k0 += 32) {
            bf16x8 af[4], bf[7];
#pragma unroll
            for (int i = 0; i < 4; ++i) af[i] = *(const GAS bf16x8*)(ap + (size_t)(16 * i) * K + k0);
#pragma unroll
            for (int j = 0; j < 7; ++j) bf[j] = *(const GAS bf16x8*)(bp + (size_t)(16 * j) * K + k0);
#pragma unroll
            for (int i = 0; i < 4; ++i)
#pragma unroll
                for (int j = 0; j < 7; ++j) acc[i][j] = __builtin_amdgcn_mfma_f32_16x16x32_bf16(bf[j], af[i], acc[i][j], 0, 0, 0);
        }
#pragma unroll
        for (int i = 0; i < 4; ++i) {
#pragma unroll
            for (int j = 0; j < 7; ++j) red[(wave * 7 + j) * 64 + lane] = acc[i][j];
            __syncthreads();
            if (wave < 7) {
                f32x4 v = red[(0 * 7 + wave) * 64 + lane];
#pragma unroll
                for (int w = 1; w < 8; ++w) v += red[(w * 7 + wave) * 64 + lane];
                const int m = rt * 64 + 16 * i + fr, n = ct * 112 + 16 * wave + 4 * fq; const size_t row = (size_t)MP + m;
                float mu, rstd; ln_row(E.st, row, E.ident, mu, rstd);
                const f32x4 u0 = *(const f32x4*)(E.uu + n), k0v = *(const f32x4*)(E.cc + n);
                const float nb = -mu * rstd; v = v * rstd + (u0 * nb + k0v);
                const int kind = n >> 9;
                if (kind == 1) { const int c = n - C_AF; const f32x4 l0 = *(const f32x4*)(E.lbv + c); f32x4 o;
#pragma unroll
                    for (int e = 0; e < 4; ++e) { const float z = v[e], ez = __builtin_amdgcn_exp2f(-LOG2E * fabsf(z)), sg = (z >= 0.f ? 1.f : ez) * __builtin_amdgcn_rcpf(1.f + ez), f = l0[e] + (1.f - l0[e]) * sg; o[e] = fmaxf(__builtin_amdgcn_logf(f) * 0.6931471805599453f, -60.f); }
                    *(f32x4*)(E.LF + row * 512 + c) = o; }
                else { u32x2 w; w.x = pk2(v[0], v[1]); w.y = pk2(v[2], v[3]); *(u32x2*)(E.H + row * INC + n) = w;
                    if (kind == 5) *(f32x4*)(E.kS + (size_t)m * 512 + (n - C_BK)) = v;
                    if (kind == 6) *(f32x4*)(E.vS + (size_t)m * 512 + (n - C_BV)) = v; }
            }
            __syncthreads();
        }
    }
}

#define XB_TMO      128
#define XB_XCNT(j)  (256  + 64 * (j))
#define XB_XSUB(j)  (1280 + 64 * (j))
#define XB_XGEN(j)  (2304 + 64 * (j))
#define XB_TOP      3328
#define XB_TOPGEN   3392
#define XCD_BAR_WORDS 3456
#define XB_SPIN_CAP (1u << 22)
__device__ __forceinline__ unsigned xb_ld(unsigned* p)              { return __hip_atomic_load(p, __ATOMIC_RELAXED, __HIP_MEMORY_SCOPE_AGENT); }
__device__ __forceinline__ unsigned xb_add(unsigned* p, unsigned v) { return __hip_atomic_fetch_add(p, v, __ATOMIC_RELAXED, __HIP_MEMORY_SCOPE_AGENT); }
__device__ __forceinline__ unsigned xb_xcc_id() { return (unsigned)__builtin_amdgcn_s_getreg((3 << 11) | 20) & 0xFu; }
#define XB_SPIN(cond, bar) do { unsigned _sp = 0; while (cond) { __builtin_amdgcn_s_sleep(1); \
    if ((++_sp & 255u) == 0u) { if (xb_ld(&(bar)[XB_TMO])) break; if (_sp > XB_SPIN_CAP) { atomicAdd(&(bar)[XB_TMO], 1u); break; } } } } while (0)
struct XcdBarrier { unsigned* bar; unsigned x; volatile LAS unsigned* st; };
__device__ __forceinline__ XcdBarrier xcd_barrier_post(unsigned* bar, volatile LAS unsigned* st) {
    XcdBarrier b; b.bar = bar; b.x = xb_xcc_id(); b.st = st;
    if (threadIdx.x == 0) (void)xb_add(&bar[XB_XCNT(b.x)], 1u);
    return b;
}
__device__ __forceinline__ void xcd_barrier_complete(unsigned* bar, unsigned x, unsigned& nloc, unsigned& nx) {
    const unsigned G = gridDim.x * gridDim.y * gridDim.z;
    unsigned sum, cnt, mine, sp = 0u;
    for (;;) {
        sum = 0u; cnt = 0u; mine = 0u;
#pragma unroll
        for (unsigned j = 0; j < 16; ++j) { const unsigned c = xb_ld(&bar[XB_XCNT(j)]); sum += c; cnt += (c > 0u) ? 1u : 0u; mine = (j == x) ? c : mine; }
        if (sum == G) break;
        __builtin_amdgcn_s_sleep(1);
        if ((++sp & 255u) == 0u) { if (xb_ld(&bar[XB_TMO])) break; if (sp > XB_SPIN_CAP) { atomicAdd(&bar[XB_TMO], 1u); break; } }
    }
    nloc = mine > 0u ? mine : 1u; nx = cnt > 0u ? cnt : 1u;
}
__device__ __forceinline__ void xcd_barrier(const XcdBarrier& b) {
    asm volatile("s_waitcnt vmcnt(0)" ::: "memory");
    __syncthreads();
    if (threadIdx.x == 0) {
        unsigned* bar = b.bar;
        __builtin_amdgcn_s_waitcnt(0);
        unsigned nloc = b.st[0], nx = b.st[1];
        if (nloc == 0u) { xcd_barrier_complete(bar, b.x, nloc, nx); b.st[0] = nloc; b.st[1] = nx; }
        const unsigned old = xb_add(&bar[XB_XSUB(b.x)], 1u);
        const unsigned gen = old / nloc;
        if (old + 1u == (gen + 1u) * nloc) {
            __builtin_amdgcn_fence(__ATOMIC_RELEASE, "agent");
            asm volatile("s_waitcnt vmcnt(0)" ::: "memory");
            const unsigned og = xb_add(&bar[XB_TOP], 1u);
            const unsigned tg = og / nx;
            if (og + 1u == (tg + 1u) * nx) xb_add(&bar[XB_TOPGEN], 1u);
            else XB_SPIN(xb_ld(&bar[XB_TOPGEN]) == tg, bar);
            __builtin_amdgcn_fence(__ATOMIC_ACQUIRE, "agent");
            xb_add(&bar[XB_XGEN(b.x)], 1u);
            asm volatile("s_waitcnt vmcnt(0)" ::: "memory");
        } else {
            XB_SPIN(xb_ld(&bar[XB_XGEN(b.x)]) == gen, bar);
            __builtin_amdgcn_fence(__ATOMIC_ACQUIRE, "agent");
            asm volatile("s_waitcnt vmcnt(0)" ::: "memory");
        }
    }
    __syncthreads();
}

struct Args { const float* in[24]; float* out; unsigned char* ws; int ph_lo, ph_hi, single, pad; };
typedef const float* cfp_t;
typedef const __attribute__((address_space(4))) cfp_t* kin_t;
struct Frame {
    LAS unsigned char* lds;
    int tid, lane, wave, bid, G;
    kin_t in;
    float* out; unsigned char* ws;
};
enum { I_XP = 0, I_XS, I_CK, I_CV, I_SH, I_SP, I_SC, I_WIN, I_WOUT, I_LBL, I_HNG, I_DLAM, I_DNG, I_RB, I_PW, I_PSC, I_WUP, I_CW, I_CB, I_WDN, I_L1G, I_L1B, I_L2G, I_L2B };

__device__ __forceinline__ void p0_transpose_item(const float* W, int K, int N, bf16_t* WT, int dst_row0, LAS float* scr, int k0, int n0, int lane, const float* gk, const float* bk, float* uo, float* co) {
#pragma unroll 8
    for (int i = 0; i < 32; ++i) { const int kk = 2 * i + (lane >> 5); scr[kk * 33 + (lane & 31)] = W[(size_t)(k0 + kk) * N + n0 + (lane & 31)]; }
    asm volatile("s_waitcnt lgkmcnt(0)" ::: "memory");
    const int c = lane & 7;
    float gv[8], bv[8];
#pragma unroll
    for (int e = 0; e < 8; ++e) { gv[e] = 1.f; bv[e] = 0.f; }
    if (gk) {
#pragma unroll
        for (int e = 0; e < 8; ++e) { gv[e] = gk[k0 + 8 * c + e]; bv[e] = bk[k0 + 8 * c + e]; } }
#pragma unroll
    for (int j = 0; j < 4; ++j) { const int n = (lane >> 3) + 8 * j; const LAS float* sp = scr + (8 * c) * 33 + n;
        float wv[8]; float cs = 0.f;
#pragma unroll
        for (int e = 0; e < 8; ++e) { const float w = sp[e * 33]; wv[e] = w * gv[e]; cs += w * bv[e]; }
        const u32x4 o = pk8(wv);
        *(u32x4*)(WT + (size_t)(dst_row0 + n) * K + k0 + 8 * c) = o;
        if (gk) { float rv[8]; unpk8(o, rv); float us = 0.f;
#pragma unroll
            for (int e = 0; e < 8; ++e) us += rv[e];
            us += __shfl_xor(us, 1); us += __shfl_xor(us, 2); us += __shfl_xor(us, 4); cs += __shfl_xor(cs, 1); cs += __shfl_xor(cs, 2); cs += __shfl_xor(cs, 4);
            if (c == 0) { atomicAdd(uo + dst_row0 + n, us); atomicAdd(co + dst_row0 + n, cs); } } }
    asm volatile("s_waitcnt lgkmcnt(0)" ::: "memory");
}
__device__ __forceinline__ void phase_prologue(Frame& F) {
    LAS float* scr = (LAS float*)(F.lds + F.wave * 16384);
    const int gw = F.bid * NWAVES + F.wave, NGW = F.G * NWAVES;
    constexpr int I_IN = (D / 64) * (INC / 32), I_OUT = (D / 64) * (D / 32), I_POOL = 4 * 8, I_UP = (D / 64) * (UPN / 32), I_DN = (DFF / 64) * (D / 32);
    constexpr int NITEMS = 2 * I_IN + 2 * I_OUT + 8 * I_POOL + 4 * I_UP + 4 * I_DN;
    for (int it = gw; it < NITEMS; it += NGW) {
        int r = it;
        if (r < 2 * I_IN) { const int m = r / I_IN; r %= I_IN; const int kb = r / (INC / 32), nb = r % (INC / 32);
            float* ctlf = (float*)(F.ws + WS_CTL);
            p0_transpose_item(F.in[I_WIN] + (size_t)m * D * INC, D, INC, (bf16_t*)(F.ws + WS_WIN) + (size_t)m * INC * D, 32 * nb, scr, 64 * kb, 32 * nb, F.lane,
                              m == 1 ? F.in[I_L2G] + 1 * D : nullptr, F.in[I_L2B] + 1 * D, ctlf + UC_UIN, ctlf + UC_CIN); continue; } r -= 2 * I_IN;
        if (r < 2 * I_OUT) { const int m = r / I_OUT; r %= I_OUT; const int kb = r / (D / 32), nb = r % (D / 32);
            p0_transpose_item(F.in[I_WOUT] + (size_t)m * D * D, D, D, (bf16_t*)(F.ws + WS_WOUT) + (size_t)m * D * D, 32 * nb, scr, 64 * kb, 32 * nb, F.lane, nullptr, nullptr, nullptr, nullptr); continue; } r -= 2 * I_OUT;
        if (r < 8 * I_POOL) { const int pg = r / I_POOL; r %= I_POOL; const int kb = r / 8, nb = r % 8;
            p0_transpose_item(F.in[I_PW] + (size_t)pg * 256 * 256, 256, 256, (bf16_t*)(F.ws + WS_WPOOL) + (size_t)pg * 256 * 256, 32 * nb, scr, 64 * kb, 32 * nb, F.lane, nullptr, nullptr, nullptr, nullptr); continue; } r -= 8 * I_POOL;
        if (r < 4 * I_UP) { const int l = r / I_UP; r %= I_UP; const int kb = r / (UPN / 32), nb = r % (UPN / 32); const int n0 = 32 * nb;
            const int dst = (n0 < DFF) ? (256 * (n0 / 128) + (n0 % 128)) : (256 * ((n0 - DFF) / 128) + 128 + ((n0 - DFF) % 128));
            float* ctlf = (float*)(F.ws + WS_CTL);
            p0_transpose_item(F.in[I_WUP] + (size_t)l * D * UPN, D, UPN, (bf16_t*)(F.ws + WS_WUP) + (size_t)l * UPN * D, dst, scr, 64 * kb, n0, F.lane,
                              F.in[I_L1G] + (size_t)l * D, F.in[I_L1B] + (size_t)l * D, ctlf + UC_UUP + l * UPN, ctlf + UC_CUP + l * UPN); continue; } r -= 4 * I_UP;
        { const int l = r / I_DN; r %= I_DN; const int kb = r / (D / 32), nb = r % (D / 32);
            p0_transpose_item(F.in[I_WDN] + (size_t)l * DFF * D, DFF, D, (bf16_t*)(F.ws + WS_WDN) + (size_t)l * D * DFF, 32 * nb, scr, 64 * kb, 32 * nb, F.lane, nullptr, nullptr, nullptr, nullptr); }
    }
    bf16_t* XB = (bf16_t*)(F.ws + WS_XB);
    for (int m0 = gw; m0 < MT; m0 += 4 * NGW) {
        f32x4 v[4][4];
#pragma unroll
        for (int q = 0; q < 4; ++q) { const int m = m0 + q * NGW;
            if (m < MT) { const float* src = (m < MP) ? F.in[I_XP] + (size_t)m * D : F.in[I_XS] + (size_t)(m - MP) * D;
#pragma unroll
                for (int j = 0; j < 4; ++j) v[q][j] = *(const f32x4*)(src + 4 * F.lane + 256 * j); } }
#pragma unroll
        for (int q = 0; q < 4; ++q) { const int m = m0 + q * NGW;
            if (m < MT) {
#pragma unroll
                for (int j = 0; j < 4; ++j) { u32x2 w; w.x = pk2(v[q][j][0], v[q][j][1]); w.y = pk2(v[q][j][2], v[q][j][3]); *(u32x2*)(XB + (size_t)m * D + 4 * F.lane + 256 * j) = w; } } }
    }
    if (F.bid == 0) {
        float* tab = (float*)(F.ws + WS_TAB);
        { const int c = F.tid; const float a = F.in[I_LBL][c], b = F.in[I_LBL][512 + c], mx = fmaxf(a, b), ea = __expf(a - mx), eb = __expf(b - mx);
          tab[TB_LB + c] = 0.f; tab[TB_LB + 512 + c] = eb / (ea + eb); }
        if (F.wave < 2) { const int m = F.wave; const float* lp = F.in[I_DLAM] + (size_t)m * 4 * 64;
            const float s01 = wave_sum(lp[F.lane] * lp[64 + F.lane]), s23 = wave_sum(lp[128 + F.lane] * lp[192 + F.lane]);
            const float lam_init = (m == 0) ? 0.2f : 0.47071302f;
            if (F.lane == 0) tab[TB_LAM + m] = __expf(s01) - __expf(s23) + lam_init; }
    }
}

__device__ __forceinline__ void phase_ln_final(Frame& F, const bf16_t* Z, const float* g, const float* b) {
    const int gw = F.bid * NWAVES + F.wave, NGW = F.G * NWAVES;
    f32x4 gv[4], bv[4];
#pragma unroll
    for (int j = 0; j < 4; ++j) { const int c = 8 * F.lane + 512 * (j >> 1) + 4 * (j & 1); gv[j] = *(const f32x4*)(g + c); bv[j] = *(const f32x4*)(b + c); }
    for (int m = gw; m < MT; m += NGW) {
        f32x4 v[4]; float s = 0.f;
#pragma unroll
        for (int j2 = 0; j2 < 2; ++j2) { const u32x4 w = *(const u32x4*)(Z + (size_t)m * D + 8 * F.lane + 512 * j2);
            v[2 * j2] = (f32x4){bflo(w.x), bfhi(w.x), bflo(w.y), bfhi(w.y)}; v[2 * j2 + 1] = (f32x4){bflo(w.z), bfhi(w.z), bflo(w.w), bfhi(w.w)}; }
#pragma unroll
        for (int j = 0; j < 4; ++j) s += (v[j][0] + v[j][1]) + (v[j][2] + v[j][3]);
        const float mean = wave_sum(s) * (1.f / D); float s2 = 0.f;
#pragma unroll
        for (int j = 0; j < 4; ++j) { v[j] = v[j] - mean; s2 += (v[j][0] * v[j][0] + v[j][1] * v[j][1]) + (v[j][2] * v[j][2] + v[j][3] * v[j][3]); }
        const float rstd = 1.f / sqrtf(wave_sum(s2) * (1.f / D) + LN_EPS);
        float* outp = (m < MP) ? F.out + O_YP + (size_t)m * D : F.out + O_YS + (size_t)(m - MP) * D;
#pragma unroll
        for (int j2 = 0; j2 < 2; ++j2) { const f32x4 y0 = v[2 * j2] * rstd * gv[2 * j2] + bv[2 * j2], y1 = v[2 * j2 + 1] * rstd * gv[2 * j2 + 1] + bv[2 * j2 + 1];
            *(f32x4*)(outp + 8 * F.lane + 512 * j2) = y0; *(f32x4*)(outp + 8 * F.lane + 512 * j2 + 4) = y1; }
    }
}

template <int J>
__device__ __forceinline__ void pool_item(Frame& F, const LnRef& R, int p, int rb, int c) {
    constexpr int W = 2 << J;
    bf16_t* PO = (bf16_t*)(F.ws + WS_MIX);
    const f32x4 g0 = *(const f32x4*)(R.g + c), g1 = *(const f32x4*)(R.g + c + 4), b0 = *(const f32x4*)(R.b + c), b1 = *(const f32x4*)(R.b + c + 4);
    const int m0 = rb * 16; const bool smp = m0 >= MP; const int b = smp ? (m0 - MP) / ST : m0 / PT, t0 = smp ? 0 : m0 % PT;
    f32x4 ring[W][2]; f32x4 s0 = {0.f, 0.f, 0.f, 0.f}, s1 = {0.f, 0.f, 0.f, 0.f};
#pragma unroll
    for (int i = 0; i < W; ++i) {
        const int tt = t0 - W + i; f32x4 v0 = {0.f, 0.f, 0.f, 0.f}, v1 = {0.f, 0.f, 0.f, 0.f};
        if (tt >= 0) { const size_t rr = (size_t)(m0 - W + i); const u32x4 q = *(const u32x4*)(R.Z + rr * D + c); float mu, rstd; ln_row(R.st, rr, 0, mu, rstd);
            v0 = ((f32x4){bflo(q.x), bfhi(q.x), bflo(q.y), bfhi(q.y)} - mu) * rstd * g0 + b0; v1 = ((f32x4){bflo(q.z), bfhi(q.z), bflo(q.w), bfhi(q.w)} - mu) * rstd * g1 + b1; }
        else if (smp && tt >= -15) { const float* hp = F.in[I_SP] + (((size_t)p * SB + b) * 15 + (15 + tt)) * D + c; v0 = *(const f32x4*)hp; v1 = *(const f32x4*)(hp + 4); }
        ring[i][0] = v0; ring[i][1] = v1; s0 += v0; s1 += v1; }
#pragma unroll
    for (int i = 0; i < 16; ++i) { const int t = t0 + i;
        const size_t rr = (size_t)(m0 + i); const u32x4 q = *(const u32x4*)(R.Z + rr * D + c); float mu, rstd; ln_row(R.st, rr, 0, mu, rstd);
        const f32x4 x0 = ((f32x4){bflo(q.x), bfhi(q.x), bflo(q.y), bfhi(q.y)} - mu) * rstd * g0 + b0, x1 = ((f32x4){bflo(q.z), bfhi(q.z), bflo(q.w), bfhi(q.w)} - mu) * rstd * g1 + b1;
        s0 += x0 - ring[i % W][0]; s1 += x1 - ring[i % W][1]; ring[i % W][0] = x0; ring[i % W][1] = x1;
        const float inv = 1.f / (float)(smp ? W : (t + 1 < W ? t + 1 : W));
        const f32x4 o0 = s0 * inv - x0, o1 = s1 * inv - x1;
        u32x4 w; w.x = pk2(o0[0], o0[1]); w.y = pk2(o0[2], o0[3]); w.z = pk2(o1[0], o1[1]); w.w = pk2(o1[2], o1[3]); *(u32x4*)(PO + (size_t)(m0 + i) * D + c) = w;
        if (!smp && t >= PT - 15) { float* op = F.out + O_PP + (((size_t)p * PB + b) * 15 + (t - (PT - 15))) * D + c; *(f32x4*)op = x0; *(f32x4*)(op + 4) = x1; }
        if (smp && t >= 1) { float* op = F.out + O_PS + (((size_t)p * SB + b) * 15 + (t - 1)) * D + c; *(f32x4*)op = x0; *(f32x4*)(op + 4) = x1; } }
}
__device__ __forceinline__ void phase_pool_prep(Frame& F, const LnRef& R, int p) {
    const int gwv = F.bid * NWAVES + F.wave, NGW = F.G * NWAVES;
    for (int wi = gwv; wi < (MT / 32) * 4; wi += NGW) { const int j = wi & 3, rb = 2 * (wi >> 2) + (F.lane >> 5), c = 256 * j + 8 * (F.lane & 31);
        if (j == 0) pool_item<0>(F, R, p, rb, c); else if (j == 1) pool_item<1>(F, R, p, rb, c); else if (j == 2) pool_item<2>(F, R, p, rb, c); else pool_item<3>(F, R, p, rb, c); }
}

__device__ __forceinline__ void conv_fix_item(Frame& F, int l, int pm, int ch) {
    bf16_t* Gb = (bf16_t*)(F.ws + WS_G);
    const float* cw = F.in[I_CW] + (size_t)l * 3 * DFF; const float* cb = F.in[I_CB] + (size_t)l * DFF;
    const float* ahead = (const float*)(F.ws + WS_AHEAD); const float* bhead = (const float*)(F.ws + WS_BHEAD); const float* atail = (const float*)(F.ws + WS_ATAIL);
    float t0[8], t1[8], a0[8], a1[8], b0[8], b1[8], o[8];
#pragma unroll
    for (int h2 = 0; h2 < 2; ++h2) {
        const f32x4 x0 = *(const f32x4*)(atail + ((size_t)(pm - 1) * 2 + 0) * DFF + ch + 4 * h2), x1 = *(const f32x4*)(atail + ((size_t)(pm - 1) * 2 + 1) * DFF + ch + 4 * h2);
        const f32x4 y0 = *(const f32x4*)(ahead + ((size_t)pm * 2 + 0) * DFF + ch + 4 * h2), y1 = *(const f32x4*)(ahead + ((size_t)pm * 2 + 1) * DFF + ch + 4 * h2);
        const f32x4 z0 = *(const f32x4*)(bhead + ((size_t)pm * 2 + 0) * DFF + ch + 4 * h2), z1 = *(const f32x4*)(bhead + ((size_t)pm * 2 + 1) * DFF + ch + 4 * h2);
#pragma unroll
        for (int e = 0; e < 4; ++e) { t0[4 * h2 + e] = x0[e]; t1[4 * h2 + e] = x1[e]; a0[4 * h2 + e] = y0[e]; a1[4 * h2 + e] = y1[e]; b0[4 * h2 + e] = z0[e]; b1[4 * h2 + e] = z1[e]; } }
#pragma unroll
    for (int e = 0; e < 8; ++e) { const float c = cb[ch + e] + t0[e] * cw[ch + e] + t1[e] * cw[DFF + ch + e] + a0[e] * cw[2 * DFF + ch + e]; o[e] = silu_mul(c, b0[e]); }
    *(u32x4*)(Gb + (size_t)(pm * 256) * DFF + ch) = pk8(o);
#pragma unroll
    for (int e = 0; e < 8; ++e) { const float c = cb[ch + e] + t1[e] * cw[ch + e] + a0[e] * cw[DFF + ch + e] + a1[e] * cw[2 * DFF + ch + e]; o[e] = silu_mul(c, b1[e]); }
    *(u32x4*)(Gb + (size_t)(pm * 256 + 1) * DFF + ch) = pk8(o);
}
__device__ __forceinline__ void conv_fix_local(Frame& F, int l, const pg8::StaticOrder& S) {
    pg8::Unit u;
    for (int i = 0; S.next(i, u); ++i)
        if (u.pm < MP / 256 && (u.pm & 7) != 0)
            for (int it = F.tid; it < DFF / 8; it += NTHREADS) conv_fix_item(F, l, u.pm, 8 * it);
    asm volatile("s_waitcnt vmcnt(0)" ::: "memory");
    __syncthreads();
}

constexpr int HG_LF = 0;
constexpr int HG_TOT = HG_LF + 16384;
constexpr int HG_G = HG_TOT + 2048;
constexpr int HG_QT = HG_G + 512;
constexpr int HG_KS = HG_QT + 32 * 272;
constexpr int HG_V = HG_KS + 32 * 320;
constexpr int HG_PF = HG_V + 32 * 320;
constexpr int HG_OX = HG_PF + 2048;
constexpr int HG_END = HG_OX + 32768;
static_assert(HG_END <= LDS_TAB, "HGRN LDS");

template <bool SMP>
__device__ __forceinline__ void hgrn_unit(Frame& F, int m, int b, int h) {
    LAS unsigned char* L = F.lds;
    const bf16_t* H = (const bf16_t*)(F.ws + WS_H); const float* LFg = (const float*)(F.ws + WS_LF); bf16_t* MIX = (bf16_t*)(F.ws + WS_MIX);
    const float* gn = F.in[I_HNG] + (size_t)m * 512 + h * 128;
    const int tid = opq(F.tid), lane = tid & 63, wave = __builtin_amdgcn_readfirstlane(tid >> 6), r = lane & 31, hh = lane >> 5;
    const int nb = wave & 3, kh = wave >> 2;
    const size_t row0 = SMP ? (size_t)MP + (size_t)b * ST : (size_t)b * PT;
    const int nsteps = SMP ? 1 : PT / 32;
    f32x16 S[2];
    if (SMP) { const float* s0 = F.in[I_SH] + (((size_t)m * SB + b) * NH + h) * 128 * 128 + (size_t)(64 * kh + 4 * hh) * 128 + 32 * nb + r;
#pragma unroll
        for (int kbl = 0; kbl < 2; ++kbl)
#pragma unroll
            for (int i = 0; i < 16; ++i) S[kbl][i] = s0[(32 * kbl + (i & 3) + 8 * (i >> 2)) * 128];
    } else {
#pragma unroll
        for (int kbl = 0; kbl < 2; ++kbl)
#pragma unroll
            for (int i = 0; i < 16; ++i) S[kbl][i] = 0.f;
    }
    const int et = tid >> 4, ek = (tid & 15) * 8;
    const bool valid = !SMP || et < ST;
    f32x4 lf0 = {0.f, 0.f, 0.f, 0.f}, lf1 = {0.f, 0.f, 0.f, 0.f}; u32x4 qw = {0u, 0u, 0u, 0u}, vw = {0u, 0u, 0u, 0u}, gw = {0u, 0u, 0u, 0u};
    if (valid) { const size_t row = row0 + et;
        lf0 = *(const f32x4*)(LFg + row * 512 + h * 128 + ek); lf1 = *(const f32x4*)(LFg + row * 512 + h * 128 + ek + 4);
        qw = *(const u32x4*)(H + row * INC + C_AQ + h * 128 + ek); vw = *(const u32x4*)(H + row * INC + C_AI + h * 128 + ek); gw = *(const u32x4*)(H + row * INC + C_AG + h * 128 + ek); }
    for (int step = 0; step < nsteps; ++step) {
        const size_t row = row0 + (size_t)step * 32 + et;
        *(LAS f32x4*)(L + HG_LF + (et * 128 + ek) * 4) = lf0; *(LAS f32x4*)(L + HG_LF + (et * 128 + ek + 4) * 4) = lf1;
        f32x4 nlf0 = lf0, nlf1 = lf1; u32x4 nqw = qw, nvw = vw, ngw = gw;
        if (!SMP && step + 1 < nsteps) { const size_t rn = row + 32;
            nlf0 = *(const f32x4*)(LFg + rn * 512 + h * 128 + ek); nlf1 = *(const f32x4*)(LFg + rn * 512 + h * 128 + ek + 4);
            nqw = *(const u32x4*)(H + rn * INC + C_AQ + h * 128 + ek); nvw = *(const u32x4*)(H + rn * INC + C_AI + h * 128 + ek); ngw = *(const u32x4*)(H + rn * INC + C_AG + h * 128 + ek); }
        __syncthreads();
        { const int k = tid & 127, tq = tid >> 7; LAS float* p = (LAS float*)(L + HG_LF) + (8 * tq) * 128 + k; float vs[8];
#pragma unroll
            for (int i = 0; i < 8; ++i) vs[i] = p[i * 128];
#pragma unroll
            for (int i = 1; i < 8; ++i) vs[i] += vs[i - 1];
#pragma unroll
            for (int i = 0; i < 8; ++i) p[i * 128] = vs[i];
            ((LAS float*)(L + HG_TOT))[tq * 128 + k] = vs[7]; }
        __syncthreads();
        { float bcum[8];
            { const f32x4 c0 = *(LAS f32x4*)(L + HG_LF + (et * 128 + ek) * 4), c1 = *(LAS f32x4*)(L + HG_LF + (et * 128 + ek + 4) * 4);
#pragma unroll
              for (int e = 0; e < 4; ++e) { bcum[e] = c0[e]; bcum[4 + e] = c1[e]; } }
            for (int gq = 0; gq < (et >> 3); ++gq) { const f32x4 c0 = *(LAS f32x4*)(L + HG_TOT + (gq * 128 + ek) * 4), c1 = *(LAS f32x4*)(L + HG_TOT + (gq * 128 + ek + 4) * 4);
#pragma unroll
                for (int e = 0; e < 4; ++e) { bcum[e] += c0[e]; bcum[4 + e] += c1[e]; } }
            float qv[8]; unpk8(qw, qv);
            float qt[8], kt[8];
#pragma unroll
            for (int e = 0; e < 8; ++e) { const float lfe = e < 4 ? lf0[e] : lf1[e - 4]; const float eb = __expf(bcum[e]);
                qt[e] = qv[e] * eb; kt[e] = (1.f - __expf(lfe)) * __expf(-bcum[e]);
                if (et == 31) ((LAS float*)(L + HG_G))[ek + e] = eb; }
            const u32x4 qp = pk8(qt), kp = pk8(kt);
            *(LAS u32x4*)(L + HG_QT + et * 272 + ek * 2) = qp;
            *(LAS u32x4*)(L + HG_KS + et * 320 + ek * 2) = kp;
            *(LAS u32x4*)(L + HG_V + et * 320 + ek * 2) = vw;
        }
        __syncthreads();
        if (wave == 0) {
            f32x16 pt;
#pragma unroll
            for (int i = 0; i < 16; ++i) pt[i] = 0.f;
#pragma unroll
            for (int st = 0; st < 8; ++st) { const bf16x8 a = *(const LAS bf16x8*)(L + HG_KS + r * 320 + (16 * st + 8 * hh) * 2), bq = *(const LAS bf16x8*)(L + HG_QT + r * 272 + (16 * st + 8 * hh) * 2);
                pt = MFMA32(a, bq, pt); }
#pragma unroll
            for (int i = 0; i < 16; ++i) if (crow(i, hh) > r) pt[i] = 0.f;
            *(LAS bf16x8*)(L + HG_PF + lane * 16) = pack_step(pt, 0); *(LAS bf16x8*)(L + HG_PF + 1024 + lane * 16) = pack_step(pt, 1);
        }
        f32x16 oacc;
#pragma unroll
        for (int i = 0; i < 16; ++i) oacc[i] = 0.f;
#pragma unroll
        for (int kbl = 0; kbl < 2; ++kbl)
#pragma unroll
            for (int s2 = 0; s2 < 2; ++s2) { const int k0 = 64 * kh + 32 * kbl + 16 * s2 + 4 * hh;
                const s16x4 lo = *(const LAS s16x4*)(L + HG_QT + r * 272 + k0 * 2), hi = *(const LAS s16x4*)(L + HG_QT + r * 272 + (k0 + 8) * 2);
                oacc = MFMA32(pack_step(S[kbl], s2), cat8(lo, hi), oacc); }
        __syncthreads();
        const int i16 = lane & 15, tq = i16 >> 2, tp = i16 & 3, gi = (lane >> 4) & 1;
        if (kh == 0) {
#pragma unroll
            for (int s2 = 0; s2 < 2; ++s2) { const int key0 = 16 * s2 + 4 * hh;
                const s16x4 lo = vtr(L + HG_V + (key0 + tq) * 320 + (32 * nb + 16 * gi + 4 * tp) * 2), hi = vtr(L + HG_V + (key0 + 8 + tq) * 320 + (32 * nb + 16 * gi + 4 * tp) * 2);
                const bf16x8 pf = *(const LAS bf16x8*)(L + HG_PF + s2 * 1024 + lane * 16);
                oacc = MFMA32(cat8(lo, hi), pf, oacc); }
        }
#pragma unroll
        for (int i = 0; i < 16; ++i) ((LAS float*)(L + HG_OX))[(kh * 128 + 32 * nb + crow(i, hh)) * 32 + r] = oacc[i];
#pragma unroll
        for (int kbl = 0; kbl < 2; ++kbl)
#pragma unroll
            for (int s2 = 0; s2 < 2; ++s2) { const int key0 = 16 * s2 + 8 * hh;
                const s16x4 alo = vtr(L + HG_KS + (key0 + tq) * 320 + (64 * kh + 32 * kbl + 16 * gi + 4 * tp) * 2), ahi = vtr(L + HG_KS + (key0 + 4 + tq) * 320 + (64 * kh + 32 * kbl + 16 * gi + 4 * tp) * 2);
                const s16x4 lo = vtr(L + HG_V + (key0 + tq) * 320 + (32 * nb + 16 * gi + 4 * tp) * 2), hi = vtr(L + HG_V + (key0 + 4 + tq) * 320 + (32 * nb + 16 * gi + 4 * tp) * 2);
                S[kbl] = MFMA32(cat8(alo, ahi), cat8(lo, hi), S[kbl]); }
#pragma unroll
        for (int kbl = 0; kbl < 2; ++kbl)
#pragma unroll
            for (int i = 0; i < 16; ++i) S[kbl][i] *= ((LAS float*)(L + HG_G))[64 * kh + 32 * kbl + crow(i, hh)];
        __syncthreads();
        { float o[8], ss = 0.f;
#pragma unroll
            for (int e = 0; e < 8; ++e) { o[e] = ((LAS float*)(L + HG_OX))[(ek + e) * 32 + et] + ((LAS float*)(L + HG_OX))[(128 + ek + e) * 32 + et]; ss += o[e] * o[e]; }
            ss += __shfl_xor(ss, 1); ss += __shfl_xor(ss, 2); ss += __shfl_xor(ss, 4); ss += __shfl_xor(ss, 8);
            const float rstd = 1.f / sqrtf(ss * (1.f / 128.f) + RMS_EPS);
            float gv[8]; unpk8(gw, gv);
            const f32x4 g0 = *(const f32x4*)(gn + ek), g1 = *(const f32x4*)(gn + ek + 4);
#pragma unroll
            for (int e = 0; e < 8; ++e) { const float y = o[e] * rstd * (e < 4 ? g0[e] : g1[e - 4]); o[e] = y * (gv[e] / (1.f + __expf(-gv[e]))); }
            if (valid) *(u32x4*)(MIX + row * D + h * 128 + ek) = pk8(o);
        }
        lf0 = nlf0; lf1 = nlf1; qw = nqw; vw = nvw; gw = ngw;
    }
    { float* so = (SMP ? F.out + O_HS + (((size_t)m * SB + b) * NH + h) * 128 * 128 : F.out + O_HP + (((size_t)m * PB + b) * NH + h) * 128 * 128);
      const int l2 = opq(lane); float* sp = so + (size_t)(64 * kh + 4 * (l2 >> 5)) * 128 + 32 * nb + (l2 & 31);
#pragma unroll
      for (int kbl = 0; kbl < 2; ++kbl)
#pragma unroll
        for (int i = 0; i < 16; ++i) sp[(32 * kbl + (i & 3) + 8 * (i >> 2)) * 128] = S[kbl][i]; }
    __syncthreads();
}

constexpr int AT_KP = 272, AT_VP = 320;
constexpr int AT_KB = 64 * AT_KP, AT_VB = 64 * AT_VP;
constexpr int AT_TILE = AT_KB + AT_VB;
static_assert(4 * AT_TILE <= LDS_TAB && (8 * 66 * 64 + 64 * 64 + 8 * 64) * 4 <= LDS_TAB && 2 * AT_TILE + 8 * 2 * 32 * 144 <= LDS_TAB, "attention LDS");

__device__ __forceinline__ void attn_build_tab(Frame& F, int h) {
    if (F.tid < 256) { const int rel = F.tid - 128, n = rel < 0 ? -rel : rel;
        int bk = n;
        if (n >= 8) bk = 8 + (n >= 12) + (n >= 16) + (n >= 23) + (n >= 32) + (n >= 46) + (n >= 64) + (n >= 91);
        if (rel > 0) bk += 16;
        ((LAS float*)(F.lds + LDS_TAB))[F.tid] = F.in[I_RB][bk * NH + h] * LOG2E; }
}
struct AttnState { f32x16 o[4]; float m, l; };
template <bool MASK_END>
__device__ __forceinline__ void attn_tile(const LAS unsigned char* Kt, const LAS unsigned char* Vt, int vh, const bf16x8 (&qf)[4], AttnState& A, int kpos0, int qpos, int qpos_min, int kv_end,
                                          const LAS float* tab, int r, int hh, int lane) {
    f32x16 st[2];
#pragma unroll
    for (int kb = 0; kb < 2; ++kb) {
#pragma unroll
        for (int i = 0; i < 16; ++i) st[kb][i] = 0.f;
#pragma unroll
        for (int s = 0; s < 4; ++s) { const bf16x8 a = *(const LAS bf16x8*)(Kt + (32 * kb + r) * AT_KP + (vh * 64 + 16 * s + 8 * hh) * 2); st[kb] = MFMA32(a, qf[s], st[kb]); }
    }
    constexpr float C2 = 0.125f * LOG2E;
    const bool far = (kpos0 + 63) <= (qpos_min - 91);
    if (far) { const float bc = tab[0];
#pragma unroll
        for (int kb = 0; kb < 2; ++kb)
#pragma unroll
            for (int i = 0; i < 16; ++i) st[kb][i] = st[kb][i] * C2 + bc;
    } else {
#pragma unroll
        for (int kb = 0; kb < 2; ++kb)
#pragma unroll
            for (int i = 0; i < 16; ++i) { const int kpos = kpos0 + 32 * kb + crow(i, hh); int rel = kpos - qpos; rel = rel < -128 ? -128 : (rel > 127 ? 127 : rel);
                float x = st[kb][i] * C2 + tab[rel + 128];
                if (MASK_END) x = (kpos < kv_end) ? x : -1e30f;
                st[kb][i] = x; }
    }
    float mx = st[0][0];
#pragma unroll
    for (int kb = 0; kb < 2; ++kb)
#pragma unroll
        for (int i = 0; i < 16; ++i) mx = fmaxf(mx, st[kb][i]);
    mx = fmaxf(mx, __shfl_xor(mx, 32));
    if (__any(mx > A.m + 8.f)) {
        const float mnew = fmaxf(A.m, mx), alpha = __builtin_amdgcn_exp2f(A.m - mnew);
        A.m = mnew; A.l *= alpha;
#pragma unroll
        for (int mb = 0; mb < 4; ++mb)
#pragma unroll
            for (int i = 0; i < 16; ++i) A.o[mb][i] *= alpha;
    }
    const float mref = A.m;
    float ls = 0.f;
#pragma unroll
    for (int kb = 0; kb < 2; ++kb)
#pragma unroll
        for (int i = 0; i < 16; ++i) { const float p = __builtin_amdgcn_exp2f(st[kb][i] - mref); st[kb][i] = p; ls += p; }
    A.l += ls;
    const int i16 = lane & 15, tq = i16 >> 2, tp = i16 & 3, gi = (lane >> 4) & 1;
#pragma unroll
    for (int kb = 0; kb < 2; ++kb)
#pragma unroll
        for (int s2 = 0; s2 < 2; ++s2) { const bf16x8 pf = pack_step(st[kb], s2); const int key0 = 32 * kb + 16 * s2 + 4 * hh;
#pragma unroll
            for (int mb = 0; mb < 4; ++mb) {
                const s16x4 lo = vtr(Vt + (key0 + tq) * AT_VP + (32 * mb + 16 * gi + 4 * tp) * 2), hi = vtr(Vt + (key0 + 8 + tq) * AT_VP + (32 * mb + 16 * gi + 4 * tp) * 2);
                A.o[mb] = MFMA32(cat8(lo, hi), pf, A.o[mb]); } }
}
__device__ __forceinline__ void attn_store(const f32x16 (&o)[4], const float* gnorm, float post, bf16_t* dst_row  , int hh, bool active) {
    float ss = 0.f;
#pragma unroll
    for (int mb = 0; mb < 4; ++mb)
#pragma unroll
        for (int i = 0; i < 16; ++i) ss += o[mb][i] * o[mb][i];
    ss += __shfl_xor(ss, 32);
    const float rstd = post / sqrtf(ss * (1.f / 128.f) + RMS_EPS);
    if (active) {
#pragma unroll
        for (int mb = 0; mb < 4; ++mb)
#pragma unroll
            for (int g4 = 0; g4 < 4; ++g4) { const int dv = 32 * mb + 8 * g4 + 4 * hh; const f32x4 gv = *(const f32x4*)(gnorm + dv);
                u32x2 w; w.x = pk2(o[mb][4 * g4] * rstd * gv[0], o[mb][4 * g4 + 1] * rstd * gv[1]); w.y = pk2(o[mb][4 * g4 + 2] * rstd * gv[2], o[mb][4 * g4 + 3] * rstd * gv[3]);
                *(u32x2*)(dst_row + dv) = w; }
    }
}

__device__ __forceinline__ void attn_prompt_unit(Frame& F, int m, int b, int h, int qb) {
    LAS unsigned char* L = F.lds; const LAS float* tab = (const LAS float*)(L + LDS_TAB);
    const bf16_t* H = (const bf16_t*)(F.ws + WS_H); bf16_t* MIX = (bf16_t*)(F.ws + WS_MIX);
    const int tid = opq(F.tid), lane = tid & 63, wave = __builtin_amdgcn_readfirstlane(tid >> 6), r = lane & 31, hh = lane >> 5, vh = wave >> 2, wq = wave & 3;
    const size_t rowb = (size_t)b * PT;
    const int q0a = qb * 256 + wq * 32, q0b = q0a + 128, qca = q0a >> 6, qcb = q0b >> 6, nkt = 4 * qb + 4;
    attn_build_tab(F, h);
    LAS unsigned char* qs = L + 2 * AT_TILE + wave * (2 * 32 * 144) + r * 144 + 16 * hh;
#pragma unroll
    for (int s = 0; s < 4; ++s) { *(LAS bf16x8*)(qs + 32 * s) = *(const bf16x8*)(H + (rowb + q0a + r) * INC + C_BQ + h * 128 + vh * 64 + 16 * s + 8 * hh);
        *(LAS bf16x8*)(qs + 32 * 144 + 32 * s) = *(const bf16x8*)(H + (rowb + q0b + r) * INC + C_BQ + h * 128 + vh * 64 + 16 * s + 8 * hh); }
    AttnState A0, A1;
#pragma unroll
    for (int mb = 0; mb < 4; ++mb)
#pragma unroll
        for (int i = 0; i < 16; ++i) { A0.o[mb][i] = 0.f; A1.o[mb][i] = 0.f; }
    A0.m = -1e30f; A0.l = 0.f; A1.m = -1e30f; A1.l = 0.f;
    u32x4 kr[2], vr[2];
#define AT_LD(kt) do { _Pragma("unroll") for (int i_ = 0; i_ < 2; ++i_) { const int c_ = tid + 512 * i_, key_ = c_ >> 4, ch_ = c_ & 15; const bf16_t* src_ = H + (rowb + 64 * (kt) + key_) * INC + h * 128 + ch_ * 8; \
        kr[i_] = *(const u32x4*)(src_ + C_BK); vr[i_] = *(const u32x4*)(src_ + C_BV); } } while (0)
#define AT_ST(buf) do { _Pragma("unroll") for (int i_ = 0; i_ < 2; ++i_) { const int c_ = tid + 512 * i_, key_ = c_ >> 4, ch_ = c_ & 15; \
        *(LAS u32x4*)(L + (buf) * AT_TILE + key_ * AT_KP + ch_ * 16) = kr[i_]; *(LAS u32x4*)(L + (buf) * AT_TILE + AT_KB + key_ * AT_VP + ch_ * 16) = vr[i_]; } } while (0)
    AT_LD(0); AT_ST(0);
    AT_LD(1);
    __syncthreads();
    for (int kt = 0; kt < nkt; ++kt) {
        if (kt <= qca) { bf16x8 qf[4];
#pragma unroll
            for (int s = 0; s < 4; ++s) qf[s] = *(const LAS bf16x8*)(qs + 32 * s);
            attn_tile<false>(L + (kt & 1) * AT_TILE, L + (kt & 1) * AT_TILE + AT_KB, vh, qf, A0, 64 * kt, q0a + r, q0a, 0, tab, r, hh, lane); }
        if (kt <= qcb) { bf16x8 qf[4];
#pragma unroll
            for (int s = 0; s < 4; ++s) qf[s] = *(const LAS bf16x8*)(qs + 32 * 144 + 32 * s);
            attn_tile<false>(L + (kt & 1) * AT_TILE, L + (kt & 1) * AT_TILE + AT_KB, vh, qf, A1, 64 * kt, q0b + r, q0b, 0, tab, r, hh, lane); }
        if (kt + 1 < nkt) AT_ST((kt + 1) & 1);
        if (kt + 2 < nkt) AT_LD(kt + 2);
        __syncthreads();
    }
#undef AT_LD
#undef AT_ST
    { const float l0 = A0.l + __shfl_xor(A0.l, 32), i0 = 1.f / l0, l1 = A1.l + __shfl_xor(A1.l, 32), i1 = 1.f / l1;
#pragma unroll
        for (int mb = 0; mb < 4; ++mb)
#pragma unroll
            for (int i = 0; i < 16; ++i) { A0.o[mb][i] *= i0; A1.o[mb][i] *= i1; } }
    LAS float* X = (LAS float*)L;
    if (vh == 1) {
#pragma unroll
        for (int mb = 0; mb < 4; ++mb)
#pragma unroll
            for (int i = 0; i < 16; ++i) { X[(wq * 64 + mb * 16 + i) * 64 + lane] = A0.o[mb][i]; X[((4 + wq) * 64 + mb * 16 + i) * 64 + lane] = A1.o[mb][i]; }
    }
    __syncthreads();
    if (vh == 0) {
        const float lam = ((const float*)(F.ws + WS_TAB))[TB_LAM + m];
        const float lam_init = (m == 0) ? 0.2f : 0.47071302f;
#pragma unroll
        for (int mb = 0; mb < 4; ++mb)
#pragma unroll
            for (int i = 0; i < 16; ++i) A0.o[mb][i] -= lam * X[(wq * 64 + mb * 16 + i) * 64 + lane];
        attn_store(A0.o, F.in[I_DNG] + (size_t)m * 128, 1.f - lam_init, MIX + (rowb + q0a + r) * D + 512 + h * 128, hh, true);
#pragma unroll
        for (int mb = 0; mb < 4; ++mb)
#pragma unroll
            for (int i = 0; i < 16; ++i) A1.o[mb][i] -= lam * X[((4 + wq) * 64 + mb * 16 + i) * 64 + lane];
        attn_store(A1.o, F.in[I_DNG] + (size_t)m * 128, 1.f - lam_init, MIX + (rowb + q0b + r) * D + 512 + h * 128, hh, true);
    }
    __syncthreads();
}

__device__ __forceinline__ void attn_sample_unit(Frame& F, int m, int b, int h) {
    LAS unsigned char* L = F.lds; const LAS float* tab = (const LAS float*)(L + LDS_TAB);
    const bf16_t* H = (const bf16_t*)(F.ws + WS_H); bf16_t* MIX = (bf16_t*)(F.ws + WS_MIX);
    const float* ck = F.in[I_CK] + (((size_t)m * SB + b) * PAST) * 512 + h * 128; const float* cv = F.in[I_CV] + (((size_t)m * SB + b) * PAST) * 512 + h * 128;
    const int tid = opq(F.tid), lane = tid & 63, wave = __builtin_amdgcn_readfirstlane(tid >> 6), r = lane & 31, hh = lane >> 5, vh = wave >> 2, ks = wave & 3;
    const size_t rows = (size_t)MP + (size_t)b * ST;
    attn_build_tab(F, h);
    bf16x8 qf[4];
#pragma unroll
    for (int s = 0; s < 4; ++s) qf[s] = *(const bf16x8*)(H + (rows + (r & 15)) * INC + C_BQ + h * 128 + vh * 64 + 16 * s + 8 * hh);
    AttnState A;
#pragma unroll
    for (int mb = 0; mb < 4; ++mb)
#pragma unroll
        for (int i = 0; i < 16; ++i) A.o[mb][i] = 0.f;
    A.m = -1e30f; A.l = 0.f;
    constexpr int NT = PAST / 64 + 1;
    for (int it = 0; it < (NT + 3) / 4; ++it) {
#pragma unroll 1
        for (int j = 0; j < 4; ++j) { const int T = 4 * it + j;
#pragma unroll
            for (int i = 0; i < 2; ++i) { const int c = tid + 512 * i, key = c >> 4, ch = c & 15;
                u32x4 kw = {0u, 0u, 0u, 0u}, vw = {0u, 0u, 0u, 0u};
                if (T < PAST / 64) { const float* pk = ck + (size_t)(64 * T + key) * 512 + ch * 8; const float* pv = cv + (size_t)(64 * T + key) * 512 + ch * 8;
                    const f32x4 k0 = *(const f32x4*)pk, k1 = *(const f32x4*)(pk + 4), v0 = *(const f32x4*)pv, v1 = *(const f32x4*)(pv + 4);
                    kw.x = pk2(k0[0], k0[1]); kw.y = pk2(k0[2], k0[3]); kw.z = pk2(k1[0], k1[1]); kw.w = pk2(k1[2], k1[3]);
                    vw.x = pk2(v0[0], v0[1]); vw.y = pk2(v0[2], v0[3]); vw.z = pk2(v1[0], v1[1]); vw.w = pk2(v1[2], v1[3]); }
                else if (T == PAST / 64 && key < ST) { const bf16_t* src = H + (rows + key) * INC + h * 128 + ch * 8; kw = *(const u32x4*)(src + C_BK); vw = *(const u32x4*)(src + C_BV); }
                *(LAS u32x4*)(L + j * AT_TILE + key * AT_KP + ch * 16) = kw; *(LAS u32x4*)(L + j * AT_TILE + AT_KB + key * AT_VP + ch * 16) = vw; } }
        __syncthreads();
        { const int T = 4 * it + ks;
            if (T < NT - 1) attn_tile<false>(L + ks * AT_TILE, L + ks * AT_TILE + AT_KB, vh, qf, A, 64 * T, PAST + (r & 15), PAST, 0, tab, r, hh, lane);
            else if (T == NT - 1) attn_tile<true>(L + ks * AT_TILE, L + ks * AT_TILE + AT_KB, vh, qf, A, 64 * T, PAST + (r & 15), PAST, PAST + ST, tab, r, hh, lane); }
        __syncthreads();
    }
    const float lt = A.l + __shfl_xor(A.l, 32);
    LAS float* X = (LAS float*)L;
#pragma unroll
    for (int mb = 0; mb < 4; ++mb)
#pragma unroll
        for (int i = 0; i < 16; ++i) X[(wave * 66 + mb * 16 + i) * 64 + lane] = A.o[mb][i];
    X[(wave * 66 + 64) * 64 + lane] = A.m; X[(wave * 66 + 65) * 64 + lane] = lt;
    LAS float* Y = X + 8 * 66 * 64;
    LAS float* SS = Y + 64 * 64;
    __syncthreads();
    {
        const float lam = ((const float*)(F.ws + WS_TAB))[TB_LAM + m];
        float coef[8];
#pragma unroll
        for (int v2 = 0; v2 < 2; ++v2) {
            float M = -1e30f;
#pragma unroll
            for (int k = 0; k < 4; ++k) M = fmaxf(M, X[((v2 * 4 + k) * 66 + 64) * 64 + lane]);
            float Ls = 0.f;
#pragma unroll
            for (int k = 0; k < 4; ++k) { coef[v2 * 4 + k] = __builtin_amdgcn_exp2f(X[((v2 * 4 + k) * 66 + 64) * 64 + lane] - M); Ls += coef[v2 * 4 + k] * X[((v2 * 4 + k) * 66 + 65) * 64 + lane]; }
            const float sc = (v2 == 0 ? 1.f : -lam) / Ls;
#pragma unroll
            for (int k = 0; k < 4; ++k) coef[v2 * 4 + k] *= sc;
        }
        float ss = 0.f;
#pragma unroll
        for (int i8 = 0; i8 < 8; ++i8) { const int row = 8 * wave + i8; float y = 0.f;
#pragma unroll
            for (int p = 0; p < 8; ++p) y += coef[p] * X[(p * 66 + row) * 64 + lane];
            Y[row * 64 + lane] = y; ss += y * y; }
        SS[wave * 64 + lane] = ss;
    }
    __syncthreads();
    if (wave == 0) {
        float ss = 0.f;
#pragma unroll
        for (int w = 0; w < 8; ++w) ss += SS[w * 64 + lane];
        ss += __shfl_xor(ss, 32);
        const float lam_init = (m == 0) ? 0.2f : 0.47071302f;
        const float rstd = (1.f - lam_init) / sqrtf(ss * (1.f / 128.f) + RMS_EPS);
        const float* gnorm = F.in[I_DNG] + (size_t)m * 128;
        bf16_t* dst_row = MIX + (rows + (r & 15)) * D + 512 + h * 128;
        if (r < ST) {
#pragma unroll
            for (int mb = 0; mb < 4; ++mb)
#pragma unroll
                for (int g4 = 0; g4 < 4; ++g4) { const int dv = 32 * mb + 8 * g4 + 4 * hh; const f32x4 gv = *(const f32x4*)(gnorm + dv); const LAS float* yp = Y + (mb * 16 + 4 * g4) * 64 + lane;
                    u32x2 w; w.x = pk2(yp[0] * rstd * gv[0], yp[64] * rstd * gv[1]); w.y = pk2(yp[128] * rstd * gv[2], yp[192] * rstd * gv[3]);
                    *(u32x2*)(dst_row + dv) = w; }
        }
    }
    __syncthreads();
}

__device__ __forceinline__ void phase_mixer(Frame& F, int m, int qsel = 0) {
    const int G = F.G, bid = F.bid;
    if (PHM & 0x1000) for (int u = bid; u < PB * NH; u += G) hgrn_unit<false>(F, m, u >> 2, u & 3);
#if PROBE_HG
    for (int u = bid; u < PB * NH; u += G) hgrn_unit<false>(F, m, u >> 2, u & 3);
#endif
    if (PHM & 0x2000) for (int u = (G >= 256 ? (bid >= 128 ? bid - 128 : bid + G - 128) : bid); u < SB * NH; u += G) attn_sample_unit(F, m, u >> 2, u & 3);
#if PROBE_SA
    for (int u = (G >= 256 ? (bid >= 128 ? bid - 128 : bid + G - 128) : bid); u < SB * NH; u += G) attn_sample_unit(F, m, u >> 2, u & 3);
#endif
    if (PHM & 0x4000) {
        gu32* head = (gu32*)(F.ws + WS_CTL) + CW_QUEUE + 64 * m + 128 * qsel;
        volatile LAS int* slot = (volatile LAS int*)(F.lds + LDS_CTRL + 64);
        for (;;) {
            if (F.tid == 0) *slot = (int)__hip_atomic_fetch_add(head, 1u, __ATOMIC_RELAXED, __HIP_MEMORY_SCOPE_AGENT);
            __syncthreads();
            const int u = *slot;
            __syncthreads();
            if (u >= PB * NH * 8) break;
            const int qb = 7 - (u >> 7), bh = u & 127;
            attn_prompt_unit(F, m, bh >> 2, bh & 3, qb);
        }
    }
    if (PHM & 0x8000) for (int u = bid; u < SB * NH; u += G) hgrn_unit<true>(F, m, u >> 2, u & 3);
}

__global__ void __launch_bounds__(NTHREADS, 2) mega_fwd(Args args) {
    extern __shared__ __attribute__((aligned(16))) unsigned char lds_raw[];
    Frame F;
    F.lds = (LAS unsigned char*)lds_raw;
    F.tid = threadIdx.x; F.lane = F.tid & 63; F.wave = __builtin_amdgcn_readfirstlane(F.tid >> 6);
    const int wave_s = F.wave;
    F.bid = blockIdx.x; F.G = gridDim.x; F.in = (kin_t)__builtin_amdgcn_kernarg_segment_ptr(); F.out = (float*)F.in[24]; F.ws = (unsigned char*)F.in[25];
    if (F.tid < 128) ((LAS unsigned*)(F.lds + LDS_CTRL))[F.tid] = 0u;
    __syncthreads();
    unsigned* barw = (unsigned*)(F.ws + WS_CTL) + CW_BAR;
    XcdBarrier bar; bar.bar = barw; bar.x = 0; bar.st = nullptr;
    const bool single = args.single != 0;
    if (single) bar = xcd_barrier_post(barw, (volatile LAS unsigned*)(F.lds + LDS_CTRL + 32));
    const int lo = args.ph_lo, hi = args.ph_hi;
#define RUN(p) (lo <= (p) && (p) < hi)
#define SEAM() do { if (single) { XcdBarrier b2_ = bar; asm volatile("" : "+s"(b2_.bar)); xcd_barrier(b2_); } } while (0)
#define REFRESH() do { { int b_ = (int)blockIdx.x, g_ = (int)gridDim.x; asm volatile("" : "+s"(b_), "+s"(g_)); F.bid = b_; F.G = g_; } { kin_t kp_ = (kin_t)__builtin_amdgcn_kernarg_segment_ptr(); asm volatile("" : "+s"(kp_)); F.in = kp_; F.out = (float*)kp_[24]; F.ws = (unsigned char*)kp_[25]; } { int l_; asm volatile("v_mbcnt_lo_u32_b32 %0, -1, 0\n\tv_mbcnt_hi_u32_b32 %0, -1, %0" : "=v"(l_)); F.lane = l_; } F.wave = wave_s; F.tid = wave_s * 64 + F.lane; } while (0)
    int ph = 0;
    if ((PHM & 1) && RUN(ph)) { REFRESH(); phase_prologue(F); SEAM();
#if PROBE_PRO
        REFRESH(); phase_prologue(F); SEAM();
#endif
    } ++ph;
    for (int l = 0; l < 4; ++l) {
#define WSB(off) ((bf16_t*)(F.ws + (off)))
#define STATS(k) ((float*)(F.ws + WS_CTL) + CW_STATS + (size_t)(k) * MT * 2)
#define LN1REF(ll) LnRef{WSB(WS_Z), STATS(2 * (ll)), F.in[I_L1G] + (size_t)(ll) * D, F.in[I_L1B] + (size_t)(ll) * D, 0}
#define LN2REF(ll) LnRef{WSB(WS_ZB), STATS(2 * (ll) + 1), F.in[I_L2G] + (size_t)(ll) * D, F.in[I_L2B] + (size_t)(ll) * D, 0}
        if ((l & 1) == 0) {
            const int m = l >> 1;
            if ((PHM & 2) && RUN(ph)) {
                REFRESH();
                const float* ctlf = (const float*)(F.ws + WS_CTL);
                pg8::Gemm g{l == 0 ? WSB(WS_XB) : WSB(WS_ZB), (const bf16_t*)(F.ws + WS_WIN) + (size_t)m * INC * D, MP, INC, D, D, 0, l == 0 ? nullptr : STATS(2 * (l - 1) + 1)}; pg8::StaticOrder S; S.init(MP, INC, F.G, F.bid);
                EpiIn E{(bf16_t*)(F.ws + WS_H), (float*)(F.ws + WS_LF), (const float*)(F.ws + WS_TAB) + TB_LB + m * 512,
                        F.out + O_KP + (size_t)m * MP * 512, F.out + O_VP + (size_t)m * MP * 512, F.out + O_KS + (size_t)m * MS * 512, F.out + O_VS + (size_t)m * MS * 512,
                        STATS(l == 0 ? 0 : 2 * (l - 1) + 1), ctlf + (l == 0 ? UC_ZERO : UC_UIN), ctlf + (l == 0 ? UC_ZERO : UC_CIN), l == 0 ? 1 : 0};
                pg8::gemm_phase<EpiIn>(F.lds, g, S, E, F.tid);
                REFRESH(); sgemm_in_phase(F.lds, g.A + (size_t)MP * D, g.Bt, F.bid, F.G, F.tid, E);
                SEAM(); } ++ph;
            if ((PHM & 4) && RUN(ph)) { REFRESH(); phase_mixer(F, m); SEAM();
#if PROBE_MIXER
                REFRESH(); phase_mixer(F, m, 1); SEAM();
#endif
            } ++ph;
            if ((PHM & 8) && RUN(ph)) {
                REFRESH();
                pg8::Gemm g{(const bf16_t*)(F.ws + WS_MIX), (const bf16_t*)(F.ws + WS_WOUT) + (size_t)m * D * D, MP, D, D, D, 0, l == 0 ? nullptr : STATS(2 * (l - 1) + 1)}; pg8::StaticOrder S; S.init(MP, D, F.G, F.bid);
                LnRef P = LN2REF(l == 0 ? 0 : l - 1); if (l == 0) { P.Z = WSB(WS_XB); P.ident = 1; }
                EpiRes E{P, WSB(WS_Z), STATS(2 * l), nullptr};
                pg8::gemm_phase<EpiRes>(F.lds, g, S, E, F.tid);
                REFRESH(); sgemm_res_phase<128>(F.lds, g.A + (size_t)MP * D, D, 0, g.Bt, D, F.bid, F.G, F.tid, P, WSB(WS_Z), STATS(2 * l), nullptr);
                SEAM(); } ++ph;
        } else {
            const int p = l >> 1;
            if ((PHM & 16) && RUN(ph)) { REFRESH(); const LnRef R = LN2REF(l - 1); phase_pool_prep(F, R, p); SEAM(); } ++ph;
            ++ph;
            if ((PHM & 32) && RUN(ph)) {
                REFRESH();
                pg8::Gemm g{(const bf16_t*)(F.ws + WS_MIX), (const bf16_t*)(F.ws + WS_WPOOL) + (size_t)p * D * 256, MP, D, 256, D, 256, STATS(2 * (l - 1) + 1)}; pg8::StaticOrder S; S.init(MP, D, F.G, F.bid);
                EpiRes E{LN2REF(l - 1), WSB(WS_Z), STATS(2 * l), F.in[I_PSC] + (size_t)p * D};
                pg8::gemm_phase<EpiRes>(F.lds, g, S, E, F.tid);
                REFRESH(); { const LnRef P2 = LN2REF(l - 1); sgemm_res_phase<32>(F.lds, g.A + (size_t)MP * D, D, 256, g.Bt, 256, F.bid, F.G, F.tid, P2, WSB(WS_Z), STATS(2 * l), E.scale); }
                SEAM(); } ++ph;
        }
        ++ph;
        if ((PHM & 128) && RUN(ph)) {
            REFRESH();
            const float* ctlf = (const float*)(F.ws + WS_CTL);
            pg8::Gemm g{WSB(WS_Z), (const bf16_t*)(F.ws + WS_WUP) + (size_t)l * UPN * D, MT, UPN, D, D, 0, STATS(2 * l)}; pg8::StaticOrder S; S.init(MT, UPN, F.G, F.bid);
            EpiUpConv E{(bf16_t*)(F.ws + WS_G), F.in[I_CW] + (size_t)l * 3 * DFF, F.in[I_CB] + (size_t)l * DFF, F.in[I_SC] + (size_t)l * SB * 2 * DFF,
                        (float*)(F.ws + WS_AHEAD), (float*)(F.ws + WS_BHEAD), (float*)(F.ws + WS_ATAIL), F.out + O_CP + (size_t)l * PB * 2 * DFF, F.out + O_CS + (size_t)l * SB * 2 * DFF, (LAS float*)(F.lds + LDS_EX),
                        STATS(2 * l), ctlf + UC_UUP + (size_t)l * UPN, ctlf + UC_CUP + (size_t)l * UPN};
            pg8::gemm_phase<EpiUpConv>(F.lds, g, S, E, F.tid); SEAM();
#if PROBE_UP
            REFRESH(); pg8::gemm_phase<EpiUpConv>(F.lds, g, S, E, F.tid); SEAM();
#endif
            } ++ph;
        ++ph;
        if ((PHM & 512) && RUN(ph)) {
            REFRESH();
            pg8::Gemm g{(const bf16_t*)(F.ws + WS_G), (const bf16_t*)(F.ws + WS_WDN) + (size_t)l * D * DFF, MP, D, DFF, DFF, 0, STATS(2 * l)}; pg8::StaticOrder S; S.init(MP, D, F.G, F.bid);
            conv_fix_local(F, l, S); REFRESH();
            EpiRes E{LN1REF(l), WSB(WS_ZB), STATS(2 * l + 1), nullptr};
            pg8::gemm_phase<EpiRes>(F.lds, g, S, E, F.tid);
            REFRESH(); { const LnRef P1 = LN1REF(l); sgemm_res_phase<352>(F.lds, g.A + (size_t)MP * DFF, DFF, 0, g.Bt, DFF, F.bid, F.G, F.tid, P1, WSB(WS_ZB), STATS(2 * l + 1), nullptr); }
            SEAM(); } ++ph;
        if ((PHM & 1024) && RUN(ph) && l == 3) { REFRESH(); phase_ln_final(F, WSB(WS_ZB), F.in[I_L2G] + (size_t)3 * D, F.in[I_L2B] + (size_t)3 * D); } ++ph;
    }
#undef RUN
#undef SEAM
}
constexpr int N_PHASES = 1 + 4 * 8;

extern "C" void kernel_launch(void* const* d_in, const int* in_sizes, int n_in, void* d_out, int out_size, void* d_ws, size_t ws_size, hipStream_t stream) {
    static int grid = 0;
    if (grid == 0) {
        if (n_in != 24 || (size_t)out_size != O_END || ws_size < WS_END2) { fprintf(stderr, "kernel_launch: unexpected problem (n_in %d out %d ws %zu)\n", n_in, out_size, ws_size); grid = -1; return; }
        int dev = 0, cus = 0;
        if (hipGetDevice(&dev) != hipSuccess || hipDeviceGetAttribute(&cus, hipDeviceAttributeMultiprocessorCount, dev) != hipSuccess) { grid = -1; return; }
        if (hipFuncSetAttribute((const void*)mega_fwd, hipFuncAttributeMaxDynamicSharedMemorySize, LDS_BYTES) != hipSuccess) { fprintf(stderr, "kernel_launch: hipFuncSetAttribute failed\n"); grid = -1; return; }
        int per_cu = 0;
        if (hipOccupancyMaxActiveBlocksPerMultiprocessor(&per_cu, (const void*)mega_fwd, NTHREADS, LDS_BYTES) != hipSuccess || per_cu < 1) fprintf(stderr, "kernel_launch: occupancy query reports %d\n", per_cu);
        (void)hipGetLastError();
        grid = cus;
    }
    if (grid < 0) return;
    (void)hipMemsetAsync((char*)d_ws + WS_CTL, 0, CTL_ZERO_BYTES, stream);
    Args a{};
    for (int i = 0; i < 24; ++i) a.in[i] = (const float*)d_in[i];
    a.out = (float*)d_out; a.ws = (unsigned char*)d_ws; a.pad = 0;
#if MK_SINGLE
    a.ph_lo = 0; a.ph_hi = N_PHASES; a.single = 1;
    hipLaunchKernelGGL(mega_fwd, dim3(grid), dim3(NTHREADS), LDS_BYTES, stream, a);
#else
    for (int p = 0; p < N_PHASES; ++p) {
        const int k = (p - 1) % 8, l = (p - 1) / 8;
        if (p > 0 && (l & 1) == 1 && k == 1) continue;
        a.ph_lo = p; a.ph_hi = p + 1; a.single = 0;
        hipLaunchKernelGGL(mega_fwd, dim3(grid), dim3(NTHREADS), LDS_BYTES, stream, a);
    }
#endif
}
```

```cpp
#include <hip/hip_runtime.h>
#include <cstdio>
#include <cstdint>

#ifndef PHM
#define PHM 0xffff
#endif
#ifndef PROBE_MIXER
#define PROBE_MIXER 0
#endif
#ifndef EMU_BF16
#define EMU_BF16 0
#endif
#ifndef PROBE_LN
#define PROBE_LN 0
#endif
#ifndef PROBE_PRO
#define PROBE_PRO 0
#endif
#ifndef PROBE_HG
#define PROBE_HG 0
#endif
#ifndef PROBE_SA
#define PROBE_SA 0
#endif
#ifndef PROBE_UP
#define PROBE_UP 0
#endif
#ifndef MK_SINGLE
#define MK_SINGLE 1
#endif

#define LAS __attribute__((address_space(3)))
#define GAS __attribute__((address_space(1)))
typedef unsigned short bf16_t;
typedef short bf16x8 __attribute__((ext_vector_type(8)));
typedef short s16x4 __attribute__((ext_vector_type(4)));
typedef float f32x2 __attribute__((ext_vector_type(2)));
typedef float f32x4 __attribute__((ext_vector_type(4)));
typedef float f32x16 __attribute__((ext_vector_type(16)));
typedef unsigned u32x2 __attribute__((ext_vector_type(2)));
typedef unsigned u32x4 __attribute__((ext_vector_type(4)));
typedef __bf16 bf16x2_t __attribute__((ext_vector_type(2)));
typedef GAS unsigned gu32;

constexpr int D = 1024, PB = 32, PT = 2048, SB = 32, ST = 16, PAST = 4096;
constexpr int MP = PB * PT, MS = SB * ST, MT = MP + MS;
constexpr int INC = 3584, DFF = 2816, UPN = 2 * DFF, NH = 4;
constexpr int C_AQ = 0, C_AF = 512, C_AI = 1024, C_AG = 1536, C_BQ = 2048, C_BK = 2560, C_BV = 3072;
constexpr float DN_ALPHA = 1.681792830507429f;
constexpr float LN_EPS = 1e-5f, RMS_EPS = 1e-6f;
constexpr float LOG2E = 1.4426950408889634f;
constexpr int NWAVES = 8, NTHREADS = 512;

constexpr size_t O_YP = 0;
constexpr size_t O_YS = O_YP + (size_t)MP * D;
constexpr size_t O_KP = O_YS + (size_t)MS * D;
constexpr size_t O_VP = O_KP + (size_t)2 * MP * 512;
constexpr size_t O_HP = O_VP + (size_t)2 * MP * 512;
constexpr size_t O_PP = O_HP + (size_t)2 * PB * NH * 128 * 128;
constexpr size_t O_CP = O_PP + (size_t)2 * PB * 15 * D;
constexpr size_t O_KS = O_CP + (size_t)4 * PB * 2 * DFF;
constexpr size_t O_VS = O_KS + (size_t)2 * MS * 512;
constexpr size_t O_HS = O_VS + (size_t)2 * MS * 512;
constexpr size_t O_PS = O_HS + (size_t)2 * SB * NH * 128 * 128;
constexpr size_t O_CS = O_PS + (size_t)2 * SB * 15 * D;
constexpr size_t O_END = O_CS + (size_t)4 * SB * 2 * DFF;
static_assert(O_END == 214695936ull, "d_out size");

constexpr size_t WS_CTL = 0, CTL_ZERO_BYTES = 8u << 20;
constexpr size_t WS_WIN = CTL_ZERO_BYTES;
constexpr size_t WS_WOUT = WS_WIN + (size_t)2 * INC * D * 2;
constexpr size_t WS_WPOOL = WS_WOUT + (size_t)2 * D * D * 2;
constexpr size_t WS_WUP = WS_WPOOL + (size_t)2 * D * 256 * 2;
constexpr size_t WS_WDN = WS_WUP + (size_t)4 * UPN * D * 2;
constexpr size_t WS_TAB = WS_WDN + (size_t)4 * D * DFF * 2;
constexpr size_t WS_XB = WS_TAB + 65536;
constexpr size_t WS_Z = WS_XB + (size_t)MT * D * 2;
constexpr size_t WS_ZB = WS_Z + (size_t)MT * D * 2;
constexpr size_t WS_MIX = WS_Z + (size_t)MT * D * 4;
constexpr size_t WS_G = WS_MIX + (size_t)MT * D * 2;
constexpr size_t WS_A = WS_G + (size_t)MT * DFF * 2;
constexpr size_t WS_H = WS_A;
constexpr size_t WS_LF = WS_H + (size_t)MT * INC * 2;
constexpr size_t WS_AB = WS_A;
constexpr size_t WS_END = WS_A + (size_t)MT * UPN * 2;
static_assert(WS_LF + (size_t)MT * 512 * 4 <= WS_END, "H|LF inside region A");
constexpr size_t SIDE_BYTES = (size_t)(MT / 256) * 2 * DFF * 4;
constexpr size_t WS_AHEAD = WS_END, WS_BHEAD = WS_AHEAD + SIDE_BYTES, WS_ATAIL = WS_BHEAD + SIDE_BYTES, WS_END2 = WS_ATAIL + SIDE_BYTES;
static_assert(WS_END2 <= 2147483648ull, "workspace");
constexpr int CW_TMO = 0;
constexpr int CW_BAR = 4096;
constexpr int CW_QUEUE = 16384;
constexpr int CW_STATS = 262144;
constexpr int CW_UC = CW_STATS + 8 * MT * 2;
constexpr int UC_UUP = CW_UC, UC_CUP = UC_UUP + 4 * UPN, UC_UIN = UC_CUP + 4 * UPN, UC_CIN = UC_UIN + INC, UC_ZERO = UC_CIN + INC, UC_END = UC_ZERO + INC;
static_assert((size_t)UC_END * 4 <= CTL_ZERO_BYTES, "zeroed region");
constexpr int TB_LB = 0;
constexpr int TB_LAM = 1024;

constexpr int LDS_BYTES = 163840;
constexpr int LDS_CTRL = LDS_BYTES - 512;
constexpr int LDS_TAB = LDS_CTRL - 1024;
constexpr int LDS_STT = 131072 + 4096;
constexpr int LDS_CT = 131072 + 8192;
constexpr int LDS_EX = 131072;

__device__ __forceinline__ unsigned pk2(float lo, float hi) { f32x2 v = {lo, hi}; bf16x2_t b = __builtin_convertvector(v, bf16x2_t); return __builtin_bit_cast(unsigned, b); }
__device__ __forceinline__ float bflo(unsigned u) { return __builtin_bit_cast(float, u << 16); }
__device__ __forceinline__ float bfhi(unsigned u) { return __builtin_bit_cast(float, u & 0xffff0000u); }
__device__ __forceinline__ u32x4 pk8(const float* v) { u32x4 w; w.x = pk2(v[0], v[1]); w.y = pk2(v[2], v[3]); w.z = pk2(v[4], v[5]); w.w = pk2(v[6], v[7]); return w; }
__device__ __forceinline__ void unpk8(u32x4 w, float* v) { v[0] = bflo(w.x); v[1] = bfhi(w.x); v[2] = bflo(w.y); v[3] = bfhi(w.y); v[4] = bflo(w.z); v[5] = bfhi(w.z); v[6] = bflo(w.w); v[7] = bfhi(w.w); }
__device__ __forceinline__ float wave_sum(float v) {
#pragma unroll
    for (int o = 1; o < 64; o <<= 1) v += __shfl_xor(v, o);
    return v;
}
__device__ __forceinline__ int opq(int x) { asm volatile("" : "+v"(x)); return x; }
__device__ __forceinline__ int lane_id_v() { int l_; asm volatile("v_mbcnt_lo_u32_b32 %0, -1, 0\n\tv_mbcnt_hi_u32_b32 %0, -1, %0" : "=v"(l_)); return l_; }
__device__ __forceinline__ float silu_mul(float c, float b) { return c * __builtin_amdgcn_rcpf(1.f + __builtin_amdgcn_exp2f(-LOG2E * c)) * b; }
__device__ __forceinline__ int crow(int reg, int h) { return (reg & 3) + 8 * (reg >> 2) + 4 * h; }
__device__ __forceinline__ s16x4 vtr(const LAS unsigned char* p) { return __builtin_bit_cast(s16x4, __builtin_amdgcn_ds_read_tr16_b64_v4i16((LAS s16x4*)p)); }
__device__ __forceinline__ bf16x8 cat8(s16x4 lo, s16x4 hi) { return (bf16x8){lo[0], lo[1], lo[2], lo[3], hi[0], hi[1], hi[2], hi[3]}; }
#define MFMA32(a, b, c) __builtin_amdgcn_mfma_f32_32x32x16_bf16((a), (b), (c), 0, 0, 0)
__device__ __forceinline__ bf16x8 pack_step(const f32x16& x, int s) {
    u32x4 p; p.x = pk2(x[8 * s], x[8 * s + 1]); p.y = pk2(x[8 * s + 2], x[8 * s + 3]); p.z = pk2(x[8 * s + 4], x[8 * s + 5]); p.w = pk2(x[8 * s + 6], x[8 * s + 7]);
    return __builtin_bit_cast(bf16x8, p);
}

namespace pg8 {
constexpr int BM = 256, BK = 64, HALF = 128, HTB = HALF * BK * 2, STAGE_BYTES = 8 * HTB, NXCD = 8, WGM = 8;
__host__ __device__ __forceinline__ int lds_byte(int r, int c) { const int st = (r >> 4) * 2 + (c >> 5), rr = r & 15, cc = c & 31, ob = rr * 64 + cc * 2; return st * 1024 + (ob ^ (((ob >> 9) & 1) << 5)); }
__host__ __device__ __forceinline__ void stage_rc(int b, int& R, int& C) { const int st = b / 1024, sb = b % 1024, swz = sb ^ (((sb >> 9) & 1) << 5); R = (st >> 1) * 16 + swz / 64; C = (st & 1) * 32 + (swz % 64) / 2; }
__host__ __device__ __forceinline__ int perm32(int rho) { const int n = rho >> 4, i = rho & 15; return 8 * (i >> 2) + 4 * n + (i & 3); }
struct Unit { int pm, pn; };
struct Gemm { const bf16_t* A; const bf16_t* Bt; int M, N, K, lda, a_pn_step; const float* st; };
struct StaticOrder {
    int nM, nN, nwg, G, c;
    __device__ void init(int M, int N, int G_, int c_) { nM = M / BM; nN = N / BM; nwg = nM * nN; G = G_; c = c_; }
    __device__ bool next(int i, Unit& u) const {
        const long L = (long)i * G + c; if (L >= nwg) return false;
        int wgid = (int)L; { const int q = nwg / NXCD, r = nwg % NXCD, xcd = wgid % NXCD, off = wgid / NXCD; wgid = (xcd < r ? xcd * (q + 1) : r * (q + 1) + (xcd - r) * q) + off; }
        const int nig = WGM * nN, gid = wgid / nig, fm = gid * WGM, gsz = (nM - fm) < WGM ? (nM - fm) : WGM;
        u.pm = fm + ((wgid % nig) % gsz); u.pn = (wgid % nig) / gsz; return true;
    }
};
template <class Epi>
__device__ __forceinline__ void gemm_phase(LAS unsigned char* lds, const Gemm g, const StaticOrder& S, const Epi& E, int tid_in) {
    const int tid = tid_in, wid = __builtin_amdgcn_readfirstlane(tid >> 6), lane = tid & 63, wr = wid >> 2, wc = wid & 3, fr = lane & 15, fq = lane >> 4;
    const int K = g.K, nt = K / BK, lda = g.lda;
    unsigned voffA[2], voffB[2];
#define PG8_VOFF() do { const int t_ = wid * 64 + lane_id_v(); _Pragma("unroll") for (int i = 0; i < 2; ++i) { int R, C; stage_rc(t_ * 16 + i * 8192, R, C); const int Rb = (R & ~31) + perm32(R & 31); \
        voffA[i] = (unsigned)(R * lda + C) * 2u; voffB[i] = (unsigned)(Rb * K + C) * 2u; } } while (0)
    PG8_VOFF();
    const size_t kstep = (size_t)(BK * 2);
    const size_t hstepA = (size_t)HALF * lda * 2, hstepB = (size_t)HALF * K * 2;
    const size_t tstepA = 2 * hstepA, tstepB = 2 * hstepB;
    const size_t pnA = (size_t)g.a_pn_step * 2;
    const unsigned ldsw = (unsigned)wid * 1024u;
    const int aoff = lds_byte(wr * 64 + fr, fq * 8), boff = lds_byte(wc * 32 + fr, fq * 8);
#define PG8_SA(b, h) (((b) * 2 + (h)) * HTB)
#define PG8_SB(b, h) ((4 + (b) * 2 + (h)) * HTB)
#define PG8_STAGE(bufoff, gbase, voff) do { _Pragma("unroll") for (int _i = 0; _i < 2; ++_i) \
        __builtin_amdgcn_global_load_lds((const unsigned*)((const char*)(gbase) + (voff)[_i]), (LAS unsigned*)(lds + (bufoff) + ldsw + _i * 8192), 16, 0, 0); } while (0)
#define PG8_LDA(dst, b, h) do { _Pragma("unroll") for (int m = 0; m < 4; ++m) _Pragma("unroll") for (int k = 0; k < 2; ++k) dst[m][k] = *(const LAS bf16x8*)(lds + PG8_SA(b, h) + aoff + m * 2048 + k * 1024); } while (0)
#define PG8_LDB(dst, b, h) do { _Pragma("unroll") for (int n = 0; n < 2; ++n) _Pragma("unroll") for (int k = 0; k < 2; ++k) dst[n][k] = *(const LAS bf16x8*)(lds + PG8_SB(b, h) + boff + n * 2048 + k * 1024); } while (0)
#define PG8_MMA(ai, bj, At, Bt) do { __builtin_amdgcn_s_setprio(1); _Pragma("unroll") for (int m = 0; m < 4; ++m) _Pragma("unroll") for (int n = 0; n < 2; ++n) _Pragma("unroll") for (int k = 0; k < 2; ++k) \
        acc[ai][bj][m][n] = __builtin_amdgcn_mfma_f32_16x16x32_bf16(Bt[n][k], At[m][k], acc[ai][bj][m][n], 0, 0, 0); __builtin_amdgcn_s_setprio(0); } while (0)
#define PG8_WAIT_V(n) asm volatile("s_waitcnt vmcnt(" #n ")" ::: "memory")
#define PG8_WAIT_L(n) asm volatile("s_waitcnt lgkmcnt(" #n ")" ::: "memory")
#define PG8_BAR __builtin_amdgcn_s_barrier()
#define PG8_SCHED __builtin_amdgcn_sched_barrier(0)
    Unit cur, nxt; int ui = 0;
    if (!S.next(0, cur)) return;
#define PG8_STATS(pm_, par_) do { if (g.st) __builtin_amdgcn_global_load_lds((const unsigned*)(g.st + (size_t)(pm_) * 512 + 64 * wid + lane_id_v()), (LAS unsigned*)(lds + LDS_STT + (par_) * 2048 + wid * 256), 4, 0, 0); } while (0)
    PG8_STATS(cur.pm, 0); __builtin_amdgcn_sched_barrier(0); E.prefetch(cur, 0, wid, lds);
    f32x4 acc[2][2][4][2];
#pragma unroll
    for (int a = 0; a < 2; ++a)
#pragma unroll
        for (int b = 0; b < 2; ++b)
#pragma unroll
            for (int m = 0; m < 4; ++m)
#pragma unroll
                for (int n = 0; n < 2; ++n) acc[a][b][m][n] = (f32x4){0.f, 0.f, 0.f, 0.f};
    bf16x8 At[4][2], B0[2][2], B1[2][2];
    const char* cA = (const char*)g.A + (size_t)cur.pm * tstepA + (size_t)cur.pn * pnA; const char* cB = (const char*)g.Bt + (size_t)cur.pn * tstepB;
    PG8_STAGE(PG8_SB(0, 0), cB, voffB); PG8_STAGE(PG8_SB(0, 1), cB + hstepB, voffB); PG8_STAGE(PG8_SA(0, 0), cA, voffA); PG8_STAGE(PG8_SA(0, 1), cA + hstepA, voffA);
    if (wr == 1) PG8_BAR;
    PG8_WAIT_V(2); PG8_BAR;
    PG8_STAGE(PG8_SB(1, 0), cB + kstep, voffB); PG8_STAGE(PG8_SA(1, 0), cA + kstep, voffA); PG8_STAGE(PG8_SB(1, 1), cB + hstepB + kstep, voffB);
    PG8_WAIT_V(6); PG8_BAR;
    for (;;) {
        const bool has_next = S.next(ui + 1, nxt);
        const char* nA = has_next ? (const char*)g.A + (size_t)nxt.pm * tstepA + (size_t)nxt.pn * pnA : cA; const char* nB = has_next ? (const char*)g.Bt + (size_t)nxt.pn * tstepB : cB;
        for (int t = 0; t < nt; t += 2) {
            const bool last = (t == nt - 2);
            const char* a1 = cA + (size_t)(t + 1) * kstep;
            const char* a2 = last ? nA : cA + (size_t)(t + 2) * kstep; const char* b2 = last ? nB : cB + (size_t)(t + 2) * kstep;
            const char* a3 = a2 + kstep; const char* b3 = b2 + kstep;
            PG8_LDB(B0, 0, 0); PG8_LDB(B1, 0, 1); PG8_SCHED; PG8_LDA(At, 0, 0); PG8_STAGE(PG8_SA(1, 1), a1 + hstepA, voffA);
            PG8_WAIT_V(8); PG8_WAIT_L(0); PG8_BAR; PG8_MMA(0, 0, At, B0); PG8_MMA(0, 1, At, B1); PG8_BAR; PG8_SCHED;
            PG8_LDA(At, 0, 1); PG8_STAGE(PG8_SB(0, 0), b2, voffB); PG8_STAGE(PG8_SB(0, 1), b2 + hstepB, voffB); PG8_STAGE(PG8_SA(0, 0), a2, voffA);
            PG8_WAIT_V(8); PG8_WAIT_L(0); PG8_BAR; PG8_MMA(1, 0, At, B0); PG8_MMA(1, 1, At, B1); PG8_BAR; PG8_SCHED;
            PG8_LDB(B0, 1, 0); PG8_LDB(B1, 1, 1); PG8_SCHED; PG8_LDA(At, 1, 0); PG8_STAGE(PG8_SA(0, 1), a2 + hstepA, voffA);
            PG8_WAIT_V(8); PG8_WAIT_L(0); PG8_BAR; PG8_MMA(0, 0, At, B0); PG8_MMA(0, 1, At, B1); PG8_BAR; PG8_SCHED;
            PG8_LDA(At, 1, 1); PG8_STAGE(PG8_SB(1, 0), b3, voffB); PG8_STAGE(PG8_SB(1, 1), b3 + hstepB, voffB); PG8_STAGE(PG8_SA(1, 0), a3, voffA);
            PG8_WAIT_V(8); PG8_WAIT_L(0); PG8_BAR; PG8_MMA(1, 0, At, B0); PG8_MMA(1, 1, At, B1); PG8_BAR; PG8_SCHED;
        }
        if (wr == 0) PG8_BAR;
        { const int le = lane_id_v(); int wr_ = wr, wc_ = wc; asm volatile("" : "+s"(wr_), "+s"(wc_));
          E(acc, cur, wr_, wc_, le & 15, le >> 4, (const LAS float*)(lds + LDS_STT + (ui & 1) * 2048), (const LAS float*)(lds + LDS_CT + (ui & 1) * 4096)); }
        if (!has_next) break;
#pragma unroll
        for (int a = 0; a < 2; ++a)
#pragma unroll
            for (int b = 0; b < 2; ++b)
#pragma unroll
                for (int m = 0; m < 4; ++m)
#pragma unroll
                    for (int n = 0; n < 2; ++n) acc[a][b][m][n] = (f32x4){0.f, 0.f, 0.f, 0.f};
        cur = nxt; cA = nA; cB = nB; ++ui;
        PG8_VOFF();
        PG8_STATS(cur.pm, ui & 1); E.prefetch(cur, ui & 1, wid, lds);
        if (wr == 1) PG8_BAR;
    }
    PG8_WAIT_V(0);
    PG8_BAR;
#undef PG8_STATS
#undef PG8_VOFF
#undef PG8_SA
#undef PG8_SB
#undef PG8_STAGE
#undef PG8_LDA
#undef PG8_LDB
#undef PG8_MMA
#undef PG8_WAIT_V
#undef PG8_WAIT_L
#undef PG8_BAR
#undef PG8_SCHED
}
}

struct LnRef { const bf16_t* Z; const float* st; const float* g; const float* b; int ident; };
__device__ __forceinline__ void ln_row(const float* st, size_t row, int ident, float& mu, float& rstd) {
    mu = 0.f; rstd = 1.f;
    if (!ident) { const f32x2 s = *(const f32x2*)(st + row * 2); mu = s[0] * (1.f / D); rstd = 1.f / sqrtf(fmaxf(s[1] * (1.f / D) - mu * mu, 0.f) + LN_EPS); }
}
__device__ __forceinline__ void ln_row_lds(const LAS float* stt, int rl, int ident, float& mu, float& rstd) {
    mu = 0.f; rstd = 1.f;
    if (!ident) { const f32x2 s = *(const LAS f32x2*)(stt + 2 * rl); mu = s[0] * (1.f / D); rstd = __builtin_amdgcn_rsqf(fmaxf(s[1] * (1.f / D) - mu * mu, 0.f) + LN_EPS); }
}
struct EpiBf16 {
    __device__ __forceinline__ void prefetch(const pg8::Unit&, int, int, LAS unsigned char*) const {}
    bf16_t* O; int ldc;
    __device__ __forceinline__ void operator()(const f32x4 (&acc)[2][2][4][2], const pg8::Unit& u, int wr, int wc, int fr, int fq, const LAS float* stt, const LAS float* ct) const {
        const int row0 = u.pm * 256 + wr * 64 + fr, col0 = u.pn * 256 + wc * 32 + 8 * fq;
#pragma unroll
        for (int ai = 0; ai < 2; ++ai)
#pragma unroll
            for (int m = 0; m < 4; ++m) { bf16_t* rowp = O + (size_t)(row0 + ai * 128 + m * 16) * ldc + col0;
#pragma unroll
                for (int bj = 0; bj < 2; ++bj) { const f32x4 v0 = acc[ai][bj][m][0], v1 = acc[ai][bj][m][1];
                    u32x4 w; w.x = pk2(v0[0], v0[1]); w.y = pk2(v0[2], v0[3]); w.z = pk2(v1[0], v1[1]); w.w = pk2(v1[2], v1[3]);
                    *(u32x4*)(rowp + bj * 128) = w; } }
    }
};
struct EpiIn {
    __device__ __forceinline__ void prefetch(const pg8::Unit&, int, int, LAS unsigned char*) const {}
    bf16_t* H; float* LF; const float* lbv; float* kP; float* vP; float* kS; float* vS; const float* st; const float* uu; const float* cc; int ident;
    __device__ __forceinline__ void operator()(const f32x4 (&acc_in)[2][2][4][2], const pg8::Unit& u, int wr, int wc, int fr, int fq, const LAS float* stt, const LAS float* ct) const {
        f32x4 acc[2][2][4][2];
        { const int r0 = u.pm * 256 + wr * 64 + fr, c0 = u.pn * 256 + wc * 32 + 8 * fq;
#pragma unroll
          for (int bj = 0; bj < 2; ++bj) { const f32x4 u0 = *(const f32x4*)(uu + c0 + bj * 128), u1 = *(const f32x4*)(uu + c0 + bj * 128 + 4), k0 = *(const f32x4*)(cc + c0 + bj * 128), k1 = *(const f32x4*)(cc + c0 + bj * 128 + 4);
#pragma unroll
            for (int ai = 0; ai < 2; ++ai)
#pragma unroll
                for (int m = 0; m < 4; ++m) { float mu, rstd; ln_row_lds(stt, wr * 64 + fr + ai * 128 + m * 16, ident, mu, rstd);
                    const float nb = -mu * rstd; acc[ai][bj][m][0] = acc_in[ai][bj][m][0] * rstd + (u0 * nb + k0); acc[ai][bj][m][1] = acc_in[ai][bj][m][1] * rstd + (u1 * nb + k1); } } }
        const int row0 = u.pm * 256 + wr * 64 + fr, col0 = u.pn * 256 + wc * 32 + 8 * fq;
        const int kind = u.pn >> 1;
        if (kind == 1) {
#pragma unroll
            for (int bj = 0; bj < 2; ++bj) { const int c = col0 + bj * 128 - C_AF;
                const f32x4 l0 = *(const f32x4*)(lbv + c), l1 = *(const f32x4*)(lbv + c + 4);
#pragma unroll
                for (int ai = 0; ai < 2; ++ai)
#pragma unroll
                    for (int m = 0; m < 4; ++m) { const int row = row0 + ai * 128 + m * 16;
                        f32x4 o0, o1;
#pragma unroll
                        for (int e = 0; e < 4; ++e) {
                            { const float z = acc[ai][bj][m][0][e], ez = __builtin_amdgcn_exp2f(-LOG2E * fabsf(z)), sg = (z >= 0.f ? 1.f : ez) * __builtin_amdgcn_rcpf(1.f + ez), f = l0[e] + (1.f - l0[e]) * sg; o0[e] = fmaxf(__builtin_amdgcn_logf(f) * 0.6931471805599453f, -60.f); }
                            { const float z = acc[ai][bj][m][1][e], ez = __builtin_amdgcn_exp2f(-LOG2E * fabsf(z)), sg = (z >= 0.f ? 1.f : ez) * __builtin_amdgcn_rcpf(1.f + ez), f = l1[e] + (1.f - l1[e]) * sg; o1[e] = fmaxf(__builtin_amdgcn_logf(f) * 0.6931471805599453f, -60.f); }
                        }
                        float* dst = LF + (size_t)row * 512 + c; *(f32x4*)dst = o0; *(f32x4*)(dst + 4) = o1; } }
            return;
        }
#pragma unroll
        for (int ai = 0; ai < 2; ++ai)
#pragma unroll
            for (int m = 0; m < 4; ++m) { const int row = row0 + ai * 128 + m * 16; bf16_t* rowp = H + (size_t)row * INC + col0;
#pragma unroll
                for (int bj = 0; bj < 2; ++bj) { const f32x4 v0 = acc[ai][bj][m][0], v1 = acc[ai][bj][m][1];
                    u32x4 w; w.x = pk2(v0[0], v0[1]); w.y = pk2(v0[2], v0[3]); w.z = pk2(v1[0], v1[1]); w.w = pk2(v1[2], v1[3]);
                    *(u32x4*)(rowp + bj * 128) = w;
                    if (kind >= 5) { const int c = col0 + bj * 128 - (kind == 5 ? C_BK : C_BV);
                        float* dst = (row < MP) ? ((kind == 5 ? kP : vP) + (size_t)row * 512 + c) : ((kind == 5 ? kS : vS) + (size_t)(row - MP) * 512 + c);
                        *(f32x4*)dst = v0; *(f32x4*)(dst + 4) = v1; } } }
    }
};
struct EpiRes {
    __device__ __forceinline__ void prefetch(const pg8::Unit&, int, int, LAS unsigned char*) const {}
    LnRef P; bf16_t* Z; float* st_out; const float* scale;
    __device__ __forceinline__ void operator()(const f32x4 (&acc)[2][2][4][2], const pg8::Unit& u, int wr, int wc, int fr, int fq, const LAS float* stt, const LAS float* ct) const {
        const int row0 = u.pm * 256 + wr * 64 + fr, col0 = u.pn * 256 + wc * 32 + 8 * fq;
        float s1[8], s2[8];
#pragma unroll
        for (int i = 0; i < 8; ++i) { s1[i] = 0.f; s2[i] = 0.f; }
#pragma unroll
        for (int bj = 0; bj < 2; ++bj) { const int c = col0 + bj * 128;
            float sc[8], gg[8], bb[8];
#pragma unroll
            for (int e = 0; e < 8; ++e) { sc[e] = 1.f; gg[e] = 1.f; bb[e] = 0.f; }
            if (scale) { const f32x4 a0 = *(const f32x4*)(scale + c), a1 = *(const f32x4*)(scale + c + 4);
#pragma unroll
                for (int e = 0; e < 4; ++e) { sc[e] = a0[e]; sc[4 + e] = a1[e]; } }
            if (!P.ident) { const f32x4 a0 = *(const f32x4*)(P.g + c), a1 = *(const f32x4*)(P.g + c + 4), b0 = *(const f32x4*)(P.b + c), b1 = *(const f32x4*)(P.b + c + 4);
#pragma unroll
                for (int e = 0; e < 4; ++e) { gg[e] = a0[e]; gg[4 + e] = a1[e]; bb[e] = b0[e]; bb[4 + e] = b1[e]; } }
#pragma unroll
            for (int ai = 0; ai < 2; ++ai)
#pragma unroll
                for (int m = 0; m < 4; ++m) { const size_t row = (size_t)(row0 + ai * 128 + m * 16), off = row * D + c;
                    float mu, rstd; ln_row_lds(stt, wr * 64 + fr + ai * 128 + m * 16, P.ident, mu, rstd);
                    const u32x4 xw = *(const u32x4*)(P.Z + off); float xv[8]; unpk8(xw, xv);
                    float o[8];
#pragma unroll
                    for (int e = 0; e < 8; ++e) { const float t = rstd * gg[e], x = fmaf(xv[e], t, fmaf(-mu, t, bb[e])); o[e] = fmaf(DN_ALPHA, x, (e < 4 ? acc[ai][bj][m][0][e] : acc[ai][bj][m][1][e - 4]) * sc[e]); }
                    const u32x4 w = pk8(o); *(u32x4*)(Z + off) = w;
                    float ov[8]; unpk8(w, ov);
#pragma unroll
                    for (int e = 0; e < 8; ++e) { s1[ai * 4 + m] += ov[e]; s2[ai * 4 + m] += ov[e] * ov[e]; } } }
#pragma unroll
        for (int i = 0; i < 8; ++i) { s1[i] += __shfl_xor(s1[i], 16); s1[i] += __shfl_xor(s1[i], 32); s2[i] += __shfl_xor(s2[i], 16); s2[i] += __shfl_xor(s2[i], 32); }
        if (fq == 0) {
#pragma unroll
            for (int i = 0; i < 8; ++i) { float* p = st_out + (size_t)(row0 + (i >> 2) * 128 + (i & 3) * 16) * 2; atomicAdd(p, s1[i]); atomicAdd(p + 1, s2[i]); } }
    }
};

template <int CTRL> __device__ __forceinline__ float dpp_f(float v) { return __builtin_bit_cast(float, __builtin_amdgcn_update_dpp(0, __builtin_bit_cast(int, v), CTRL, 0xf, 0xf, false)); }
struct EpiUpConv {
    bf16_t* G; const float* cw; const float* cb; const float* hist; float* ahead; float* bhead; float* atail; float* outP; float* outS; LAS float* ex; const float* st; const float* uu; const float* cc;
    __device__ __forceinline__ void prefetch(const pg8::Unit& u, int par, int wid, LAS unsigned char* lds) const {
        const int l = lane_id_v();
#pragma unroll
        for (int j = 0; j < 2; ++j) { const int arr = j * 4 + (wid >> 1), off = (wid & 1) * 64 + l;
            const float* src = (arr < 3) ? cw + (size_t)arr * DFF + 128 * u.pn : (arr == 3) ? cb + 128 * u.pn : (arr == 4) ? uu + 256 * u.pn : (arr == 5) ? cc + 256 * u.pn : (arr == 6) ? uu + 256 * u.pn + 128 : cc + 256 * u.pn + 128;
            __builtin_amdgcn_global_load_lds((const unsigned*)(src + off), (LAS unsigned*)(lds + LDS_CT + par * 4096 + (j * 512 + wid * 64) * 4), 4, 0, 0); __builtin_amdgcn_sched_barrier(0); }
    }
    __device__ __forceinline__ void corr2(const f32x4& a0, const f32x4& a1, const LAS float* up, const LAS float* kp, float mu, float rstd, f32x2 (&o)[4]) const {
        const f32x4 u0 = *(const LAS f32x4*)up, u1 = *(const LAS f32x4*)(up + 4), k0 = *(const LAS f32x4*)kp, k1 = *(const LAS f32x4*)(kp + 4);
        const float nb = -mu * rstd; const f32x2 r2 = {rstd, rstd}, n2 = {nb, nb};
        o[0] = (f32x2){a0[0], a0[1]} * r2 + ((f32x2){u0[0], u0[1]} * n2 + (f32x2){k0[0], k0[1]});
        o[1] = (f32x2){a0[2], a0[3]} * r2 + ((f32x2){u0[2], u0[3]} * n2 + (f32x2){k0[2], k0[3]});
        o[2] = (f32x2){a1[0], a1[1]} * r2 + ((f32x2){u1[0], u1[1]} * n2 + (f32x2){k1[0], k1[1]});
        o[3] = (f32x2){a1[2], a1[3]} * r2 + ((f32x2){u1[2], u1[3]} * n2 + (f32x2){k1[2], k1[3]});
    }
    template <bool SMP>
    __device__ __forceinline__ void body(const f32x4 (&acc)[2][2][4][2], const pg8::Unit& u, int wr, int fr, int chl, int ch, const LAS float* stt, const LAS float* T) const {
        const int seq_first = (u.pm & 7) == 0;
#pragma unroll
        for (int ai = 0; ai < 2; ++ai) {
            f32x2 h1[4], h2[4];
#pragma unroll
            for (int e = 0; e < 4; ++e) { h1[e] = (f32x2){0.f, 0.f}; h2[e] = (f32x2){0.f, 0.f}; }
            bool top_missing = false;
            if (!SMP) {
                if (wr == 1 || ai == 1) { const int sa = (wr == 1) ? ai : 0, sw = (wr == 1) ? 0 : 1; const LAS float* p = ex + ((sa * 2 + sw) * 2) * 128 + chl;
                    const f32x4 a0 = *(const LAS f32x4*)p, a1 = *(const LAS f32x4*)(p + 4), b0 = *(const LAS f32x4*)(p + 128), b1 = *(const LAS f32x4*)(p + 132);
                    h2[0] = (f32x2){a0[0], a0[1]}; h2[1] = (f32x2){a0[2], a0[3]}; h2[2] = (f32x2){a1[0], a1[1]}; h2[3] = (f32x2){a1[2], a1[3]};
                    h1[0] = (f32x2){b0[0], b0[1]}; h1[1] = (f32x2){b0[2], b0[3]}; h1[2] = (f32x2){b1[0], b1[1]}; h1[3] = (f32x2){b1[2], b1[3]}; }
                else top_missing = !seq_first;
            }
            f32x2 r1p[4], r2p[4];
#pragma unroll
            for (int e = 0; e < 4; ++e) { r1p[e] = (f32x2){0.f, 0.f}; r2p[e] = (f32x2){0.f, 0.f}; }
#pragma unroll
            for (int m = 0; m < 4; ++m) {
                const int rloc = 128 * ai + 64 * wr + 16 * m + fr;
                f32x2 cur[4], bb[4], r1[4], r2[4], p1[4], p2[4], o[4];
                const LAS float* Tm = T; asm volatile("" : "+v"(Tm));
                { float mu, rstd; ln_row_lds(stt, rloc, 0, mu, rstd);
                  corr2(acc[ai][0][m][0], acc[ai][0][m][1], Tm + 4 * 128, Tm + 5 * 128, mu, rstd, cur); corr2(acc[ai][1][m][0], acc[ai][1][m][1], Tm + 6 * 128, Tm + 7 * 128, mu, rstd, bb); }
#pragma unroll
                for (int e = 0; e < 4; ++e) { r1[e] = (f32x2){dpp_f<0x121>(cur[e][0]), dpp_f<0x121>(cur[e][1])}; r2[e] = (f32x2){dpp_f<0x122>(cur[e][0]), dpp_f<0x122>(cur[e][1])}; }
                if (SMP) { const int sb = ((u.pm - MP / 256) * 256 + 128 * ai + 64 * wr + 16 * m) >> 4; const float* hp = hist + (size_t)sb * 2 * DFF + ch;
                    const f32x4 a0 = *(const f32x4*)hp, a1 = *(const f32x4*)(hp + 4), b0 = *(const f32x4*)(hp + DFF), b1 = *(const f32x4*)(hp + DFF + 4);
                    const f32x2 hh0[4] = {{a0[0], a0[1]}, {a0[2], a0[3]}, {a1[0], a1[1]}, {a1[2], a1[3]}}, hh1[4] = {{b0[0], b0[1]}, {b0[2], b0[3]}, {b1[0], b1[1]}, {b1[2], b1[3]}};
#pragma unroll
                    for (int e = 0; e < 4; ++e) { p1[e] = fr >= 1 ? r1[e] : hh1[e]; p2[e] = fr >= 2 ? r2[e] : (fr == 1 ? hh1[e] : hh0[e]); } }
                else if (m == 0) {
#pragma unroll
                    for (int e = 0; e < 4; ++e) { p1[e] = fr >= 1 ? r1[e] : h1[e]; p2[e] = fr >= 2 ? r2[e] : (fr == 1 ? h1[e] : h2[e]); } }
                else {
#pragma unroll
                    for (int e = 0; e < 4; ++e) { p1[e] = fr >= 1 ? r1[e] : r1p[e]; p2[e] = fr >= 2 ? r2[e] : r2p[e]; } }
                { const f32x4 x0a = *(const LAS f32x4*)(Tm + 0 * 128), x0b = *(const LAS f32x4*)(Tm + 0 * 128 + 4), x1a = *(const LAS f32x4*)(Tm + 1 * 128), x1b = *(const LAS f32x4*)(Tm + 1 * 128 + 4);
                  const f32x4 x2a = *(const LAS f32x4*)(Tm + 2 * 128), x2b = *(const LAS f32x4*)(Tm + 2 * 128 + 4), xba = *(const LAS f32x4*)(Tm + 3 * 128), xbb = *(const LAS f32x4*)(Tm + 3 * 128 + 4);
                  const f32x2 w0[4] = {{x0a[0], x0a[1]}, {x0a[2], x0a[3]}, {x0b[0], x0b[1]}, {x0b[2], x0b[3]}}, w1[4] = {{x1a[0], x1a[1]}, {x1a[2], x1a[3]}, {x1b[0], x1b[1]}, {x1b[2], x1b[3]}};
                  const f32x2 w2[4] = {{x2a[0], x2a[1]}, {x2a[2], x2a[3]}, {x2b[0], x2b[1]}, {x2b[2], x2b[3]}}, wb[4] = {{xba[0], xba[1]}, {xba[2], xba[3]}, {xbb[0], xbb[1]}, {xbb[2], xbb[3]}};
#pragma unroll
                  for (int e = 0; e < 4; ++e) { const f32x2 c = cur[e] * w2[e] + (p1[e] * w1[e] + (p2[e] * w0[e] + wb[e]));
                      const f32x2 t = c * (f32x2){-LOG2E, -LOG2E}; const f32x2 d = (f32x2){__builtin_amdgcn_exp2f(t[0]), __builtin_amdgcn_exp2f(t[1])} + (f32x2){1.f, 1.f};
                      o[e] = (c * bb[e]) * (f32x2){__builtin_amdgcn_rcpf(d[0]), __builtin_amdgcn_rcpf(d[1])}; r1p[e] = r1[e]; r2p[e] = r2[e]; } }
                if (!(top_missing && m == 0 && fr < 2)) { u32x4 w; w.x = pk2(o[0][0], o[0][1]); w.y = pk2(o[1][0], o[1][1]); w.z = pk2(o[2][0], o[2][1]); w.w = pk2(o[3][0], o[3][1]);
                    *(u32x4*)(G + (size_t)(u.pm * 256 + rloc) * DFF + ch) = w; }
                const f32x4 ca0 = {cur[0][0], cur[0][1], cur[1][0], cur[1][1]}, ca1 = {cur[2][0], cur[2][1], cur[3][0], cur[3][1]};
                if (ai == 0 && m == 0 && wr == 0 && fr < 2) { float* pa = ahead + ((size_t)u.pm * 2 + fr) * DFF + ch; float* pb = bhead + ((size_t)u.pm * 2 + fr) * DFF + ch;
                    *(f32x4*)pa = ca0; *(f32x4*)(pa + 4) = ca1; *(f32x4*)pb = (f32x4){bb[0][0], bb[0][1], bb[1][0], bb[1][1]}; *(f32x4*)(pb + 4) = (f32x4){bb[2][0], bb[2][1], bb[3][0], bb[3][1]}; }
                if (ai == 1 && m == 3 && wr == 1 && fr >= 14) { float* pt = atail + ((size_t)u.pm * 2 + (fr - 14)) * DFF + ch; *(f32x4*)pt = ca0; *(f32x4*)(pt + 4) = ca1;
                    if (!SMP && (u.pm & 7) == 7) { float* po = outP + ((size_t)(u.pm >> 3) * 2 + (fr - 14)) * DFF + ch; *(f32x4*)po = ca0; *(f32x4*)(po + 4) = ca1; } }
                if (SMP && fr >= 14) { const int sb = ((u.pm - MP / 256) * 256 + 128 * ai + 64 * wr + 16 * m) >> 4; float* po = outS + ((size_t)sb * 2 + (fr - 14)) * DFF + ch;
                    *(f32x4*)po = ca0; *(f32x4*)(po + 4) = ca1; }
            }
        }
    }
    __device__ __forceinline__ void operator()(const f32x4 (&acc)[2][2][4][2], const pg8::Unit& u, int wr, int wc, int fr, int fq, const LAS float* stt, const LAS float* ct) const {
        const int chl = 32 * wc + 8 * fq, ch = 128 * u.pn + chl;
        const LAS float* T = ct + chl;
        if (fr >= 14) {
#pragma unroll
            for (int ai = 0; ai < 2; ++ai) { float mu, rstd; f32x2 t[4]; ln_row_lds(stt, wr * 64 + fr + ai * 128 + 48, 0, mu, rstd); corr2(acc[ai][0][3][0], acc[ai][0][3][1], T + 4 * 128, T + 5 * 128, mu, rstd, t);
                LAS float* p = ex + ((ai * 2 + wr) * 2 + (fr - 14)) * 128 + chl; *(LAS f32x4*)p = (f32x4){t[0][0], t[0][1], t[1][0], t[1][1]}; *(LAS f32x4*)(p + 4) = (f32x4){t[2][0], t[2][1], t[3][0], t[3][1]}; }
        }
        asm volatile("s_waitcnt lgkmcnt(0)" ::: "memory"); __builtin_amdgcn_s_barrier(); asm volatile("" ::: "memory");
        if (u.pm >= MP / 256) body<true>(acc, u, wr, fr, chl, ch, stt, T); else body<false>(acc, u, wr, fr, chl, ch, stt, T);
    }
};


template <int KW  >
__device__ __forceinline__ void sgemm_res_phase(LAS unsigned char* lds, const bf16_t* A, int lda, int a_grp_step, const bf16_t* Bt, int K, int bid, int G, int tid, const LnRef& P, bf16_t* Z, float* st_out, const float* scale) {
    const int lane = tid & 63, wave = __builtin_amdgcn_readfirstlane(tid >> 6), fr = lane & 15, fq = lane >> 4;
    LAS f32x4* red = (LAS f32x4*)lds;
    for (int t = bid; t < 256; t += G) {
        const int rt = t >> 5, ct = t & 31;
        const GAS bf16_t* ap = (const GAS bf16_t*)(A + (size_t)(rt * 64 + fr) * lda + (size_t)((ct * 32) >> 8) * a_grp_step + wave * KW + 8 * fq);
        const GAS bf16_t* bp = (const GAS bf16_t*)(Bt + (size_t)(ct * 32 + fr) * K + wave * KW + 8 * fq);
        f32x4 acc[4][2];
#pragma unroll
        for (int i = 0; i < 4; ++i) { acc[i][0] = (f32x4){0.f, 0.f, 0.f, 0.f}; acc[i][1] = (f32x4){0.f, 0.f, 0.f, 0.f}; }
#pragma unroll
        for (int k0 = 0; k0 < KW; k0 += 32) {
            bf16x8 af[4], bf[2];
#pragma unroll
            for (int i = 0; i < 4; ++i) af[i] = *(const GAS bf16x8*)(ap + (size_t)(16 * i) * lda + k0);
#pragma unroll
            for (int j = 0; j < 2; ++j) bf[j] = *(const GAS bf16x8*)(bp + (size_t)(16 * j) * K + k0);
#pragma unroll
            for (int i = 0; i < 4; ++i)
#pragma unroll
                for (int j = 0; j < 2; ++j) acc[i][j] = __builtin_amdgcn_mfma_f32_16x16x32_bf16(bf[j], af[i], acc[i][j], 0, 0, 0);
        }
#pragma unroll
        for (int i = 0; i < 4; ++i)
#pragma unroll
            for (int j = 0; j < 2; ++j) red[(wave * 8 + i * 2 + j) * 64 + lane] = acc[i][j];
        __syncthreads();
        f32x4 v = red[(0 * 8 + wave) * 64 + lane];
#pragma unroll
        for (int w = 1; w < 8; ++w) v += red[(w * 8 + wave) * 64 + lane];
        __syncthreads();
        const int row = rt * 64 + 16 * (wave >> 1) + fr, n = ct * 32 + 16 * (wave & 1) + 4 * fq; const size_t grow = (size_t)MP + row, off = grow * D + n;
        float mu, rstd; ln_row(P.st, grow, P.ident, mu, rstd);
        f32x4 gg = {1.f, 1.f, 1.f, 1.f}, bb = {0.f, 0.f, 0.f, 0.f}, sc = {1.f, 1.f, 1.f, 1.f};
        if (!P.ident) { gg = *(const f32x4*)(P.g + n); bb = *(const f32x4*)(P.b + n); }
        if (scale) sc = *(const f32x4*)(scale + n);
        const u32x2 xw = *(const u32x2*)(P.Z + off); const float xv[4] = {bflo(xw.x), bfhi(xw.x), bflo(xw.y), bfhi(xw.y)};
        float o[4];
#pragma unroll
        for (int e = 0; e < 4; ++e) { const float tt = rstd * gg[e], x = fmaf(xv[e], tt, fmaf(-mu, tt, bb[e])); o[e] = fmaf(DN_ALPHA, x, v[e] * sc[e]); }
        u32x2 w; w.x = pk2(o[0], o[1]); w.y = pk2(o[2], o[3]); *(u32x2*)(Z + off) = w;
        float s1 = (bflo(w.x) + bfhi(w.x)) + (bflo(w.y) + bfhi(w.y)), s2 = (bflo(w.x) * bflo(w.x) + bfhi(w.x) * bfhi(w.x)) + (bflo(w.y) * bflo(w.y) + bfhi(w.y) * bfhi(w.y));
        s1 += __shfl_xor(s1, 16); s1 += __shfl_xor(s1, 32); s2 += __shfl_xor(s2, 16); s2 += __shfl_xor(s2, 32);
        if (fq == 0) { atomicAdd(st_out + grow * 2, s1); atomicAdd(st_out + grow * 2 + 1, s2); }
    }
}

__device__ __forceinline__ void sgemm_in_phase(LAS unsigned char* lds, const bf16_t* A, const bf16_t* Bt, int bid, int G, int tid, const EpiIn& E) {
    constexpr int K = D, KW = K / 8;
    const int lane = tid & 63, wave = __builtin_amdgcn_readfirstlane(tid >> 6), fr = lane & 15, fq = lane >> 4;
    LAS f32x4* red = (LAS f32x4*)lds;
    for (int t = bid; t < 256; t += G) {
        const int rt = t >> 5, ct = t & 31;
        const GAS bf16_t* ap = (const GAS bf16_t*)(A + (size_t)(rt * 64 + fr) * K + wave * KW + 8 * fq);
        const GAS bf16_t* bp = (const GAS bf16_t*)(Bt + (size_t)(ct * 112 + fr) * K + wave * KW + 8 * fq);
        f32x4 acc[4][7];
#pragma unroll
        for (int i = 0; i < 4; ++i)
#pragma unroll
            for (int j = 0; j < 7; ++j) acc[i][j] = (f32x4){0.f, 0.f, 0.f, 0.f};
#pragma unroll
        for (int k0 = 0; k0 < KW; k0 += 32) {
            bf16x8 af[4], bf[7];
#pragma unroll
            for (int i = 0; i < 4; ++i) af[i] = *(const GAS bf16x8*)(ap + (size_t)(16 * i) * K + k0);
#pragma unroll
            for (int j = 0; j < 7; ++j) bf[j] = *(const GAS bf16x8*)(bp + (size_t)(16 * j) * K + k0);
#pragma unroll
            for (int i = 0; i < 4; ++i)
#pragma unroll
                for (int j = 0; j < 7; ++j) acc[i][j] = __builtin_amdgcn_mfma_f32_16x16x32_bf16(bf[j], af[i], acc[i][j], 0, 0, 0);
        }
#pragma unroll
        for (int i = 0; i < 4; ++i) {
#pragma unroll
            for (int j = 0; j < 7; ++j) red[(wave * 7 + j) * 64 + lane] = acc[i][j];
            __syncthreads();
            if (wave < 7) {
                f32x4 v = red[(0 * 7 + wave) * 64 + lane];
#pragma unroll
                for (int w = 1; w < 8; ++w) v += red[(w * 7 + wave) * 64 + lane];
                const int m = rt * 64 + 16 * i + fr, n = ct * 112 + 16 * wave + 4 * fq; const size_t row = (size_t)MP + m;
                float mu, rstd; ln_row(E.st, row, E.ident, mu, rstd);
                const f32x4 u0 = *(const f32x4*)(E.uu + n), k0v = *(const f32x4*)(E.cc + n);
                const float nb = -mu * rstd; v = v * rstd + (u0 * nb + k0v);
                const int kind = n >> 9;
                if (kind == 1) { const int c = n - C_AF; const f32x4 l0 = *(const f32x4*)(E.lbv + c); f32x4 o;
#pragma unroll
                    for (int e = 0; e < 4; ++e) { const float z = v[e], ez = __builtin_amdgcn_exp2f(-LOG2E * fabsf(z)), sg = (z >= 0.f ? 1.f : ez) * __builtin_amdgcn_rcpf(1.f + ez), f = l0[e] + (1.f - l0[e]) * sg; o[e] = fmaxf(__builtin_amdgcn_logf(f) * 0.6931471805599453f, -60.f); }
                    *(f32x4*)(E.LF + row * 512 + c) = o; }
                else { u32x2 w; w.x = pk2(v[0], v[1]); w.y = pk2(v[2], v[3]); *(u32x2*)(E.H + row * INC + n) = w;
                    if (kind == 5) *(f32x4*)(E.kS + (size_t)m * 512 + (n - C_BK)) = v;
                    if (kind == 6) *(f32x4*)(E.vS + (size_t)m * 512 + (n - C_BV)) = v; }
            }
            __syncthreads();
        }
    }
}

#define XB_TMO      128
#define XB_XCNT(j)  (256  + 64 * (j))
#define XB_XSUB(j)  (1280 + 64 * (j))
#define XB_XGEN(j)  (2304 + 64 * (j))
#define XB_TOP      3328
#define XB_TOPGEN   3392
#define XCD_BAR_WORDS 3456
#define XB_SPIN_CAP (1u << 22)
__device__ __forceinline__ unsigned xb_ld(unsigned* p)              { return __hip_atomic_load(p, __ATOMIC_RELAXED, __HIP_MEMORY_SCOPE_AGENT); }
__device__ __forceinline__ unsigned xb_add(unsigned* p, unsigned v) { return __hip_atomic_fetch_add(p, v, __ATOMIC_RELAXED, __HIP_MEMORY_SCOPE_AGENT); }
__device__ __forceinline__ unsigned xb_xcc_id() { return (unsigned)__builtin_amdgcn_s_getreg((3 << 11) | 20) & 0xFu; }
#define XB_SPIN(cond, bar) do { unsigned _sp = 0; while (cond) { __builtin_amdgcn_s_sleep(1); \
    if ((++_sp & 255u) == 0u) { if (xb_ld(&(bar)[XB_TMO])) break; if (_sp > XB_SPIN_CAP) { atomicAdd(&(bar)[XB_TMO], 1u); break; } } } } while (0)
struct XcdBarrier { unsigned* bar; unsigned x; volatile LAS unsigned* st; };
__device__ __forceinline__ XcdBarrier xcd_barrier_post(unsigned* bar, volatile LAS unsigned* st) {
    XcdBarrier b; b.bar = bar; b.x = xb_xcc_id(); b.st = st;
    if (threadIdx.x == 0) (void)xb_add(&bar[XB_XCNT(b.x)], 1u);
    return b;
}
__device__ __forceinline__ void xcd_barrier_complete(unsigned* bar, unsigned x, unsigned& nloc, unsigned& nx) {
    const unsigned G = gridDim.x * gridDim.y * gridDim.z;
    unsigned sum, cnt, mine, sp = 0u;
    for (;;) {
        sum = 0u; cnt = 0u; mine = 0u;
#pragma unroll
        for (unsigned j = 0; j < 16; ++j) { const unsigned c = xb_ld(&bar[XB_XCNT(j)]); sum += c; cnt += (c > 0u) ? 1u : 0u; mine = (j == x) ? c : mine; }
        if (sum == G) break;
        __builtin_amdgcn_s_sleep(1);
        if ((++sp & 255u) == 0u) { if (xb_ld(&bar[XB_TMO])) break; if (sp > XB_SPIN_CAP) { atomicAdd(&bar[XB_TMO], 1u); break; } }
    }
    nloc = mine > 0u ? mine : 1u; nx = cnt > 0u ? cnt : 1u;
}
__device__ __forceinline__ void xcd_barrier(const XcdBarrier& b) {
    asm volatile("s_waitcnt vmcnt(0)" ::: "memory");
    __syncthreads();
    if (threadIdx.x == 0) {
        unsigned* bar = b.bar;
        __builtin_amdgcn_s_waitcnt(0);
        unsigned nloc = b.st[0], nx = b.st[1];
        if (nloc == 0u) { xcd_barrier_complete(bar, b.x, nloc, nx); b.st[0] = nloc; b.st[1] = nx; }
        const unsigned old = xb_add(&bar[XB_XSUB(b.x)], 1u);
        const unsigned gen = old / nloc;
        if (old + 1u == (gen + 1u) * nloc) {
            __builtin_amdgcn_fence(__ATOMIC_RELEASE, "agent");
            asm volatile("s_waitcnt vmcnt(0)" ::: "memory");
            const unsigned og = xb_add(&bar[XB_TOP], 1u);
            const unsigned tg = og / nx;
            if (og + 1u == (tg + 1u) * nx) xb_add(&bar[XB_TOPGEN], 1u);
            else XB_SPIN(xb_ld(&bar[XB_TOPGEN]) == tg, bar);
            __builtin_amdgcn_fence(__ATOMIC_ACQUIRE, "agent");
            xb_add(&bar[XB_XGEN(b.x)], 1u);
            asm volatile("s_waitcnt vmcnt(0)" ::: "memory");
        } else {
            XB_SPIN(xb_ld(&bar[XB_XGEN(b.x)]) == gen, bar);
            __builtin_amdgcn_fence(__ATOMIC_ACQUIRE, "agent");
            asm volatile("s_waitcnt vmcnt(0)" ::: "memory");
        }
    }
    __syncthreads();
}

struct Args { const float* in[24]; float* out; unsigned char* ws; int ph_lo, ph_hi, single, pad; };
typedef const float* cfp_t;
typedef const __attribute__((address_space(4))) cfp_t* kin_t;
struct Frame {
    LAS unsigned char* lds;
    int tid, lane, wave, bid, G;
    kin_t in;
    float* out; unsigned char* ws;
};
enum { I_XP = 0, I_XS, I_CK, I_CV, I_SH, I_SP, I_SC, I_WIN, I_WOUT, I_LBL, I_HNG, I_DLAM, I_DNG, I_RB, I_PW, I_PSC, I_WUP, I_CW, I_CB, I_WDN, I_L1G, I_L1B, I_L2G, I_L2B };

__device__ __forceinline__ void p0_transpose_item(const float* W, int K, int N, bf16_t* WT, int dst_row0, LAS float* scr, int k0, int n0, int lane, const float* gk, const float* bk, float* uo, float* co) {
#pragma unroll 8
    for (int i = 0; i < 32; ++i) { const int kk = 2 * i + (lane >> 5); scr[kk * 33 + (lane & 31)] = W[(size_t)(k0 + kk) * N + n0 + (lane & 31)]; }
    asm volatile("s_waitcnt lgkmcnt(0)" ::: "memory");
    const int c = lane & 7;
    float gv[8], bv[8];
#pragma unroll
    for (int e = 0; e < 8; ++e) { gv[e] = 1.f; bv[e] = 0.f; }
    if (gk) {
#pragma unroll
        for (int e = 0; e < 8; ++e) { gv[e] = gk[k0 + 8 * c + e]; bv[e] = bk[k0 + 8 * c + e]; } }
#pragma unroll
    for (int j = 0; j < 4; ++j) { const int n = (lane >> 3) + 8 * j; const LAS float* sp = scr + (8 * c) * 33 + n;
        float wv[8]; float cs = 0.f;
#pragma unroll
        for (int e = 0; e < 8; ++e) { const float w = sp[e * 33]; wv[e] = w * gv[e]; cs += w * bv[e]; }
        const u32x4 o = pk8(wv);
        *(u32x4*)(WT + (size_t)(dst_row0 + n) * K + k0 + 8 * c) = o;
        if (gk) { float rv[8]; unpk8(o, rv); float us = 0.f;
#pragma unroll
            for (int e = 0; e < 8; ++e) us += rv[e];
            us += __shfl_xor(us, 1); us += __shfl_xor(us, 2); us += __shfl_xor(us, 4); cs += __shfl_xor(cs, 1); cs += __shfl_xor(cs, 2); cs += __shfl_xor(cs, 4);
            if (c == 0) { atomicAdd(uo + dst_row0 + n, us); atomicAdd(co + dst_row0 + n, cs); } } }
    asm volatile("s_waitcnt lgkmcnt(0)" ::: "memory");
}
__device__ __forceinline__ void phase_prologue(Frame& F) {
    LAS float* scr = (LAS float*)(F.lds + F.wave * 16384);
    const int gw = F.bid * NWAVES + F.wave, NGW = F.G * NWAVES;
    constexpr int I_IN = (D / 64) * (INC / 32), I_OUT = (D / 64) * (D / 32), I_POOL = 4 * 8, I_UP = (D / 64) * (UPN / 32), I_DN = (DFF / 64) * (D / 32);
    constexpr int NITEMS = 2 * I_IN + 2 * I_OUT + 8 * I_POOL + 4 * I_UP + 4 * I_DN;
    for (int it = gw; it < NITEMS; it += NGW) {
        int r = it;
        if (r < 2 * I_IN) { const int m = r / I_IN; r %= I_IN; const int kb = r / (INC / 32), nb = r % (INC / 32);
            float* ctlf = (float*)(F.ws + WS_CTL);
            p0_transpose_item(F.in[I_WIN] + (size_t)m * D * INC, D, INC, (bf16_t*)(F.ws + WS_WIN) + (size_t)m * INC * D, 32 * nb, scr, 64 * kb, 32 * nb, F.lane,
                              m == 1 ? F.in[I_L2G] + 1 * D : nullptr, F.in[I_L2B] + 1 * D, ctlf + UC_UIN, ctlf + UC_CIN); continue; } r -= 2 * I_IN;
        if (r < 2 * I_OUT) { const int m = r / I_OUT; r %= I_OUT; const int kb = r / (D / 32), nb = r % (D / 32);
            p0_transpose_item(F.in[I_WOUT] + (size_t)m * D * D, D, D, (bf16_t*)(F.ws + WS_WOUT) + (size_t)m * D * D, 32 * nb, scr, 64 * kb, 32 * nb, F.lane, nullptr, nullptr, nullptr, nullptr); continue; } r -= 2 * I_OUT;
        if (r < 8 * I_POOL) { const int pg = r / I_POOL; r %= I_POOL; const int kb = r / 8, nb = r % 8;
            p0_transpose_item(F.in[I_PW] + (size_t)pg * 256 * 256, 256, 256, (bf16_t*)(F.ws + WS_WPOOL) + (size_t)pg * 256 * 256, 32 * nb, scr, 64 * kb, 32 * nb, F.lane, nullptr, nullptr, nullptr, nullptr); continue; } r -= 8 * I_POOL;
        if (r < 4 * I_UP) { const int l = r / I_UP; r %= I_UP; const int kb = r / (UPN / 32), nb = r % (UPN / 32); const int n0 = 32 * nb;
            const int dst = (n0 < DFF) ? (256 * (n0 / 128) + (n0 % 128)) : (256 * ((n0 - DFF) / 128) + 128 + ((n0 - DFF) % 128));
            float* ctlf = (float*)(F.ws + WS_CTL);
            p0_transpose_item(F.in[I_WUP] + (size_t)l * D * UPN, D, UPN, (bf16_t*)(F.ws + WS_WUP) + (size_t)l * UPN * D, dst, scr, 64 * kb, n0, F.lane,
                              F.in[I_L1G] + (size_t)l * D, F.in[I_L1B] + (size_t)l * D, ctlf + UC_UUP + l * UPN, ctlf + UC_CUP + l * UPN); continue; } r -= 4 * I_UP;
        { const int l = r / I_DN; r %= I_DN; const int kb = r / (D / 32), nb = r % (D / 32);
            p0_transpose_item(F.in[I_WDN] + (size_t)l * DFF * D, DFF, D, (bf16_t*)(F.ws + WS_WDN) + (size_t)l * D * DFF, 32 * nb, scr, 64 * kb, 32 * nb, F.lane, nullptr, nullptr, nullptr, nullptr); }
    }
    bf16_t* XB = (bf16_t*)(F.ws + WS_XB);
    for (int m0 = gw; m0 < MT; m0 += 4 * NGW) {
        f32x4 v[4][4];
#pragma unroll
        for (int q = 0; q < 4; ++q) { const int m = m0 + q * NGW;
            if (m < MT) { const float* src = (m < MP) ? F.in[I_XP] + (size_t)m * D : F.in[I_XS] + (size_t)(m - MP) * D;
#pragma unroll
                for (int j = 0; j < 4; ++j) v[q][j] = *(const f32x4*)(src + 4 * F.lane + 256 * j); } }
#pragma unroll
        for (int q = 0; q < 4; ++q) { const int m = m0 + q * NGW;
            if (m < MT) {
#pragma unroll
                for (int j = 0; j < 4; ++j) { u32x2 w; w.x = pk2(v[q][j][0], v[q][j][1]); w.y = pk2(v[q][j][2], v[q][j][3]); *(u32x2*)(XB + (size_t)m * D + 4 * F.lane + 256 * j) = w; } } }
    }
    if (F.bid == 0) {
        float* tab = (float*)(F.ws + WS_TAB);
        { const int c = F.tid; const float a = F.in[I_LBL][c], b = F.in[I_LBL][512 + c], mx = fmaxf(a, b), ea = __expf(a - mx), eb = __expf(b - mx);
          tab[TB_LB + c] = 0.f; tab[TB_LB + 512 + c] = eb / (ea + eb); }
        if (F.wave < 2) { const int m = F.wave; const float* lp = F.in[I_DLAM] + (size_t)m * 4 * 64;
            const float s01 = wave_sum(lp[F.lane] * lp[64 + F.lane]), s23 = wave_sum(lp[128 + F.lane] * lp[192 + F.lane]);
            const float lam_init = (m == 0) ? 0.2f : 0.47071302f;
            if (F.lane == 0) tab[TB_LAM + m] = __expf(s01) - __expf(s23) + lam_init; }
    }
}

__device__ __forceinline__ void phase_ln_final(Frame& F, const bf16_t* Z, const float* g, const float* b) {
    const int gw = F.bid * NWAVES + F.wave, NGW = F.G * NWAVES;
    f32x4 gv[4], bv[4];
#pragma unroll
    for (int j = 0; j < 4; ++j) { const int c = 8 * F.lane + 512 * (j >> 1) + 4 * (j & 1); gv[j] = *(const f32x4*)(g + c); bv[j] = *(const f32x4*)(b + c); }
    for (int m = gw; m < MT; m += NGW) {
        f32x4 v[4]; float s = 0.f;
#pragma unroll
        for (int j2 = 0; j2 < 2; ++j2) { const u32x4 w = *(const u32x4*)(Z + (size_t)m * D + 8 * F.lane + 512 * j2);
            v[2 * j2] = (f32x4){bflo(w.x), bfhi(w.x), bflo(w.y), bfhi(w.y)}; v[2 * j2 + 1] = (f32x4){bflo(w.z), bfhi(w.z), bflo(w.w), bfhi(w.w)}; }
#pragma unroll
        for (int j = 0; j < 4; ++j) s += (v[j][0] + v[j][1]) + (v[j][2] + v[j][3]);
        const float mean = wave_sum(s) * (1.f / D); float s2 = 0.f;
#pragma unroll
        for (int j = 0; j < 4; ++j) { v[j] = v[j] - mean; s2 += (v[j][0] * v[j][0] + v[j][1] * v[j][1]) + (v[j][2] * v[j][2] + v[j][3] * v[j][3]); }
        const float rstd = 1.f / sqrtf(wave_sum(s2) * (1.f / D) + LN_EPS);
        float* outp = (m < MP) ? F.out + O_YP + (size_t)m * D : F.out + O_YS + (size_t)(m - MP) * D;
#pragma unroll
        for (int j2 = 0; j2 < 2; ++j2) { const f32x4 y0 = v[2 * j2] * rstd * gv[2 * j2] + bv[2 * j2], y1 = v[2 * j2 + 1] * rstd * gv[2 * j2 + 1] + bv[2 * j2 + 1];
            *(f32x4*)(outp + 8 * F.lane + 512 * j2) = y0; *(f32x4*)(outp + 8 * F.lane + 512 * j2 + 4) = y1; }
    }
}

template <int J>
__device__ __forceinline__ void pool_item(Frame& F, const LnRef& R, int p, int rb, int c) {
    constexpr int W = 2 << J;
    bf16_t* PO = (bf16_t*)(F.ws + WS_MIX);
    const f32x4 g0 = *(const f32x4*)(R.g + c), g1 = *(const f32x4*)(R.g + c + 4), b0 = *(const f32x4*)(R.b + c), b1 = *(const f32x4*)(R.b + c + 4);
    const int m0 = rb * 16; const bool smp = m0 >= MP; const int b = smp ? (m0 - MP) / ST : m0 / PT, t0 = smp ? 0 : m0 % PT;
    f32x4 ring[W][2]; f32x4 s0 = {0.f, 0.f, 0.f, 0.f}, s1 = {0.f, 0.f, 0.f, 0.f};
#pragma unroll
    for (int i = 0; i < W; ++i) {
        const int tt = t0 - W + i; f32x4 v0 = {0.f, 0.f, 0.f, 0.f}, v1 = {0.f, 0.f, 0.f, 0.f};
        if (tt >= 0) { const size_t rr = (size_t)(m0 - W + i); const u32x4 q = *(const u32x4*)(R.Z + rr * D + c); float mu, rstd; ln_row(R.st, rr, 0, mu, rstd);
            v0 = ((f32x4){bflo(q.x), bfhi(q.x), bflo(q.y), bfhi(q.y)} - mu) * rstd * g0 + b0; v1 = ((f32x4){bflo(q.z), bfhi(q.z), bflo(q.w), bfhi(q.w)} - mu) * rstd * g1 + b1; }
        else if (smp && tt >= -15) { const float* hp = F.in[I_SP] + (((size_t)p * SB + b) * 15 + (15 + tt)) * D + c; v0 = *(const f32x4*)hp; v1 = *(const f32x4*)(hp + 4); }
        ring[i][0] = v0; ring[i][1] = v1; s0 += v0; s1 += v1; }
#pragma unroll
    for (int i = 0; i < 16; ++i) { const int t = t0 + i;
        const size_t rr = (size_t)(m0 + i); const u32x4 q = *(const u32x4*)(R.Z + rr * D + c); float mu, rstd; ln_row(R.st, rr, 0, mu, rstd);
        const f32x4 x0 = ((f32x4){bflo(q.x), bfhi(q.x), bflo(q.y), bfhi(q.y)} - mu) * rstd * g0 + b0, x1 = ((f32x4){bflo(q.z), bfhi(q.z), bflo(q.w), bfhi(q.w)} - mu) * rstd * g1 + b1;
        s0 += x0 - ring[i % W][0]; s1 += x1 - ring[i % W][1]; ring[i % W][0] = x0; ring[i % W][1] = x1;
        const float inv = 1.f / (float)(smp ? W : (t + 1 < W ? t + 1 : W));
        const f32x4 o0 = s0 * inv - x0, o1 = s1 * inv - x1;
        u32x4 w; w.x = pk2(o0[0], o0[1]); w.y = pk2(o0[2], o0[3]); w.z = pk2(o1[0], o1[1]); w.w = pk2(o1[2], o1[3]); *(u32x4*)(PO + (size_t)(m0 + i) * D + c) = w;
        if (!smp && t >= PT - 15) { float* op = F.out + O_PP + (((size_t)p * PB + b) * 15 + (t - (PT - 15))) * D + c; *(f32x4*)op = x0; *(f32x4*)(op + 4) = x1; }
        if (smp && t >= 1) { float* op = F.out + O_PS + (((size_t)p * SB + b) * 15 + (t - 1)) * D + c; *(f32x4*)op = x0; *(f32x4*)(op + 4) = x1; } }
}
__device__ __forceinline__ void phase_pool_prep(Frame& F, const LnRef& R, int p) {
    const int gwv = F.bid * NWAVES + F.wave, NGW = F.G * NWAVES;
    for (int wi = gwv; wi < (MT / 32) * 4; wi += NGW) { const int j = wi & 3, rb = 2 * (wi >> 2) + (F.lane >> 5), c = 256 * j + 8 * (F.lane & 31);
        if (j == 0) pool_item<0>(F, R, p, rb, c); else if (j == 1) pool_item<1>(F, R, p, rb, c); else if (j == 2) pool_item<2>(F, R, p, rb, c); else pool_item<3>(F, R, p, rb, c); }
}

__device__ __forceinline__ void conv_fix_item(Frame& F, int l, int pm, int ch) {
    bf16_t* Gb = (bf16_t*)(F.ws + WS_G);
    const float* cw = F.in[I_CW] + (size_t)l * 3 * DFF; const float* cb = F.in[I_CB] + (size_t)l * DFF;
    const float* ahead = (const float*)(F.ws + WS_AHEAD); const float* bhead = (const float*)(F.ws + WS_BHEAD); const float* atail = (const float*)(F.ws + WS_ATAIL);
    float t0[8], t1[8], a0[8], a1[8], b0[8], b1[8], o[8];
#pragma unroll
    for (int h2 = 0; h2 < 2; ++h2) {
        const f32x4 x0 = *(const f32x4*)(atail + ((size_t)(pm - 1) * 2 + 0) * DFF + ch + 4 * h2), x1 = *(const f32x4*)(atail + ((size_t)(pm - 1) * 2 + 1) * DFF + ch + 4 * h2);
        const f32x4 y0 = *(const f32x4*)(ahead + ((size_t)pm * 2 + 0) * DFF + ch + 4 * h2), y1 = *(const f32x4*)(ahead + ((size_t)pm * 2 + 1) * DFF + ch + 4 * h2);
        const f32x4 z0 = *(const f32x4*)(bhead + ((size_t)pm * 2 + 0) * DFF + ch + 4 * h2), z1 = *(const f32x4*)(bhead + ((size_t)pm * 2 + 1) * DFF + ch + 4 * h2);
#pragma unroll
        for (int e = 0; e < 4; ++e) { t0[4 * h2 + e] = x0[e]; t1[4 * h2 + e] = x1[e]; a0[4 * h2 + e] = y0[e]; a1[4 * h2 + e] = y1[e]; b0[4 * h2 + e] = z0[e]; b1[4 * h2 + e] = z1[e]; } }
#pragma unroll
    for (int e = 0; e < 8; ++e) { const float c = cb[ch + e] + t0[e] * cw[ch + e] + t1[e] * cw[DFF + ch + e] + a0[e] * cw[2 * DFF + ch + e]; o[e] = silu_mul(c, b0[e]); }
    *(u32x4*)(Gb + (size_t)(pm * 256) * DFF + ch) = pk8(o);
#pragma unroll
    for (int e = 0; e < 8; ++e) { const float c = cb[ch + e] + t1[e] * cw[ch + e] + a0[e] * cw[DFF + ch + e] + a1[e] * cw[2 * DFF + ch + e]; o[e] = silu_mul(c, b1[e]); }
    *(u32x4*)(Gb + (size_t)(pm * 256 + 1) * DFF + ch) = pk8(o);
}
__device__ __forceinline__ void conv_fix_local(Frame& F, int l, const pg8::StaticOrder& S) {
    pg8::Unit u;
    for (int i = 0; S.next(i, u); ++i)
        if (u.pm < MP / 256 && (u.pm & 7) != 0)
            for (int it = F.tid; it < DFF / 8; it += NTHREADS) conv_fix_item(F, l, u.pm, 8 * it);
    asm volatile("s_waitcnt vmcnt(0)" ::: "memory");
    __syncthreads();
}

constexpr int HG_LF = 0;
constexpr int HG_TOT = HG_LF + 16384;
constexpr int HG_G = HG_TOT + 2048;
constexpr int HG_QT = HG_G + 512;
constexpr int HG_KS = HG_QT + 32 * 272;
constexpr int HG_V = HG_KS + 32 * 320;
constexpr int HG_PF = HG_V + 32 * 320;
constexpr int HG_OX = HG_PF + 2048;
constexpr int HG_OXP = 132;
constexpr int HG_END = HG_OX + 2 * 32 * HG_OXP * 4;
static_assert(HG_END <= LDS_TAB, "HGRN LDS");

template <bool SMP>
__device__ __forceinline__ void hgrn_unit(Frame& F, int m, int b, int h) {
    LAS unsigned char* L = F.lds;
    const bf16_t* H = (const bf16_t*)(F.ws + WS_H); const float* LFg = (const float*)(F.ws + WS_LF); bf16_t* MIX = (bf16_t*)(F.ws + WS_MIX);
    const float* gn = F.in[I_HNG] + (size_t)m * 512 + h * 128;
    const int tid = opq(F.tid), lane = tid & 63, wave = __builtin_amdgcn_readfirstlane(tid >> 6), r = lane & 31, hh = lane >> 5;
    const int nb = wave & 3, kh = wave >> 2;
    const size_t row0 = SMP ? (size_t)MP + (size_t)b * ST : (size_t)b * PT;
    const int nsteps = SMP ? 1 : PT / 32;
    f32x16 S[2];
    if (SMP) { const float* s0 = F.in[I_SH] + (((size_t)m * SB + b) * NH + h) * 128 * 128 + (size_t)(64 * kh + 4 * hh) * 128 + 32 * nb + r;
#pragma unroll
        for (int kbl = 0; kbl < 2; ++kbl)
#pragma unroll
            for (int i = 0; i < 16; ++i) S[kbl][i] = s0[(32 * kbl + (i & 3) + 8 * (i >> 2)) * 128];
    } else {
#pragma unroll
        for (int kbl = 0; kbl < 2; ++kbl)
#pragma unroll
            for (int i = 0; i < 16; ++i) S[kbl][i] = 0.f;
    }
    const int et = tid >> 4, ek = (tid & 15) * 8;
    const bool valid = !SMP || et < ST;
    f32x4 lf0 = {0.f, 0.f, 0.f, 0.f}, lf1 = {0.f, 0.f, 0.f, 0.f}; u32x4 qw = {0u, 0u, 0u, 0u}, vw = {0u, 0u, 0u, 0u}, gw = {0u, 0u, 0u, 0u};
    if (valid) { const size_t row = row0 + et;
        lf0 = *(const f32x4*)(LFg + row * 512 + h * 128 + ek); lf1 = *(const f32x4*)(LFg + row * 512 + h * 128 + ek + 4);
        qw = *(const u32x4*)(H + row * INC + C_AQ + h * 128 + ek); vw = *(const u32x4*)(H + row * INC + C_AI + h * 128 + ek); gw = *(const u32x4*)(H + row * INC + C_AG + h * 128 + ek); }
    for (int step = 0; step < nsteps; ++step) {
        const size_t row = row0 + (size_t)step * 32 + et;
        *(LAS f32x4*)(L + HG_LF + (et * 128 + ek) * 4) = lf0; *(LAS f32x4*)(L + HG_LF + (et * 128 + ek + 4) * 4) = lf1;
        f32x4 nlf0 = lf0, nlf1 = lf1; u32x4 nqw = qw, nvw = vw, ngw = gw;
        if (!SMP && step + 1 < nsteps) { const size_t rn = row + 32;
            nlf0 = *(const f32x4*)(LFg + rn * 512 + h * 128 + ek); nlf1 = *(const f32x4*)(LFg + rn * 512 + h * 128 + ek + 4);
            nqw = *(const u32x4*)(H + rn * INC + C_AQ + h * 128 + ek); nvw = *(const u32x4*)(H + rn * INC + C_AI + h * 128 + ek); ngw = *(const u32x4*)(H + rn * INC + C_AG + h * 128 + ek); }
        __syncthreads();
        { const int k = tid & 127, tq = tid >> 7; LAS float* p = (LAS float*)(L + HG_LF) + (8 * tq) * 128 + k; float vs[8];
#pragma unroll
            for (int i = 0; i < 8; ++i) vs[i] = p[i * 128];
#pragma unroll
            for (int i = 1; i < 8; ++i) vs[i] += vs[i - 1];
#pragma unroll
            for (int i = 0; i < 8; ++i) p[i * 128] = vs[i];
            ((LAS float*)(L + HG_TOT))[tq * 128 + k] = vs[7]; }
        __syncthreads();
        { float bcum[8];
            { const f32x4 c0 = *(LAS f32x4*)(L + HG_LF + (et * 128 + ek) * 4), c1 = *(LAS f32x4*)(L + HG_LF + (et * 128 + ek + 4) * 4);
#pragma unroll
              for (int e = 0; e < 4; ++e) { bcum[e] = c0[e]; bcum[4 + e] = c1[e]; } }
            for (int gq = 0; gq < (et >> 3); ++gq) { const f32x4 c0 = *(LAS f32x4*)(L + HG_TOT + (gq * 128 + ek) * 4), c1 = *(LAS f32x4*)(L + HG_TOT + (gq * 128 + ek + 4) * 4);
#pragma unroll
                for (int e = 0; e < 4; ++e) { bcum[e] += c0[e]; bcum[4 + e] += c1[e]; } }
            float qv[8]; unpk8(qw, qv);
            float qt[8], kt[8];
#pragma unroll
            for (int e = 0; e < 8; ++e) { const float lfe = e < 4 ? lf0[e] : lf1[e - 4]; const float eb = __expf(bcum[e]);
                qt[e] = qv[e] * eb; kt[e] = (1.f - __expf(lfe)) * __expf(-bcum[e]);
                if (et == 31) ((LAS float*)(L + HG_G))[ek + e] = eb; }
            const u32x4 qp = pk8(qt), kp = pk8(kt);
            *(LAS u32x4*)(L + HG_QT + et * 272 + ek * 2) = qp;
            *(LAS u32x4*)(L + HG_KS + et * 320 + ek * 2) = kp;
            *(LAS u32x4*)(L + HG_V + et * 320 + ek * 2) = vw;
        }
        __syncthreads();
        if (wave == 0) {
            f32x16 pt;
#pragma unroll
            for (int i = 0; i < 16; ++i) pt[i] = 0.f;
#pragma unroll
            for (int st = 0; st < 8; ++st) { const bf16x8 a = *(const LAS bf16x8*)(L + HG_KS + r * 320 + (16 * st + 8 * hh) * 2), bq = *(const LAS bf16x8*)(L + HG_QT + r * 272 + (16 * st + 8 * hh) * 2);
                pt = MFMA32(a, bq, pt); }
#pragma unroll
            for (int i = 0; i < 16; ++i) if (crow(i, hh) > r) pt[i] = 0.f;
            *(LAS bf16x8*)(L + HG_PF + lane * 16) = pack_step(pt, 0); *(LAS bf16x8*)(L + HG_PF + 1024 + lane * 16) = pack_step(pt, 1);
        }
        f32x16 oacc;
#pragma unroll
        for (int i = 0; i < 16; ++i) oacc[i] = 0.f;
#pragma unroll
        for (int kbl = 0; kbl < 2; ++kbl)
#pragma unroll
            for (int s2 = 0; s2 < 2; ++s2) { const int k0 = 64 * kh + 32 * kbl + 16 * s2 + 4 * hh;
                const s16x4 lo = *(const LAS s16x4*)(L + HG_QT + r * 272 + k0 * 2), hi = *(const LAS s16x4*)(L + HG_QT + r * 272 + (k0 + 8) * 2);
                oacc = MFMA32(pack_step(S[kbl], s2), cat8(lo, hi), oacc); }
        __syncthreads();
        const int i16 = lane & 15, tq = i16 >> 2, tp = i16 & 3, gi = (lane >> 4) & 1;
        if (kh == 0) {
#pragma unroll
            for (int s2 = 0; s2 < 2; ++s2) { const int key0 = 16 * s2 + 4 * hh;
                const s16x4 lo = vtr(L + HG_V + (key0 + tq) * 320 + (32 * nb + 16 * gi + 4 * tp) * 2), hi = vtr(L + HG_V + (key0 + 8 + tq) * 320 + (32 * nb + 16 * gi + 4 * tp) * 2);
                const bf16x8 pf = *(const LAS bf16x8*)(L + HG_PF + s2 * 1024 + lane * 16);
                oacc = MFMA32(cat8(lo, hi), pf, oacc); }
        }
#pragma unroll
        for (int i4 = 0; i4 < 4; ++i4) { const f32x4 o4 = {oacc[4 * i4], oacc[4 * i4 + 1], oacc[4 * i4 + 2], oacc[4 * i4 + 3]};
            *(LAS f32x4*)(L + HG_OX + ((kh * 32 + r) * HG_OXP + 32 * nb + 8 * i4 + 4 * hh) * 4) = o4; }
#pragma unroll
        for (int kbl = 0; kbl < 2; ++kbl)
#pragma unroll
            for (int s2 = 0; s2 < 2; ++s2) { const int key0 = 16 * s2 + 8 * hh;
                const s16x4 alo = vtr(L + HG_KS + (key0 + tq) * 320 + (64 * kh + 32 * kbl + 16 * gi + 4 * tp) * 2), ahi = vtr(L + HG_KS + (key0 + 4 + tq) * 320 + (64 * kh + 32 * kbl + 16 * gi + 4 * tp) * 2);
                const s16x4 lo = vtr(L + HG_V + (key0 + tq) * 320 + (32 * nb + 16 * gi + 4 * tp) * 2), hi = vtr(L + HG_V + (key0 + 4 + tq) * 320 + (32 * nb + 16 * gi + 4 * tp) * 2);
                S[kbl] = MFMA32(cat8(alo, ahi), cat8(lo, hi), S[kbl]); }
#pragma unroll
        for (int kbl = 0; kbl < 2; ++kbl)
#pragma unroll
            for (int i = 0; i < 16; ++i) S[kbl][i] *= ((LAS float*)(L + HG_G))[64 * kh + 32 * kbl + crow(i, hh)];
        __syncthreads();
        { float o[8], ss = 0.f;
#pragma unroll
            for (int e4 = 0; e4 < 2; ++e4) { const f32x4 a4 = *(LAS f32x4*)(L + HG_OX + (et * HG_OXP + ek + 4 * e4) * 4), b4 = *(LAS f32x4*)(L + HG_OX + ((32 + et) * HG_OXP + ek + 4 * e4) * 4);
#pragma unroll
                for (int e = 0; e < 4; ++e) { o[4 * e4 + e] = a4[e] + b4[e]; ss += o[4 * e4 + e] * o[4 * e4 + e]; } }
            ss += __shfl_xor(ss, 1); ss += __shfl_xor(ss, 2); ss += __shfl_xor(ss, 4); ss += __shfl_xor(ss, 8);
            const float rstd = 1.f / sqrtf(ss * (1.f / 128.f) + RMS_EPS);
            float gv[8]; unpk8(gw, gv);
            const f32x4 g0 = *(const f32x4*)(gn + ek), g1 = *(const f32x4*)(gn + ek + 4);
#pragma unroll
            for (int e = 0; e < 8; ++e) { const float y = o[e] * rstd * (e < 4 ? g0[e] : g1[e - 4]); o[e] = y * (gv[e] / (1.f + __expf(-gv[e]))); }
            if (valid) *(u32x4*)(MIX + row * D + h * 128 + ek) = pk8(o);
        }
        lf0 = nlf0; lf1 = nlf1; qw = nqw; vw = nvw; gw = ngw;
    }
    { float* so = (SMP ? F.out + O_HS + (((size_t)m * SB + b) * NH + h) * 128 * 128 : F.out + O_HP + (((size_t)m * PB + b) * NH + h) * 128 * 128);
      const int l2 = opq(lane); float* sp = so + (size_t)(64 * kh + 4 * (l2 >> 5)) * 128 + 32 * nb + (l2 & 31);
#pragma unroll
      for (int kbl = 0; kbl < 2; ++kbl)
#pragma unroll
        for (int i = 0; i < 16; ++i) sp[(32 * kbl + (i & 3) + 8 * (i >> 2)) * 128] = S[kbl][i]; }
    __syncthreads();
}

constexpr int AT_KP = 272, AT_VP = 320;
constexpr int AT_KB = 64 * AT_KP, AT_VB = 64 * AT_VP;
constexpr int AT_TILE = AT_KB + AT_VB;
static_assert(4 * AT_TILE <= LDS_TAB && (8 * 66 * 64 + 64 * 64 + 8 * 64) * 4 <= LDS_TAB && 2 * AT_TILE + 8 * 2 * 32 * 144 <= LDS_TAB, "attention LDS");

__device__ __forceinline__ void attn_build_tab(Frame& F, int h) {
    if (F.tid < 256) { const int rel = F.tid - 128, n = rel < 0 ? -rel : rel;
        int bk = n;
        if (n >= 8) bk = 8 + (n >= 12) + (n >= 16) + (n >= 23) + (n >= 32) + (n >= 46) + (n >= 64) + (n >= 91);
        if (rel > 0) bk += 16;
        ((LAS float*)(F.lds + LDS_TAB))[F.tid] = F.in[I_RB][bk * NH + h] * LOG2E; }
}
struct AttnState { f32x16 o[4]; float m, l; };
template <bool MASK_END>
__device__ __forceinline__ void attn_tile(const LAS unsigned char* Kt, const LAS unsigned char* Vt, int vh, const bf16x8 (&qf)[4], AttnState& A, int kpos0, int qpos, int qpos_min, int kv_end,
                                          const LAS float* tab, int r, int hh, int lane) {
    f32x16 st[2];
#pragma unroll
    for (int kb = 0; kb < 2; ++kb) {
#pragma unroll
        for (int i = 0; i < 16; ++i) st[kb][i] = 0.f;
#pragma unroll
        for (int s = 0; s < 4; ++s) { const bf16x8 a = *(const LAS bf16x8*)(Kt + (32 * kb + r) * AT_KP + (vh * 64 + 16 * s + 8 * hh) * 2); st[kb] = MFMA32(a, qf[s], st[kb]); }
    }
    constexpr float C2 = 0.125f * LOG2E;
    const bool far = (kpos0 + 63) <= (qpos_min - 91);
    if (far) { const float bc = tab[0];
#pragma unroll
        for (int kb = 0; kb < 2; ++kb)
#pragma unroll
            for (int i = 0; i < 16; ++i) st[kb][i] = st[kb][i] * C2 + bc;
    } else {
#pragma unroll
        for (int kb = 0; kb < 2; ++kb)
#pragma unroll
            for (int i = 0; i < 16; ++i) { const int kpos = kpos0 + 32 * kb + crow(i, hh); int rel = kpos - qpos; rel = rel < -128 ? -128 : (rel > 127 ? 127 : rel);
                float x = st[kb][i] * C2 + tab[rel + 128];
                if (MASK_END) x = (kpos < kv_end) ? x : -1e30f;
                st[kb][i] = x; }
    }
    float mx = st[0][0];
#pragma unroll
    for (int kb = 0; kb < 2; ++kb)
#pragma unroll
        for (int i = 0; i < 16; ++i) mx = fmaxf(mx, st[kb][i]);
    mx = fmaxf(mx, __shfl_xor(mx, 32));
    if (__any(mx > A.m + 8.f)) {
        const float mnew = fmaxf(A.m, mx), alpha = __builtin_amdgcn_exp2f(A.m - mnew);
        A.m = mnew; A.l *= alpha;
#pragma unroll
        for (int mb = 0; mb < 4; ++mb)
#pragma unroll
            for (int i = 0; i < 16; ++i) A.o[mb][i] *= alpha;
    }
    const float mref = A.m;
    float ls = 0.f;
#pragma unroll
    for (int kb = 0; kb < 2; ++kb)
#pragma unroll
        for (int i = 0; i < 16; ++i) { const float p = __builtin_amdgcn_exp2f(st[kb][i] - mref); st[kb][i] = p; ls += p; }
    A.l += ls;
    const int i16 = lane & 15, tq = i16 >> 2, tp = i16 & 3, gi = (lane >> 4) & 1;
#pragma unroll
    for (int kb = 0; kb < 2; ++kb)
#pragma unroll
        for (int s2 = 0; s2 < 2; ++s2) { const bf16x8 pf = pack_step(st[kb], s2); const int key0 = 32 * kb + 16 * s2 + 4 * hh;
#pragma unroll
            for (int mb = 0; mb < 4; ++mb) {
                const s16x4 lo = vtr(Vt + (key0 + tq) * AT_VP + (32 * mb + 16 * gi + 4 * tp) * 2), hi = vtr(Vt + (key0 + 8 + tq) * AT_VP + (32 * mb + 16 * gi + 4 * tp) * 2);
                A.o[mb] = MFMA32(cat8(lo, hi), pf, A.o[mb]); } }
}
__device__ __forceinline__ void attn_store(const f32x16 (&o)[4], const float* gnorm, float post, bf16_t* dst_row  , int hh, bool active) {
    float ss = 0.f;
#pragma unroll
    for (int mb = 0; mb < 4; ++mb)
#pragma unroll
        for (int i = 0; i < 16; ++i) ss += o[mb][i] * o[mb][i];
    ss += __shfl_xor(ss, 32);
    const float rstd = post / sqrtf(ss * (1.f / 128.f) + RMS_EPS);
    if (active) {
#pragma unroll
        for (int mb = 0; mb < 4; ++mb)
#pragma unroll
            for (int g4 = 0; g4 < 4; ++g4) { const int dv = 32 * mb + 8 * g4 + 4 * hh; const f32x4 gv = *(const f32x4*)(gnorm + dv);
                u32x2 w; w.x = pk2(o[mb][4 * g4] * rstd * gv[0], o[mb][4 * g4 + 1] * rstd * gv[1]); w.y = pk2(o[mb][4 * g4 + 2] * rstd * gv[2], o[mb][4 * g4 + 3] * rstd * gv[3]);
                *(u32x2*)(dst_row + dv) = w; }
    }
}

__device__ __forceinline__ void attn_prompt_unit(Frame& F, int m, int b, int h, int qb) {
    LAS unsigned char* L = F.lds; const LAS float* tab = (const LAS float*)(L + LDS_TAB);
    const bf16_t* H = (const bf16_t*)(F.ws + WS_H); bf16_t* MIX = (bf16_t*)(F.ws + WS_MIX);
    const int tid = opq(F.tid), lane = tid & 63, wave = __builtin_amdgcn_readfirstlane(tid >> 6), r = lane & 31, hh = lane >> 5, vh = wave >> 2, wq = wave & 3;
    const size_t rowb = (size_t)b * PT;
    const int q0a = qb * 256 + wq * 32, q0b = q0a + 128, qca = q0a >> 6, qcb = q0b >> 6, nkt = 4 * qb + 4;
    attn_build_tab(F, h);
    LAS unsigned char* qs = L + 2 * AT_TILE + wave * (2 * 32 * 144) + r * 144 + 16 * hh;
#pragma unroll
    for (int s = 0; s < 4; ++s) { *(LAS bf16x8*)(qs + 32 * s) = *(const bf16x8*)(H + (rowb + q0a + r) * INC + C_BQ + h * 128 + vh * 64 + 16 * s + 8 * hh);
        *(LAS bf16x8*)(qs + 32 * 144 + 32 * s) = *(const bf16x8*)(H + (rowb + q0b + r) * INC + C_BQ + h * 128 + vh * 64 + 16 * s + 8 * hh); }
    AttnState A0, A1;
#pragma unroll
    for (int mb = 0; mb < 4; ++mb)
#pragma unroll
        for (int i = 0; i < 16; ++i) { A0.o[mb][i] = 0.f; A1.o[mb][i] = 0.f; }
    A0.m = -1e30f; A0.l = 0.f; A1.m = -1e30f; A1.l = 0.f;
    u32x4 kr[2], vr[2];
#define AT_LD(kt) do { _Pragma("unroll") for (int i_ = 0; i_ < 2; ++i_) { const int c_ = tid + 512 * i_, key_ = c_ >> 4, ch_ = c_ & 15; const bf16_t* src_ = H + (rowb + 64 * (kt) + key_) * INC + h * 128 + ch_ * 8; \
        kr[i_] = *(const u32x4*)(src_ + C_BK); vr[i_] = *(const u32x4*)(src_ + C_BV); } } while (0)
#define AT_ST(buf) do { _Pragma("unroll") for (int i_ = 0; i_ < 2; ++i_) { const int c_ = tid + 512 * i_, key_ = c_ >> 4, ch_ = c_ & 15; \
        *(LAS u32x4*)(L + (buf) * AT_TILE + key_ * AT_KP + ch_ * 16) = kr[i_]; *(LAS u32x4*)(L + (buf) * AT_TILE + AT_KB + key_ * AT_VP + ch_ * 16) = vr[i_]; } } while (0)
    AT_LD(0); AT_ST(0);
    AT_LD(1);
    __syncthreads();
    for (int kt = 0; kt < nkt; ++kt) {
        if (kt <= qca) { bf16x8 qf[4];
#pragma unroll
            for (int s = 0; s < 4; ++s) qf[s] = *(const LAS bf16x8*)(qs + 32 * s);
            attn_tile<false>(L + (kt & 1) * AT_TILE, L + (kt & 1) * AT_TILE + AT_KB, vh, qf, A0, 64 * kt, q0a + r, q0a, 0, tab, r, hh, lane); }
        if (kt <= qcb) { bf16x8 qf[4];
#pragma unroll
            for (int s = 0; s < 4; ++s) qf[s] = *(const LAS bf16x8*)(qs + 32 * 144 + 32 * s);
            attn_tile<false>(L + (kt & 1) * AT_TILE, L + (kt & 1) * AT_TILE + AT_KB, vh, qf, A1, 64 * kt, q0b + r, q0b, 0, tab, r, hh, lane); }
        if (kt + 1 < nkt) AT_ST((kt + 1) & 1);
        if (kt + 2 < nkt) AT_LD(kt + 2);
        __syncthreads();
    }
#undef AT_LD
#undef AT_ST
    { const float l0 = A0.l + __shfl_xor(A0.l, 32), i0 = 1.f / l0, l1 = A1.l + __shfl_xor(A1.l, 32), i1 = 1.f / l1;
#pragma unroll
        for (int mb = 0; mb < 4; ++mb)
#pragma unroll
            for (int i = 0; i < 16; ++i) { A0.o[mb][i] *= i0; A1.o[mb][i] *= i1; } }
    LAS float* X = (LAS float*)L;
    if (vh == 1) {
#pragma unroll
        for (int mb = 0; mb < 4; ++mb)
#pragma unroll
            for (int i = 0; i < 16; ++i) { X[(wq * 64 + mb * 16 + i) * 64 + lane] = A0.o[mb][i]; X[((4 + wq) * 64 + mb * 16 + i) * 64 + lane] = A1.o[mb][i]; }
    }
    __syncthreads();
    if (vh == 0) {
        const float lam = ((const float*)(F.ws + WS_TAB))[TB_LAM + m];
        const float lam_init = (m == 0) ? 0.2f : 0.47071302f;
#pragma unroll
        for (int mb = 0; mb < 4; ++mb)
#pragma unroll
            for (int i = 0; i < 16; ++i) A0.o[mb][i] -= lam * X[(wq * 64 + mb * 16 + i) * 64 + lane];
        attn_store(A0.o, F.in[I_DNG] + (size_t)m * 128, 1.f - lam_init, MIX + (rowb + q0a + r) * D + 512 + h * 128, hh, true);
#pragma unroll
        for (int mb = 0; mb < 4; ++mb)
#pragma unroll
            for (int i = 0; i < 16; ++i) A1.o[mb][i] -= lam * X[((4 + wq) * 64 + mb * 16 + i) * 64 + lane];
        attn_store(A1.o, F.in[I_DNG] + (size_t)m * 128, 1.f - lam_init, MIX + (rowb + q0b + r) * D + 512 + h * 128, hh, true);
    }
    __syncthreads();
}

__device__ __forceinline__ void attn_sample_unit(Frame& F, int m, int b, int h) {
    LAS unsigned char* L = F.lds; const LAS float* tab = (const LAS float*)(L + LDS_TAB);
    const bf16_t* H = (const bf16_t*)(F.ws + WS_H); bf16_t* MIX = (bf16_t*)(F.ws + WS_MIX);
    const float* ck = F.in[I_CK] + (((size_t)m * SB + b) * PAST) * 512 + h * 128; const float* cv = F.in[I_CV] + (((size_t)m * SB + b) * PAST) * 512 + h * 128;
    const int tid = opq(F.tid), lane = tid & 63, wave = __builtin_amdgcn_readfirstlane(tid >> 6), r = lane & 31, hh = lane >> 5, vh = wave >> 2, ks = wave & 3;
    const size_t rows = (size_t)MP + (size_t)b * ST;
    attn_build_tab(F, h);
    bf16x8 qf[4];
#pragma unroll
    for (int s = 0; s < 4; ++s) qf[s] = *(const bf16x8*)(H + (rows + (r & 15)) * INC + C_BQ + h * 128 + vh * 64 + 16 * s + 8 * hh);
    AttnState A;
#pragma unroll
    for (int mb = 0; mb < 4; ++mb)
#pragma unroll
        for (int i = 0; i < 16; ++i) A.o[mb][i] = 0.f;
    A.m = -1e30f; A.l = 0.f;
    constexpr int NT = PAST / 64 + 1;
    for (int it = 0; it < (NT + 3) / 4; ++it) {
#pragma unroll 1
        for (int j = 0; j < 4; ++j) { const int T = 4 * it + j;
#pragma unroll
            for (int i = 0; i < 2; ++i) { const int c = tid + 512 * i, key = c >> 4, ch = c & 15;
                u32x4 kw = {0u, 0u, 0u, 0u}, vw = {0u, 0u, 0u, 0u};
                if (T < PAST / 64) { const float* pk = ck + (size_t)(64 * T + key) * 512 + ch * 8; const float* pv = cv + (size_t)(64 * T + key) * 512 + ch * 8;
                    const f32x4 k0 = *(const f32x4*)pk, k1 = *(const f32x4*)(pk + 4), v0 = *(const f32x4*)pv, v1 = *(const f32x4*)(pv + 4);
                    kw.x = pk2(k0[0], k0[1]); kw.y = pk2(k0[2], k0[3]); kw.z = pk2(k1[0], k1[1]); kw.w = pk2(k1[2], k1[3]);
                    vw.x = pk2(v0[0], v0[1]); vw.y = pk2(v0[2], v0[3]); vw.z = pk2(v1[0], v1[1]); vw.w = pk2(v1[2], v1[3]); }
                else if (T == PAST / 64 && key < ST) { const bf16_t* src = H + (rows + key) * INC + h * 128 + ch * 8; kw = *(const u32x4*)(src + C_BK); vw = *(const u32x4*)(src + C_BV); }
                *(LAS u32x4*)(L + j * AT_TILE + key * AT_KP + ch * 16) = kw; *(LAS u32x4*)(L + j * AT_TILE + AT_KB + key * AT_VP + ch * 16) = vw; } }
        __syncthreads();
        { const int T = 4 * it + ks;
            if (T < NT - 1) attn_tile<false>(L + ks * AT_TILE, L + ks * AT_TILE + AT_KB, vh, qf, A, 64 * T, PAST + (r & 15), PAST, 0, tab, r, hh, lane);
            else if (T == NT - 1) attn_tile<true>(L + ks * AT_TILE, L + ks * AT_TILE + AT_KB, vh, qf, A, 64 * T, PAST + (r & 15), PAST, PAST + ST, tab, r, hh, lane); }
        __syncthreads();
    }
    const float lt = A.l + __shfl_xor(A.l, 32);
    LAS float* X = (LAS float*)L;
#pragma unroll
    for (int mb = 0; mb < 4; ++mb)
#pragma unroll
        for (int i = 0; i < 16; ++i) X[(wave * 66 + mb * 16 + i) * 64 + lane] = A.o[mb][i];
    X[(wave * 66 + 64) * 64 + lane] = A.m; X[(wave * 66 + 65) * 64 + lane] = lt;
    LAS float* Y = X + 8 * 66 * 64;
    LAS float* SS = Y + 64 * 64;
    __syncthreads();
    {
        const float lam = ((const float*)(F.ws + WS_TAB))[TB_LAM + m];
        float coef[8];
#pragma unroll
        for (int v2 = 0; v2 < 2; ++v2) {
            float M = -1e30f;
#pragma unroll
            for (int k = 0; k < 4; ++k) M = fmaxf(M, X[((v2 * 4 + k) * 66 + 64) * 64 + lane]);
            float Ls = 0.f;
#pragma unroll
            for (int k = 0; k < 4; ++k) { coef[v2 * 4 + k] = __builtin_amdgcn_exp2f(X[((v2 * 4 + k) * 66 + 64) * 64 + lane] - M); Ls += coef[v2 * 4 + k] * X[((v2 * 4 + k) * 66 + 65) * 64 + lane]; }
            const float sc = (v2 == 0 ? 1.f : -lam) / Ls;
#pragma unroll
            for (int k = 0; k < 4; ++k) coef[v2 * 4 + k] *= sc;
        }
        float ss = 0.f;
#pragma unroll
        for (int i8 = 0; i8 < 8; ++i8) { const int row = 8 * wave + i8; float y = 0.f;
#pragma unroll
            for (int p = 0; p < 8; ++p) y += coef[p] * X[(p * 66 + row) * 64 + lane];
            Y[row * 64 + lane] = y; ss += y * y; }
        SS[wave * 64 + lane] = ss;
    }
    __syncthreads();
    if (wave == 0) {
        float ss = 0.f;
#pragma unroll
        for (int w = 0; w < 8; ++w) ss += SS[w * 64 + lane];
        ss += __shfl_xor(ss, 32);
        const float lam_init = (m == 0) ? 0.2f : 0.47071302f;
        const float rstd = (1.f - lam_init) / sqrtf(ss * (1.f / 128.f) + RMS_EPS);
        const float* gnorm = F.in[I_DNG] + (size_t)m * 128;
        bf16_t* dst_row = MIX + (rows + (r & 15)) * D + 512 + h * 128;
        if (r < ST) {
#pragma unroll
            for (int mb = 0; mb < 4; ++mb)
#pragma unroll
                for (int g4 = 0; g4 < 4; ++g4) { const int dv = 32 * mb + 8 * g4 + 4 * hh; const f32x4 gv = *(const f32x4*)(gnorm + dv); const LAS float* yp = Y + (mb * 16 + 4 * g4) * 64 + lane;
                    u32x2 w; w.x = pk2(yp[0] * rstd * gv[0], yp[64] * rstd * gv[1]); w.y = pk2(yp[128] * rstd * gv[2], yp[192] * rstd * gv[3]);
                    *(u32x2*)(dst_row + dv) = w; }
        }
    }
    __syncthreads();
}

__device__ __forceinline__ void phase_mixer(Frame& F, int m, int qsel = 0) {
    const int G = F.G, bid = F.bid;
    if (PHM & 0x1000) for (int u = bid; u < PB * NH; u += G) hgrn_unit<false>(F, m, u >> 2, u & 3);
#if PROBE_HG
    for (int u = bid; u < PB * NH; u += G) hgrn_unit<false>(F, m, u >> 2, u & 3);
#endif
    if (PHM & 0x2000) for (int u = (G >= 256 ? (bid >= 128 ? bid - 128 : bid + G - 128) : bid); u < SB * NH; u += G) attn_sample_unit(F, m, u >> 2, u & 3);
#if PROBE_SA
    for (int u = (G >= 256 ? (bid >= 128 ? bid - 128 : bid + G - 128) : bid); u < SB * NH; u += G) attn_sample_unit(F, m, u >> 2, u & 3);
#endif
    if (PHM & 0x4000) {
        gu32* head = (gu32*)(F.ws + WS_CTL) + CW_QUEUE + 64 * m + 128 * qsel;
        volatile LAS int* slot = (volatile LAS int*)(F.lds + LDS_CTRL + 64);
        for (;;) {
            if (F.tid == 0) *slot = (int)__hip_atomic_fetch_add(head, 1u, __ATOMIC_RELAXED, __HIP_MEMORY_SCOPE_AGENT);
            __syncthreads();
            const int u = *slot;
            __syncthreads();
            if (u >= PB * NH * 8) break;
            const int qb = 7 - (u >> 7), bh = u & 127;
            attn_prompt_unit(F, m, bh >> 2, bh & 3, qb);
        }
    }
    if (PHM & 0x8000) for (int u = bid; u < SB * NH; u += G) hgrn_unit<true>(F, m, u >> 2, u & 3);
}

__global__ void __launch_bounds__(NTHREADS, 2) mega_fwd(Args args) {
    extern __shared__ __attribute__((aligned(16))) unsigned char lds_raw[];
    Frame F;
    F.lds = (LAS unsigned char*)lds_raw;
    F.tid = threadIdx.x; F.lane = F.tid & 63; F.wave = __builtin_amdgcn_readfirstlane(F.tid >> 6);
    const int wave_s = F.wave;
    F.bid = blockIdx.x; F.G = gridDim.x; F.in = (kin_t)__builtin_amdgcn_kernarg_segment_ptr(); F.out = (float*)F.in[24]; F.ws = (unsigned char*)F.in[25];
    if (F.tid < 128) ((LAS unsigned*)(F.lds + LDS_CTRL))[F.tid] = 0u;
    __syncthreads();
    unsigned* barw = (unsigned*)(F.ws + WS_CTL) + CW_BAR;
    XcdBarrier bar; bar.bar = barw; bar.x = 0; bar.st = nullptr;
    const bool single = args.single != 0;
    if (single) bar = xcd_barrier_post(barw, (volatile LAS unsigned*)(F.lds + LDS_CTRL + 32));
    const int lo = args.ph_lo, hi = args.ph_hi;
#define RUN(p) (lo <= (p) && (p) < hi)
#define SEAM() do { if (single) { XcdBarrier b2_ = bar; asm volatile("" : "+s"(b2_.bar)); xcd_barrier(b2_); } } while (0)
#define REFRESH() do { { int b_ = (int)blockIdx.x, g_ = (int)gridDim.x; asm volatile("" : "+s"(b_), "+s"(g_)); F.bid = b_; F.G = g_; } { kin_t kp_ = (kin_t)__builtin_amdgcn_kernarg_segment_ptr(); asm volatile("" : "+s"(kp_)); F.in = kp_; F.out = (float*)kp_[24]; F.ws = (unsigned char*)kp_[25]; } { int l_; asm volatile("v_mbcnt_lo_u32_b32 %0, -1, 0\n\tv_mbcnt_hi_u32_b32 %0, -1, %0" : "=v"(l_)); F.lane = l_; } F.wave = wave_s; F.tid = wave_s * 64 + F.lane; } while (0)
    int ph = 0;
    if ((PHM & 1) && RUN(ph)) { REFRESH(); phase_prologue(F); SEAM();
#if PROBE_PRO
        REFRESH(); phase_prologue(F); SEAM();
#endif
    } ++ph;
    for (int l = 0; l < 4; ++l) {
#define WSB(off) ((bf16_t*)(F.ws + (off)))
#define STATS(k) ((float*)(F.ws + WS_CTL) + CW_STATS + (size_t)(k) * MT * 2)
#define LN1REF(ll) LnRef{WSB(WS_Z), STATS(2 * (ll)), F.in[I_L1G] + (size_t)(ll) * D, F.in[I_L1B] + (size_t)(ll) * D, 0}
#define LN2REF(ll) LnRef{WSB(WS_ZB), STATS(2 * (ll) + 1), F.in[I_L2G] + (size_t)(ll) * D, F.in[I_L2B] + (size_t)(ll) * D, 0}
        if ((l & 1) == 0) {
            const int m = l >> 1;
            if ((PHM & 2) && RUN(ph)) {
                REFRESH();
                const float* ctlf = (const float*)(F.ws + WS_CTL);
                pg8::Gemm g{l == 0 ? WSB(WS_XB) : WSB(WS_ZB), (const bf16_t*)(F.ws + WS_WIN) + (size_t)m * INC * D, MP, INC, D, D, 0, l == 0 ? nullptr : STATS(2 * (l - 1) + 1)}; pg8::StaticOrder S; S.init(MP, INC, F.G, F.bid);
                EpiIn E{(bf16_t*)(F.ws + WS_H), (float*)(F.ws + WS_LF), (const float*)(F.ws + WS_TAB) + TB_LB + m * 512,
                        F.out + O_KP + (size_t)m * MP * 512, F.out + O_VP + (size_t)m * MP * 512, F.out + O_KS + (size_t)m * MS * 512, F.out + O_VS + (size_t)m * MS * 512,
                        STATS(l == 0 ? 0 : 2 * (l - 1) + 1), ctlf + (l == 0 ? UC_ZERO : UC_UIN), ctlf + (l == 0 ? UC_ZERO : UC_CIN), l == 0 ? 1 : 0};
                pg8::gemm_phase<EpiIn>(F.lds, g, S, E, F.tid);
                REFRESH(); sgemm_in_phase(F.lds, g.A + (size_t)MP * D, g.Bt, F.bid, F.G, F.tid, E);
                SEAM(); } ++ph;
            if ((PHM & 4) && RUN(ph)) { REFRESH(); phase_mixer(F, m); SEAM();
#if PROBE_MIXER
                REFRESH(); phase_mixer(F, m, 1); SEAM();
#endif
            } ++ph;
            if ((PHM & 8) && RUN(ph)) {
                REFRESH();
                pg8::Gemm g{(const bf16_t*)(F.ws + WS_MIX), (const bf16_t*)(F.ws + WS_WOUT) + (size_t)m * D * D, MP, D, D, D, 0, l == 0 ? nullptr : STATS(2 * (l - 1) + 1)}; pg8::StaticOrder S; S.init(MP, D, F.G, F.bid);
                LnRef P = LN2REF(l == 0 ? 0 : l - 1); if (l == 0) { P.Z = WSB(WS_XB); P.ident = 1; }
                EpiRes E{P, WSB(WS_Z), STATS(2 * l), nullptr};
                pg8::gemm_phase<EpiRes>(F.lds, g, S, E, F.tid);
                REFRESH(); sgemm_res_phase<128>(F.lds, g.A + (size_t)MP * D, D, 0, g.Bt, D, F.bid, F.G, F.tid, P, WSB(WS_Z), STATS(2 * l), nullptr);
                SEAM(); } ++ph;
        } else {
            const int p = l >> 1;
            if ((PHM & 16) && RUN(ph)) { REFRESH(); const LnRef R = LN2REF(l - 1); phase_pool_prep(F, R, p); SEAM(); } ++ph;
            ++ph;
            if ((PHM & 32) && RUN(ph)) {
                REFRESH();
                pg8::Gemm g{(const bf16_t*)(F.ws + WS_MIX), (const bf16_t*)(F.ws + WS_WPOOL) + (size_t)p * D * 256, MP, D, 256, D, 256, STATS(2 * (l - 1) + 1)}; pg8::StaticOrder S; S.init(MP, D, F.G, F.bid);
                EpiRes E{LN2REF(l - 1), WSB(WS_Z), STATS(2 * l), F.in[I_PSC] + (size_t)p * D};
                pg8::gemm_phase<EpiRes>(F.lds, g, S, E, F.tid);
                REFRESH(); { const LnRef P2 = LN2REF(l - 1); sgemm_res_phase<32>(F.lds, g.A + (size_t)MP * D, D, 256, g.Bt, 256, F.bid, F.G, F.tid, P2, WSB(WS_Z), STATS(2 * l), E.scale); }
                SEAM(); } ++ph;
        }
        ++ph;
        if ((PHM & 128) && RUN(ph)) {
            REFRESH();
            const float* ctlf = (const float*)(F.ws + WS_CTL);
            pg8::Gemm g{WSB(WS_Z), (const bf16_t*)(F.ws + WS_WUP) + (size_t)l * UPN * D, MT, UPN, D, D, 0, STATS(2 * l)}; pg8::StaticOrder S; S.init(MT, UPN, F.G, F.bid);
            EpiUpConv E{(bf16_t*)(F.ws + WS_G), F.in[I_CW] + (size_t)l * 3 * DFF, F.in[I_CB] + (size_t)l * DFF, F.in[I_SC] + (size_t)l * SB * 2 * DFF,
                        (float*)(F.ws + WS_AHEAD), (float*)(F.ws + WS_BHEAD), (float*)(F.ws + WS_ATAIL), F.out + O_CP + (size_t)l * PB * 2 * DFF, F.out + O_CS + (size_t)l * SB * 2 * DFF, (LAS float*)(F.lds + LDS_EX),
                        STATS(2 * l), ctlf + UC_UUP + (size_t)l * UPN, ctlf + UC_CUP + (size_t)l * UPN};
            pg8::gemm_phase<EpiUpConv>(F.lds, g, S, E, F.tid); SEAM();
#if PROBE_UP
            REFRESH(); pg8::gemm_phase<EpiUpConv>(F.lds, g, S, E, F.tid); SEAM();
#endif
            } ++ph;
        ++ph;
        if ((PHM & 512) && RUN(ph)) {
            REFRESH();
            pg8::Gemm g{(const bf16_t*)(F.ws + WS_G), (const bf16_t*)(F.ws + WS_WDN) + (size_t)l * D * DFF, MP, D, DFF, DFF, 0, STATS(2 * l)}; pg8::StaticOrder S; S.init(MP, D, F.G, F.bid);
            conv_fix_local(F, l, S); REFRESH();
            EpiRes E{LN1REF(l), WSB(WS_ZB), STATS(2 * l + 1), nullptr};
            pg8::gemm_phase<EpiRes>(F.lds, g, S, E, F.tid);
            REFRESH(); { const LnRef P1 = LN1REF(l); sgemm_res_phase<352>(F.lds, g.A + (size_t)MP * DFF, DFF, 0, g.Bt, DFF, F.bid, F.G, F.tid, P1, WSB(WS_ZB), STATS(2 * l + 1), nullptr); }
            SEAM(); } ++ph;
        if ((PHM & 1024) && RUN(ph) && l == 3) { REFRESH(); phase_ln_final(F, WSB(WS_ZB), F.in[I_L2G] + (size_t)3 * D, F.in[I_L2B] + (size_t)3 * D); } ++ph;
    }
#undef RUN
#undef SEAM
}
constexpr int N_PHASES = 1 + 4 * 8;

extern "C" void kernel_launch(void* const* d_in, const int* in_sizes, int n_in, void* d_out, int out_size, void* d_ws, size_t ws_size, hipStream_t stream) {
    static int grid = 0;
    if (grid == 0) {
        if (n_in != 24 || (size_t)out_size != O_END || ws_size < WS_END2) { fprintf(stderr, "kernel_launch: unexpected problem (n_in %d out %d ws %zu)\n", n_in, out_size, ws_size); grid = -1; return; }
        int dev = 0, cus = 0;
        if (hipGetDevice(&dev) != hipSuccess || hipDeviceGetAttribute(&cus, hipDeviceAttributeMultiprocessorCount, dev) != hipSuccess) { grid = -1; return; }
        if (hipFuncSetAttribute((const void*)mega_fwd, hipFuncAttributeMaxDynamicSharedMemorySize, LDS_BYTES) != hipSuccess) { fprintf(stderr, "kernel_launch: hipFuncSetAttribute failed\n"); grid = -1; return; }
        int per_cu = 0;
        if (hipOccupancyMaxActiveBlocksPerMultiprocessor(&per_cu, (const void*)mega_fwd, NTHREADS, LDS_BYTES) != hipSuccess || per_cu < 1) fprintf(stderr, "kernel_launch: occupancy query reports %d\n", per_cu);
        (void)hipGetLastError();
        grid = cus;
    }
    if (grid < 0) return;
    (void)hipMemsetAsync((char*)d_ws + WS_CTL, 0, CTL_ZERO_BYTES, stream);
    Args a{};
    for (int i = 0; i < 24; ++i) a.in[i] = (const float*)d_in[i];
    a.out = (float*)d_out; a.ws = (unsigned char*)d_ws; a.pad = 0;
#if MK_SINGLE
    a.ph_lo = 0; a.ph_hi = N_PHASES; a.single = 1;
    hipLaunchKernelGGL(mega_fwd, dim3(grid), dim3(NTHREADS), LDS_BYTES, stream, a);
#else
    for (int p = 0; p < N_PHASES; ++p) {
        const int k = (p - 1) % 8, l = (p - 1) / 8;
        if (p > 0 && (l & 1) == 1 && k == 1) continue;
        a.ph_lo = p; a.ph_hi = p + 1; a.single = 0;
        hipLaunchKernelGGL(mega_fwd, dim3(grid), dim3(NTHREADS), LDS_BYTES, stream, a);
    }
#endif
}
```

```cpp
#include <hip/hip_runtime.h>
#include <cstdio>
#include <cstdint>

#ifndef PHM
#define PHM 0xffff
#endif
#ifndef PROBE_MIXER
#define PROBE_MIXER 0
#endif
#ifndef EMU_BF16
#define EMU_BF16 0
#endif
#ifndef PROBE_LN
#define PROBE_LN 0
#endif
#ifndef PROBE_PRO
#define PROBE_PRO 0
#endif
#ifndef PROBE_HG
#define PROBE_HG 0
#endif
#ifndef PROBE_SA
#define PROBE_SA 0
#endif
#ifndef PROBE_UP
#define PROBE_UP 0
#endif
#ifndef MK_SINGLE
#define MK_SINGLE 1
#endif

#define LAS __attribute__((address_space(3)))
#define GAS __attribute__((address_space(1)))
typedef unsigned short bf16_t;
typedef short bf16x8 __attribute__((ext_vector_type(8)));
typedef short s16x4 __attribute__((ext_vector_type(4)));
typedef float f32x2 __attribute__((ext_vector_type(2)));
typedef float f32x4 __attribute__((ext_vector_type(4)));
typedef float f32x16 __attribute__((ext_vector_type(16)));
typedef unsigned u32x2 __attribute__((ext_vector_type(2)));
typedef unsigned u32x4 __attribute__((ext_vector_type(4)));
typedef __bf16 bf16x2_t __attribute__((ext_vector_type(2)));
typedef GAS unsigned gu32;

constexpr int D = 1024, PB = 32, PT = 2048, SB = 32, ST = 16, PAST = 4096;
constexpr int MP = PB * PT, MS = SB * ST, MT = MP + MS;
constexpr int INC = 3584, DFF = 2816, UPN = 2 * DFF, NH = 4;
constexpr int C_AQ = 0, C_AF = 512, C_AI = 1024, C_AG = 1536, C_BQ = 2048, C_BK = 2560, C_BV = 3072;
constexpr float DN_ALPHA = 1.681792830507429f;
constexpr float LN_EPS = 1e-5f, RMS_EPS = 1e-6f;
constexpr float LOG2E = 1.4426950408889634f;
constexpr int NWAVES = 8, NTHREADS = 512;

constexpr size_t O_YP = 0;
constexpr size_t O_YS = O_YP + (size_t)MP * D;
constexpr size_t O_KP = O_YS + (size_t)MS * D;
constexpr size_t O_VP = O_KP + (size_t)2 * MP * 512;
constexpr size_t O_HP = O_VP + (size_t)2 * MP * 512;
constexpr size_t O_PP = O_HP + (size_t)2 * PB * NH * 128 * 128;
constexpr size_t O_CP = O_PP + (size_t)2 * PB * 15 * D;
constexpr size_t O_KS = O_CP + (size_t)4 * PB * 2 * DFF;
constexpr size_t O_VS = O_KS + (size_t)2 * MS * 512;
constexpr size_t O_HS = O_VS + (size_t)2 * MS * 512;
constexpr size_t O_PS = O_HS + (size_t)2 * SB * NH * 128 * 128;
constexpr size_t O_CS = O_PS + (size_t)2 * SB * 15 * D;
constexpr size_t O_END = O_CS + (size_t)4 * SB * 2 * DFF;
static_assert(O_END == 214695936ull, "d_out size");

constexpr size_t WS_CTL = 0, CTL_ZERO_BYTES = 8u << 20;
constexpr size_t WS_WIN = CTL_ZERO_BYTES;
constexpr size_t WS_WOUT = WS_WIN + (size_t)2 * INC * D * 2;
constexpr size_t WS_WPOOL = WS_WOUT + (size_t)2 * D * D * 2;
constexpr size_t WS_WUP = WS_WPOOL + (size_t)2 * D * 256 * 2;
constexpr size_t WS_WDN = WS_WUP + (size_t)4 * UPN * D * 2;
constexpr size_t WS_TAB = WS_WDN + (size_t)4 * D * DFF * 2;
constexpr size_t WS_XB = WS_TAB + 65536;
constexpr size_t WS_Z = WS_XB + (size_t)MT * D * 2;
constexpr size_t WS_ZB = WS_Z + (size_t)MT * D * 2;
constexpr size_t WS_MIX = WS_Z + (size_t)MT * D * 4;
constexpr size_t WS_G = WS_MIX + (size_t)MT * D * 2;
constexpr size_t WS_A = WS_G + (size_t)MT * DFF * 2;
constexpr size_t WS_H = WS_A;
constexpr size_t WS_LF = WS_H + (size_t)MT * INC * 2;
constexpr size_t WS_AB = WS_A;
constexpr size_t WS_END = WS_A + (size_t)MT * UPN * 2;
static_assert(WS_LF + (size_t)MT * 512 * 4 <= WS_END, "H|LF inside region A");
constexpr size_t SIDE_BYTES = (size_t)(MT / 256) * 2 * DFF * 4;
constexpr size_t WS_AHEAD = WS_END, WS_BHEAD = WS_AHEAD + SIDE_BYTES, WS_ATAIL = WS_BHEAD + SIDE_BYTES, WS_END2 = WS_ATAIL + SIDE_BYTES;
static_assert(WS_END2 <= 2147483648ull, "workspace");
constexpr int CW_TMO = 0;
constexpr int CW_BAR = 4096;
constexpr int CW_QUEUE = 16384;
constexpr int CW_STATS = 262144;
constexpr int CW_UC = CW_STATS + 8 * MT * 2;
constexpr int UC_UUP = CW_UC, UC_CUP = UC_UUP + 4 * UPN, UC_UIN = UC_CUP + 4 * UPN, UC_CIN = UC_UIN + INC, UC_ZERO = UC_CIN + INC, UC_END = UC_ZERO + INC;
static_assert((size_t)UC_END * 4 <= CTL_ZERO_BYTES, "zeroed region");
constexpr int TB_LB = 0;
constexpr int TB_LAM = 1024;

constexpr int LDS_BYTES = 163840;
constexpr int LDS_CTRL = LDS_BYTES - 512;
constexpr int LDS_TAB = LDS_CTRL - 1024;
constexpr int LDS_STT = 131072 + 4096;
constexpr int LDS_CT = 131072 + 8192;
constexpr int LDS_EX = 131072;

__device__ __forceinline__ unsigned pk2(float lo, float hi) { f32x2 v = {lo, hi}; bf16x2_t b = __builtin_convertvector(v, bf16x2_t); return __builtin_bit_cast(unsigned, b); }
__device__ __forceinline__ float bflo(unsigned u) { return __builtin_bit_cast(float, u << 16); }
__device__ __forceinline__ float bfhi(unsigned u) { return __builtin_bit_cast(float, u & 0xffff0000u); }
__device__ __forceinline__ u32x4 pk8(const float* v) { u32x4 w; w.x = pk2(v[0], v[1]); w.y = pk2(v[2], v[3]); w.z = pk2(v[4], v[5]); w.w = pk2(v[6], v[7]); return w; }
__device__ __forceinline__ void unpk8(u32x4 w, float* v) { v[0] = bflo(w.x); v[1] = bfhi(w.x); v[2] = bflo(w.y); v[3] = bfhi(w.y); v[4] = bflo(w.z); v[5] = bfhi(w.z); v[6] = bflo(w.w); v[7] = bfhi(w.w); }
__device__ __forceinline__ float wave_sum(float v) {
#pragma unroll
    for (int o = 1; o < 64; o <<= 1) v += __shfl_xor(v, o);
    return v;
}
__device__ __forceinline__ int opq(int x) { asm volatile("" : "+v"(x)); return x; }
__device__ __forceinline__ int lane_id_v() { int l_; asm volatile("v_mbcnt_lo_u32_b32 %0, -1, 0\n\tv_mbcnt_hi_u32_b32 %0, -1, %0" : "=v"(l_)); return l_; }
__device__ __forceinline__ float silu_mul(float c, float b) { return c * __builtin_amdgcn_rcpf(1.f + __builtin_amdgcn_exp2f(-LOG2E * c)) * b; }
__device__ __forceinline__ int crow(int reg, int h) { return (reg & 3) + 8 * (reg >> 2) + 4 * h; }
__device__ __forceinline__ s16x4 vtr(const LAS unsigned char* p) { return __builtin_bit_cast(s16x4, __builtin_amdgcn_ds_read_tr16_b64_v4i16((LAS s16x4*)p)); }
__device__ __forceinline__ bf16x8 cat8(s16x4 lo, s16x4 hi) { return (bf16x8){lo[0], lo[1], lo[2], lo[3], hi[0], hi[1], hi[2], hi[3]}; }
#define MFMA32(a, b, c) __builtin_amdgcn_mfma_f32_32x32x16_bf16((a), (b), (c), 0, 0, 0)
__device__ __forceinline__ bf16x8 pack_step(const f32x16& x, int s) {
    u32x4 p; p.x = pk2(x[8 * s], x[8 * s + 1]); p.y = pk2(x[8 * s + 2], x[8 * s + 3]); p.z = pk2(x[8 * s + 4], x[8 * s + 5]); p.w = pk2(x[8 * s + 6], x[8 * s + 7]);
    return __builtin_bit_cast(bf16x8, p);
}

namespace pg8 {
constexpr int BM = 256, BK = 64, HALF = 128, HTB = HALF * BK * 2, STAGE_BYTES = 8 * HTB, NXCD = 8, WGM = 8;
__host__ __device__ __forceinline__ int lds_byte(int r, int c) { const int st = (r >> 4) * 2 + (c >> 5), rr = r & 15, cc = c & 31, ob = rr * 64 + cc * 2; return st * 1024 + (ob ^ (((ob >> 9) & 1) << 5)); }
__host__ __device__ __forceinline__ void stage_rc(int b, int& R, int& C) { const int st = b / 1024, sb = b % 1024, swz = sb ^ (((sb >> 9) & 1) << 5); R = (st >> 1) * 16 + swz / 64; C = (st & 1) * 32 + (swz % 64) / 2; }
__host__ __device__ __forceinline__ int perm32(int rho) { const int n = rho >> 4, i = rho & 15; return 8 * (i >> 2) + 4 * n + (i & 3); }
struct Unit { int pm, pn; };
struct Gemm { const bf16_t* A; const bf16_t* Bt; int M, N, K, lda, a_pn_step; const float* st; };
struct StaticOrder {
    int nM, nN, nwg, G, c;
    __device__ void init(int M, int N, int G_, int c_) { nM = M / BM; nN = N / BM; nwg = nM * nN; G = G_; c = c_; }
    __device__ bool next(int i, Unit& u) const {
        const long L = (long)i * G + c; if (L >= nwg) return false;
        int wgid = (int)L; { const int q = nwg / NXCD, r = nwg % NXCD, xcd = wgid % NXCD, off = wgid / NXCD; wgid = (xcd < r ? xcd * (q + 1) : r * (q + 1) + (xcd - r) * q) + off; }
        const int nig = WGM * nN, gid = wgid / nig, fm = gid * WGM, gsz = (nM - fm) < WGM ? (nM - fm) : WGM;
        u.pm = fm + ((wgid % nig) % gsz); u.pn = (wgid % nig) / gsz; return true;
    }
};
template <class Epi>
__device__ __forceinline__ void gemm_phase(LAS unsigned char* lds, const Gemm g, const StaticOrder& S, const Epi& E, int tid_in) {
    const int tid = tid_in, wid = __builtin_amdgcn_readfirstlane(tid >> 6), lane = tid & 63, wr = wid >> 2, wc = wid & 3, fr = lane & 15, fq = lane >> 4;
    const int K = g.K, nt = K / BK, lda = g.lda;
    unsigned voffA[2], voffB[2];
#define PG8_VOFF() do { const int t_ = wid * 64 + lane_id_v(); _Pragma("unroll") for (int i = 0; i < 2; ++i) { int R, C; stage_rc(t_ * 16 + i * 8192, R, C); const int Rb = (R & ~31) + perm32(R & 31); \
        voffA[i] = (unsigned)(R * lda + C) * 2u; voffB[i] = (unsigned)(Rb * K + C) * 2u; } } while (0)
    PG8_VOFF();
    const size_t kstep = (size_t)(BK * 2);
    const size_t hstepA = (size_t)HALF * lda * 2, hstepB = (size_t)HALF * K * 2;
    const size_t tstepA = 2 * hstepA, tstepB = 2 * hstepB;
    const size_t pnA = (size_t)g.a_pn_step * 2;
    const unsigned ldsw = (unsigned)wid * 1024u;
    const int aoff = lds_byte(wr * 64 + fr, fq * 8), boff = lds_byte(wc * 32 + fr, fq * 8);
#define PG8_SA(b, h) (((b) * 2 + (h)) * HTB)
#define PG8_SB(b, h) ((4 + (b) * 2 + (h)) * HTB)
#define PG8_STAGE(bufoff, gbase, voff) do { _Pragma("unroll") for (int _i = 0; _i < 2; ++_i) \
        __builtin_amdgcn_global_load_lds((const unsigned*)((const char*)(gbase) + (voff)[_i]), (LAS unsigned*)(lds + (bufoff) + ldsw + _i * 8192), 16, 0, 0); } while (0)
#define PG8_LDA(dst, b, h) do { _Pragma("unroll") for (int m = 0; m < 4; ++m) _Pragma("unroll") for (int k = 0; k < 2; ++k) dst[m][k] = *(const LAS bf16x8*)(lds + PG8_SA(b, h) + aoff + m * 2048 + k * 1024); } while (0)
#define PG8_LDB(dst, b, h) do { _Pragma("unroll") for (int n = 0; n < 2; ++n) _Pragma("unroll") for (int k = 0; k < 2; ++k) dst[n][k] = *(const LAS bf16x8*)(lds + PG8_SB(b, h) + boff + n * 2048 + k * 1024); } while (0)
#define PG8_MMA(ai, bj, At, Bt) do { __builtin_amdgcn_s_setprio(1); _Pragma("unroll") for (int m = 0; m < 4; ++m) _Pragma("unroll") for (int n = 0; n < 2; ++n) _Pragma("unroll") for (int k = 0; k < 2; ++k) \
        acc[ai][bj][m][n] = __builtin_amdgcn_mfma_f32_16x16x32_bf16(Bt[n][k], At[m][k], acc[ai][bj][m][n], 0, 0, 0); __builtin_amdgcn_s_setprio(0); } while (0)
#define PG8_WAIT_V(n) asm volatile("s_waitcnt vmcnt(" #n ")" ::: "memory")
#define PG8_WAIT_L(n) asm volatile("s_waitcnt lgkmcnt(" #n ")" ::: "memory")
#define PG8_BAR __builtin_amdgcn_s_barrier()
#define PG8_SCHED __builtin_amdgcn_sched_barrier(0)
    Unit cur, nxt; int ui = 0;
    if (!S.next(0, cur)) return;
#define PG8_STATS(pm_, par_) do { if (g.st) __builtin_amdgcn_global_load_lds((const unsigned*)(g.st + (size_t)(pm_) * 512 + 64 * wid + lane_id_v()), (LAS unsigned*)(lds + LDS_STT + (par_) * 2048 + wid * 256), 4, 0, 0); } while (0)
    PG8_STATS(cur.pm, 0); __builtin_amdgcn_sched_barrier(0); E.prefetch(cur, 0, wid, lds);
    f32x4 acc[2][2][4][2];
#pragma unroll
    for (int a = 0; a < 2; ++a)
#pragma unroll
        for (int b = 0; b < 2; ++b)
#pragma unroll
            for (int m = 0; m < 4; ++m)
#pragma unroll
                for (int n = 0; n < 2; ++n) acc[a][b][m][n] = (f32x4){0.f, 0.f, 0.f, 0.f};
    bf16x8 At[4][2], B0[2][2], B1[2][2];
    const char* cA = (const char*)g.A + (size_t)cur.pm * tstepA + (size_t)cur.pn * pnA; const char* cB = (const char*)g.Bt + (size_t)cur.pn * tstepB;
    PG8_STAGE(PG8_SB(0, 0), cB, voffB); PG8_STAGE(PG8_SB(0, 1), cB + hstepB, voffB); PG8_STAGE(PG8_SA(0, 0), cA, voffA); PG8_STAGE(PG8_SA(0, 1), cA + hstepA, voffA);
    if (wr == 1) PG8_BAR;
    PG8_WAIT_V(2); PG8_BAR;
    PG8_STAGE(PG8_SB(1, 0), cB + kstep, voffB); PG8_STAGE(PG8_SA(1, 0), cA + kstep, voffA); PG8_STAGE(PG8_SB(1, 1), cB + hstepB + kstep, voffB);
    PG8_WAIT_V(6); PG8_BAR;
    for (;;) {
        const bool has_next = S.next(ui + 1, nxt);
        const char* nA = has_next ? (const char*)g.A + (size_t)nxt.pm * tstepA + (size_t)nxt.pn * pnA : cA; const char* nB = has_next ? (const char*)g.Bt + (size_t)nxt.pn * tstepB : cB;
        for (int t = 0; t < nt; t += 2) {
            const bool last = (t == nt - 2);
            const char* a1 = cA + (size_t)(t + 1) * kstep;
            const char* a2 = last ? nA : cA + (size_t)(t + 2) * kstep; const char* b2 = last ? nB : cB + (size_t)(t + 2) * kstep;
            const char* a3 = a2 + kstep; const char* b3 = b2 + kstep;
            PG8_LDB(B0, 0, 0); PG8_LDB(B1, 0, 1); PG8_SCHED; PG8_LDA(At, 0, 0); PG8_STAGE(PG8_SA(1, 1), a1 + hstepA, voffA);
            PG8_WAIT_V(8); PG8_WAIT_L(0); PG8_BAR; PG8_MMA(0, 0, At, B0); PG8_MMA(0, 1, At, B1); PG8_BAR; PG8_SCHED;
            PG8_LDA(At, 0, 1); PG8_STAGE(PG8_SB(0, 0), b2, voffB); PG8_STAGE(PG8_SB(0, 1), b2 + hstepB, voffB); PG8_STAGE(PG8_SA(0, 0), a2, voffA);
            PG8_WAIT_V(8); PG8_WAIT_L(0); PG8_BAR; PG8_MMA(1, 0, At, B0); PG8_MMA(1, 1, At, B1); PG8_BAR; PG8_SCHED;
            PG8_LDB(B0, 1, 0); PG8_LDB(B1, 1, 1); PG8_SCHED; PG8_LDA(At, 1, 0); PG8_STAGE(PG8_SA(0, 1), a2 + hstepA, voffA);
            PG8_WAIT_V(8); PG8_WAIT_L(0); PG8_BAR; PG8_MMA(0, 0, At, B0); PG8_MMA(0, 1, At, B1); PG8_BAR; PG8_SCHED;
            PG8_LDA(At, 1, 1); PG8_STAGE(PG8_SB(1, 0), b3, voffB); PG8_STAGE(PG8_SB(1, 1), b3 + hstepB, voffB); PG8_STAGE(PG8_SA(1, 0), a3, voffA);
            PG8_WAIT_V(8); PG8_WAIT_L(0); PG8_BAR; PG8_MMA(1, 0, At, B0); PG8_MMA(1, 1, At, B1); PG8_BAR; PG8_SCHED;
        }
        if (wr == 0) PG8_BAR;
        { const int le = lane_id_v(); int wr_ = wr, wc_ = wc; asm volatile("" : "+s"(wr_), "+s"(wc_));
          E(acc, cur, wr_, wc_, le & 15, le >> 4, (const LAS float*)(lds + LDS_STT + (ui & 1) * 2048), (const LAS float*)(lds + LDS_CT + (ui & 1) * 4096)); }
        if (!has_next) break;
#pragma unroll
        for (int a = 0; a < 2; ++a)
#pragma unroll
            for (int b = 0; b < 2; ++b)
#pragma unroll
                for (int m = 0; m < 4; ++m)
#pragma unroll
                    for (int n = 0; n < 2; ++n) acc[a][b][m][n] = (f32x4){0.f, 0.f, 0.f, 0.f};
        cur = nxt; cA = nA; cB = nB; ++ui;
        PG8_VOFF();
        PG8_STATS(cur.pm, ui & 1); E.prefetch(cur, ui & 1, wid, lds);
        if (wr == 1) PG8_BAR;
    }
    PG8_WAIT_V(0);
    PG8_BAR;
#undef PG8_STATS
#undef PG8_VOFF
#undef PG8_SA
#undef PG8_SB
#undef PG8_STAGE
#undef PG8_LDA
#undef PG8_LDB
#undef PG8_MMA
#undef PG8_WAIT_V
#undef PG8_WAIT_L
#undef PG8_BAR
#undef PG8_SCHED
}
}

struct LnRef { const bf16_t* Z; const float* st; const float* g; const float* b; int ident; };
__device__ __forceinline__ void ln_row(const float* st, size_t row, int ident, float& mu, float& rstd) {
    mu = 0.f; rstd = 1.f;
    if (!ident) { const f32x2 s = *(const f32x2*)(st + row * 2); mu = s[0] * (1.f / D); rstd = 1.f / sqrtf(fmaxf(s[1] * (1.f / D) - mu * mu, 0.f) + LN_EPS); }
}
__device__ __forceinline__ void ln_row_lds(const LAS float* stt, int rl, int ident, float& mu, float& rstd) {
    mu = 0.f; rstd = 1.f;
    if (!ident) { const f32x2 s = *(const LAS f32x2*)(stt + 2 * rl); mu = s[0] * (1.f / D); rstd = __builtin_amdgcn_rsqf(fmaxf(s[1] * (1.f / D) - mu * mu, 0.f) + LN_EPS); }
}
struct EpiBf16 {
    __device__ __forceinline__ void prefetch(const pg8::Unit&, int, int, LAS unsigned char*) const {}
    bf16_t* O; int ldc;
    __device__ __forceinline__ void operator()(const f32x4 (&acc)[2][2][4][2], const pg8::Unit& u, int wr, int wc, int fr, int fq, const LAS float* stt, const LAS float* ct) const {
        const int row0 = u.pm * 256 + wr * 64 + fr, col0 = u.pn * 256 + wc * 32 + 8 * fq;
#pragma unroll
        for (int ai = 0; ai < 2; ++ai)
#pragma unroll
            for (int m = 0; m < 4; ++m) { bf16_t* rowp = O + (size_t)(row0 + ai * 128 + m * 16) * ldc + col0;
#pragma unroll
                for (int bj = 0; bj < 2; ++bj) { const f32x4 v0 = acc[ai][bj][m][0], v1 = acc[ai][bj][m][1];
                    u32x4 w; w.x = pk2(v0[0], v0[1]); w.y = pk2(v0[2], v0[3]); w.z = pk2(v1[0], v1[1]); w.w = pk2(v1[2], v1[3]);
                    *(u32x4*)(rowp + bj * 128) = w; } }
    }
};
struct EpiIn {
    __device__ __forceinline__ void prefetch(const pg8::Unit&, int, int, LAS unsigned char*) const {}
    bf16_t* H; float* LF; const float* lbv; float* kP; float* vP; float* kS; float* vS; const float* st; const float* uu; const float* cc; int ident;
    __device__ __forceinline__ void operator()(const f32x4 (&acc_in)[2][2][4][2], const pg8::Unit& u, int wr, int wc, int fr, int fq, const LAS float* stt, const LAS float* ct) const {
        f32x4 acc[2][2][4][2];
        { const int r0 = u.pm * 256 + wr * 64 + fr, c0 = u.pn * 256 + wc * 32 + 8 * fq;
#pragma unroll
          for (int bj = 0; bj < 2; ++bj) { const f32x4 u0 = *(const f32x4*)(uu + c0 + bj * 128), u1 = *(const f32x4*)(uu + c0 + bj * 128 + 4), k0 = *(const f32x4*)(cc + c0 + bj * 128), k1 = *(const f32x4*)(cc + c0 + bj * 128 + 4);
#pragma unroll
            for (int ai = 0; ai < 2; ++ai)
#pragma unroll
                for (int m = 0; m < 4; ++m) { float mu, rstd; ln_row_lds(stt, wr * 64 + fr + ai * 128 + m * 16, ident, mu, rstd);
                    const float nb = -mu * rstd; acc[ai][bj][m][0] = acc_in[ai][bj][m][0] * rstd + (u0 * nb + k0); acc[ai][bj][m][1] = acc_in[ai][bj][m][1] * rstd + (u1 * nb + k1); } } }
        const int row0 = u.pm * 256 + wr * 64 + fr, col0 = u.pn * 256 + wc * 32 + 8 * fq;
        const int kind = u.pn >> 1;
        if (kind == 1) {
#pragma unroll
            for (int bj = 0; bj < 2; ++bj) { const int c = col0 + bj * 128 - C_AF;
                const f32x4 l0 = *(const f32x4*)(lbv + c), l1 = *(const f32x4*)(lbv + c + 4);
#pragma unroll
                for (int ai = 0; ai < 2; ++ai)
#pragma unroll
                    for (int m = 0; m < 4; ++m) { const int row = row0 + ai * 128 + m * 16;
                        f32x4 o0, o1;
#pragma unroll
                        for (int e = 0; e < 4; ++e) {
                            { const float z = acc[ai][bj][m][0][e], ez = __builtin_amdgcn_exp2f(-LOG2E * fabsf(z)), sg = (z >= 0.f ? 1.f : ez) * __builtin_amdgcn_rcpf(1.f + ez), f = l0[e] + (1.f - l0[e]) * sg; o0[e] = fmaxf(__builtin_amdgcn_logf(f) * 0.6931471805599453f, -60.f); }
                            { const float z = acc[ai][bj][m][1][e], ez = __builtin_amdgcn_exp2f(-LOG2E * fabsf(z)), sg = (z >= 0.f ? 1.f : ez) * __builtin_amdgcn_rcpf(1.f + ez), f = l1[e] + (1.f - l1[e]) * sg; o1[e] = fmaxf(__builtin_amdgcn_logf(f) * 0.6931471805599453f, -60.f); }
                        }
                        float* dst = LF + (size_t)row * 512 + c; *(f32x4*)dst = o0; *(f32x4*)(dst + 4) = o1; } }
            return;
        }
#pragma unroll
        for (int ai = 0; ai < 2; ++ai)
#pragma unroll
            for (int m = 0; m < 4; ++m) { const int row = row0 + ai * 128 + m * 16; bf16_t* rowp = H + (size_t)row * INC + col0;
#pragma unroll
                for (int bj = 0; bj < 2; ++bj) { const f32x4 v0 = acc[ai][bj][m][0], v1 = acc[ai][bj][m][1];
                    u32x4 w; w.x = pk2(v0[0], v0[1]); w.y = pk2(v0[2], v0[3]); w.z = pk2(v1[0], v1[1]); w.w = pk2(v1[2], v1[3]);
                    *(u32x4*)(rowp + bj * 128) = w;
                    if (kind >= 5) { const int c = col0 + bj * 128 - (kind == 5 ? C_BK : C_BV);
                        float* dst = (row < MP) ? ((kind == 5 ? kP : vP) + (size_t)row * 512 + c) : ((kind == 5 ? kS : vS) + (size_t)(row - MP) * 512 + c);
                        *(f32x4*)dst = v0; *(f32x4*)(dst + 4) = v1; } } }
    }
};
struct EpiRes {
    __device__ __forceinline__ void prefetch(const pg8::Unit&, int, int, LAS unsigned char*) const {}
    LnRef P; bf16_t* Z; float* st_out; const float* scale;
    __device__ __forceinline__ void operator()(const f32x4 (&acc)[2][2][4][2], const pg8::Unit& u, int wr, int wc, int fr, int fq, const LAS float* stt, const LAS float* ct) const {
        const int row0 = u.pm * 256 + wr * 64 + fr, col0 = u.pn * 256 + wc * 32 + 8 * fq;
        const unsigned rb = (unsigned)(row0 * D + col0) * 2u;
        const char* zin = (const char*)P.Z; char* zout = (char*)Z;
        float s1[8], s2[8];
#pragma unroll
        for (int i = 0; i < 8; ++i) { s1[i] = 0.f; s2[i] = 0.f; }
#pragma unroll
        for (int bj = 0; bj < 2; ++bj) { const int c = col0 + bj * 128;
            u32x4 xr[2][4];
#pragma unroll
            for (int ai = 0; ai < 2; ++ai)
#pragma unroll
                for (int m = 0; m < 4; ++m) xr[ai][m] = *(const u32x4*)(zin + (rb + (unsigned)(((ai * 128 + m * 16) * D + bj * 128) * 2)));
            float sc[8], gg[8], bb[8];
#pragma unroll
            for (int e = 0; e < 8; ++e) { sc[e] = 1.f; gg[e] = 1.f; bb[e] = 0.f; }
            if (scale) { const f32x4 a0 = *(const f32x4*)(scale + c), a1 = *(const f32x4*)(scale + c + 4);
#pragma unroll
                for (int e = 0; e < 4; ++e) { sc[e] = a0[e]; sc[4 + e] = a1[e]; } }
            if (!P.ident) { const f32x4 a0 = *(const f32x4*)(P.g + c), a1 = *(const f32x4*)(P.g + c + 4), b0 = *(const f32x4*)(P.b + c), b1 = *(const f32x4*)(P.b + c + 4);
#pragma unroll
                for (int e = 0; e < 4; ++e) { gg[e] = a0[e]; gg[4 + e] = a1[e]; bb[e] = b0[e]; bb[4 + e] = b1[e]; } }
#pragma unroll
            for (int ai = 0; ai < 2; ++ai)
#pragma unroll
                for (int m = 0; m < 4; ++m) {
                    float mu, rstd; ln_row_lds(stt, wr * 64 + fr + ai * 128 + m * 16, P.ident, mu, rstd);
                    const u32x4 xw = xr[ai][m]; float xv[8]; unpk8(xw, xv);
                    float o[8];
#pragma unroll
                    for (int e = 0; e < 8; ++e) { const float t = rstd * gg[e], x = fmaf(xv[e], t, fmaf(-mu, t, bb[e])); o[e] = fmaf(DN_ALPHA, x, (e < 4 ? acc[ai][bj][m][0][e] : acc[ai][bj][m][1][e - 4]) * sc[e]); }
                    const u32x4 w = pk8(o); *(u32x4*)(zout + (rb + (unsigned)(((ai * 128 + m * 16) * D + bj * 128) * 2))) = w;
                    float ov[8]; unpk8(w, ov);
#pragma unroll
                    for (int e = 0; e < 8; ++e) { s1[ai * 4 + m] += ov[e]; s2[ai * 4 + m] += ov[e] * ov[e]; } } }
#pragma unroll
        for (int i = 0; i < 8; ++i) { s1[i] += __shfl_xor(s1[i], 16); s1[i] += __shfl_xor(s1[i], 32); s2[i] += __shfl_xor(s2[i], 16); s2[i] += __shfl_xor(s2[i], 32); }
        if (fq == 0) { char* sp = (char*)st_out; const unsigned sb = (unsigned)row0 * 8u;
#pragma unroll
            for (int i = 0; i < 8; ++i) { float* p = (float*)(sp + (sb + (unsigned)(((i >> 2) * 128 + (i & 3) * 16) * 8))); atomicAdd(p, s1[i]); atomicAdd(p + 1, s2[i]); } }
    }
};

template <int CTRL> __device__ __forceinline__ float dpp_f(float v) { return __builtin_bit_cast(float, __builtin_amdgcn_update_dpp(0, __builtin_bit_cast(int, v), CTRL, 0xf, 0xf, false)); }
struct EpiUpConv {
    bf16_t* G; const float* cw; const float* cb; const float* hist; float* ahead; float* bhead; float* atail; float* outP; float* outS; LAS float* ex; const float* st; const float* uu; const float* cc;
    __device__ __forceinline__ void prefetch(const pg8::Unit& u, int par, int wid, LAS unsigned char* lds) const {
        const int l = lane_id_v();
#pragma unroll
        for (int j = 0; j < 2; ++j) { const int arr = j * 4 + (wid >> 1), off = (wid & 1) * 64 + l;
            const float* src = (arr < 3) ? cw + (size_t)arr * DFF + 128 * u.pn : (arr == 3) ? cb + 128 * u.pn : (arr == 4) ? uu + 256 * u.pn : (arr == 5) ? cc + 256 * u.pn : (arr == 6) ? uu + 256 * u.pn + 128 : cc + 256 * u.pn + 128;
            __builtin_amdgcn_global_load_lds((const unsigned*)(src + off), (LAS unsigned*)(lds + LDS_CT + par * 4096 + (j * 512 + wid * 64) * 4), 4, 0, 0); __builtin_amdgcn_sched_barrier(0); }
    }
    __device__ __forceinline__ void corr2(const f32x4& a0, const f32x4& a1, const LAS float* up, const LAS float* kp, float mu, float rstd, f32x2 (&o)[4]) const {
        const f32x4 u0 = *(const LAS f32x4*)up, u1 = *(const LAS f32x4*)(up + 4), k0 = *(const LAS f32x4*)kp, k1 = *(const LAS f32x4*)(kp + 4);
        const float nb = -mu * rstd; const f32x2 r2 = {rstd, rstd}, n2 = {nb, nb};
        o[0] = (f32x2){a0[0], a0[1]} * r2 + ((f32x2){u0[0], u0[1]} * n2 + (f32x2){k0[0], k0[1]});
        o[1] = (f32x2){a0[2], a0[3]} * r2 + ((f32x2){u0[2], u0[3]} * n2 + (f32x2){k0[2], k0[3]});
        o[2] = (f32x2){a1[0], a1[1]} * r2 + ((f32x2){u1[0], u1[1]} * n2 + (f32x2){k1[0], k1[1]});
        o[3] = (f32x2){a1[2], a1[3]} * r2 + ((f32x2){u1[2], u1[3]} * n2 + (f32x2){k1[2], k1[3]});
    }
    template <bool SMP>
    __device__ __forceinline__ void body(const f32x4 (&acc)[2][2][4][2], const pg8::Unit& u, int wr, int fr, int chl, int ch, const LAS float* stt, const LAS float* T) const {
        const int seq_first = (u.pm & 7) == 0;
#pragma unroll
        for (int ai = 0; ai < 2; ++ai) {
            f32x2 h1[4], h2[4];
#pragma unroll
            for (int e = 0; e < 4; ++e) { h1[e] = (f32x2){0.f, 0.f}; h2[e] = (f32x2){0.f, 0.f}; }
            bool top_missing = false;
            if (!SMP) {
                if (wr == 1 || ai == 1) { const int sa = (wr == 1) ? ai : 0, sw = (wr == 1) ? 0 : 1; const LAS float* p = ex + ((sa * 2 + sw) * 2) * 128 + chl;
                    const f32x4 a0 = *(const LAS f32x4*)p, a1 = *(const LAS f32x4*)(p + 4), b0 = *(const LAS f32x4*)(p + 128), b1 = *(const LAS f32x4*)(p + 132);
                    h2[0] = (f32x2){a0[0], a0[1]}; h2[1] = (f32x2){a0[2], a0[3]}; h2[2] = (f32x2){a1[0], a1[1]}; h2[3] = (f32x2){a1[2], a1[3]};
                    h1[0] = (f32x2){b0[0], b0[1]}; h1[1] = (f32x2){b0[2], b0[3]}; h1[2] = (f32x2){b1[0], b1[1]}; h1[3] = (f32x2){b1[2], b1[3]}; }
                else top_missing = !seq_first;
            }
            f32x2 r1p[4], r2p[4];
#pragma unroll
            for (int e = 0; e < 4; ++e) { r1p[e] = (f32x2){0.f, 0.f}; r2p[e] = (f32x2){0.f, 0.f}; }
#pragma unroll
            for (int m = 0; m < 4; ++m) {
                const int rloc = 128 * ai + 64 * wr + 16 * m + fr;
                f32x2 cur[4], bb[4], r1[4], r2[4], p1[4], p2[4], o[4];
                const LAS float* Tm = T; asm volatile("" : "+v"(Tm));
                { float mu, rstd; ln_row_lds(stt, rloc, 0, mu, rstd);
                  corr2(acc[ai][0][m][0], acc[ai][0][m][1], Tm + 4 * 128, Tm + 5 * 128, mu, rstd, cur); corr2(acc[ai][1][m][0], acc[ai][1][m][1], Tm + 6 * 128, Tm + 7 * 128, mu, rstd, bb); }
#pragma unroll
                for (int e = 0; e < 4; ++e) { r1[e] = (f32x2){dpp_f<0x121>(cur[e][0]), dpp_f<0x121>(cur[e][1])}; r2[e] = (f32x2){dpp_f<0x122>(cur[e][0]), dpp_f<0x122>(cur[e][1])}; }
                if (SMP) { const int sb = ((u.pm - MP / 256) * 256 + 128 * ai + 64 * wr + 16 * m) >> 4; const float* hp = hist + (size_t)sb * 2 * DFF + ch;
                    const f32x4 a0 = *(const f32x4*)hp, a1 = *(const f32x4*)(hp + 4), b0 = *(const f32x4*)(hp + DFF), b1 = *(const f32x4*)(hp + DFF + 4);
                    const f32x2 hh0[4] = {{a0[0], a0[1]}, {a0[2], a0[3]}, {a1[0], a1[1]}, {a1[2], a1[3]}}, hh1[4] = {{b0[0], b0[1]}, {b0[2], b0[3]}, {b1[0], b1[1]}, {b1[2], b1[3]}};
#pragma unroll
                    for (int e = 0; e < 4; ++e) { p1[e] = fr >= 1 ? r1[e] : hh1[e]; p2[e] = fr >= 2 ? r2[e] : (fr == 1 ? hh1[e] : hh0[e]); } }
                else if (m == 0) {
#pragma unroll
                    for (int e = 0; e < 4; ++e) { p1[e] = fr >= 1 ? r1[e] : h1[e]; p2[e] = fr >= 2 ? r2[e] : (fr == 1 ? h1[e] : h2[e]); } }
                else {
#pragma unroll
                    for (int e = 0; e < 4; ++e) { p1[e] = fr >= 1 ? r1[e] : r1p[e]; p2[e] = fr >= 2 ? r2[e] : r2p[e]; } }
                { const f32x4 x0a = *(const LAS f32x4*)(Tm + 0 * 128), x0b = *(const LAS f32x4*)(Tm + 0 * 128 + 4), x1a = *(const LAS f32x4*)(Tm + 1 * 128), x1b = *(const LAS f32x4*)(Tm + 1 * 128 + 4);
                  const f32x4 x2a = *(const LAS f32x4*)(Tm + 2 * 128), x2b = *(const LAS f32x4*)(Tm + 2 * 128 + 4), xba = *(const LAS f32x4*)(Tm + 3 * 128), xbb = *(const LAS f32x4*)(Tm + 3 * 128 + 4);
                  const f32x2 w0[4] = {{x0a[0], x0a[1]}, {x0a[2], x0a[3]}, {x0b[0], x0b[1]}, {x0b[2], x0b[3]}}, w1[4] = {{x1a[0], x1a[1]}, {x1a[2], x1a[3]}, {x1b[0], x1b[1]}, {x1b[2], x1b[3]}};
                  const f32x2 w2[4] = {{x2a[0], x2a[1]}, {x2a[2], x2a[3]}, {x2b[0], x2b[1]}, {x2b[2], x2b[3]}}, wb[4] = {{xba[0], xba[1]}, {xba[2], xba[3]}, {xbb[0], xbb[1]}, {xbb[2], xbb[3]}};
#pragma unroll
                  for (int e = 0; e < 4; ++e) { const f32x2 c = cur[e] * w2[e] + (p1[e] * w1[e] + (p2[e] * w0[e] + wb[e]));
                      const f32x2 t = c * (f32x2){-LOG2E, -LOG2E}; const f32x2 d = (f32x2){__builtin_amdgcn_exp2f(t[0]), __builtin_amdgcn_exp2f(t[1])} + (f32x2){1.f, 1.f};
                      o[e] = (c * bb[e]) * (f32x2){__builtin_amdgcn_rcpf(d[0]), __builtin_amdgcn_rcpf(d[1])}; r1p[e] = r1[e]; r2p[e] = r2[e]; } }
                if (!(top_missing && m == 0 && fr < 2)) { u32x4 w; w.x = pk2(o[0][0], o[0][1]); w.y = pk2(o[1][0], o[1][1]); w.z = pk2(o[2][0], o[2][1]); w.w = pk2(o[3][0], o[3][1]);
                    *(u32x4*)(G + (size_t)(u.pm * 256 + rloc) * DFF + ch) = w; }
                const f32x4 ca0 = {cur[0][0], cur[0][1], cur[1][0], cur[1][1]}, ca1 = {cur[2][0], cur[2][1], cur[3][0], cur[3][1]};
                if (ai == 0 && m == 0 && wr == 0 && fr < 2) { float* pa = ahead + ((size_t)u.pm * 2 + fr) * DFF + ch; float* pb = bhead + ((size_t)u.pm * 2 + fr) * DFF + ch;
                    *(f32x4*)pa = ca0; *(f32x4*)(pa + 4) = ca1; *(f32x4*)pb = (f32x4){bb[0][0], bb[0][1], bb[1][0], bb[1][1]}; *(f32x4*)(pb + 4) = (f32x4){bb[2][0], bb[2][1], bb[3][0], bb[3][1]}; }
                if (ai == 1 && m == 3 && wr == 1 && fr >= 14) { float* pt = atail + ((size_t)u.pm * 2 + (fr - 14)) * DFF + ch; *(f32x4*)pt = ca0; *(f32x4*)(pt + 4) = ca1;
                    if (!SMP && (u.pm & 7) == 7) { float* po = outP + ((size_t)(u.pm >> 3) * 2 + (fr - 14)) * DFF + ch; *(f32x4*)po = ca0; *(f32x4*)(po + 4) = ca1; } }
                if (SMP && fr >= 14) { const int sb = ((u.pm - MP / 256) * 256 + 128 * ai + 64 * wr + 16 * m) >> 4; float* po = outS + ((size_t)sb * 2 + (fr - 14)) * DFF + ch;
                    *(f32x4*)po = ca0; *(f32x4*)(po + 4) = ca1; }
            }
        }
    }
    __device__ __forceinline__ void operator()(const f32x4 (&acc)[2][2][4][2], const pg8::Unit& u, int wr, int wc, int fr, int fq, const LAS float* stt, const LAS float* ct) const {
        const int chl = 32 * wc + 8 * fq, ch = 128 * u.pn + chl;
        const LAS float* T = ct + chl;
        if (fr >= 14) {
#pragma unroll
            for (int ai = 0; ai < 2; ++ai) { float mu, rstd; f32x2 t[4]; ln_row_lds(stt, wr * 64 + fr + ai * 128 + 48, 0, mu, rstd); corr2(acc[ai][0][3][0], acc[ai][0][3][1], T + 4 * 128, T + 5 * 128, mu, rstd, t);
                LAS float* p = ex + ((ai * 2 + wr) * 2 + (fr - 14)) * 128 + chl; *(LAS f32x4*)p = (f32x4){t[0][0], t[0][1], t[1][0], t[1][1]}; *(LAS f32x4*)(p + 4) = (f32x4){t[2][0], t[2][1], t[3][0], t[3][1]}; }
        }
        asm volatile("s_waitcnt lgkmcnt(0)" ::: "memory"); __builtin_amdgcn_s_barrier(); asm volatile("" ::: "memory");
        if (u.pm >= MP / 256) body<true>(acc, u, wr, fr, chl, ch, stt, T); else body<false>(acc, u, wr, fr, chl, ch, stt, T);
    }
};


template <int KW  >
__device__ __forceinline__ void sgemm_res_phase(LAS unsigned char* lds, const bf16_t* A, int lda, int a_grp_step, const bf16_t* Bt, int K, int bid, int G, int tid, const LnRef& P, bf16_t* Z, float* st_out, const float* scale) {
    const int lane = tid & 63, wave = __builtin_amdgcn_readfirstlane(tid >> 6), fr = lane & 15, fq = lane >> 4;
    LAS f32x4* red = (LAS f32x4*)lds;
    for (int t = bid; t < 256; t += G) {
        const int rt = t >> 5, ct = t & 31;
        const GAS bf16_t* ap = (const GAS bf16_t*)(A + (size_t)(rt * 64 + fr) * lda + (size_t)((ct * 32) >> 8) * a_grp_step + wave * KW + 8 * fq);
        const GAS bf16_t* bp = (const GAS bf16_t*)(Bt + (size_t)(ct * 32 + fr) * K + wave * KW + 8 * fq);
        f32x4 acc[4][2];
#pragma unroll
        for (int i = 0; i < 4; ++i) { acc[i][0] = (f32x4){0.f, 0.f, 0.f, 0.f}; acc[i][1] = (f32x4){0.f, 0.f, 0.f, 0.f}; }
#pragma unroll
        for (int k0 = 0; k0 < KW; k0 += 32) {
            bf16x8 af[4], bf[2];
#pragma unroll
            for (int i = 0; i < 4; ++i) af[i] = *(const GAS bf16x8*)(ap + (size_t)(16 * i) * lda + k0);
#pragma unroll
            for (int j = 0; j < 2; ++j) bf[j] = *(const GAS bf16x8*)(bp + (size_t)(16 * j) * K + k0);
#pragma unroll
            for (int i = 0; i < 4; ++i)
#pragma unroll
                for (int j = 0; j < 2; ++j) acc[i][j] = __builtin_amdgcn_mfma_f32_16x16x32_bf16(bf[j], af[i], acc[i][j], 0, 0, 0);
        }
#pragma unroll
        for (int i = 0; i < 4; ++i)
#pragma unroll
            for (int j = 0; j < 2; ++j) red[(wave * 8 + i * 2 + j) * 64 + lane] = acc[i][j];
        __syncthreads();
        f32x4 v = red[(0 * 8 + wave) * 64 + lane];
#pragma unroll
        for (int w = 1; w < 8; ++w) v += red[(w * 8 + wave) * 64 + lane];
        __syncthreads();
        const int row = rt * 64 + 16 * (wave >> 1) + fr, n = ct * 32 + 16 * (wave & 1) + 4 * fq; const size_t grow = (size_t)MP + row, off = grow * D + n;
        float mu, rstd; ln_row(P.st, grow, P.ident, mu, rstd);
        f32x4 gg = {1.f, 1.f, 1.f, 1.f}, bb = {0.f, 0.f, 0.f, 0.f}, sc = {1.f, 1.f, 1.f, 1.f};
        if (!P.ident) { gg = *(const f32x4*)(P.g + n); bb = *(const f32x4*)(P.b + n); }
        if (scale) sc = *(const f32x4*)(scale + n);
        const u32x2 xw = *(const u32x2*)(P.Z + off); const float xv[4] = {bflo(xw.x), bfhi(xw.x), bflo(xw.y), bfhi(xw.y)};
        float o[4];
#pragma unroll
        for (int e = 0; e < 4; ++e) { const float tt = rstd * gg[e], x = fmaf(xv[e], tt, fmaf(-mu, tt, bb[e])); o[e] = fmaf(DN_ALPHA, x, v[e] * sc[e]); }
        u32x2 w; w.x = pk2(o[0], o[1]); w.y = pk2(o[2], o[3]); *(u32x2*)(Z + off) = w;
        float s1 = (bflo(w.x) + bfhi(w.x)) + (bflo(w.y) + bfhi(w.y)), s2 = (bflo(w.x) * bflo(w.x) + bfhi(w.x) * bfhi(w.x)) + (bflo(w.y) * bflo(w.y) + bfhi(w.y) * bfhi(w.y));
        s1 += __shfl_xor(s1, 16); s1 += __shfl_xor(s1, 32); s2 += __shfl_xor(s2, 16); s2 += __shfl_xor(s2, 32);
        if (fq == 0) { atomicAdd(st_out + grow * 2, s1); atomicAdd(st_out + grow * 2 + 1, s2); }
    }
}

__device__ __forceinline__ void sgemm_in_phase(LAS unsigned char* lds, const bf16_t* A, const bf16_t* Bt, int bid, int G, int tid, const EpiIn& E) {
    constexpr int K = D, KW = K / 8;
    const int lane = tid & 63, wave = __builtin_amdgcn_readfirstlane(tid >> 6), fr = lane & 15, fq = lane >> 4;
    LAS f32x4* red = (LAS f32x4*)lds;
    for (int t = bid; t < 256; t += G) {
        const int rt = t >> 5, ct = t & 31;
        const GAS bf16_t* ap = (const GAS bf16_t*)(A + (size_t)(rt * 64 + fr) * K + wave * KW + 8 * fq);
        const GAS bf16_t* bp = (const GAS bf16_t*)(Bt + (size_t)(ct * 112 + fr) * K + wave * KW + 8 * fq);
        f32x4 acc[4][7];
#pragma unroll
        for (int i = 0; i < 4; ++i)
#pragma unroll
            for (int j = 0; j < 7; ++j) acc[i][j] = (f32x4){0.f, 0.f, 0.f, 0.f};
#pragma unroll
        for (int k0 = 0; k0 < KW; k0 += 32) {
            bf16x8 af[4], bf[7];
#pragma unroll
            for (int i = 0; i < 4; ++i) af[i] = *(const GAS bf16x8*)(ap + (size_t)(16 * i) * K + k0);
#pragma unroll
            for (int j = 0; j < 7; ++j) bf[j] = *(const GAS bf16x8*)(bp + (size_t)(16 * j) * K + k0);
#pragma unroll
            for (int i = 0; i < 4; ++i)
#pragma unroll
                for (int j = 0; j < 7; ++j) acc[i][j] = __builtin_amdgcn_mfma_f32_16x16x32_bf16(bf[j], af[i], acc[i][j], 0, 0, 0);
        }
#pragma unroll
        for (int i = 0; i < 4; ++i) {
#pragma unroll
            for (int j = 0; j < 7; ++j) red[(wave * 7 + j) * 64 + lane] = acc[i][j];
            __syncthreads();
            if (wave < 7) {
                f32x4 v = red[(0 * 7 + wave) * 64 + lane];
#pragma unroll
                for (int w = 1; w < 8; ++w) v += red[(w * 7 + wave) * 64 + lane];
                const int m = rt * 64 + 16 * i + fr, n = ct * 112 + 16 * wave + 4 * fq; const size_t row = (size_t)MP + m;
                float mu, rstd; ln_row(E.st, row, E.ident, mu, rstd);
                const f32x4 u0 = *(const f32x4*)(E.uu + n), k0v = *(const f32x4*)(E.cc + n);
                const float nb = -mu * rstd; v = v * rstd + (u0 * nb + k0v);
                const int kind = n >> 9;
                if (kind == 1) { const int c = n - C_AF; const f32x4 l0 = *(const f32x4*)(E.lbv + c); f32x4 o;
#pragma unroll
                    for (int e = 0; e < 4; ++e) { const float z = v[e], ez = __builtin_amdgcn_exp2f(-LOG2E * fabsf(z)), sg = (z >= 0.f ? 1.f : ez) * __builtin_amdgcn_rcpf(1.f + ez), f = l0[e] + (1.f - l0[e]) * sg; o[e] = fmaxf(__builtin_amdgcn_logf(f) * 0.6931471805599453f, -60.f); }
                    *(f32x4*)(E.LF + row * 512 + c) = o; }
                else { u32x2 w; w.x = pk2(v[0], v[1]); w.y = pk2(v[2], v[3]); *(u32x2*)(E.H + row * INC + n) = w;
                    if (kind == 5) *(f32x4*)(E.kS + (size_t)m * 512 + (n - C_BK)) = v;
                    if (kind == 6) *(f32x4*)(E.vS + (size_t)m * 512 + (n - C_BV)) = v; }
            }
            __syncthreads();
        }
    }
}

#define XB_TMO      128
#define XB_XCNT(j)  (256  + 64 * (j))
#define XB_XSUB(j)  (1280 + 64 * (j))
#define XB_XGEN(j)  (2304 + 64 * (j))
#define XB_TOP      3328
#define XB_TOPGEN   3392
#define XCD_BAR_WORDS 3456
#define XB_SPIN_CAP (1u << 22)
__device__ __forceinline__ unsigned xb_ld(unsigned* p)              { return __hip_atomic_load(p, __ATOMIC_RELAXED, __HIP_MEMORY_SCOPE_AGENT); }
__device__ __forceinline__ unsigned xb_add(unsigned* p, unsigned v) { return __hip_atomic_fetch_add(p, v, __ATOMIC_RELAXED, __HIP_MEMORY_SCOPE_AGENT); }
__device__ __forceinline__ unsigned xb_xcc_id() { return (unsigned)__builtin_amdgcn_s_getreg((3 << 11) | 20) & 0xFu; }
#define XB_SPIN(cond, bar) do { unsigned _sp = 0; while (cond) { __builtin_amdgcn_s_sleep(1); \
    if ((++_sp & 255u) == 0u) { if (xb_ld(&(bar)[XB_TMO])) break; if (_sp > XB_SPIN_CAP) { atomicAdd(&(bar)[XB_TMO], 1u); break; } } } } while (0)
struct XcdBarrier { unsigned* bar; unsigned x; volatile LAS unsigned* st; };
__device__ __forceinline__ XcdBarrier xcd_barrier_post(unsigned* bar, volatile LAS unsigned* st) {
    XcdBarrier b; b.bar = bar; b.x = xb_xcc_id(); b.st = st;
    if (threadIdx.x == 0) (void)xb_add(&bar[XB_XCNT(b.x)], 1u);
    return b;
}
__device__ __forceinline__ void xcd_barrier_complete(unsigned* bar, unsigned x, unsigned& nloc, unsigned& nx) {
    const unsigned G = gridDim.x * gridDim.y * gridDim.z;
    unsigned sum, cnt, mine, sp = 0u;
    for (;;) {
        sum = 0u; cnt = 0u; mine = 0u;
#pragma unroll
        for (unsigned j = 0; j < 16; ++j) { const unsigned c = xb_ld(&bar[XB_XCNT(j)]); sum += c; cnt += (c > 0u) ? 1u : 0u; mine = (j == x) ? c : mine; }
        if (sum == G) break;
        __builtin_amdgcn_s_sleep(1);
        if ((++sp & 255u) == 0u) { if (xb_ld(&bar[XB_TMO])) break; if (sp > XB_SPIN_CAP) { atomicAdd(&bar[XB_TMO], 1u); break; } }
    }
    nloc = mine > 0u ? mine : 1u; nx = cnt > 0u ? cnt : 1u;
}
__device__ __forceinline__ void xcd_barrier(const XcdBarrier& b) {
    asm volatile("s_waitcnt vmcnt(0)" ::: "memory");
    __syncthreads();
    if (threadIdx.x == 0) {
        unsigned* bar = b.bar;
        __builtin_amdgcn_s_waitcnt(0);
        unsigned nloc = b.st[0], nx = b.st[1];
        if (nloc == 0u) { xcd_barrier_complete(bar, b.x, nloc, nx); b.st[0] = nloc; b.st[1] = nx; }
        const unsigned old = xb_add(&bar[XB_XSUB(b.x)], 1u);
        const unsigned gen = old / nloc;
        if (old + 1u == (gen + 1u) * nloc) {
            __builtin_amdgcn_fence(__ATOMIC_RELEASE, "agent");
            asm volatile("s_waitcnt vmcnt(0)" ::: "memory");
            const unsigned og = xb_add(&bar[XB_TOP], 1u);
            const unsigned tg = og / nx;
            if (og + 1u == (tg + 1u) * nx) xb_add(&bar[XB_TOPGEN], 1u);
            else XB_SPIN(xb_ld(&bar[XB_TOPGEN]) == tg, bar);
            __builtin_amdgcn_fence(__ATOMIC_ACQUIRE, "agent");
            xb_add(&bar[XB_XGEN(b.x)], 1u);
            asm volatile("s_waitcnt vmcnt(0)" ::: "memory");
        } else {
            XB_SPIN(xb_ld(&bar[XB_XGEN(b.x)]) == gen, bar);
            __builtin_amdgcn_fence(__ATOMIC_ACQUIRE, "agent");
            asm volatile("s_waitcnt vmcnt(0)" ::: "memory");
        }
    }
    __syncthreads();
}

struct Args { const float* in[24]; float* out; unsigned char* ws; int ph_lo, ph_hi, single, pad; };
typedef const float* cfp_t;
typedef const __attribute__((address_space(4))) cfp_t* kin_t;
struct Frame {
    LAS unsigned char* lds;
    int tid, lane, wave, bid, G;
    kin_t in;
    float* out; unsigned char* ws;
};
enum { I_XP = 0, I_XS, I_CK, I_CV, I_SH, I_SP, I_SC, I_WIN, I_WOUT, I_LBL, I_HNG, I_DLAM, I_DNG, I_RB, I_PW, I_PSC, I_WUP, I_CW, I_CB, I_WDN, I_L1G, I_L1B, I_L2G, I_L2B };

__device__ __forceinline__ void p0_transpose_item(const float* W, int K, int N, bf16_t* WT, int dst_row0, LAS float* scr, int k0, int n0, int lane, const float* gk, const float* bk, float* uo, float* co) {
#pragma unroll 8
    for (int i = 0; i < 32; ++i) { const int kk = 2 * i + (lane >> 5); scr[kk * 33 + (lane & 31)] = W[(size_t)(k0 + kk) * N + n0 + (lane & 31)]; }
    asm volatile("s_waitcnt lgkmcnt(0)" ::: "memory");
    const int c = lane & 7;
    float gv[8], bv[8];
#pragma unroll
    for (int e = 0; e < 8; ++e) { gv[e] = 1.f; bv[e] = 0.f; }
    if (gk) {
#pragma unroll
        for (int e = 0; e < 8; ++e) { gv[e] = gk[k0 + 8 * c + e]; bv[e] = bk[k0 + 8 * c + e]; } }
#pragma unroll
    for (int j = 0; j < 4; ++j) { const int n = (lane >> 3) + 8 * j; const LAS float* sp = scr + (8 * c) * 33 + n;
        float wv[8]; float cs = 0.f;
#pragma unroll
        for (int e = 0; e < 8; ++e) { const float w = sp[e * 33]; wv[e] = w * gv[e]; cs += w * bv[e]; }
        const u32x4 o = pk8(wv);
        *(u32x4*)(WT + (size_t)(dst_row0 + n) * K + k0 + 8 * c) = o;
        if (gk) { float rv[8]; unpk8(o, rv); float us = 0.f;
#pragma unroll
            for (int e = 0; e < 8; ++e) us += rv[e];
            us += __shfl_xor(us, 1); us += __shfl_xor(us, 2); us += __shfl_xor(us, 4); cs += __shfl_xor(cs, 1); cs += __shfl_xor(cs, 2); cs += __shfl_xor(cs, 4);
            if (c == 0) { atomicAdd(uo + dst_row0 + n, us); atomicAdd(co + dst_row0 + n, cs); } } }
    asm volatile("s_waitcnt lgkmcnt(0)" ::: "memory");
}
__device__ __forceinline__ void phase_prologue(Frame& F) {
    LAS float* scr = (LAS float*)(F.lds + F.wave * 16384);
    const int gw = F.bid * NWAVES + F.wave, NGW = F.G * NWAVES;
    constexpr int I_IN = (D / 64) * (INC / 32), I_OUT = (D / 64) * (D / 32), I_POOL = 4 * 8, I_UP = (D / 64) * (UPN / 32), I_DN = (DFF / 64) * (D / 32);
    constexpr int NITEMS = 2 * I_IN + 2 * I_OUT + 8 * I_POOL + 4 * I_UP + 4 * I_DN;
    for (int it = gw; it < NITEMS; it += NGW) {
        int r = it;
        if (r < 2 * I_IN) { const int m = r / I_IN; r %= I_IN; const int kb = r / (INC / 32), nb = r % (INC / 32);
            float* ctlf = (float*)(F.ws + WS_CTL);
            p0_transpose_item(F.in[I_WIN] + (size_t)m * D * INC, D, INC, (bf16_t*)(F.ws + WS_WIN) + (size_t)m * INC * D, 32 * nb, scr, 64 * kb, 32 * nb, F.lane,
                              m == 1 ? F.in[I_L2G] + 1 * D : nullptr, F.in[I_L2B] + 1 * D, ctlf + UC_UIN, ctlf + UC_CIN); continue; } r -= 2 * I_IN;
        if (r < 2 * I_OUT) { const int m = r / I_OUT; r %= I_OUT; const int kb = r / (D / 32), nb = r % (D / 32);
            p0_transpose_item(F.in[I_WOUT] + (size_t)m * D * D, D, D, (bf16_t*)(F.ws + WS_WOUT) + (size_t)m * D * D, 32 * nb, scr, 64 * kb, 32 * nb, F.lane, nullptr, nullptr, nullptr, nullptr); continue; } r -= 2 * I_OUT;
        if (r < 8 * I_POOL) { const int pg = r / I_POOL; r %= I_POOL; const int kb = r / 8, nb = r % 8;
            p0_transpose_item(F.in[I_PW] + (size_t)pg * 256 * 256, 256, 256, (bf16_t*)(F.ws + WS_WPOOL) + (size_t)pg * 256 * 256, 32 * nb, scr, 64 * kb, 32 * nb, F.lane, nullptr, nullptr, nullptr, nullptr); continue; } r -= 8 * I_POOL;
        if (r < 4 * I_UP) { const int l = r / I_UP; r %= I_UP; const int kb = r / (UPN / 32), nb = r % (UPN / 32); const int n0 = 32 * nb;
            const int dst = (n0 < DFF) ? (256 * (n0 / 128) + (n0 % 128)) : (256 * ((n0 - DFF) / 128) + 128 + ((n0 - DFF) % 128));
            float* ctlf = (float*)(F.ws + WS_CTL);
            p0_transpose_item(F.in[I_WUP] + (size_t)l * D * UPN, D, UPN, (bf16_t*)(F.ws + WS_WUP) + (size_t)l * UPN * D, dst, scr, 64 * kb, n0, F.lane,
                              F.in[I_L1G] + (size_t)l * D, F.in[I_L1B] + (size_t)l * D, ctlf + UC_UUP + l * UPN, ctlf + UC_CUP + l * UPN); continue; } r -= 4 * I_UP;
        { const int l = r / I_DN; r %= I_DN; const int kb = r / (D / 32), nb = r % (D / 32);
            p0_transpose_item(F.in[I_WDN] + (size_t)l * DFF * D, DFF, D, (bf16_t*)(F.ws + WS_WDN) + (size_t)l * D * DFF, 32 * nb, scr, 64 * kb, 32 * nb, F.lane, nullptr, nullptr, nullptr, nullptr); }
    }
    bf16_t* XB = (bf16_t*)(F.ws + WS_XB);
    for (int m0 = gw; m0 < MT; m0 += 4 * NGW) {
        f32x4 v[4][4];
#pragma unroll
        for (int q = 0; q < 4; ++q) { const int m = m0 + q * NGW;
            if (m < MT) { const float* src = (m < MP) ? F.in[I_XP] + (size_t)m * D : F.in[I_XS] + (size_t)(m - MP) * D;
#pragma unroll
                for (int j = 0; j < 4; ++j) v[q][j] = *(const f32x4*)(src + 4 * F.lane + 256 * j); } }
#pragma unroll
        for (int q = 0; q < 4; ++q) { const int m = m0 + q * NGW;
            if (m < MT) {
#pragma unroll
                for (int j = 0; j < 4; ++j) { u32x2 w; w.x = pk2(v[q][j][0], v[q][j][1]); w.y = pk2(v[q][j][2], v[q][j][3]); *(u32x2*)(XB + (size_t)m * D + 4 * F.lane + 256 * j) = w; } } }
    }
    if (F.bid == 0) {
        float* tab = (float*)(F.ws + WS_TAB);
        { const int c = F.tid; const float a = F.in[I_LBL][c], b = F.in[I_LBL][512 + c], mx = fmaxf(a, b), ea = __expf(a - mx), eb = __expf(b - mx);
          tab[TB_LB + c] = 0.f; tab[TB_LB + 512 + c] = eb / (ea + eb); }
        if (F.wave < 2) { const int m = F.wave; const float* lp = F.in[I_DLAM] + (size_t)m * 4 * 64;
            const float s01 = wave_sum(lp[F.lane] * lp[64 + F.lane]), s23 = wave_sum(lp[128 + F.lane] * lp[192 + F.lane]);
            const float lam_init = (m == 0) ? 0.2f : 0.47071302f;
            if (F.lane == 0) tab[TB_LAM + m] = __expf(s01) - __expf(s23) + lam_init; }
    }
}

__device__ __forceinline__ void phase_ln_final(Frame& F, const bf16_t* Z, const float* g, const float* b) {
    const int gw = F.bid * NWAVES + F.wave, NGW = F.G * NWAVES;
    f32x4 gv[4], bv[4];
#pragma unroll
    for (int j = 0; j < 4; ++j) { const int c = 8 * F.lane + 512 * (j >> 1) + 4 * (j & 1); gv[j] = *(const f32x4*)(g + c); bv[j] = *(const f32x4*)(b + c); }
    for (int m = gw; m < MT; m += NGW) {
        f32x4 v[4]; float s = 0.f;
#pragma unroll
        for (int j2 = 0; j2 < 2; ++j2) { const u32x4 w = *(const u32x4*)(Z + (size_t)m * D + 8 * F.lane + 512 * j2);
            v[2 * j2] = (f32x4){bflo(w.x), bfhi(w.x), bflo(w.y), bfhi(w.y)}; v[2 * j2 + 1] = (f32x4){bflo(w.z), bfhi(w.z), bflo(w.w), bfhi(w.w)}; }
#pragma unroll
        for (int j = 0; j < 4; ++j) s += (v[j][0] + v[j][1]) + (v[j][2] + v[j][3]);
        const float mean = wave_sum(s) * (1.f / D); float s2 = 0.f;
#pragma unroll
        for (int j = 0; j < 4; ++j) { v[j] = v[j] - mean; s2 += (v[j][0] * v[j][0] + v[j][1] * v[j][1]) + (v[j][2] * v[j][2] + v[j][3] * v[j][3]); }
        const float rstd = 1.f / sqrtf(wave_sum(s2) * (1.f / D) + LN_EPS);
        float* outp = (m < MP) ? F.out + O_YP + (size_t)m * D : F.out + O_YS + (size_t)(m - MP) * D;
#pragma unroll
        for (int j2 = 0; j2 < 2; ++j2) { const f32x4 y0 = v[2 * j2] * rstd * gv[2 * j2] + bv[2 * j2], y1 = v[2 * j2 + 1] * rstd * gv[2 * j2 + 1] + bv[2 * j2 + 1];
            *(f32x4*)(outp + 8 * F.lane + 512 * j2) = y0; *(f32x4*)(outp + 8 * F.lane + 512 * j2 + 4) = y1; }
    }
}

template <int J>
__device__ __forceinline__ void pool_item(Frame& F, const LnRef& R, int p, int rb, int c) {
    constexpr int W = 2 << J;
    bf16_t* PO = (bf16_t*)(F.ws + WS_MIX);
    const f32x4 g0 = *(const f32x4*)(R.g + c), g1 = *(const f32x4*)(R.g + c + 4), b0 = *(const f32x4*)(R.b + c), b1 = *(const f32x4*)(R.b + c + 4);
    const int m0 = rb * 16; const bool smp = m0 >= MP; const int b = smp ? (m0 - MP) / ST : m0 / PT, t0 = smp ? 0 : m0 % PT;
    f32x4 ring[W][2]; f32x4 s0 = {0.f, 0.f, 0.f, 0.f}, s1 = {0.f, 0.f, 0.f, 0.f};
#pragma unroll
    for (int i = 0; i < W; ++i) {
        const int tt = t0 - W + i; f32x4 v0 = {0.f, 0.f, 0.f, 0.f}, v1 = {0.f, 0.f, 0.f, 0.f};
        if (tt >= 0) { const size_t rr = (size_t)(m0 - W + i); const u32x4 q = *(const u32x4*)(R.Z + rr * D + c); float mu, rstd; ln_row(R.st, rr, 0, mu, rstd);
            v0 = ((f32x4){bflo(q.x), bfhi(q.x), bflo(q.y), bfhi(q.y)} - mu) * rstd * g0 + b0; v1 = ((f32x4){bflo(q.z), bfhi(q.z), bflo(q.w), bfhi(q.w)} - mu) * rstd * g1 + b1; }
        else if (smp && tt >= -15) { const float* hp = F.in[I_SP] + (((size_t)p * SB + b) * 15 + (15 + tt)) * D + c; v0 = *(const f32x4*)hp; v1 = *(const f32x4*)(hp + 4); }
        ring[i][0] = v0; ring[i][1] = v1; s0 += v0; s1 += v1; }
#pragma unroll
    for (int i = 0; i < 16; ++i) { const int t = t0 + i;
        const size_t rr = (size_t)(m0 + i); const u32x4 q = *(const u32x4*)(R.Z + rr * D + c); float mu, rstd; ln_row(R.st, rr, 0, mu, rstd);
        const f32x4 x0 = ((f32x4){bflo(q.x), bfhi(q.x), bflo(q.y), bfhi(q.y)} - mu) * rstd * g0 + b0, x1 = ((f32x4){bflo(q.z), bfhi(q.z), bflo(q.w), bfhi(q.w)} - mu) * rstd * g1 + b1;
        s0 += x0 - ring[i % W][0]; s1 += x1 - ring[i % W][1]; ring[i % W][0] = x0; ring[i % W][1] = x1;
        const float inv = 1.f / (float)(smp ? W : (t + 1 < W ? t + 1 : W));
        const f32x4 o0 = s0 * inv - x0, o1 = s1 * inv - x1;
        u32x4 w; w.x = pk2(o0[0], o0[1]); w.y = pk2(o0[2], o0[3]); w.z = pk2(o1[0], o1[1]); w.w = pk2(o1[2], o1[3]); *(u32x4*)(PO + (size_t)(m0 + i) * D + c) = w;
        if (!smp && t >= PT - 15) { float* op = F.out + O_PP + (((size_t)p * PB + b) * 15 + (t - (PT - 15))) * D + c; *(f32x4*)op = x0; *(f32x4*)(op + 4) = x1; }
        if (smp && t >= 1) { float* op = F.out + O_PS + (((size_t)p * SB + b) * 15 + (t - 1)) * D + c; *(f32x4*)op = x0; *(f32x4*)(op + 4) = x1; } }
}
__device__ __forceinline__ void phase_pool_prep(Frame& F, const LnRef& R, int p) {
    const int gwv = F.bid * NWAVES + F.wave, NGW = F.G * NWAVES;
    for (int wi = gwv; wi < (MT / 32) * 4; wi += NGW) { const int j = wi & 3, rb = 2 * (wi >> 2) + (F.lane >> 5), c = 256 * j + 8 * (F.lane & 31);
        if (j == 0) pool_item<0>(F, R, p, rb, c); else if (j == 1) pool_item<1>(F, R, p, rb, c); else if (j == 2) pool_item<2>(F, R, p, rb, c); else pool_item<3>(F, R, p, rb, c); }
}

__device__ __forceinline__ void conv_fix_item(Frame& F, int l, int pm, int ch) {
    bf16_t* Gb = (bf16_t*)(F.ws + WS_G);
    const float* cw = F.in[I_CW] + (size_t)l * 3 * DFF; const float* cb = F.in[I_CB] + (size_t)l * DFF;
    const float* ahead = (const float*)(F.ws + WS_AHEAD); const float* bhead = (const float*)(F.ws + WS_BHEAD); const float* atail = (const float*)(F.ws + WS_ATAIL);
    float t0[8], t1[8], a0[8], a1[8], b0[8], b1[8], o[8];
#pragma unroll
    for (int h2 = 0; h2 < 2; ++h2) {
        const f32x4 x0 = *(const f32x4*)(atail + ((size_t)(pm - 1) * 2 + 0) * DFF + ch + 4 * h2), x1 = *(const f32x4*)(atail + ((size_t)(pm - 1) * 2 + 1) * DFF + ch + 4 * h2);
        const f32x4 y0 = *(const f32x4*)(ahead + ((size_t)pm * 2 + 0) * DFF + ch + 4 * h2), y1 = *(const f32x4*)(ahead + ((size_t)pm * 2 + 1) * DFF + ch + 4 * h2);
        const f32x4 z0 = *(const f32x4*)(bhead + ((size_t)pm * 2 + 0) * DFF + ch + 4 * h2), z1 = *(const f32x4*)(bhead + ((size_t)pm * 2 + 1) * DFF + ch + 4 * h2);
#pragma unroll
        for (int e = 0; e < 4; ++e) { t0[4 * h2 + e] = x0[e]; t1[4 * h2 + e] = x1[e]; a0[4 * h2 + e] = y0[e]; a1[4 * h2 + e] = y1[e]; b0[4 * h2 + e] = z0[e]; b1[4 * h2 + e] = z1[e]; } }
#pragma unroll
    for (int e = 0; e < 8; ++e) { const float c = cb[ch + e] + t0[e] * cw[ch + e] + t1[e] * cw[DFF + ch + e] + a0[e] * cw[2 * DFF + ch + e]; o[e] = silu_mul(c, b0[e]); }
    *(u32x4*)(Gb + (size_t)(pm * 256) * DFF + ch) = pk8(o);
#pragma unroll
    for (int e = 0; e < 8; ++e) { const float c = cb[ch + e] + t1[e] * cw[ch + e] + a0[e] * cw[DFF + ch + e] + a1[e] * cw[2 * DFF + ch + e]; o[e] = silu_mul(c, b1[e]); }
    *(u32x4*)(Gb + (size_t)(pm * 256 + 1) * DFF + ch) = pk8(o);
}
__device__ __forceinline__ void conv_fix_local(Frame& F, int l, const pg8::StaticOrder& S) {
    pg8::Unit u;
    for (int i = 0; S.next(i, u); ++i)
        if (u.pm < MP / 256 && (u.pm & 7) != 0)
            for (int it = F.tid; it < DFF / 8; it += NTHREADS) conv_fix_item(F, l, u.pm, 8 * it);
    asm volatile("s_waitcnt vmcnt(0)" ::: "memory");
    __syncthreads();
}

constexpr int HG_LF = 0;
constexpr int HG_TOT = HG_LF + 16384;
constexpr int HG_G = HG_TOT + 2048;
constexpr int HG_QT = HG_G + 512;
constexpr int HG_KS = HG_QT + 32 * 272;
constexpr int HG_V = HG_KS + 32 * 320;
constexpr int HG_PF = HG_V + 32 * 320;
constexpr int HG_OX = HG_PF + 2048;
constexpr int HG_OXP = 132;
constexpr int HG_END = HG_OX + 2 * 32 * HG_OXP * 4;
static_assert(HG_END <= LDS_TAB, "HGRN LDS");

template <bool SMP>
__device__ __forceinline__ void hgrn_unit(Frame& F, int m, int b, int h) {
    LAS unsigned char* L = F.lds;
    const bf16_t* H = (const bf16_t*)(F.ws + WS_H); const float* LFg = (const float*)(F.ws + WS_LF); bf16_t* MIX = (bf16_t*)(F.ws + WS_MIX);
    const float* gn = F.in[I_HNG] + (size_t)m * 512 + h * 128;
    const int tid = opq(F.tid), lane = tid & 63, wave = __builtin_amdgcn_readfirstlane(tid >> 6), r = lane & 31, hh = lane >> 5;
    const int nb = wave & 3, kh = wave >> 2;
    const size_t row0 = SMP ? (size_t)MP + (size_t)b * ST : (size_t)b * PT;
    const int nsteps = SMP ? 1 : PT / 32;
    f32x16 S[2];
    if (SMP) { const float* s0 = F.in[I_SH] + (((size_t)m * SB + b) * NH + h) * 128 * 128 + (size_t)(64 * kh + 4 * hh) * 128 + 32 * nb + r;
#pragma unroll
        for (int kbl = 0; kbl < 2; ++kbl)
#pragma unroll
            for (int i = 0; i < 16; ++i) S[kbl][i] = s0[(32 * kbl + (i & 3) + 8 * (i >> 2)) * 128];
    } else {
#pragma unroll
        for (int kbl = 0; kbl < 2; ++kbl)
#pragma unroll
            for (int i = 0; i < 16; ++i) S[kbl][i] = 0.f;
    }
    const int et = tid >> 4, ek = (tid & 15) * 8;
    const bool valid = !SMP || et < ST;
    f32x4 lf0 = {0.f, 0.f, 0.f, 0.f}, lf1 = {0.f, 0.f, 0.f, 0.f}; u32x4 qw = {0u, 0u, 0u, 0u}, vw = {0u, 0u, 0u, 0u}, gw = {0u, 0u, 0u, 0u};
    if (valid) { const size_t row = row0 + et;
        lf0 = *(const f32x4*)(LFg + row * 512 + h * 128 + ek); lf1 = *(const f32x4*)(LFg + row * 512 + h * 128 + ek + 4);
        qw = *(const u32x4*)(H + row * INC + C_AQ + h * 128 + ek); vw = *(const u32x4*)(H + row * INC + C_AI + h * 128 + ek); gw = *(const u32x4*)(H + row * INC + C_AG + h * 128 + ek); }
    for (int step = 0; step < nsteps; ++step) {
        const size_t row = row0 + (size_t)step * 32 + et;
        *(LAS f32x4*)(L + HG_LF + (et * 128 + ek) * 4) = lf0; *(LAS f32x4*)(L + HG_LF + (et * 128 + ek + 4) * 4) = lf1;
        f32x4 nlf0 = lf0, nlf1 = lf1; u32x4 nqw = qw, nvw = vw, ngw = gw;
        if (!SMP && step + 1 < nsteps) { const size_t rn = row + 32;
            nlf0 = *(const f32x4*)(LFg + rn * 512 + h * 128 + ek); nlf1 = *(const f32x4*)(LFg + rn * 512 + h * 128 + ek + 4);
            nqw = *(const u32x4*)(H + rn * INC + C_AQ + h * 128 + ek); nvw = *(const u32x4*)(H + rn * INC + C_AI + h * 128 + ek); ngw = *(const u32x4*)(H + rn * INC + C_AG + h * 128 + ek); }
        __syncthreads();
        { const int k = tid & 127, tq = tid >> 7; LAS float* p = (LAS float*)(L + HG_LF) + (8 * tq) * 128 + k; float vs[8];
#pragma unroll
            for (int i = 0; i < 8; ++i) vs[i] = p[i * 128];
#pragma unroll
            for (int i = 1; i < 8; ++i) vs[i] += vs[i - 1];
#pragma unroll
            for (int i = 0; i < 8; ++i) p[i * 128] = vs[i];
            ((LAS float*)(L + HG_TOT))[tq * 128 + k] = vs[7]; }
        __syncthreads();
        { float bcum[8];
            { const f32x4 c0 = *(LAS f32x4*)(L + HG_LF + (et * 128 + ek) * 4), c1 = *(LAS f32x4*)(L + HG_LF + (et * 128 + ek + 4) * 4);
#pragma unroll
              for (int e = 0; e < 4; ++e) { bcum[e] = c0[e]; bcum[4 + e] = c1[e]; } }
            for (int gq = 0; gq < (et >> 3); ++gq) { const f32x4 c0 = *(LAS f32x4*)(L + HG_TOT + (gq * 128 + ek) * 4), c1 = *(LAS f32x4*)(L + HG_TOT + (gq * 128 + ek + 4) * 4);
#pragma unroll
                for (int e = 0; e < 4; ++e) { bcum[e] += c0[e]; bcum[4 + e] += c1[e]; } }
            float qv[8]; unpk8(qw, qv);
            float qt[8], kt[8];
#pragma unroll
            for (int e = 0; e < 8; ++e) { const float lfe = e < 4 ? lf0[e] : lf1[e - 4]; const float eb = __expf(bcum[e]);
                qt[e] = qv[e] * eb; kt[e] = (1.f - __expf(lfe)) * __expf(-bcum[e]);
                if (et == 31) ((LAS float*)(L + HG_G))[ek + e] = eb; }
            const u32x4 qp = pk8(qt), kp = pk8(kt);
            *(LAS u32x4*)(L + HG_QT + et * 272 + ek * 2) = qp;
            *(LAS u32x4*)(L + HG_KS + et * 320 + ek * 2) = kp;
            *(LAS u32x4*)(L + HG_V + et * 320 + ek * 2) = vw;
        }
        __syncthreads();
        if (wave == 0) {
            f32x16 pt;
#pragma unroll
            for (int i = 0; i < 16; ++i) pt[i] = 0.f;
#pragma unroll
            for (int st = 0; st < 8; ++st) { const bf16x8 a = *(const LAS bf16x8*)(L + HG_KS + r * 320 + (16 * st + 8 * hh) * 2), bq = *(const LAS bf16x8*)(L + HG_QT + r * 272 + (16 * st + 8 * hh) * 2);
                pt = MFMA32(a, bq, pt); }
#pragma unroll
            for (int i = 0; i < 16; ++i) if (crow(i, hh) > r) pt[i] = 0.f;
            *(LAS bf16x8*)(L + HG_PF + lane * 16) = pack_step(pt, 0); *(LAS bf16x8*)(L + HG_PF + 1024 + lane * 16) = pack_step(pt, 1);
        }
        f32x16 oacc;
#pragma unroll
        for (int i = 0; i < 16; ++i) oacc[i] = 0.f;
#pragma unroll
        for (int kbl = 0; kbl < 2; ++kbl)
#pragma unroll
            for (int s2 = 0; s2 < 2; ++s2) { const int k0 = 64 * kh + 32 * kbl + 16 * s2 + 4 * hh;
                const s16x4 lo = *(const LAS s16x4*)(L + HG_QT + r * 272 + k0 * 2), hi = *(const LAS s16x4*)(L + HG_QT + r * 272 + (k0 + 8) * 2);
                oacc = MFMA32(pack_step(S[kbl], s2), cat8(lo, hi), oacc); }
        __syncthreads();
        const int i16 = lane & 15, tq = i16 >> 2, tp = i16 & 3, gi = (lane >> 4) & 1;
        if (kh == 0) {
#pragma unroll
            for (int s2 = 0; s2 < 2; ++s2) { const int key0 = 16 * s2 + 4 * hh;
                const s16x4 lo = vtr(L + HG_V + (key0 + tq) * 320 + (32 * nb + 16 * gi + 4 * tp) * 2), hi = vtr(L + HG_V + (key0 + 8 + tq) * 320 + (32 * nb + 16 * gi + 4 * tp) * 2);
                const bf16x8 pf = *(const LAS bf16x8*)(L + HG_PF + s2 * 1024 + lane * 16);
                oacc = MFMA32(cat8(lo, hi), pf, oacc); }
        }
#pragma unroll
        for (int i4 = 0; i4 < 4; ++i4) { const f32x4 o4 = {oacc[4 * i4], oacc[4 * i4 + 1], oacc[4 * i4 + 2], oacc[4 * i4 + 3]};
            *(LAS f32x4*)(L + HG_OX + ((kh * 32 + r) * HG_OXP + 32 * nb + 8 * i4 + 4 * hh) * 4) = o4; }
#pragma unroll
        for (int kbl = 0; kbl < 2; ++kbl)
#pragma unroll
            for (int s2 = 0; s2 < 2; ++s2) { const int key0 = 16 * s2 + 8 * hh;
                const s16x4 alo = vtr(L + HG_KS + (key0 + tq) * 320 + (64 * kh + 32 * kbl + 16 * gi + 4 * tp) * 2), ahi = vtr(L + HG_KS + (key0 + 4 + tq) * 320 + (64 * kh + 32 * kbl + 16 * gi + 4 * tp) * 2);
                const s16x4 lo = vtr(L + HG_V + (key0 + tq) * 320 + (32 * nb + 16 * gi + 4 * tp) * 2), hi = vtr(L + HG_V + (key0 + 4 + tq) * 320 + (32 * nb + 16 * gi + 4 * tp) * 2);
                S[kbl] = MFMA32(cat8(alo, ahi), cat8(lo, hi), S[kbl]); }
#pragma unroll
        for (int kbl = 0; kbl < 2; ++kbl)
#pragma unroll
            for (int i = 0; i < 16; ++i) S[kbl][i] *= ((LAS float*)(L + HG_G))[64 * kh + 32 * kbl + crow(i, hh)];
        __syncthreads();
        { float o[8], ss = 0.f;
#pragma unroll
            for (int e4 = 0; e4 < 2; ++e4) { const f32x4 a4 = *(LAS f32x4*)(L + HG_OX + (et * HG_OXP + ek + 4 * e4) * 4), b4 = *(LAS f32x4*)(L + HG_OX + ((32 + et) * HG_OXP + ek + 4 * e4) * 4);
#pragma unroll
                for (int e = 0; e < 4; ++e) { o[4 * e4 + e] = a4[e] + b4[e]; ss += o[4 * e4 + e] * o[4 * e4 + e]; } }
            ss += __shfl_xor(ss, 1); ss += __shfl_xor(ss, 2); ss += __shfl_xor(ss, 4); ss += __shfl_xor(ss, 8);
            const float rstd = 1.f / sqrtf(ss * (1.f / 128.f) + RMS_EPS);
            float gv[8]; unpk8(gw, gv);
            const f32x4 g0 = *(const f32x4*)(gn + ek), g1 = *(const f32x4*)(gn + ek + 4);
#pragma unroll
            for (int e = 0; e < 8; ++e) { const float y = o[e] * rstd * (e < 4 ? g0[e] : g1[e - 4]); o[e] = y * (gv[e] / (1.f + __expf(-gv[e]))); }
            if (valid) *(u32x4*)(MIX + row * D + h * 128 + ek) = pk8(o);
        }
        lf0 = nlf0; lf1 = nlf1; qw = nqw; vw = nvw; gw = ngw;
    }
    { float* so = (SMP ? F.out + O_HS + (((size_t)m * SB + b) * NH + h) * 128 * 128 : F.out + O_HP + (((size_t)m * PB + b) * NH + h) * 128 * 128);
      const int l2 = opq(lane); float* sp = so + (size_t)(64 * kh + 4 * (l2 >> 5)) * 128 + 32 * nb + (l2 & 31);
#pragma unroll
      for (int kbl = 0; kbl < 2; ++kbl)
#pragma unroll
        for (int i = 0; i < 16; ++i) sp[(32 * kbl + (i & 3) + 8 * (i >> 2)) * 128] = S[kbl][i]; }
    __syncthreads();
}

constexpr int AT_KP = 272, AT_VP = 320;
constexpr int AT_KB = 64 * AT_KP, AT_VB = 64 * AT_VP;
constexpr int AT_TILE = AT_KB + AT_VB;
static_assert(4 * AT_TILE <= LDS_TAB && (8 * 66 * 64 + 64 * 64 + 8 * 64) * 4 <= LDS_TAB && 2 * AT_TILE + 8 * 2 * 32 * 144 <= LDS_TAB, "attention LDS");

__device__ __forceinline__ void attn_build_tab(Frame& F, int h) {
    const int tid = opq(F.tid);
    if (tid < 256) { const int rel = tid - 128, n = rel < 0 ? -rel : rel;
        int bk = n;
        if (n >= 8) bk = 8 + (n >= 12) + (n >= 16) + (n >= 23) + (n >= 32) + (n >= 46) + (n >= 64) + (n >= 91);
        if (rel > 0) bk += 16;
        ((LAS float*)(F.lds + LDS_TAB))[tid] = F.in[I_RB][bk * NH + h] * LOG2E; }
}
struct AttnState { f32x16 o[4]; float m, l; };
template <bool MASK_END>
__device__ __forceinline__ void attn_tile(const LAS unsigned char* Kt, const LAS unsigned char* Vt, int vh, const bf16x8 (&qf)[4], AttnState& A, int kpos0, int qpos, int qpos_min, int kv_end,
                                          const LAS float* tab, int r, int hh, int lane) {
    f32x16 st[2];
#pragma unroll
    for (int kb = 0; kb < 2; ++kb) {
#pragma unroll
        for (int i = 0; i < 16; ++i) st[kb][i] = 0.f;
#pragma unroll
        for (int s = 0; s < 4; ++s) { const bf16x8 a = *(const LAS bf16x8*)(Kt + (32 * kb + r) * AT_KP + (vh * 64 + 16 * s + 8 * hh) * 2); st[kb] = MFMA32(a, qf[s], st[kb]); }
    }
    constexpr float C2 = 0.125f * LOG2E;
    const bool far = (kpos0 + 63) <= (qpos_min - 91);
    if (far) { const float bc = tab[0]; const f32x2 c2 = {C2, C2}, b2 = {bc, bc};
#pragma unroll
        for (int kb = 0; kb < 2; ++kb)
#pragma unroll
            for (int j = 0; j < 8; ++j) { const f32x2 x = (f32x2){st[kb][2 * j], st[kb][2 * j + 1]} * c2 + b2; st[kb][2 * j] = x[0]; st[kb][2 * j + 1] = x[1]; }
    } else {
#pragma unroll
        for (int kb = 0; kb < 2; ++kb)
#pragma unroll
            for (int i = 0; i < 16; ++i) { const int kpos = kpos0 + 32 * kb + crow(i, hh); int rel = kpos - qpos; rel = rel < -128 ? -128 : (rel > 127 ? 127 : rel);
                float x = st[kb][i] * C2 + tab[rel + 128];
                if (MASK_END) x = (kpos < kv_end) ? x : -1e30f;
                st[kb][i] = x; }
    }
    float mx = st[0][0];
#pragma unroll
    for (int kb = 0; kb < 2; ++kb)
#pragma unroll
        for (int i = 0; i < 16; ++i) mx = fmaxf(mx, st[kb][i]);
    mx = fmaxf(mx, __shfl_xor(mx, 32));
    if (__any(mx > A.m + 8.f)) {
        const float mnew = fmaxf(A.m, mx), alpha = __builtin_amdgcn_exp2f(A.m - mnew);
        A.m = mnew; A.l *= alpha;
#pragma unroll
        for (int mb = 0; mb < 4; ++mb)
#pragma unroll
            for (int i = 0; i < 16; ++i) A.o[mb][i] *= alpha;
    }
    { const float off = -A.m; const f32x2 off2 = {off, off};
      f32x2 ls2 = {0.f, 0.f};
#pragma unroll
      for (int kb = 0; kb < 2; ++kb)
#pragma unroll
        for (int j = 0; j < 8; ++j) { const f32x2 x = (f32x2){st[kb][2 * j], st[kb][2 * j + 1]} + off2;
            const f32x2 p = {__builtin_amdgcn_exp2f(x[0]), __builtin_amdgcn_exp2f(x[1])};
            st[kb][2 * j] = p[0]; st[kb][2 * j + 1] = p[1]; ls2 += p; }
      A.l += ls2[0] + ls2[1]; }
    const int i16 = lane & 15, tq = i16 >> 2, tp = i16 & 3, gi = (lane >> 4) & 1;
#pragma unroll
    for (int kb = 0; kb < 2; ++kb)
#pragma unroll
        for (int s2 = 0; s2 < 2; ++s2) { const bf16x8 pf = pack_step(st[kb], s2); const int key0 = 32 * kb + 16 * s2 + 4 * hh;
#pragma unroll
            for (int mb = 0; mb < 4; ++mb) {
                const s16x4 lo = vtr(Vt + (key0 + tq) * AT_VP + (32 * mb + 16 * gi + 4 * tp) * 2), hi = vtr(Vt + (key0 + 8 + tq) * AT_VP + (32 * mb + 16 * gi + 4 * tp) * 2);
                A.o[mb] = MFMA32(cat8(lo, hi), pf, A.o[mb]); } }
}
__device__ __forceinline__ void attn_store(const f32x16 (&o)[4], const float* gnorm, float post, bf16_t* dst_row  , int hh, bool active) {
    float ss = 0.f;
#pragma unroll
    for (int mb = 0; mb < 4; ++mb)
#pragma unroll
        for (int i = 0; i < 16; ++i) ss += o[mb][i] * o[mb][i];
    ss += __shfl_xor(ss, 32);
    const float rstd = post / sqrtf(ss * (1.f / 128.f) + RMS_EPS);
    if (active) {
#pragma unroll
        for (int mb = 0; mb < 4; ++mb)
#pragma unroll
            for (int g4 = 0; g4 < 4; ++g4) { const int dv = 32 * mb + 8 * g4 + 4 * hh; const f32x4 gv = *(const f32x4*)(gnorm + dv);
                u32x2 w; w.x = pk2(o[mb][4 * g4] * rstd * gv[0], o[mb][4 * g4 + 1] * rstd * gv[1]); w.y = pk2(o[mb][4 * g4 + 2] * rstd * gv[2], o[mb][4 * g4 + 3] * rstd * gv[3]);
                *(u32x2*)(dst_row + dv) = w; }
    }
}

__device__ __forceinline__ void attn_prompt_unit(Frame& F, int m, int b, int h, int qb) {
    LAS unsigned char* L = F.lds; const LAS float* tab = (const LAS float*)(L + LDS_TAB);
    const bf16_t* H = (const bf16_t*)(F.ws + WS_H); bf16_t* MIX = (bf16_t*)(F.ws + WS_MIX);
    const int tid = opq(F.tid), lane = tid & 63, wave = __builtin_amdgcn_readfirstlane(tid >> 6), r = lane & 31, hh = lane >> 5, vh = wave >> 2, wq = wave & 3;
    const size_t rowb = (size_t)b * PT;
    const int q0a = qb * 256 + wq * 32, q0b = q0a + 128, qca = q0a >> 6, qcb = q0b >> 6, nkt = 4 * qb + 4;
    attn_build_tab(F, h);
    LAS unsigned char* qs = L + 2 * AT_TILE + wave * (2 * 32 * 144) + r * 144 + 16 * hh;
#pragma unroll
    for (int s = 0; s < 4; ++s) { *(LAS bf16x8*)(qs + 32 * s) = *(const bf16x8*)(H + (rowb + q0a + r) * INC + C_BQ + h * 128 + vh * 64 + 16 * s + 8 * hh);
        *(LAS bf16x8*)(qs + 32 * 144 + 32 * s) = *(const bf16x8*)(H + (rowb + q0b + r) * INC + C_BQ + h * 128 + vh * 64 + 16 * s + 8 * hh); }
    AttnState A0, A1;
#pragma unroll
    for (int mb = 0; mb < 4; ++mb)
#pragma unroll
        for (int i = 0; i < 16; ++i) { A0.o[mb][i] = 0.f; A1.o[mb][i] = 0.f; }
    A0.m = -1e30f; A0.l = 0.f; A1.m = -1e30f; A1.l = 0.f;
    u32x4 kr[2], vr[2];
#define AT_LD(kt) do { _Pragma("unroll") for (int i_ = 0; i_ < 2; ++i_) { const int c_ = tid + 512 * i_, key_ = c_ >> 4, ch_ = c_ & 15; const bf16_t* src_ = H + (rowb + 64 * (kt) + key_) * INC + h * 128 + ch_ * 8; \
        kr[i_] = *(const u32x4*)(src_ + C_BK); vr[i_] = *(const u32x4*)(src_ + C_BV); } } while (0)
#define AT_ST(buf) do { _Pragma("unroll") for (int i_ = 0; i_ < 2; ++i_) { const int c_ = tid + 512 * i_, key_ = c_ >> 4, ch_ = c_ & 15; \
        *(LAS u32x4*)(L + (buf) * AT_TILE + key_ * AT_KP + ch_ * 16) = kr[i_]; *(LAS u32x4*)(L + (buf) * AT_TILE + AT_KB + key_ * AT_VP + ch_ * 16) = vr[i_]; } } while (0)
    AT_LD(0); AT_ST(0);
    AT_LD(1);
    __syncthreads();
    for (int kt = 0; kt < nkt; ++kt) {
        if (kt <= qca) { bf16x8 qf[4];
#pragma unroll
            for (int s = 0; s < 4; ++s) qf[s] = *(const LAS bf16x8*)(qs + 32 * s);
            attn_tile<false>(L + (kt & 1) * AT_TILE, L + (kt & 1) * AT_TILE + AT_KB, vh, qf, A0, 64 * kt, q0a + r, q0a, 0, tab, r, hh, lane); }
        if (kt <= qcb) { bf16x8 qf[4];
#pragma unroll
            for (int s = 0; s < 4; ++s) qf[s] = *(const LAS bf16x8*)(qs + 32 * 144 + 32 * s);
            attn_tile<false>(L + (kt & 1) * AT_TILE, L + (kt & 1) * AT_TILE + AT_KB, vh, qf, A1, 64 * kt, q0b + r, q0b, 0, tab, r, hh, lane); }
        if (kt + 1 < nkt) AT_ST((kt + 1) & 1);
        if (kt + 2 < nkt) AT_LD(kt + 2);
        __syncthreads();
    }
#undef AT_LD
#undef AT_ST
    { const float l0 = A0.l + __shfl_xor(A0.l, 32), i0 = 1.f / l0, l1 = A1.l + __shfl_xor(A1.l, 32), i1 = 1.f / l1;
#pragma unroll
        for (int mb = 0; mb < 4; ++mb)
#pragma unroll
            for (int i = 0; i < 16; ++i) { A0.o[mb][i] *= i0; A1.o[mb][i] *= i1; } }
    LAS float* X = (LAS float*)L;
    if (vh == 1) {
#pragma unroll
        for (int mb = 0; mb < 4; ++mb)
#pragma unroll
            for (int i = 0; i < 16; ++i) { X[(wq * 64 + mb * 16 + i) * 64 + lane] = A0.o[mb][i]; X[((4 + wq) * 64 + mb * 16 + i) * 64 + lane] = A1.o[mb][i]; }
    }
    __syncthreads();
    if (vh == 0) {
        const float lam = ((const float*)(F.ws + WS_TAB))[TB_LAM + m];
        const float lam_init = (m == 0) ? 0.2f : 0.47071302f;
#pragma unroll
        for (int mb = 0; mb < 4; ++mb)
#pragma unroll
            for (int i = 0; i < 16; ++i) A0.o[mb][i] -= lam * X[(wq * 64 + mb * 16 + i) * 64 + lane];
        attn_store(A0.o, F.in[I_DNG] + (size_t)m * 128, 1.f - lam_init, MIX + (rowb + q0a + r) * D + 512 + h * 128, hh, true);
#pragma unroll
        for (int mb = 0; mb < 4; ++mb)
#pragma unroll
            for (int i = 0; i < 16; ++i) A1.o[mb][i] -= lam * X[((4 + wq) * 64 + mb * 16 + i) * 64 + lane];
        attn_store(A1.o, F.in[I_DNG] + (size_t)m * 128, 1.f - lam_init, MIX + (rowb + q0b + r) * D + 512 + h * 128, hh, true);
    }
    __syncthreads();
}

__device__ __forceinline__ void attn_sample_unit(Frame& F, int m, int b, int h) {
    LAS unsigned char* L = F.lds; const LAS float* tab = (const LAS float*)(L + LDS_TAB);
    const bf16_t* H = (const bf16_t*)(F.ws + WS_H); bf16_t* MIX = (bf16_t*)(F.ws + WS_MIX);
    const float* ck = F.in[I_CK] + (((size_t)m * SB + b) * PAST) * 512 + h * 128; const float* cv = F.in[I_CV] + (((size_t)m * SB + b) * PAST) * 512 + h * 128;
    const int tid = opq(F.tid), lane = tid & 63, wave = __builtin_amdgcn_readfirstlane(tid >> 6), r = lane & 31, hh = lane >> 5, vh = wave >> 2, ks = wave & 3;
    const size_t rows = (size_t)MP + (size_t)b * ST;
    attn_build_tab(F, h);
    bf16x8 qf[4];
#pragma unroll
    for (int s = 0; s < 4; ++s) qf[s] = *(const bf16x8*)(H + (rows + (r & 15)) * INC + C_BQ + h * 128 + vh * 64 + 16 * s + 8 * hh);
    AttnState A;
#pragma unroll
    for (int mb = 0; mb < 4; ++mb)
#pragma unroll
        for (int i = 0; i < 16; ++i) A.o[mb][i] = 0.f;
    A.m = -1e30f; A.l = 0.f;
    constexpr int NT = PAST / 64 + 1;
    for (int it = 0; it < (NT + 3) / 4; ++it) {
#pragma unroll 1
        for (int j = 0; j < 4; ++j) { const int T = 4 * it + j;
#pragma unroll
            for (int i = 0; i < 2; ++i) { const int c = tid + 512 * i, key = c >> 4, ch = c & 15;
                u32x4 kw = {0u, 0u, 0u, 0u}, vw = {0u, 0u, 0u, 0u};
                if (T < PAST / 64) { const float* pk = ck + (size_t)(64 * T + key) * 512 + ch * 8; const float* pv = cv + (size_t)(64 * T + key) * 512 + ch * 8;
                    const f32x4 k0 = *(const f32x4*)pk, k1 = *(const f32x4*)(pk + 4), v0 = *(const f32x4*)pv, v1 = *(const f32x4*)(pv + 4);
                    kw.x = pk2(k0[0], k0[1]); kw.y = pk2(k0[2], k0[3]); kw.z = pk2(k1[0], k1[1]); kw.w = pk2(k1[2], k1[3]);
                    vw.x = pk2(v0[0], v0[1]); vw.y = pk2(v0[2], v0[3]); vw.z = pk2(v1[0], v1[1]); vw.w = pk2(v1[2], v1[3]); }
                else if (T == PAST / 64 && key < ST) { const bf16_t* src = H + (rows + key) * INC + h * 128 + ch * 8; kw = *(const u32x4*)(src + C_BK); vw = *(const u32x4*)(src + C_BV); }
                *(LAS u32x4*)(L + j * AT_TILE + key * AT_KP + ch * 16) = kw; *(LAS u32x4*)(L + j * AT_TILE + AT_KB + key * AT_VP + ch * 16) = vw; } }
        __syncthreads();
        { const int T = 4 * it + ks;
            if (T < NT - 1) attn_tile<false>(L + ks * AT_TILE, L + ks * AT_TILE + AT_KB, vh, qf, A, 64 * T, PAST + (r & 15), PAST, 0, tab, r, hh, lane);
            else if (T == NT - 1) attn_tile<true>(L + ks * AT_TILE, L + ks * AT_TILE + AT_KB, vh, qf, A, 64 * T, PAST + (r & 15), PAST, PAST + ST, tab, r, hh, lane); }
        __syncthreads();
    }
    const float lt = A.l + __shfl_xor(A.l, 32);
    LAS float* X = (LAS float*)L;
#pragma unroll
    for (int mb = 0; mb < 4; ++mb)
#pragma unroll
        for (int i = 0; i < 16; ++i) X[(wave * 66 + mb * 16 + i) * 64 + lane] = A.o[mb][i];
    X[(wave * 66 + 64) * 64 + lane] = A.m; X[(wave * 66 + 65) * 64 + lane] = lt;
    LAS float* Y = X + 8 * 66 * 64;
    LAS float* SS = Y + 64 * 64;
    __syncthreads();
    {
        const float lam = ((const float*)(F.ws + WS_TAB))[TB_LAM + m];
        float coef[8];
#pragma unroll
        for (int v2 = 0; v2 < 2; ++v2) {
            float M = -1e30f;
#pragma unroll
            for (int k = 0; k < 4; ++k) M = fmaxf(M, X[((v2 * 4 + k) * 66 + 64) * 64 + lane]);
            float Ls = 0.f;
#pragma unroll
            for (int k = 0; k < 4; ++k) { coef[v2 * 4 + k] = __builtin_amdgcn_exp2f(X[((v2 * 4 + k) * 66 + 64) * 64 + lane] - M); Ls += coef[v2 * 4 + k] * X[((v2 * 4 + k) * 66 + 65) * 64 + lane]; }
            const float sc = (v2 == 0 ? 1.f : -lam) / Ls;
#pragma unroll
            for (int k = 0; k < 4; ++k) coef[v2 * 4 + k] *= sc;
        }
        float ss = 0.f;
#pragma unroll
        for (int i8 = 0; i8 < 8; ++i8) { const int row = 8 * wave + i8; float y = 0.f;
#pragma unroll
            for (int p = 0; p < 8; ++p) y += coef[p] * X[(p * 66 + row) * 64 + lane];
            Y[row * 64 + lane] = y; ss += y * y; }
        SS[wave * 64 + lane] = ss;
    }
    __syncthreads();
    if (wave == 0) {
        float ss = 0.f;
#pragma unroll
        for (int w = 0; w < 8; ++w) ss += SS[w * 64 + lane];
        ss += __shfl_xor(ss, 32);
        const float lam_init = (m == 0) ? 0.2f : 0.47071302f;
        const float rstd = (1.f - lam_init) / sqrtf(ss * (1.f / 128.f) + RMS_EPS);
        const float* gnorm = F.in[I_DNG] + (size_t)m * 128;
        bf16_t* dst_row = MIX + (rows + (r & 15)) * D + 512 + h * 128;
        if (r < ST) {
#pragma unroll
            for (int mb = 0; mb < 4; ++mb)
#pragma unroll
                for (int g4 = 0; g4 < 4; ++g4) { const int dv = 32 * mb + 8 * g4 + 4 * hh; const f32x4 gv = *(const f32x4*)(gnorm + dv); const LAS float* yp = Y + (mb * 16 + 4 * g4) * 64 + lane;
                    u32x2 w; w.x = pk2(yp[0] * rstd * gv[0], yp[64] * rstd * gv[1]); w.y = pk2(yp[128] * rstd * gv[2], yp[192] * rstd * gv[3]);
                    *(u32x2*)(dst_row + dv) = w; }
        }
    }
    __syncthreads();
}

__device__ __forceinline__ void phase_mixer(Frame& F, int m, int qsel = 0) {
    const int G = F.G, bid = F.bid;
    if (PHM & 0x1000) for (int u = bid; u < PB * NH; u += G) hgrn_unit<false>(F, m, u >> 2, u & 3);
#if PROBE_HG
    for (int u = bid; u < PB * NH; u += G) hgrn_unit<false>(F, m, u >> 2, u & 3);
#endif
    if (PHM & 0x2000) for (int u = (G >= 256 ? (bid >= 128 ? bid - 128 : bid + G - 128) : bid); u < SB * NH; u += G) attn_sample_unit(F, m, u >> 2, u & 3);
#if PROBE_SA
    for (int u = (G >= 256 ? (bid >= 128 ? bid - 128 : bid + G - 128) : bid); u < SB * NH; u += G) attn_sample_unit(F, m, u >> 2, u & 3);
#endif
    if (PHM & 0x4000) {
        gu32* head = (gu32*)(F.ws + WS_CTL) + CW_QUEUE + 64 * m + 128 * qsel;
        volatile LAS int* slot = (volatile LAS int*)(F.lds + LDS_CTRL + 64);
        for (;;) {
            if (F.tid == 0) *slot = (int)__hip_atomic_fetch_add(head, 1u, __ATOMIC_RELAXED, __HIP_MEMORY_SCOPE_AGENT);
            __syncthreads();
            const int u = *slot;
            __syncthreads();
            if (u >= PB * NH * 8) break;
            const int qb = 7 - (u >> 7), bh = u & 127;
            attn_prompt_unit(F, m, bh >> 2, bh & 3, qb);
        }
    }
    if (PHM & 0x8000) for (int u = bid; u < SB * NH; u += G) hgrn_unit<true>(F, m, u >> 2, u & 3);
}

__global__ void __launch_bounds__(NTHREADS, 2) mega_fwd(Args args) {
    extern __shared__ __attribute__((aligned(16))) unsigned char lds_raw[];
    Frame F;
    F.lds = (LAS unsigned char*)lds_raw;
    F.tid = threadIdx.x; F.lane = F.tid & 63; F.wave = __builtin_amdgcn_readfirstlane(F.tid >> 6);
    const int wave_s = F.wave;
    F.bid = blockIdx.x; F.G = gridDim.x; F.in = (kin_t)__builtin_amdgcn_kernarg_segment_ptr(); F.out = (float*)F.in[24]; F.ws = (unsigned char*)F.in[25];
    if (F.tid < 128) ((LAS unsigned*)(F.lds + LDS_CTRL))[F.tid] = 0u;
    __syncthreads();
    unsigned* barw = (unsigned*)(F.ws + WS_CTL) + CW_BAR;
    XcdBarrier bar; bar.bar = barw; bar.x = 0; bar.st = nullptr;
    const bool single = args.single != 0;
    if (single) bar = xcd_barrier_post(barw, (volatile LAS unsigned*)(F.lds + LDS_CTRL + 32));
    const int lo = args.ph_lo, hi = args.ph_hi;
#define RUN(p) (lo <= (p) && (p) < hi)
#define SEAM() do { if (single) { XcdBarrier b2_ = bar; asm volatile("" : "+s"(b2_.bar)); xcd_barrier(b2_); } } while (0)
#define REFRESH() do { { int b_ = (int)blockIdx.x, g_ = (int)gridDim.x; asm volatile("" : "+s"(b_), "+s"(g_)); F.bid = b_; F.G = g_; } { kin_t kp_ = (kin_t)__builtin_amdgcn_kernarg_segment_ptr(); asm volatile("" : "+s"(kp_)); F.in = kp_; F.out = (float*)kp_[24]; F.ws = (unsigned char*)kp_[25]; } { int l_; asm volatile("v_mbcnt_lo_u32_b32 %0, -1, 0\n\tv_mbcnt_hi_u32_b32 %0, -1, %0" : "=v"(l_)); F.lane = l_; } F.wave = wave_s; F.tid = wave_s * 64 + F.lane; } while (0)
    int ph = 0;
    if ((PHM & 1) && RUN(ph)) { REFRESH(); phase_prologue(F); SEAM();
#if PROBE_PRO
        REFRESH(); phase_prologue(F); SEAM();
#endif
    } ++ph;
    for (int l = 0; l < 4; ++l) {
#define WSB(off) ((bf16_t*)(F.ws + (off)))
#define STATS(k) ((float*)(F.ws + WS_CTL) + CW_STATS + (size_t)(k) * MT * 2)
#define LN1REF(ll) LnRef{WSB(WS_Z), STATS(2 * (ll)), F.in[I_L1G] + (size_t)(ll) * D, F.in[I_L1B] + (size_t)(ll) * D, 0}
#define LN2REF(ll) LnRef{WSB(WS_ZB), STATS(2 * (ll) + 1), F.in[I_L2G] + (size_t)(ll) * D, F.in[I_L2B] + (size_t)(ll) * D, 0}
        if ((l & 1) == 0) {
            const int m = l >> 1;
            if ((PHM & 2) && RUN(ph)) {
                REFRESH();
                const float* ctlf = (const float*)(F.ws + WS_CTL);
                pg8::Gemm g{l == 0 ? WSB(WS_XB) : WSB(WS_ZB), (const bf16_t*)(F.ws + WS_WIN) + (size_t)m * INC * D, MP, INC, D, D, 0, l == 0 ? nullptr : STATS(2 * (l - 1) + 1)}; pg8::StaticOrder S; S.init(MP, INC, F.G, F.bid);
                EpiIn E{(bf16_t*)(F.ws + WS_H), (float*)(F.ws + WS_LF), (const float*)(F.ws + WS_TAB) + TB_LB + m * 512,
                        F.out + O_KP + (size_t)m * MP * 512, F.out + O_VP + (size_t)m * MP * 512, F.out + O_KS + (size_t)m * MS * 512, F.out + O_VS + (size_t)m * MS * 512,
                        STATS(l == 0 ? 0 : 2 * (l - 1) + 1), ctlf + (l == 0 ? UC_ZERO : UC_UIN), ctlf + (l == 0 ? UC_ZERO : UC_CIN), l == 0 ? 1 : 0};
                pg8::gemm_phase<EpiIn>(F.lds, g, S, E, F.tid);
                REFRESH(); sgemm_in_phase(F.lds, g.A + (size_t)MP * D, g.Bt, F.bid, F.G, F.tid, E);
                SEAM(); } ++ph;
            if ((PHM & 4) && RUN(ph)) { REFRESH(); phase_mixer(F, m); SEAM();
#if PROBE_MIXER
                REFRESH(); phase_mixer(F, m, 1); SEAM();
#endif
            } ++ph;
            if ((PHM & 8) && RUN(ph)) {
                REFRESH();
                pg8::Gemm g{(const bf16_t*)(F.ws + WS_MIX), (const bf16_t*)(F.ws + WS_WOUT) + (size_t)m * D * D, MP, D, D, D, 0, l == 0 ? nullptr : STATS(2 * (l - 1) + 1)}; pg8::StaticOrder S; S.init(MP, D, F.G, F.bid);
                LnRef P = LN2REF(l == 0 ? 0 : l - 1); if (l == 0) { P.Z = WSB(WS_XB); P.ident = 1; }
                EpiRes E{P, WSB(WS_Z), STATS(2 * l), nullptr};
                pg8::gemm_phase<EpiRes>(F.lds, g, S, E, F.tid);
                REFRESH(); sgemm_res_phase<128>(F.lds, g.A + (size_t)MP * D, D, 0, g.Bt, D, F.bid, F.G, F.tid, P, WSB(WS_Z), STATS(2 * l), nullptr);
                SEAM(); } ++ph;
        } else {
            const int p = l >> 1;
            if ((PHM & 16) && RUN(ph)) { REFRESH(); const LnRef R = LN2REF(l - 1); phase_pool_prep(F, R, p); SEAM(); } ++ph;
            ++ph;
            if ((PHM & 32) && RUN(ph)) {
                REFRESH();
                pg8::Gemm g{(const bf16_t*)(F.ws + WS_MIX), (const bf16_t*)(F.ws + WS_WPOOL) + (size_t)p * D * 256, MP, D, 256, D, 256, STATS(2 * (l - 1) + 1)}; pg8::StaticOrder S; S.init(MP, D, F.G, F.bid);
                EpiRes E{LN2REF(l - 1), WSB(WS_Z), STATS(2 * l), F.in[I_PSC] + (size_t)p * D};
                pg8::gemm_phase<EpiRes>(F.lds, g, S, E, F.tid);
                REFRESH(); { const LnRef P2 = LN2REF(l - 1); sgemm_res_phase<32>(F.lds, g.A + (size_t)MP * D, D, 256, g.Bt, 256, F.bid, F.G, F.tid, P2, WSB(WS_Z), STATS(2 * l), E.scale); }
                SEAM(); } ++ph;
        }
        ++ph;
        if ((PHM & 128) && RUN(ph)) {
            REFRESH();
            const float* ctlf = (const float*)(F.ws + WS_CTL);
            pg8::Gemm g{WSB(WS_Z), (const bf16_t*)(F.ws + WS_WUP) + (size_t)l * UPN * D, MT, UPN, D, D, 0, STATS(2 * l)}; pg8::StaticOrder S; S.init(MT, UPN, F.G, F.bid);
            EpiUpConv E{(bf16_t*)(F.ws + WS_G), F.in[I_CW] + (size_t)l * 3 * DFF, F.in[I_CB] + (size_t)l * DFF, F.in[I_SC] + (size_t)l * SB * 2 * DFF,
                        (float*)(F.ws + WS_AHEAD), (float*)(F.ws + WS_BHEAD), (float*)(F.ws + WS_ATAIL), F.out + O_CP + (size_t)l * PB * 2 * DFF, F.out + O_CS + (size_t)l * SB * 2 * DFF, (LAS float*)(F.lds + LDS_EX),
                        STATS(2 * l), ctlf + UC_UUP + (size_t)l * UPN, ctlf + UC_CUP + (size_t)l * UPN};
            pg8::gemm_phase<EpiUpConv>(F.lds, g, S, E, F.tid); SEAM();
#if PROBE_UP
            REFRESH(); pg8::gemm_phase<EpiUpConv>(F.lds, g, S, E, F.tid); SEAM();
#endif
            } ++ph;
        ++ph;
        if ((PHM & 512) && RUN(ph)) {
            REFRESH();
            pg8::Gemm g{(const bf16_t*)(F.ws + WS_G), (const bf16_t*)(F.ws + WS_WDN) + (size_t)l * D * DFF, MP, D, DFF, DFF, 0, STATS(2 * l)}; pg8::StaticOrder S; S.init(MP, D, F.G, F.bid);
            conv_fix_local(F, l, S); REFRESH();
            EpiRes E{LN1REF(l), WSB(WS_ZB), STATS(2 * l + 1), nullptr};
            pg8::gemm_phase<EpiRes>(F.lds, g, S, E, F.tid);
            REFRESH(); { const LnRef P1 = LN1REF(l); sgemm_res_phase<352>(F.lds, g.A + (size_t)MP * DFF, DFF, 0, g.Bt, DFF, F.bid, F.G, F.tid, P1, WSB(WS_ZB), STATS(2 * l + 1), nullptr); }
            SEAM(); } ++ph;
        if ((PHM & 1024) && RUN(ph) && l == 3) { REFRESH(); phase_ln_final(F, WSB(WS_ZB), F.in[I_L2G] + (size_t)3 * D, F.in[I_L2B] + (size_t)3 * D); } ++ph;
    }
#undef RUN
#undef SEAM
}
constexpr int N_PHASES = 1 + 4 * 8;

extern "C" void kernel_launch(void* const* d_in, const int* in_sizes, int n_in, void* d_out, int out_size, void* d_ws, size_t ws_size, hipStream_t stream) {
    static int grid = 0;
    if (grid == 0) {
        if (n_in != 24 || (size_t)out_size != O_END || ws_size < WS_END2) { fprintf(stderr, "kernel_launch: unexpected problem (n_in %d out %d ws %zu)\n", n_in, out_size, ws_size); grid = -1; return; }
        int dev = 0, cus = 0;
        if (hipGetDevice(&dev) != hipSuccess || hipDeviceGetAttribute(&cus, hipDeviceAttributeMultiprocessorCount, dev) != hipSuccess) { grid = -1; return; }
        if (hipFuncSetAttribute((const void*)mega_fwd, hipFuncAttributeMaxDynamicSharedMemorySize, LDS_BYTES) != hipSuccess) { fprintf(stderr, "kernel_launch: hipFuncSetAttribute failed\n"); grid = -1; return; }
        int per_cu = 0;
        if (hipOccupancyMaxActiveBlocksPerMultiprocessor(&per_cu, (const void*)mega_fwd, NTHREADS, LDS_BYTES) != hipSuccess || per_cu < 1) fprintf(stderr, "kernel_launch: occupancy query reports %d\n", per_cu);
        (void)hipGetLastError();
        grid = cus;
    }
    if (grid < 0) return;
    (void)hipMemsetAsync((char*)d_ws + WS_CTL, 0, CTL_ZERO_BYTES, stream);
    Args a{};
    for (int i = 0; i < 24; ++i) a.in[i] = (const float*)d_in[i];
    a.out = (float*)d_out; a.ws = (unsigned char*)d_ws; a.pad = 0;
#if MK_SINGLE
    a.ph_lo = 0; a.ph_hi = N_PHASES; a.single = 1;
    hipLaunchKernelGGL(mega_fwd, dim3(grid), dim3(NTHREADS), LDS_BYTES, stream, a);
#else
    for (int p = 0; p < N_PHASES; ++p) {
        const int k = (p - 1) % 8, l = (p - 1) / 8;
        if (p > 0 && (l & 1) == 1 && k == 1) continue;
        a.ph_lo = p; a.ph_hi = p + 1; a.single = 0;
        hipLaunchKernelGGL(mega_fwd, dim3(grid), dim3(NTHREADS), LDS_BYTES, stream, a);
    }
#endif
}
```

```cpp
#include <hip/hip_runtime.h>
#include <cstdio>
#include <cstdint>

#ifndef PHM
#define PHM 0xffff
#endif
#ifndef PROBE_MIXER
#define PROBE_MIXER 0
#endif
#ifndef EMU_BF16
#define EMU_BF16 0
#endif
#ifndef PROBE_LN
#define PROBE_LN 0
#endif
#ifndef PROBE_PRO
#define PROBE_PRO 0
#endif
#ifndef PROBE_HG
#define PROBE_HG 0
#endif
#ifndef PROBE_SA
#define PROBE_SA 0
#endif
#ifndef PROBE_UP
#define PROBE_UP 0
#endif
#ifndef MK_SINGLE
#define MK_SINGLE 1
#endif

#define LAS __attribute__((address_space(3)))
#define GAS __attribute__((address_space(1)))
typedef unsigned short bf16_t;
typedef short bf16x8 __attribute__((ext_vector_type(8)));
typedef short s16x4 __attribute__((ext_vector_type(4)));
typedef float f32x2 __attribute__((ext_vector_type(2)));
typedef float f32x4 __attribute__((ext_vector_type(4)));
typedef float f32x16 __attribute__((ext_vector_type(16)));
typedef unsigned u32x2 __attribute__((ext_vector_type(2)));
typedef unsigned u32x4 __attribute__((ext_vector_type(4)));
typedef __bf16 bf16x2_t __attribute__((ext_vector_type(2)));
typedef GAS unsigned gu32;

constexpr int D = 1024, PB = 32, PT = 2048, SB = 32, ST = 16, PAST = 4096;
constexpr int MP = PB * PT, MS = SB * ST, MT = MP + MS;
constexpr int INC = 3584, DFF = 2816, UPN = 2 * DFF, NH = 4;
constexpr int C_AQ = 0, C_AF = 512, C_AI = 1024, C_AG = 1536, C_BQ = 2048, C_BK = 2560, C_BV = 3072;
constexpr float DN_ALPHA = 1.681792830507429f;
constexpr float LN_EPS = 1e-5f, RMS_EPS = 1e-6f;
constexpr float LOG2E = 1.4426950408889634f;
constexpr int NWAVES = 8, NTHREADS = 512;

constexpr size_t O_YP = 0;
constexpr size_t O_YS = O_YP + (size_t)MP * D;
constexpr size_t O_KP = O_YS + (size_t)MS * D;
constexpr size_t O_VP = O_KP + (size_t)2 * MP * 512;
constexpr size_t O_HP = O_VP + (size_t)2 * MP * 512;
constexpr size_t O_PP = O_HP + (size_t)2 * PB * NH * 128 * 128;
constexpr size_t O_CP = O_PP + (size_t)2 * PB * 15 * D;
constexpr size_t O_KS = O_CP + (size_t)4 * PB * 2 * DFF;
constexpr size_t O_VS = O_KS + (size_t)2 * MS * 512;
constexpr size_t O_HS = O_VS + (size_t)2 * MS * 512;
constexpr size_t O_PS = O_HS + (size_t)2 * SB * NH * 128 * 128;
constexpr size_t O_CS = O_PS + (size_t)2 * SB * 15 * D;
constexpr size_t O_END = O_CS + (size_t)4 * SB * 2 * DFF;
static_assert(O_END == 214695936ull, "d_out size");

constexpr size_t WS_CTL = 0, CTL_ZERO_BYTES = 8u << 20;
constexpr size_t WS_WIN = CTL_ZERO_BYTES;
constexpr size_t WS_WOUT = WS_WIN + (size_t)2 * INC * D * 2;
constexpr size_t WS_WPOOL = WS_WOUT + (size_t)2 * D * D * 2;
constexpr size_t WS_WUP = WS_WPOOL + (size_t)2 * D * 256 * 2;
constexpr size_t WS_WDN = WS_WUP + (size_t)4 * UPN * D * 2;
constexpr size_t WS_TAB = WS_WDN + (size_t)4 * D * DFF * 2;
constexpr size_t WS_XB = WS_TAB + 65536;
constexpr size_t WS_Z = WS_XB + (size_t)MT * D * 2;
constexpr size_t WS_ZB = WS_Z + (size_t)MT * D * 2;
constexpr size_t WS_MIX = WS_Z + (size_t)MT * D * 4;
constexpr size_t WS_G = WS_MIX + (size_t)MT * D * 2;
constexpr size_t WS_A = WS_G + (size_t)MT * DFF * 2;
constexpr size_t WS_H = WS_A;
constexpr size_t WS_LF = WS_H + (size_t)MT * INC * 2;
constexpr size_t WS_AB = WS_A;
constexpr size_t WS_END = WS_A + (size_t)MT * UPN * 2;
static_assert(WS_LF + (size_t)MT * 512 * 4 <= WS_END, "H|LF inside region A");
constexpr size_t SIDE_BYTES = (size_t)(MT / 256) * 2 * DFF * 4;
constexpr size_t WS_AHEAD = WS_END, WS_BHEAD = WS_AHEAD + SIDE_BYTES, WS_ATAIL = WS_BHEAD + SIDE_BYTES, WS_END2 = WS_ATAIL + SIDE_BYTES;
static_assert(WS_END2 <= 2147483648ull, "workspace");
constexpr int CW_TMO = 0;
constexpr int CW_BAR = 4096;
constexpr int CW_QUEUE = 16384;
constexpr int CW_STATS = 262144;
constexpr int CW_UC = CW_STATS + 8 * MT * 2;
constexpr int UC_UUP = CW_UC, UC_CUP = UC_UUP + 4 * UPN, UC_UIN = UC_CUP + 4 * UPN, UC_CIN = UC_UIN + INC, UC_ZERO = UC_CIN + INC, UC_END = UC_ZERO + INC;
static_assert((size_t)UC_END * 4 <= CTL_ZERO_BYTES, "zeroed region");
constexpr int TB_LB = 0;
constexpr int TB_LAM = 1024;

constexpr int LDS_BYTES = 163840;
constexpr int LDS_CTRL = LDS_BYTES - 512;
constexpr int LDS_TAB = LDS_CTRL - 1024;
constexpr int LDS_STT = 131072 + 4096;
constexpr int LDS_CT = 131072 + 8192;
constexpr int LDS_EX = 131072;

__device__ __forceinline__ unsigned pk2(float lo, float hi) { f32x2 v = {lo, hi}; bf16x2_t b = __builtin_convertvector(v, bf16x2_t); return __builtin_bit_cast(unsigned, b); }
__device__ __forceinline__ float bflo(unsigned u) { return __builtin_bit_cast(float, u << 16); }
__device__ __forceinline__ float bfhi(unsigned u) { return __builtin_bit_cast(float, u & 0xffff0000u); }
__device__ __forceinline__ u32x4 pk8(const float* v) { u32x4 w; w.x = pk2(v[0], v[1]); w.y = pk2(v[2], v[3]); w.z = pk2(v[4], v[5]); w.w = pk2(v[6], v[7]); return w; }
__device__ __forceinline__ void unpk8(u32x4 w, float* v) { v[0] = bflo(w.x); v[1] = bfhi(w.x); v[2] = bflo(w.y); v[3] = bfhi(w.y); v[4] = bflo(w.z); v[5] = bfhi(w.z); v[6] = bflo(w.w); v[7] = bfhi(w.w); }
__device__ __forceinline__ int opq(int x) { asm volatile("" : "+v"(x)); return x; }
__device__ __forceinline__ int lane_id_v() { int l_; asm volatile("v_mbcnt_lo_u32_b32 %0, -1, 0\n\tv_mbcnt_hi_u32_b32 %0, -1, %0" : "=v"(l_)); return l_; }
__device__ __forceinline__ float shx_lb(float v, int lb4, int m) { return __builtin_bit_cast(float, __builtin_amdgcn_ds_bpermute(lb4 ^ (m << 2), __builtin_bit_cast(int, v))); }
__device__ __forceinline__ float shx(float v, int m) { return shx_lb(v, lane_id_v() << 2, m); }
__device__ __forceinline__ float wave_sum(float v) { const int lb = lane_id_v() << 2;
#pragma unroll
    for (int o = 1; o < 64; o <<= 1) v += shx_lb(v, lb, o);
    return v; }
__device__ __forceinline__ float silu_mul(float c, float b) { return c * __builtin_amdgcn_rcpf(1.f + __builtin_amdgcn_exp2f(-LOG2E * c)) * b; }
__device__ __forceinline__ int crow(int reg, int h) { return (reg & 3) + 8 * (reg >> 2) + 4 * h; }
__device__ __forceinline__ s16x4 vtr(const LAS unsigned char* p) { return __builtin_bit_cast(s16x4, __builtin_amdgcn_ds_read_tr16_b64_v4i16((LAS s16x4*)p)); }
__device__ __forceinline__ bf16x8 cat8(s16x4 lo, s16x4 hi) { return (bf16x8){lo[0], lo[1], lo[2], lo[3], hi[0], hi[1], hi[2], hi[3]}; }
#define MFMA32(a, b, c) __builtin_amdgcn_mfma_f32_32x32x16_bf16((a), (b), (c), 0, 0, 0)
__device__ __forceinline__ bf16x8 pack_step(const f32x16& x, int s) {
    u32x4 p; p.x = pk2(x[8 * s], x[8 * s + 1]); p.y = pk2(x[8 * s + 2], x[8 * s + 3]); p.z = pk2(x[8 * s + 4], x[8 * s + 5]); p.w = pk2(x[8 * s + 6], x[8 * s + 7]);
    return __builtin_bit_cast(bf16x8, p);
}

namespace pg8 {
constexpr int BM = 256, BK = 64, HALF = 128, HTB = HALF * BK * 2, STAGE_BYTES = 8 * HTB, NXCD = 8, WGM = 8;
__host__ __device__ __forceinline__ int lds_byte(int r, int c) { const int st = (r >> 4) * 2 + (c >> 5), rr = r & 15, cc = c & 31, ob = rr * 64 + cc * 2; return st * 1024 + (ob ^ (((ob >> 9) & 1) << 5)); }
__host__ __device__ __forceinline__ void stage_rc(int b, int& R, int& C) { const int st = b / 1024, sb = b % 1024, swz = sb ^ (((sb >> 9) & 1) << 5); R = (st >> 1) * 16 + swz / 64; C = (st & 1) * 32 + (swz % 64) / 2; }
__host__ __device__ __forceinline__ int perm32(int rho) { const int n = rho >> 4, i = rho & 15; return 8 * (i >> 2) + 4 * n + (i & 3); }
struct Unit { int pm, pn; };
struct Gemm { const bf16_t* A; const bf16_t* Bt; int M, N, K, lda, a_pn_step; const float* st; };
template <int N> __device__ __forceinline__ void wait_v() { asm volatile("s_waitcnt vmcnt(%0)" :: "n"(N) : "memory"); }
struct StaticOrder {
    int nM, nN, nwg, G, c;
    __device__ void init(int M, int N, int G_, int c_) { nM = M / BM; nN = N / BM; nwg = nM * nN; G = G_; c = c_; }
    __device__ bool next(int i, Unit& u) const {
        const long L = (long)i * G + c; if (L >= nwg) return false;
        int wgid = (int)L; { const int q = nwg / NXCD, r = nwg % NXCD, xcd = wgid % NXCD, off = wgid / NXCD; wgid = (xcd < r ? xcd * (q + 1) : r * (q + 1) + (xcd - r) * q) + off; }
        const int nig = WGM * nN, gid = wgid / nig, fm = gid * WGM, gsz = (nM - fm) < WGM ? (nM - fm) : WGM;
        u.pm = fm + ((wgid % nig) % gsz); u.pn = (wgid % nig) / gsz; return true;
    }
};
template <class Epi>
__device__ __forceinline__ void gemm_phase(LAS unsigned char* lds, const Gemm g, const StaticOrder& S, const Epi& E, int tid_in) {
    const int tid = tid_in, wid = __builtin_amdgcn_readfirstlane(tid >> 6), lane = tid & 63, wr = wid >> 2, wc = wid & 3, fr = lane & 15, fq = lane >> 4;
    const int K = g.K, nt = K / BK, lda = g.lda;
    unsigned voffA[2], voffB[2];
#define PG8_VOFF() do { const int t_ = wid * 64 + lane_id_v(); _Pragma("unroll") for (int i = 0; i < 2; ++i) { int R, C; stage_rc(t_ * 16 + i * 8192, R, C); const int Rb = (R & ~31) + perm32(R & 31); \
        voffA[i] = (unsigned)(R * lda + C) * 2u; voffB[i] = (unsigned)(Rb * K + C) * 2u; } } while (0)
    PG8_VOFF();
    const size_t kstep = (size_t)(BK * 2);
    const size_t hstepA = (size_t)HALF * lda * 2, hstepB = (size_t)HALF * K * 2;
    const size_t tstepA = 2 * hstepA, tstepB = 2 * hstepB;
    const size_t pnA = (size_t)g.a_pn_step * 2;
    const unsigned ldsw = (unsigned)wid * 1024u;
    const int aoff = lds_byte(wr * 64 + fr, fq * 8), boff = lds_byte(wc * 32 + fr, fq * 8);
#define PG8_SA(b, h) (((b) * 2 + (h)) * HTB)
#define PG8_SB(b, h) ((4 + (b) * 2 + (h)) * HTB)
#define PG8_STAGE(bufoff, gbase, voff) do { _Pragma("unroll") for (int _i = 0; _i < 2; ++_i) \
        __builtin_amdgcn_global_load_lds((const unsigned*)((const char*)(gbase) + (voff)[_i]), (LAS unsigned*)(lds + (bufoff) + ldsw + _i * 8192), 16, 0, 0); } while (0)
#define PG8_LDA(dst, b, h) do { _Pragma("unroll") for (int m = 0; m < 4; ++m) _Pragma("unroll") for (int k = 0; k < 2; ++k) dst[m][k] = *(const LAS bf16x8*)(lds + PG8_SA(b, h) + aoff + m * 2048 + k * 1024); } while (0)
#define PG8_LDB(dst, b, h) do { _Pragma("unroll") for (int n = 0; n < 2; ++n) _Pragma("unroll") for (int k = 0; k < 2; ++k) dst[n][k] = *(const LAS bf16x8*)(lds + PG8_SB(b, h) + boff + n * 2048 + k * 1024); } while (0)
#define PG8_MMA(ai, bj, At, Bt) do { __builtin_amdgcn_s_setprio(1); _Pragma("unroll") for (int m = 0; m < 4; ++m) _Pragma("unroll") for (int n = 0; n < 2; ++n) _Pragma("unroll") for (int k = 0; k < 2; ++k) \
        acc[ai][bj][m][n] = __builtin_amdgcn_mfma_f32_16x16x32_bf16(Bt[n][k], At[m][k], acc[ai][bj][m][n], 0, 0, 0); __builtin_amdgcn_s_setprio(0); } while (0)
#define PG8_WAIT_V(n) asm volatile("s_waitcnt vmcnt(" #n ")" ::: "memory")
#define PG8_WAIT_L(n) asm volatile("s_waitcnt lgkmcnt(" #n ")" ::: "memory")
#define PG8_BAR __builtin_amdgcn_s_barrier()
#define PG8_SCHED __builtin_amdgcn_sched_barrier(0)
    Unit cur, nxt; int ui = 0; bool pre = false;
    if (!S.next(0, cur)) return;
#define PG8_STATS(pm_, par_) do { if (g.st) __builtin_amdgcn_global_load_lds((const unsigned*)(g.st + (size_t)(pm_) * 512 + 64 * wid + lane_id_v()), (LAS unsigned*)(lds + LDS_STT + (par_) * 2048 + wid * 256), 4, 0, 0); } while (0)
    PG8_STATS(cur.pm, 0); __builtin_amdgcn_sched_barrier(0); E.prefetch(cur, 0, wid, lds);
    f32x4 acc[2][2][4][2];
#pragma unroll
    for (int a = 0; a < 2; ++a)
#pragma unroll
        for (int b = 0; b < 2; ++b)
#pragma unroll
            for (int m = 0; m < 4; ++m)
#pragma unroll
                for (int n = 0; n < 2; ++n) acc[a][b][m][n] = (f32x4){0.f, 0.f, 0.f, 0.f};
    bf16x8 At[4][2], B0[2][2], B1[2][2];
    const char* cA = (const char*)g.A + (size_t)cur.pm * tstepA + (size_t)cur.pn * pnA; const char* cB = (const char*)g.Bt + (size_t)cur.pn * tstepB;
    PG8_STAGE(PG8_SB(0, 0), cB, voffB); PG8_STAGE(PG8_SB(0, 1), cB + hstepB, voffB); PG8_STAGE(PG8_SA(0, 0), cA, voffA); PG8_STAGE(PG8_SA(0, 1), cA + hstepA, voffA);
    if (wr == 1) PG8_BAR;
    PG8_WAIT_V(2); PG8_BAR;
    PG8_STAGE(PG8_SB(1, 0), cB + kstep, voffB); PG8_STAGE(PG8_SA(1, 0), cA + kstep, voffA); PG8_STAGE(PG8_SB(1, 1), cB + hstepB + kstep, voffB);
    PG8_WAIT_V(6); PG8_BAR;
    for (;;) {
        const bool has_next = S.next(ui + 1, nxt);
        const char* nA = has_next ? (const char*)g.A + (size_t)nxt.pm * tstepA + (size_t)nxt.pn * pnA : cA; const char* nB = has_next ? (const char*)g.Bt + (size_t)nxt.pn * tstepB : cB;
#define PG8_ITER(t, W12) do { \
            const bool last = ((t) == nt - 2); \
            const char* a1 = cA + (size_t)((t) + 1) * kstep; \
            const char* a2 = last ? nA : cA + (size_t)((t) + 2) * kstep; const char* b2 = last ? nB : cB + (size_t)((t) + 2) * kstep; \
            const char* a3 = a2 + kstep; const char* b3 = b2 + kstep; \
            PG8_LDB(B0, 0, 0); PG8_LDB(B1, 0, 1); PG8_SCHED; PG8_LDA(At, 0, 0); PG8_STAGE(PG8_SA(1, 1), a1 + hstepA, voffA); \
            W12; PG8_WAIT_L(0); PG8_BAR; PG8_MMA(0, 0, At, B0); PG8_MMA(0, 1, At, B1); PG8_BAR; PG8_SCHED; \
            PG8_LDA(At, 0, 1); PG8_STAGE(PG8_SB(0, 0), b2, voffB); PG8_STAGE(PG8_SB(0, 1), b2 + hstepB, voffB); PG8_STAGE(PG8_SA(0, 0), a2, voffA); \
            W12; PG8_WAIT_L(0); PG8_BAR; PG8_MMA(1, 0, At, B0); PG8_MMA(1, 1, At, B1); PG8_BAR; PG8_SCHED; \
            PG8_LDB(B0, 1, 0); PG8_LDB(B1, 1, 1); PG8_SCHED; PG8_LDA(At, 1, 0); PG8_STAGE(PG8_SA(0, 1), a2 + hstepA, voffA); \
            PG8_WAIT_V(8); PG8_WAIT_L(0); PG8_BAR; PG8_MMA(0, 0, At, B0); PG8_MMA(0, 1, At, B1); PG8_BAR; PG8_SCHED; \
            PG8_LDA(At, 1, 1); PG8_STAGE(PG8_SB(1, 0), b3, voffB); PG8_STAGE(PG8_SB(1, 1), b3 + hstepB, voffB); PG8_STAGE(PG8_SA(1, 0), a3, voffA); \
            PG8_WAIT_V(8); PG8_WAIT_L(0); PG8_BAR; PG8_MMA(1, 0, At, B0); PG8_MMA(1, 1, At, B1); PG8_BAR; PG8_SCHED; \
        } while (0)
        int t0 = 0;
        if (pre) { PG8_ITER(0, wait_v<8 + Epi::VM_MIN>()); t0 = 2; }
        for (int t = t0; t < nt; t += 2) PG8_ITER(t, PG8_WAIT_V(8));
#undef PG8_ITER
        if (wr == 0) PG8_BAR;
        pre = has_next;
        { const int le = lane_id_v(); int wr_ = wr, wc_ = wc; asm volatile("" : "+s"(wr_), "+s"(wc_));
          E(acc, cur, wr_, wc_, le & 15, le >> 4, (const LAS float*)(lds + LDS_STT + (ui & 1) * 2048), (const LAS float*)(lds + LDS_CT + (ui & 1) * 4096)); }
        if (!has_next) break;
#pragma unroll
        for (int a = 0; a < 2; ++a)
#pragma unroll
            for (int b = 0; b < 2; ++b)
#pragma unroll
                for (int m = 0; m < 4; ++m)
#pragma unroll
                    for (int n = 0; n < 2; ++n) acc[a][b][m][n] = (f32x4){0.f, 0.f, 0.f, 0.f};
        cur = nxt; cA = nA; cB = nB; ++ui;
        PG8_VOFF();
        PG8_STATS(cur.pm, ui & 1); E.prefetch(cur, ui & 1, wid, lds);
        if (wr == 1) PG8_BAR;
    }
    PG8_WAIT_V(0);
    PG8_BAR;
#undef PG8_STATS
#undef PG8_VOFF
#undef PG8_SA
#undef PG8_SB
#undef PG8_STAGE
#undef PG8_LDA
#undef PG8_LDB
#undef PG8_MMA
#undef PG8_WAIT_V
#undef PG8_WAIT_L
#undef PG8_BAR
#undef PG8_SCHED
}
}

struct LnRef { const bf16_t* Z; const float* st; const float* g; const float* b; int ident; };
__device__ __forceinline__ void ln_row(const float* st, size_t row, int ident, float& mu, float& rstd) {
    mu = 0.f; rstd = 1.f;
    if (!ident) { const f32x2 s = *(const f32x2*)(st + row * 2); mu = s[0] * (1.f / D); rstd = 1.f / sqrtf(fmaxf(s[1] * (1.f / D) - mu * mu, 0.f) + LN_EPS); }
}
__device__ __forceinline__ void ln_row_lds(const LAS float* stt, int rl, int ident, float& mu, float& rstd) {
    mu = 0.f; rstd = 1.f;
    if (!ident) { const f32x2 s = *(const LAS f32x2*)(stt + 2 * rl); mu = s[0] * (1.f / D); rstd = __builtin_amdgcn_rsqf(fmaxf(s[1] * (1.f / D) - mu * mu, 0.f) + LN_EPS); }
}
struct EpiBf16 {
    __device__ __forceinline__ void prefetch(const pg8::Unit&, int, int, LAS unsigned char*) const {}
    bf16_t* O; int ldc;
    __device__ __forceinline__ void operator()(const f32x4 (&acc)[2][2][4][2], const pg8::Unit& u, int wr, int wc, int fr, int fq, const LAS float* stt, const LAS float* ct) const {
        const int row0 = u.pm * 256 + wr * 64 + fr, col0 = u.pn * 256 + wc * 32 + 8 * fq;
#pragma unroll
        for (int ai = 0; ai < 2; ++ai)
#pragma unroll
            for (int m = 0; m < 4; ++m) { bf16_t* rowp = O + (size_t)(row0 + ai * 128 + m * 16) * ldc + col0;
#pragma unroll
                for (int bj = 0; bj < 2; ++bj) { const f32x4 v0 = acc[ai][bj][m][0], v1 = acc[ai][bj][m][1];
                    u32x4 w; w.x = pk2(v0[0], v0[1]); w.y = pk2(v0[2], v0[3]); w.z = pk2(v1[0], v1[1]); w.w = pk2(v1[2], v1[3]);
                    *(u32x4*)(rowp + bj * 128) = w; } }
    }
};
struct EpiIn {
    static constexpr int VM_MIN = 24;
    __device__ __forceinline__ void prefetch(const pg8::Unit&, int, int, LAS unsigned char*) const {}
    bf16_t* H; float* LF; const float* lbv; float* kP; float* vP; float* kS; float* vS; const float* st; const float* uu; const float* cc; int ident;
    __device__ __forceinline__ void operator()(const f32x4 (&acc_in)[2][2][4][2], const pg8::Unit& u, int wr, int wc, int fr, int fq, const LAS float* stt, const LAS float* ct) const {
        f32x4 acc[2][2][4][2];
        { const int r0 = u.pm * 256 + wr * 64 + fr, c0 = u.pn * 256 + wc * 32 + 8 * fq;
#pragma unroll
          for (int bj = 0; bj < 2; ++bj) { const f32x4 u0 = *(const f32x4*)(uu + c0 + bj * 128), u1 = *(const f32x4*)(uu + c0 + bj * 128 + 4), k0 = *(const f32x4*)(cc + c0 + bj * 128), k1 = *(const f32x4*)(cc + c0 + bj * 128 + 4);
#pragma unroll
            for (int ai = 0; ai < 2; ++ai)
#pragma unroll
                for (int m = 0; m < 4; ++m) { float mu, rstd; ln_row_lds(stt, wr * 64 + fr + ai * 128 + m * 16, ident, mu, rstd);
                    const float nb = -mu * rstd; acc[ai][bj][m][0] = acc_in[ai][bj][m][0] * rstd + (u0 * nb + k0); acc[ai][bj][m][1] = acc_in[ai][bj][m][1] * rstd + (u1 * nb + k1); } } }
        const int row0 = u.pm * 256 + wr * 64 + fr, col0 = u.pn * 256 + wc * 32 + 8 * fq;
        const int kind = u.pn >> 1;
        if (kind == 1) {
#pragma unroll
            for (int bj = 0; bj < 2; ++bj) { const int c = col0 + bj * 128 - C_AF;
                const f32x4 l0 = *(const f32x4*)(lbv + c), l1 = *(const f32x4*)(lbv + c + 4);
#pragma unroll
                for (int ai = 0; ai < 2; ++ai)
#pragma unroll
                    for (int m = 0; m < 4; ++m) { const int row = row0 + ai * 128 + m * 16;
                        f32x4 o0, o1;
#pragma unroll
                        for (int e = 0; e < 4; ++e) {
                            { const float z = acc[ai][bj][m][0][e], ez = __builtin_amdgcn_exp2f(-LOG2E * fabsf(z)), sg = (z >= 0.f ? 1.f : ez) * __builtin_amdgcn_rcpf(1.f + ez), f = l0[e] + (1.f - l0[e]) * sg; o0[e] = fmaxf(__builtin_amdgcn_logf(f) * 0.6931471805599453f, -60.f); }
                            { const float z = acc[ai][bj][m][1][e], ez = __builtin_amdgcn_exp2f(-LOG2E * fabsf(z)), sg = (z >= 0.f ? 1.f : ez) * __builtin_amdgcn_rcpf(1.f + ez), f = l1[e] + (1.f - l1[e]) * sg; o1[e] = fmaxf(__builtin_amdgcn_logf(f) * 0.6931471805599453f, -60.f); }
                        }
                        float* dst = LF + (size_t)row * 512 + c; *(f32x4*)dst = o0; *(f32x4*)(dst + 4) = o1; } }
            return;
        }
#pragma unroll
        for (int ai = 0; ai < 2; ++ai)
#pragma unroll
            for (int m = 0; m < 4; ++m) { const int row = row0 + ai * 128 + m * 16; bf16_t* rowp = H + (size_t)row * INC + col0;
#pragma unroll
                for (int bj = 0; bj < 2; ++bj) { const f32x4 v0 = acc[ai][bj][m][0], v1 = acc[ai][bj][m][1];
                    u32x4 w; w.x = pk2(v0[0], v0[1]); w.y = pk2(v0[2], v0[3]); w.z = pk2(v1[0], v1[1]); w.w = pk2(v1[2], v1[3]);
                    *(u32x4*)(rowp + bj * 128) = w;
                    if (kind >= 5) { const int c = col0 + bj * 128 - (kind == 5 ? C_BK : C_BV);
                        float* dst = (row < MP) ? ((kind == 5 ? kP : vP) + (size_t)row * 512 + c) : ((kind == 5 ? kS : vS) + (size_t)(row - MP) * 512 + c);
                        *(f32x4*)dst = v0; *(f32x4*)(dst + 4) = v1; } } }
    }
};
struct EpiRes {
    static constexpr int VM_MIN = 32;
    __device__ __forceinline__ void prefetch(const pg8::Unit&, int, int, LAS unsigned char*) const {}
    LnRef P; bf16_t* Z; float* st_out; const float* scale;
    __device__ __forceinline__ void operator()(const f32x4 (&acc)[2][2][4][2], const pg8::Unit& u, int wr, int wc, int fr, int fq, const LAS float* stt, const LAS float* ct) const {
        const int row0 = u.pm * 256 + wr * 64 + fr, col0 = u.pn * 256 + wc * 32 + 8 * fq;
        const unsigned rb = (unsigned)(row0 * D + col0) * 2u;
        const char* zin = (const char*)P.Z; char* zout = (char*)Z;
        float s1[8], s2[8];
#pragma unroll
        for (int i = 0; i < 8; ++i) { s1[i] = 0.f; s2[i] = 0.f; }
#pragma unroll
        for (int bj = 0; bj < 2; ++bj) { const int c = col0 + bj * 128;
            u32x4 xr[2][4];
#pragma unroll
            for (int ai = 0; ai < 2; ++ai)
#pragma unroll
                for (int m = 0; m < 4; ++m) xr[ai][m] = *(const u32x4*)(zin + (rb + (unsigned)(((ai * 128 + m * 16) * D + bj * 128) * 2)));
            float sc[8], gg[8], bb[8];
#pragma unroll
            for (int e = 0; e < 8; ++e) { sc[e] = 1.f; gg[e] = 1.f; bb[e] = 0.f; }
            if (scale) { const f32x4 a0 = *(const f32x4*)(scale + c), a1 = *(const f32x4*)(scale + c + 4);
#pragma unroll
                for (int e = 0; e < 4; ++e) { sc[e] = a0[e]; sc[4 + e] = a1[e]; } }
            if (!P.ident) { const f32x4 a0 = *(const f32x4*)(P.g + c), a1 = *(const f32x4*)(P.g + c + 4), b0 = *(const f32x4*)(P.b + c), b1 = *(const f32x4*)(P.b + c + 4);
#pragma unroll
                for (int e = 0; e < 4; ++e) { gg[e] = a0[e]; gg[4 + e] = a1[e]; bb[e] = b0[e]; bb[4 + e] = b1[e]; } }
#pragma unroll
            for (int ai = 0; ai < 2; ++ai)
#pragma unroll
                for (int m = 0; m < 4; ++m) {
                    float mu, rstd; ln_row_lds(stt, wr * 64 + fr + ai * 128 + m * 16, P.ident, mu, rstd);
                    const u32x4 xw = xr[ai][m]; float xv[8]; unpk8(xw, xv);
                    float o[8];
#pragma unroll
                    for (int e = 0; e < 8; ++e) { const float t = rstd * gg[e], x = fmaf(xv[e], t, fmaf(-mu, t, bb[e])); o[e] = fmaf(DN_ALPHA, x, (e < 4 ? acc[ai][bj][m][0][e] : acc[ai][bj][m][1][e - 4]) * sc[e]); }
                    const u32x4 w = pk8(o); *(u32x4*)(zout + (rb + (unsigned)(((ai * 128 + m * 16) * D + bj * 128) * 2))) = w;
                    float ov[8]; unpk8(w, ov);
#pragma unroll
                    for (int e = 0; e < 8; ++e) { s1[ai * 4 + m] += ov[e]; s2[ai * 4 + m] += ov[e] * ov[e]; } } }
        const int lb4 = lane_id_v() << 2;
#pragma unroll
        for (int i = 0; i < 8; ++i) { s1[i] += shx_lb(s1[i], lb4, 16); s1[i] += shx_lb(s1[i], lb4, 32); s2[i] += shx_lb(s2[i], lb4, 16); s2[i] += shx_lb(s2[i], lb4, 32); }
        if (fq == 0) { char* sp = (char*)st_out; const unsigned sb = (unsigned)row0 * 8u;
#pragma unroll
            for (int i = 0; i < 8; ++i) { float* p = (float*)(sp + (sb + (unsigned)(((i >> 2) * 128 + (i & 3) * 16) * 8))); atomicAdd(p, s1[i]); atomicAdd(p + 1, s2[i]); } }
    }
};

template <int CTRL> __device__ __forceinline__ float dpp_f(float v) { return __builtin_bit_cast(float, __builtin_amdgcn_update_dpp(0, __builtin_bit_cast(int, v), CTRL, 0xf, 0xf, false)); }
struct EpiUpConv {
    static constexpr int VM_MIN = 16;
    bf16_t* G; const float* cw; const float* cb; const float* hist; float* ahead; float* bhead; float* atail; float* outP; float* outS; LAS float* ex; const float* st; const float* uu; const float* cc;
    __device__ __forceinline__ void prefetch(const pg8::Unit& u, int par, int wid, LAS unsigned char* lds) const {
        const int l = lane_id_v();
#pragma unroll
        for (int j = 0; j < 2; ++j) { const int arr = j * 4 + (wid >> 1), off = (wid & 1) * 64 + l;
            const float* src = (arr < 3) ? cw + (size_t)arr * DFF + 128 * u.pn : (arr == 3) ? cb + 128 * u.pn : (arr == 4) ? uu + 256 * u.pn : (arr == 5) ? cc + 256 * u.pn : (arr == 6) ? uu + 256 * u.pn + 128 : cc + 256 * u.pn + 128;
            __builtin_amdgcn_global_load_lds((const unsigned*)(src + off), (LAS unsigned*)(lds + LDS_CT + par * 4096 + (j * 512 + wid * 64) * 4), 4, 0, 0); __builtin_amdgcn_sched_barrier(0); }
    }
    __device__ __forceinline__ void corr2(const f32x4& a0, const f32x4& a1, const LAS float* up, const LAS float* kp, float mu, float rstd, f32x2 (&o)[4]) const {
        const f32x4 u0 = *(const LAS f32x4*)up, u1 = *(const LAS f32x4*)(up + 4), k0 = *(const LAS f32x4*)kp, k1 = *(const LAS f32x4*)(kp + 4);
        const float nb = -mu * rstd; const f32x2 r2 = {rstd, rstd}, n2 = {nb, nb};
        o[0] = (f32x2){a0[0], a0[1]} * r2 + ((f32x2){u0[0], u0[1]} * n2 + (f32x2){k0[0], k0[1]});
        o[1] = (f32x2){a0[2], a0[3]} * r2 + ((f32x2){u0[2], u0[3]} * n2 + (f32x2){k0[2], k0[3]});
        o[2] = (f32x2){a1[0], a1[1]} * r2 + ((f32x2){u1[0], u1[1]} * n2 + (f32x2){k1[0], k1[1]});
        o[3] = (f32x2){a1[2], a1[3]} * r2 + ((f32x2){u1[2], u1[3]} * n2 + (f32x2){k1[2], k1[3]});
    }
    template <bool SMP>
    __device__ __forceinline__ void body(const f32x4 (&acc)[2][2][4][2], const pg8::Unit& u, int wr, int fr, int chl, int ch, const LAS float* stt, const LAS float* T) const {
        const int seq_first = (u.pm & 7) == 0;
#pragma unroll
        for (int ai = 0; ai < 2; ++ai) {
            f32x2 h1[4], h2[4];
#pragma unroll
            for (int e = 0; e < 4; ++e) { h1[e] = (f32x2){0.f, 0.f}; h2[e] = (f32x2){0.f, 0.f}; }
            bool top_missing = false;
            if (!SMP) {
                if (wr == 1 || ai == 1) { const int sa = (wr == 1) ? ai : 0, sw = (wr == 1) ? 0 : 1; const LAS float* p = ex + ((sa * 2 + sw) * 2) * 128 + chl;
                    const f32x4 a0 = *(const LAS f32x4*)p, a1 = *(const LAS f32x4*)(p + 4), b0 = *(const LAS f32x4*)(p + 128), b1 = *(const LAS f32x4*)(p + 132);
                    h2[0] = (f32x2){a0[0], a0[1]}; h2[1] = (f32x2){a0[2], a0[3]}; h2[2] = (f32x2){a1[0], a1[1]}; h2[3] = (f32x2){a1[2], a1[3]};
                    h1[0] = (f32x2){b0[0], b0[1]}; h1[1] = (f32x2){b0[2], b0[3]}; h1[2] = (f32x2){b1[0], b1[1]}; h1[3] = (f32x2){b1[2], b1[3]}; }
                else top_missing = !seq_first;
            }
            f32x2 r1p[4], r2p[4];
#pragma unroll
            for (int e = 0; e < 4; ++e) { r1p[e] = (f32x2){0.f, 0.f}; r2p[e] = (f32x2){0.f, 0.f}; }
#pragma unroll
            for (int m = 0; m < 4; ++m) {
                const int rloc = 128 * ai + 64 * wr + 16 * m + fr;
                f32x2 cur[4], bb[4], r1[4], r2[4], p1[4], p2[4], o[4];
                const LAS float* Tm = T; asm volatile("" : "+v"(Tm));
                { float mu, rstd; ln_row_lds(stt, rloc, 0, mu, rstd);
                  corr2(acc[ai][0][m][0], acc[ai][0][m][1], Tm + 4 * 128, Tm + 5 * 128, mu, rstd, cur); corr2(acc[ai][1][m][0], acc[ai][1][m][1], Tm + 6 * 128, Tm + 7 * 128, mu, rstd, bb); }
#pragma unroll
                for (int e = 0; e < 4; ++e) { r1[e] = (f32x2){dpp_f<0x121>(cur[e][0]), dpp_f<0x121>(cur[e][1])}; r2[e] = (f32x2){dpp_f<0x122>(cur[e][0]), dpp_f<0x122>(cur[e][1])}; }
                if (SMP) { const int sb = ((u.pm - MP / 256) * 256 + 128 * ai + 64 * wr + 16 * m) >> 4; const float* hp = hist + (size_t)sb * 2 * DFF + ch;
                    const f32x4 a0 = *(const f32x4*)hp, a1 = *(const f32x4*)(hp + 4), b0 = *(const f32x4*)(hp + DFF), b1 = *(const f32x4*)(hp + DFF + 4);
                    const f32x2 hh0[4] = {{a0[0], a0[1]}, {a0[2], a0[3]}, {a1[0], a1[1]}, {a1[2], a1[3]}}, hh1[4] = {{b0[0], b0[1]}, {b0[2], b0[3]}, {b1[0], b1[1]}, {b1[2], b1[3]}};
#pragma unroll
                    for (int e = 0; e < 4; ++e) { p1[e] = fr >= 1 ? r1[e] : hh1[e]; p2[e] = fr >= 2 ? r2[e] : (fr == 1 ? hh1[e] : hh0[e]); } }
                else if (m == 0) {
#pragma unroll
                    for (int e = 0; e < 4; ++e) { p1[e] = fr >= 1 ? r1[e] : h1[e]; p2[e] = fr >= 2 ? r2[e] : (fr == 1 ? h1[e] : h2[e]); } }
                else {
#pragma unroll
                    for (int e = 0; e < 4; ++e) { p1[e] = fr >= 1 ? r1[e] : r1p[e]; p2[e] = fr >= 2 ? r2[e] : r2p[e]; } }
                { const f32x4 x0a = *(const LAS f32x4*)(Tm + 0 * 128), x0b = *(const LAS f32x4*)(Tm + 0 * 128 + 4), x1a = *(const LAS f32x4*)(Tm + 1 * 128), x1b = *(const LAS f32x4*)(Tm + 1 * 128 + 4);
                  const f32x4 x2a = *(const LAS f32x4*)(Tm + 2 * 128), x2b = *(const LAS f32x4*)(Tm + 2 * 128 + 4), xba = *(const LAS f32x4*)(Tm + 3 * 128), xbb = *(const LAS f32x4*)(Tm + 3 * 128 + 4);
                  const f32x2 w0[4] = {{x0a[0], x0a[1]}, {x0a[2], x0a[3]}, {x0b[0], x0b[1]}, {x0b[2], x0b[3]}}, w1[4] = {{x1a[0], x1a[1]}, {x1a[2], x1a[3]}, {x1b[0], x1b[1]}, {x1b[2], x1b[3]}};
                  const f32x2 w2[4] = {{x2a[0], x2a[1]}, {x2a[2], x2a[3]}, {x2b[0], x2b[1]}, {x2b[2], x2b[3]}}, wb[4] = {{xba[0], xba[1]}, {xba[2], xba[3]}, {xbb[0], xbb[1]}, {xbb[2], xbb[3]}};
#pragma unroll
                  for (int e = 0; e < 4; ++e) { const f32x2 c = cur[e] * w2[e] + (p1[e] * w1[e] + (p2[e] * w0[e] + wb[e]));
                      const f32x2 t = c * (f32x2){-LOG2E, -LOG2E}; const f32x2 d = (f32x2){__builtin_amdgcn_exp2f(t[0]), __builtin_amdgcn_exp2f(t[1])} + (f32x2){1.f, 1.f};
                      o[e] = (c * bb[e]) * (f32x2){__builtin_amdgcn_rcpf(d[0]), __builtin_amdgcn_rcpf(d[1])}; r1p[e] = r1[e]; r2p[e] = r2[e]; } }
                if (!(top_missing && m == 0 && fr < 2)) { u32x4 w; w.x = pk2(o[0][0], o[0][1]); w.y = pk2(o[1][0], o[1][1]); w.z = pk2(o[2][0], o[2][1]); w.w = pk2(o[3][0], o[3][1]);
                    *(u32x4*)(G + (size_t)(u.pm * 256 + rloc) * DFF + ch) = w; }
                const f32x4 ca0 = {cur[0][0], cur[0][1], cur[1][0], cur[1][1]}, ca1 = {cur[2][0], cur[2][1], cur[3][0], cur[3][1]};
                if (ai == 0 && m == 0 && wr == 0 && fr < 2) { float* pa = ahead + ((size_t)u.pm * 2 + fr) * DFF + ch; float* pb = bhead + ((size_t)u.pm * 2 + fr) * DFF + ch;
                    *(f32x4*)pa = ca0; *(f32x4*)(pa + 4) = ca1; *(f32x4*)pb = (f32x4){bb[0][0], bb[0][1], bb[1][0], bb[1][1]}; *(f32x4*)(pb + 4) = (f32x4){bb[2][0], bb[2][1], bb[3][0], bb[3][1]}; }
                if (ai == 1 && m == 3 && wr == 1 && fr >= 14) { float* pt = atail + ((size_t)u.pm * 2 + (fr - 14)) * DFF + ch; *(f32x4*)pt = ca0; *(f32x4*)(pt + 4) = ca1;
                    if (!SMP && (u.pm & 7) == 7) { float* po = outP + ((size_t)(u.pm >> 3) * 2 + (fr - 14)) * DFF + ch; *(f32x4*)po = ca0; *(f32x4*)(po + 4) = ca1; } }
                if (SMP && fr >= 14) { const int sb = ((u.pm - MP / 256) * 256 + 128 * ai + 64 * wr + 16 * m) >> 4; float* po = outS + ((size_t)sb * 2 + (fr - 14)) * DFF + ch;
                    *(f32x4*)po = ca0; *(f32x4*)(po + 4) = ca1; }
            }
        }
    }
    __device__ __forceinline__ void operator()(const f32x4 (&acc)[2][2][4][2], const pg8::Unit& u, int wr, int wc, int fr, int fq, const LAS float* stt, const LAS float* ct) const {
        const int chl = 32 * wc + 8 * fq, ch = 128 * u.pn + chl;
        const LAS float* T = ct + chl;
        if (fr >= 14) {
#pragma unroll
            for (int ai = 0; ai < 2; ++ai) { float mu, rstd; f32x2 t[4]; ln_row_lds(stt, wr * 64 + fr + ai * 128 + 48, 0, mu, rstd); corr2(acc[ai][0][3][0], acc[ai][0][3][1], T + 4 * 128, T + 5 * 128, mu, rstd, t);
                LAS float* p = ex + ((ai * 2 + wr) * 2 + (fr - 14)) * 128 + chl; *(LAS f32x4*)p = (f32x4){t[0][0], t[0][1], t[1][0], t[1][1]}; *(LAS f32x4*)(p + 4) = (f32x4){t[2][0], t[2][1], t[3][0], t[3][1]}; }
        }
        asm volatile("s_waitcnt lgkmcnt(0)" ::: "memory"); __builtin_amdgcn_s_barrier(); asm volatile("" ::: "memory");
        if (u.pm >= MP / 256) body<true>(acc, u, wr, fr, chl, ch, stt, T); else body<false>(acc, u, wr, fr, chl, ch, stt, T);
    }
};


template <int KW  >
__device__ __forceinline__ void sgemm_res_phase(LAS unsigned char* lds, const bf16_t* A, int lda, int a_grp_step, const bf16_t* Bt, int K, int bid, int G, int tid, const LnRef& P, bf16_t* Z, float* st_out, const float* scale) {
    const int lane = tid & 63, wave = __builtin_amdgcn_readfirstlane(tid >> 6), fr = lane & 15, fq = lane >> 4;
    LAS f32x4* red = (LAS f32x4*)lds;
    for (int t = bid; t < 256; t += G) {
        const int rt = t >> 5, ct = t & 31;
        const GAS bf16_t* ap = (const GAS bf16_t*)(A + (size_t)(rt * 64 + fr) * lda + (size_t)((ct * 32) >> 8) * a_grp_step + wave * KW + 8 * fq);
        const GAS bf16_t* bp = (const GAS bf16_t*)(Bt + (size_t)(ct * 32 + fr) * K + wave * KW + 8 * fq);
        f32x4 acc[4][2];
#pragma unroll
        for (int i = 0; i < 4; ++i) { acc[i][0] = (f32x4){0.f, 0.f, 0.f, 0.f}; acc[i][1] = (f32x4){0.f, 0.f, 0.f, 0.f}; }
#pragma unroll
        for (int k0 = 0; k0 < KW; k0 += 32) {
            bf16x8 af[4], bf[2];
#pragma unroll
            for (int i = 0; i < 4; ++i) af[i] = *(const GAS bf16x8*)(ap + (size_t)(16 * i) * lda + k0);
#pragma unroll
            for (int j = 0; j < 2; ++j) bf[j] = *(const GAS bf16x8*)(bp + (size_t)(16 * j) * K + k0);
#pragma unroll
            for (int i = 0; i < 4; ++i)
#pragma unroll
                for (int j = 0; j < 2; ++j) acc[i][j] = __builtin_amdgcn_mfma_f32_16x16x32_bf16(bf[j], af[i], acc[i][j], 0, 0, 0);
        }
#pragma unroll
        for (int i = 0; i < 4; ++i)
#pragma unroll
            for (int j = 0; j < 2; ++j) red[(wave * 8 + i * 2 + j) * 64 + lane] = acc[i][j];
        __syncthreads();
        f32x4 v = red[(0 * 8 + wave) * 64 + lane];
#pragma unroll
        for (int w = 1; w < 8; ++w) v += red[(w * 8 + wave) * 64 + lane];
        __syncthreads();
        const int row = rt * 64 + 16 * (wave >> 1) + fr, n = ct * 32 + 16 * (wave & 1) + 4 * fq; const size_t grow = (size_t)MP + row, off = grow * D + n;
        float mu, rstd; ln_row(P.st, grow, P.ident, mu, rstd);
        f32x4 gg = {1.f, 1.f, 1.f, 1.f}, bb = {0.f, 0.f, 0.f, 0.f}, sc = {1.f, 1.f, 1.f, 1.f};
        if (!P.ident) { gg = *(const f32x4*)(P.g + n); bb = *(const f32x4*)(P.b + n); }
        if (scale) sc = *(const f32x4*)(scale + n);
        const u32x2 xw = *(const u32x2*)(P.Z + off); const float xv[4] = {bflo(xw.x), bfhi(xw.x), bflo(xw.y), bfhi(xw.y)};
        float o[4];
#pragma unroll
        for (int e = 0; e < 4; ++e) { const float tt = rstd * gg[e], x = fmaf(xv[e], tt, fmaf(-mu, tt, bb[e])); o[e] = fmaf(DN_ALPHA, x, v[e] * sc[e]); }
        u32x2 w; w.x = pk2(o[0], o[1]); w.y = pk2(o[2], o[3]); *(u32x2*)(Z + off) = w;
        float s1 = (bflo(w.x) + bfhi(w.x)) + (bflo(w.y) + bfhi(w.y)), s2 = (bflo(w.x) * bflo(w.x) + bfhi(w.x) * bfhi(w.x)) + (bflo(w.y) * bflo(w.y) + bfhi(w.y) * bfhi(w.y));
        s1 += shx(s1, 16); s1 += shx(s1, 32); s2 += shx(s2, 16); s2 += shx(s2, 32);
        if (fq == 0) { atomicAdd(st_out + grow * 2, s1); atomicAdd(st_out + grow * 2 + 1, s2); }
    }
}

__device__ __forceinline__ void sgemm_in_phase(LAS unsigned char* lds, const bf16_t* A, const bf16_t* Bt, int bid, int G, int tid, const EpiIn& E) {
    constexpr int K = D, KW = K / 8;
    const int lane = tid & 63, wave = __builtin_amdgcn_readfirstlane(tid >> 6), fr = lane & 15, fq = lane >> 4;
    LAS f32x4* red = (LAS f32x4*)lds;
    for (int t = bid; t < 256; t += G) {
        const int rt = t >> 5, ct = t & 31;
        const GAS bf16_t* ap = (const GAS bf16_t*)(A + (size_t)(rt * 64 + fr) * K + wave * KW + 8 * fq);
        const GAS bf16_t* bp = (const GAS bf16_t*)(Bt + (size_t)(ct * 112 + fr) * K + wave * KW + 8 * fq);
        f32x4 acc[4][7];
#pragma unroll
        for (int i = 0; i < 4; ++i)
#pragma unroll
            for (int j = 0; j < 7; ++j) acc[i][j] = (f32x4){0.f, 0.f, 0.f, 0.f};
#pragma unroll
        for (int k0 = 0; k0 < KW; k0 += 32) {
            bf16x8 af[4], bf[7];
#pragma unroll
            for (int i = 0; i < 4; ++i) af[i] = *(const GAS bf16x8*)(ap + (size_t)(16 * i) * K + k0);
#pragma unroll
            for (int j = 0; j < 7; ++j) bf[j] = *(const GAS bf16x8*)(bp + (size_t)(16 * j) * K + k0);
#pragma unroll
            for (int i = 0; i < 4; ++i)
#pragma unroll
                for (int j = 0; j < 7; ++j) acc[i][j] = __builtin_amdgcn_mfma_f32_16x16x32_bf16(bf[j], af[i], acc[i][j], 0, 0, 0);
        }
#pragma unroll
        for (int i = 0; i < 4; ++i) {
#pragma unroll
            for (int j = 0; j < 7; ++j) red[(wave * 7 + j) * 64 + lane] = acc[i][j];
            __syncthreads();
            if (wave < 7) {
                f32x4 v = red[(0 * 7 + wave) * 64 + lane];
#pragma unroll
                for (int w = 1; w < 8; ++w) v += red[(w * 7 + wave) * 64 + lane];
                const int m = rt * 64 + 16 * i + fr, n = ct * 112 + 16 * wave + 4 * fq; const size_t row = (size_t)MP + m;
                float mu, rstd; ln_row(E.st, row, E.ident, mu, rstd);
                const f32x4 u0 = *(const f32x4*)(E.uu + n), k0v = *(const f32x4*)(E.cc + n);
                const float nb = -mu * rstd; v = v * rstd + (u0 * nb + k0v);
                const int kind = n >> 9;
                if (kind == 1) { const int c = n - C_AF; const f32x4 l0 = *(const f32x4*)(E.lbv + c); f32x4 o;
#pragma unroll
                    for (int e = 0; e < 4; ++e) { const float z = v[e], ez = __builtin_amdgcn_exp2f(-LOG2E * fabsf(z)), sg = (z >= 0.f ? 1.f : ez) * __builtin_amdgcn_rcpf(1.f + ez), f = l0[e] + (1.f - l0[e]) * sg; o[e] = fmaxf(__builtin_amdgcn_logf(f) * 0.6931471805599453f, -60.f); }
                    *(f32x4*)(E.LF + row * 512 + c) = o; }
                else { u32x2 w; w.x = pk2(v[0], v[1]); w.y = pk2(v[2], v[3]); *(u32x2*)(E.H + row * INC + n) = w;
                    if (kind == 5) *(f32x4*)(E.kS + (size_t)m * 512 + (n - C_BK)) = v;
                    if (kind == 6) *(f32x4*)(E.vS + (size_t)m * 512 + (n - C_BV)) = v; }
            }
            __syncthreads();
        }
    }
}

#define XB_TMO      128
#define XB_XCNT(j)  (256  + 64 * (j))
#define XB_XSUB(j)  (1280 + 64 * (j))
#define XB_XGEN(j)  (2304 + 64 * (j))
#define XB_TOP      3328
#define XB_TOPGEN   3392
#define XCD_BAR_WORDS 3456
#define XB_SPIN_CAP (1u << 22)
__device__ __forceinline__ unsigned xb_ld(unsigned* p)              { return __hip_atomic_load(p, __ATOMIC_RELAXED, __HIP_MEMORY_SCOPE_AGENT); }
__device__ __forceinline__ unsigned xb_add(unsigned* p, unsigned v) { return __hip_atomic_fetch_add(p, v, __ATOMIC_RELAXED, __HIP_MEMORY_SCOPE_AGENT); }
__device__ __forceinline__ unsigned xb_xcc_id() { return (unsigned)__builtin_amdgcn_s_getreg((3 << 11) | 20) & 0xFu; }
#define XB_SPIN(cond, bar) do { unsigned _sp = 0; while (cond) { __builtin_amdgcn_s_sleep(1); \
    if ((++_sp & 255u) == 0u) { if (xb_ld(&(bar)[XB_TMO])) break; if (_sp > XB_SPIN_CAP) { atomicAdd(&(bar)[XB_TMO], 1u); break; } } } } while (0)
struct XcdBarrier { unsigned* bar; unsigned x; volatile LAS unsigned* st; };
__device__ __forceinline__ XcdBarrier xcd_barrier_post(unsigned* bar, volatile LAS unsigned* st) {
    XcdBarrier b; b.bar = bar; b.x = xb_xcc_id(); b.st = st;
    if (threadIdx.x == 0) (void)xb_add(&bar[XB_XCNT(b.x)], 1u);
    return b;
}
__device__ __forceinline__ void xcd_barrier_complete(unsigned* bar, unsigned x, unsigned& nloc, unsigned& nx) {
    const unsigned G = gridDim.x * gridDim.y * gridDim.z;
    unsigned sum, cnt, mine, sp = 0u;
    for (;;) {
        sum = 0u; cnt = 0u; mine = 0u;
#pragma unroll
        for (unsigned j = 0; j < 16; ++j) { const unsigned c = xb_ld(&bar[XB_XCNT(j)]); sum += c; cnt += (c > 0u) ? 1u : 0u; mine = (j == x) ? c : mine; }
        if (sum == G) break;
        __builtin_amdgcn_s_sleep(1);
        if ((++sp & 255u) == 0u) { if (xb_ld(&bar[XB_TMO])) break; if (sp > XB_SPIN_CAP) { atomicAdd(&bar[XB_TMO], 1u); break; } }
    }
    nloc = mine > 0u ? mine : 1u; nx = cnt > 0u ? cnt : 1u;
}
__device__ __forceinline__ void xcd_barrier(const XcdBarrier& b) {
    asm volatile("s_waitcnt vmcnt(0)" ::: "memory");
    __syncthreads();
    if (threadIdx.x == 0) {
        unsigned* bar = b.bar;
        __builtin_amdgcn_s_waitcnt(0);
        unsigned nloc = b.st[0], nx = b.st[1];
        if (nloc == 0u) { xcd_barrier_complete(bar, b.x, nloc, nx); b.st[0] = nloc; b.st[1] = nx; }
        const unsigned old = xb_add(&bar[XB_XSUB(b.x)], 1u);
        const unsigned gen = old / nloc;
        if (old + 1u == (gen + 1u) * nloc) {
            __builtin_amdgcn_fence(__ATOMIC_RELEASE, "agent");
            asm volatile("s_waitcnt vmcnt(0)" ::: "memory");
            const unsigned og = xb_add(&bar[XB_TOP], 1u);
            const unsigned tg = og / nx;
            if (og + 1u == (tg + 1u) * nx) xb_add(&bar[XB_TOPGEN], 1u);
            else XB_SPIN(xb_ld(&bar[XB_TOPGEN]) == tg, bar);
            __builtin_amdgcn_fence(__ATOMIC_ACQUIRE, "agent");
            xb_add(&bar[XB_XGEN(b.x)], 1u);
            asm volatile("s_waitcnt vmcnt(0)" ::: "memory");
        } else {
            XB_SPIN(xb_ld(&bar[XB_XGEN(b.x)]) == gen, bar);
            __builtin_amdgcn_fence(__ATOMIC_ACQUIRE, "agent");
            asm volatile("s_waitcnt vmcnt(0)" ::: "memory");
        }
    }
    __syncthreads();
}

struct Args { const float* in[24]; float* out; unsigned char* ws; int ph_lo, ph_hi, single, pad; };
typedef const float* cfp_t;
typedef const __attribute__((address_space(4))) cfp_t* kin_t;
struct Frame {
    LAS unsigned char* lds;
    int tid, lane, wave, bid, G;
    kin_t in;
    float* out; unsigned char* ws;
};
enum { I_XP = 0, I_XS, I_CK, I_CV, I_SH, I_SP, I_SC, I_WIN, I_WOUT, I_LBL, I_HNG, I_DLAM, I_DNG, I_RB, I_PW, I_PSC, I_WUP, I_CW, I_CB, I_WDN, I_L1G, I_L1B, I_L2G, I_L2B };

__device__ __forceinline__ void p0_transpose_item(const float* W, int K, int N, bf16_t* WT, int dst_row0, LAS float* scr, int k0, int n0, int lane, const float* gk, const float* bk, float* uo, float* co) {
#pragma unroll 8
    for (int i = 0; i < 32; ++i) { const int kk = 2 * i + (lane >> 5); scr[kk * 33 + (lane & 31)] = W[(size_t)(k0 + kk) * N + n0 + (lane & 31)]; }
    asm volatile("s_waitcnt lgkmcnt(0)" ::: "memory");
    const int c = lane & 7;
    float gv[8], bv[8];
#pragma unroll
    for (int e = 0; e < 8; ++e) { gv[e] = 1.f; bv[e] = 0.f; }
    if (gk) {
#pragma unroll
        for (int e = 0; e < 8; ++e) { gv[e] = gk[k0 + 8 * c + e]; bv[e] = bk[k0 + 8 * c + e]; } }
#pragma unroll
    for (int j = 0; j < 4; ++j) { const int n = (lane >> 3) + 8 * j; const LAS float* sp = scr + (8 * c) * 33 + n;
        float wv[8]; float cs = 0.f;
#pragma unroll
        for (int e = 0; e < 8; ++e) { const float w = sp[e * 33]; wv[e] = w * gv[e]; cs += w * bv[e]; }
        const u32x4 o = pk8(wv);
        *(u32x4*)(WT + (size_t)(dst_row0 + n) * K + k0 + 8 * c) = o;
        if (gk) { float rv[8]; unpk8(o, rv); float us = 0.f;
#pragma unroll
            for (int e = 0; e < 8; ++e) us += rv[e];
            us += shx(us, 1); us += shx(us, 2); us += shx(us, 4); cs += shx(cs, 1); cs += shx(cs, 2); cs += shx(cs, 4);
            if (c == 0) { atomicAdd(uo + dst_row0 + n, us); atomicAdd(co + dst_row0 + n, cs); } } }
    asm volatile("s_waitcnt lgkmcnt(0)" ::: "memory");
}
__device__ __forceinline__ void phase_prologue(Frame& F) {
    LAS float* scr = (LAS float*)(F.lds + F.wave * 16384);
    const int gw = F.bid * NWAVES + F.wave, NGW = F.G * NWAVES;
    constexpr int I_IN = (D / 64) * (INC / 32), I_OUT = (D / 64) * (D / 32), I_POOL = 4 * 8, I_UP = (D / 64) * (UPN / 32), I_DN = (DFF / 64) * (D / 32);
    constexpr int NITEMS = 2 * I_IN + 2 * I_OUT + 8 * I_POOL + 4 * I_UP + 4 * I_DN;
    for (int it = gw; it < NITEMS; it += NGW) {
        int r = it;
        if (r < 2 * I_IN) { const int m = r / I_IN; r %= I_IN; const int kb = r / (INC / 32), nb = r % (INC / 32);
            float* ctlf = (float*)(F.ws + WS_CTL);
            p0_transpose_item(F.in[I_WIN] + (size_t)m * D * INC, D, INC, (bf16_t*)(F.ws + WS_WIN) + (size_t)m * INC * D, 32 * nb, scr, 64 * kb, 32 * nb, F.lane,
                              m == 1 ? F.in[I_L2G] + 1 * D : nullptr, F.in[I_L2B] + 1 * D, ctlf + UC_UIN, ctlf + UC_CIN); continue; } r -= 2 * I_IN;
        if (r < 2 * I_OUT) { const int m = r / I_OUT; r %= I_OUT; const int kb = r / (D / 32), nb = r % (D / 32);
            p0_transpose_item(F.in[I_WOUT] + (size_t)m * D * D, D, D, (bf16_t*)(F.ws + WS_WOUT) + (size_t)m * D * D, 32 * nb, scr, 64 * kb, 32 * nb, F.lane, nullptr, nullptr, nullptr, nullptr); continue; } r -= 2 * I_OUT;
        if (r < 8 * I_POOL) { const int pg = r / I_POOL; r %= I_POOL; const int kb = r / 8, nb = r % 8;
            p0_transpose_item(F.in[I_PW] + (size_t)pg * 256 * 256, 256, 256, (bf16_t*)(F.ws + WS_WPOOL) + (size_t)pg * 256 * 256, 32 * nb, scr, 64 * kb, 32 * nb, F.lane, nullptr, nullptr, nullptr, nullptr); continue; } r -= 8 * I_POOL;
        if (r < 4 * I_UP) { const int l = r / I_UP; r %= I_UP; const int kb = r / (UPN / 32), nb = r % (UPN / 32); const int n0 = 32 * nb;
            const int dst = (n0 < DFF) ? (256 * (n0 / 128) + (n0 % 128)) : (256 * ((n0 - DFF) / 128) + 128 + ((n0 - DFF) % 128));
            float* ctlf = (float*)(F.ws + WS_CTL);
            p0_transpose_item(F.in[I_WUP] + (size_t)l * D * UPN, D, UPN, (bf16_t*)(F.ws + WS_WUP) + (size_t)l * UPN * D, dst, scr, 64 * kb, n0, F.lane,
                              F.in[I_L1G] + (size_t)l * D, F.in[I_L1B] + (size_t)l * D, ctlf + UC_UUP + l * UPN, ctlf + UC_CUP + l * UPN); continue; } r -= 4 * I_UP;
        { const int l = r / I_DN; r %= I_DN; const int kb = r / (D / 32), nb = r % (D / 32);
            p0_transpose_item(F.in[I_WDN] + (size_t)l * DFF * D, DFF, D, (bf16_t*)(F.ws + WS_WDN) + (size_t)l * D * DFF, 32 * nb, scr, 64 * kb, 32 * nb, F.lane, nullptr, nullptr, nullptr, nullptr); }
    }
    bf16_t* XB = (bf16_t*)(F.ws + WS_XB);
    for (int m0 = gw; m0 < MT; m0 += 4 * NGW) {
        f32x4 v[4][4];
#pragma unroll
        for (int q = 0; q < 4; ++q) { const int m = m0 + q * NGW;
            if (m < MT) { const float* src = (m < MP) ? F.in[I_XP] + (size_t)m * D : F.in[I_XS] + (size_t)(m - MP) * D;
#pragma unroll
                for (int j = 0; j < 4; ++j) v[q][j] = *(const f32x4*)(src + 4 * F.lane + 256 * j); } }
#pragma unroll
        for (int q = 0; q < 4; ++q) { const int m = m0 + q * NGW;
            if (m < MT) {
#pragma unroll
                for (int j = 0; j < 4; ++j) { u32x2 w; w.x = pk2(v[q][j][0], v[q][j][1]); w.y = pk2(v[q][j][2], v[q][j][3]); *(u32x2*)(XB + (size_t)m * D + 4 * F.lane + 256 * j) = w; } } }
    }
    if (F.bid == 0) {
        float* tab = (float*)(F.ws + WS_TAB);
        { const int c = F.tid; const float a = F.in[I_LBL][c], b = F.in[I_LBL][512 + c], mx = fmaxf(a, b), ea = __expf(a - mx), eb = __expf(b - mx);
          tab[TB_LB + c] = 0.f; tab[TB_LB + 512 + c] = eb / (ea + eb); }
        if (F.wave < 2) { const int m = F.wave; const float* lp = F.in[I_DLAM] + (size_t)m * 4 * 64;
            const float s01 = wave_sum(lp[F.lane] * lp[64 + F.lane]), s23 = wave_sum(lp[128 + F.lane] * lp[192 + F.lane]);
            const float lam_init = (m == 0) ? 0.2f : 0.47071302f;
            if (F.lane == 0) tab[TB_LAM + m] = __expf(s01) - __expf(s23) + lam_init; }
    }
}

__device__ __forceinline__ void phase_ln_final(Frame& F, const bf16_t* Z, const float* g, const float* b) {
    const int gw = F.bid * NWAVES + F.wave, NGW = F.G * NWAVES;
    f32x4 gv[4], bv[4];
#pragma unroll
    for (int j = 0; j < 4; ++j) { const int c = 8 * F.lane + 512 * (j >> 1) + 4 * (j & 1); gv[j] = *(const f32x4*)(g + c); bv[j] = *(const f32x4*)(b + c); }
    for (int m = gw; m < MT; m += NGW) {
        f32x4 v[4]; float s = 0.f;
#pragma unroll
        for (int j2 = 0; j2 < 2; ++j2) { const u32x4 w = *(const u32x4*)(Z + (size_t)m * D + 8 * F.lane + 512 * j2);
            v[2 * j2] = (f32x4){bflo(w.x), bfhi(w.x), bflo(w.y), bfhi(w.y)}; v[2 * j2 + 1] = (f32x4){bflo(w.z), bfhi(w.z), bflo(w.w), bfhi(w.w)}; }
#pragma unroll
        for (int j = 0; j < 4; ++j) s += (v[j][0] + v[j][1]) + (v[j][2] + v[j][3]);
        const float mean = wave_sum(s) * (1.f / D); float s2 = 0.f;
#pragma unroll
        for (int j = 0; j < 4; ++j) { v[j] = v[j] - mean; s2 += (v[j][0] * v[j][0] + v[j][1] * v[j][1]) + (v[j][2] * v[j][2] + v[j][3] * v[j][3]); }
        const float rstd = 1.f / sqrtf(wave_sum(s2) * (1.f / D) + LN_EPS);
        float* outp = (m < MP) ? F.out + O_YP + (size_t)m * D : F.out + O_YS + (size_t)(m - MP) * D;
#pragma unroll
        for (int j2 = 0; j2 < 2; ++j2) { const f32x4 y0 = v[2 * j2] * rstd * gv[2 * j2] + bv[2 * j2], y1 = v[2 * j2 + 1] * rstd * gv[2 * j2 + 1] + bv[2 * j2 + 1];
            *(f32x4*)(outp + 8 * F.lane + 512 * j2) = y0; *(f32x4*)(outp + 8 * F.lane + 512 * j2 + 4) = y1; }
    }
}

template <int J>
__device__ __forceinline__ void pool_item(Frame& F, const LnRef& R, int p, int rb, int c) {
    constexpr int W = 2 << J;
    bf16_t* PO = (bf16_t*)(F.ws + WS_MIX);
    const f32x4 g0 = *(const f32x4*)(R.g + c), g1 = *(const f32x4*)(R.g + c + 4), b0 = *(const f32x4*)(R.b + c), b1 = *(const f32x4*)(R.b + c + 4);
    const int m0 = rb * 16; const bool smp = m0 >= MP; const int b = smp ? (m0 - MP) / ST : m0 / PT, t0 = smp ? 0 : m0 % PT;
    f32x4 ring[W][2]; f32x4 s0 = {0.f, 0.f, 0.f, 0.f}, s1 = {0.f, 0.f, 0.f, 0.f};
#pragma unroll
    for (int i = 0; i < W; ++i) {
        const int tt = t0 - W + i; f32x4 v0 = {0.f, 0.f, 0.f, 0.f}, v1 = {0.f, 0.f, 0.f, 0.f};
        if (tt >= 0) { const size_t rr = (size_t)(m0 - W + i); const u32x4 q = *(const u32x4*)(R.Z + rr * D + c); float mu, rstd; ln_row(R.st, rr, 0, mu, rstd);
            v0 = ((f32x4){bflo(q.x), bfhi(q.x), bflo(q.y), bfhi(q.y)} - mu) * rstd * g0 + b0; v1 = ((f32x4){bflo(q.z), bfhi(q.z), bflo(q.w), bfhi(q.w)} - mu) * rstd * g1 + b1; }
        else if (smp && tt >= -15) { const float* hp = F.in[I_SP] + (((size_t)p * SB + b) * 15 + (15 + tt)) * D + c; v0 = *(const f32x4*)hp; v1 = *(const f32x4*)(hp + 4); }
        ring[i][0] = v0; ring[i][1] = v1; s0 += v0; s1 += v1; }
#pragma unroll
    for (int i = 0; i < 16; ++i) { const int t = t0 + i;
        const size_t rr = (size_t)(m0 + i); const u32x4 q = *(const u32x4*)(R.Z + rr * D + c); float mu, rstd; ln_row(R.st, rr, 0, mu, rstd);
        const f32x4 x0 = ((f32x4){bflo(q.x), bfhi(q.x), bflo(q.y), bfhi(q.y)} - mu) * rstd * g0 + b0, x1 = ((f32x4){bflo(q.z), bfhi(q.z), bflo(q.w), bfhi(q.w)} - mu) * rstd * g1 + b1;
        s0 += x0 - ring[i % W][0]; s1 += x1 - ring[i % W][1]; ring[i % W][0] = x0; ring[i % W][1] = x1;
        const float inv = 1.f / (float)(smp ? W : (t + 1 < W ? t + 1 : W));
        const f32x4 o0 = s0 * inv - x0, o1 = s1 * inv - x1;
        u32x4 w; w.x = pk2(o0[0], o0[1]); w.y = pk2(o0[2], o0[3]); w.z = pk2(o1[0], o1[1]); w.w = pk2(o1[2], o1[3]); *(u32x4*)(PO + (size_t)(m0 + i) * D + c) = w;
        if (!smp && t >= PT - 15) { float* op = F.out + O_PP + (((size_t)p * PB + b) * 15 + (t - (PT - 15))) * D + c; *(f32x4*)op = x0; *(f32x4*)(op + 4) = x1; }
        if (smp && t >= 1) { float* op = F.out + O_PS + (((size_t)p * SB + b) * 15 + (t - 1)) * D + c; *(f32x4*)op = x0; *(f32x4*)(op + 4) = x1; } }
}
__device__ __forceinline__ void phase_pool_prep(Frame& F, const LnRef& R, int p) {
    const int gwv = F.bid * NWAVES + F.wave, NGW = F.G * NWAVES;
    for (int wi = gwv; wi < (MT / 32) * 4; wi += NGW) { const int j = wi & 3, rb = 2 * (wi >> 2) + (F.lane >> 5), c = 256 * j + 8 * (F.lane & 31);
        if (j == 0) pool_item<0>(F, R, p, rb, c); else if (j == 1) pool_item<1>(F, R, p, rb, c); else if (j == 2) pool_item<2>(F, R, p, rb, c); else pool_item<3>(F, R, p, rb, c); }
}

__device__ __forceinline__ void conv_fix_item(Frame& F, int l, int pm, int ch) {
    bf16_t* Gb = (bf16_t*)(F.ws + WS_G);
    const float* cw = F.in[I_CW] + (size_t)l * 3 * DFF; const float* cb = F.in[I_CB] + (size_t)l * DFF;
    const float* ahead = (const float*)(F.ws + WS_AHEAD); const float* bhead = (const float*)(F.ws + WS_BHEAD); const float* atail = (const float*)(F.ws + WS_ATAIL);
    float t0[8], t1[8], a0[8], a1[8], b0[8], b1[8], o[8];
#pragma unroll
    for (int h2 = 0; h2 < 2; ++h2) {
        const f32x4 x0 = *(const f32x4*)(atail + ((size_t)(pm - 1) * 2 + 0) * DFF + ch + 4 * h2), x1 = *(const f32x4*)(atail + ((size_t)(pm - 1) * 2 + 1) * DFF + ch + 4 * h2);
        const f32x4 y0 = *(const f32x4*)(ahead + ((size_t)pm * 2 + 0) * DFF + ch + 4 * h2), y1 = *(const f32x4*)(ahead + ((size_t)pm * 2 + 1) * DFF + ch + 4 * h2);
        const f32x4 z0 = *(const f32x4*)(bhead + ((size_t)pm * 2 + 0) * DFF + ch + 4 * h2), z1 = *(const f32x4*)(bhead + ((size_t)pm * 2 + 1) * DFF + ch + 4 * h2);
#pragma unroll
        for (int e = 0; e < 4; ++e) { t0[4 * h2 + e] = x0[e]; t1[4 * h2 + e] = x1[e]; a0[4 * h2 + e] = y0[e]; a1[4 * h2 + e] = y1[e]; b0[4 * h2 + e] = z0[e]; b1[4 * h2 + e] = z1[e]; } }
#pragma unroll
    for (int e = 0; e < 8; ++e) { const float c = cb[ch + e] + t0[e] * cw[ch + e] + t1[e] * cw[DFF + ch + e] + a0[e] * cw[2 * DFF + ch + e]; o[e] = silu_mul(c, b0[e]); }
    *(u32x4*)(Gb + (size_t)(pm * 256) * DFF + ch) = pk8(o);
#pragma unroll
    for (int e = 0; e < 8; ++e) { const float c = cb[ch + e] + t1[e] * cw[ch + e] + a0[e] * cw[DFF + ch + e] + a1[e] * cw[2 * DFF + ch + e]; o[e] = silu_mul(c, b1[e]); }
    *(u32x4*)(Gb + (size_t)(pm * 256 + 1) * DFF + ch) = pk8(o);
}
__device__ __forceinline__ void conv_fix_local(Frame& F, int l, const pg8::StaticOrder& S) {
    pg8::Unit u;
    for (int i = 0; S.next(i, u); ++i)
        if (u.pm < MP / 256 && (u.pm & 7) != 0)
            for (int it = F.tid; it < DFF / 8; it += NTHREADS) conv_fix_item(F, l, u.pm, 8 * it);
    asm volatile("s_waitcnt vmcnt(0)" ::: "memory");
    __syncthreads();
}

constexpr int HG_LF = 0;
constexpr int HG_TOT = HG_LF + 16384;
constexpr int HG_G = HG_TOT + 2048;
constexpr int HG_QT = HG_G + 512;
constexpr int HG_KS = HG_QT + 32 * 272;
constexpr int HG_V = HG_KS + 32 * 320;
constexpr int HG_PF = HG_V + 32 * 320;
constexpr int HG_OX = HG_PF + 2048;
constexpr int HG_OXP = 132;
constexpr int HG_END = HG_OX + 2 * 32 * HG_OXP * 4;
static_assert(HG_END <= LDS_TAB, "HGRN LDS");

template <bool SMP>
__device__ __forceinline__ void hgrn_unit(Frame& F, int m, int b, int h) {
    LAS unsigned char* L = F.lds;
    const bf16_t* H = (const bf16_t*)(F.ws + WS_H); const float* LFg = (const float*)(F.ws + WS_LF); bf16_t* MIX = (bf16_t*)(F.ws + WS_MIX);
    const float* gn = F.in[I_HNG] + (size_t)m * 512 + h * 128;
    const int tid = opq(F.tid), lane = tid & 63, wave = __builtin_amdgcn_readfirstlane(tid >> 6), r = lane & 31, hh = lane >> 5;
    const int nb = wave & 3, kh = wave >> 2;
    const size_t row0 = SMP ? (size_t)MP + (size_t)b * ST : (size_t)b * PT;
    const int nsteps = SMP ? 1 : PT / 32;
    f32x16 S[2];
    if (SMP) { const float* s0 = F.in[I_SH] + (((size_t)m * SB + b) * NH + h) * 128 * 128 + (size_t)(64 * kh + 4 * hh) * 128 + 32 * nb + r;
#pragma unroll
        for (int kbl = 0; kbl < 2; ++kbl)
#pragma unroll
            for (int i = 0; i < 16; ++i) S[kbl][i] = s0[(32 * kbl + (i & 3) + 8 * (i >> 2)) * 128];
    } else {
#pragma unroll
        for (int kbl = 0; kbl < 2; ++kbl)
#pragma unroll
            for (int i = 0; i < 16; ++i) S[kbl][i] = 0.f;
    }
    const int et = tid >> 4, ek = (tid & 15) * 8;
    const bool valid = !SMP || et < ST;
    f32x4 lf0 = {0.f, 0.f, 0.f, 0.f}, lf1 = {0.f, 0.f, 0.f, 0.f}; u32x4 qw = {0u, 0u, 0u, 0u}, vw = {0u, 0u, 0u, 0u}, gw = {0u, 0u, 0u, 0u};
    if (valid) { const size_t row = row0 + et;
        lf0 = *(const f32x4*)(LFg + row * 512 + h * 128 + ek); lf1 = *(const f32x4*)(LFg + row * 512 + h * 128 + ek + 4);
        qw = *(const u32x4*)(H + row * INC + C_AQ + h * 128 + ek); vw = *(const u32x4*)(H + row * INC + C_AI + h * 128 + ek); gw = *(const u32x4*)(H + row * INC + C_AG + h * 128 + ek); }
    for (int step = 0; step < nsteps; ++step) {
        const size_t row = row0 + (size_t)step * 32 + et;
        *(LAS f32x4*)(L + HG_LF + (et * 128 + ek) * 4) = lf0; *(LAS f32x4*)(L + HG_LF + (et * 128 + ek + 4) * 4) = lf1;
        f32x4 nlf0 = lf0, nlf1 = lf1; u32x4 nqw = qw, nvw = vw, ngw = gw;
        if (!SMP && step + 1 < nsteps) { const size_t rn = row + 32;
            nlf0 = *(const f32x4*)(LFg + rn * 512 + h * 128 + ek); nlf1 = *(const f32x4*)(LFg + rn * 512 + h * 128 + ek + 4);
            nqw = *(const u32x4*)(H + rn * INC + C_AQ + h * 128 + ek); nvw = *(const u32x4*)(H + rn * INC + C_AI + h * 128 + ek); ngw = *(const u32x4*)(H + rn * INC + C_AG + h * 128 + ek); }
        __syncthreads();
        { const int k = tid & 127, tq = tid >> 7; LAS float* p = (LAS float*)(L + HG_LF) + (8 * tq) * 128 + k; float vs[8];
#pragma unroll
            for (int i = 0; i < 8; ++i) vs[i] = p[i * 128];
#pragma unroll
            for (int i = 1; i < 8; ++i) vs[i] += vs[i - 1];
#pragma unroll
            for (int i = 0; i < 8; ++i) p[i * 128] = vs[i];
            ((LAS float*)(L + HG_TOT))[tq * 128 + k] = vs[7]; }
        __syncthreads();
        { float bcum[8];
            { const f32x4 c0 = *(LAS f32x4*)(L + HG_LF + (et * 128 + ek) * 4), c1 = *(LAS f32x4*)(L + HG_LF + (et * 128 + ek + 4) * 4);
#pragma unroll
              for (int e = 0; e < 4; ++e) { bcum[e] = c0[e]; bcum[4 + e] = c1[e]; } }
            for (int gq = 0; gq < (et >> 3); ++gq) { const f32x4 c0 = *(LAS f32x4*)(L + HG_TOT + (gq * 128 + ek) * 4), c1 = *(LAS f32x4*)(L + HG_TOT + (gq * 128 + ek + 4) * 4);
#pragma unroll
                for (int e = 0; e < 4; ++e) { bcum[e] += c0[e]; bcum[4 + e] += c1[e]; } }
            float qv[8]; unpk8(qw, qv);
            float qt[8], kt[8];
#pragma unroll
            for (int e = 0; e < 8; ++e) { const float lfe = e < 4 ? lf0[e] : lf1[e - 4]; const float eb = __expf(bcum[e]);
                qt[e] = qv[e] * eb; kt[e] = (1.f - __expf(lfe)) * __expf(-bcum[e]);
                if (et == 31) ((LAS float*)(L + HG_G))[ek + e] = eb; }
            const u32x4 qp = pk8(qt), kp = pk8(kt);
            *(LAS u32x4*)(L + HG_QT + et * 272 + ek * 2) = qp;
            *(LAS u32x4*)(L + HG_KS + et * 320 + ek * 2) = kp;
            *(LAS u32x4*)(L + HG_V + et * 320 + ek * 2) = vw;
        }
        __syncthreads();
        if (wave == 0) {
            f32x16 pt;
#pragma unroll
            for (int i = 0; i < 16; ++i) pt[i] = 0.f;
#pragma unroll
            for (int st = 0; st < 8; ++st) { const bf16x8 a = *(const LAS bf16x8*)(L + HG_KS + r * 320 + (16 * st + 8 * hh) * 2), bq = *(const LAS bf16x8*)(L + HG_QT + r * 272 + (16 * st + 8 * hh) * 2);
                pt = MFMA32(a, bq, pt); }
#pragma unroll
            for (int i = 0; i < 16; ++i) if (crow(i, hh) > r) pt[i] = 0.f;
            *(LAS bf16x8*)(L + HG_PF + lane * 16) = pack_step(pt, 0); *(LAS bf16x8*)(L + HG_PF + 1024 + lane * 16) = pack_step(pt, 1);
        }
        f32x16 oacc;
#pragma unroll
        for (int i = 0; i < 16; ++i) oacc[i] = 0.f;
#pragma unroll
        for (int kbl = 0; kbl < 2; ++kbl)
#pragma unroll
            for (int s2 = 0; s2 < 2; ++s2) { const int k0 = 64 * kh + 32 * kbl + 16 * s2 + 4 * hh;
                const s16x4 lo = *(const LAS s16x4*)(L + HG_QT + r * 272 + k0 * 2), hi = *(const LAS s16x4*)(L + HG_QT + r * 272 + (k0 + 8) * 2);
                oacc = MFMA32(pack_step(S[kbl], s2), cat8(lo, hi), oacc); }
        __syncthreads();
        const int i16 = lane & 15, tq = i16 >> 2, tp = i16 & 3, gi = (lane >> 4) & 1;
        if (kh == 0) {
#pragma unroll
            for (int s2 = 0; s2 < 2; ++s2) { const int key0 = 16 * s2 + 4 * hh;
                const s16x4 lo = vtr(L + HG_V + (key0 + tq) * 320 + (32 * nb + 16 * gi + 4 * tp) * 2), hi = vtr(L + HG_V + (key0 + 8 + tq) * 320 + (32 * nb + 16 * gi + 4 * tp) * 2);
                const bf16x8 pf = *(const LAS bf16x8*)(L + HG_PF + s2 * 1024 + lane * 16);
                oacc = MFMA32(cat8(lo, hi), pf, oacc); }
        }
#pragma unroll
        for (int i4 = 0; i4 < 4; ++i4) { const f32x4 o4 = {oacc[4 * i4], oacc[4 * i4 + 1], oacc[4 * i4 + 2], oacc[4 * i4 + 3]};
            *(LAS f32x4*)(L + HG_OX + ((kh * 32 + r) * HG_OXP + 32 * nb + 8 * i4 + 4 * hh) * 4) = o4; }
#pragma unroll
        for (int kbl = 0; kbl < 2; ++kbl)
#pragma unroll
            for (int s2 = 0; s2 < 2; ++s2) { const int key0 = 16 * s2 + 8 * hh;
                const s16x4 alo = vtr(L + HG_KS + (key0 + tq) * 320 + (64 * kh + 32 * kbl + 16 * gi + 4 * tp) * 2), ahi = vtr(L + HG_KS + (key0 + 4 + tq) * 320 + (64 * kh + 32 * kbl + 16 * gi + 4 * tp) * 2);
                const s16x4 lo = vtr(L + HG_V + (key0 + tq) * 320 + (32 * nb + 16 * gi + 4 * tp) * 2), hi = vtr(L + HG_V + (key0 + 4 + tq) * 320 + (32 * nb + 16 * gi + 4 * tp) * 2);
                S[kbl] = MFMA32(cat8(alo, ahi), cat8(lo, hi), S[kbl]); }
#pragma unroll
        for (int kbl = 0; kbl < 2; ++kbl)
#pragma unroll
            for (int i = 0; i < 16; ++i) S[kbl][i] *= ((LAS float*)(L + HG_G))[64 * kh + 32 * kbl + crow(i, hh)];
        __syncthreads();
        { float o[8], ss = 0.f;
#pragma unroll
            for (int e4 = 0; e4 < 2; ++e4) { const f32x4 a4 = *(LAS f32x4*)(L + HG_OX + (et * HG_OXP + ek + 4 * e4) * 4), b4 = *(LAS f32x4*)(L + HG_OX + ((32 + et) * HG_OXP + ek + 4 * e4) * 4);
#pragma unroll
                for (int e = 0; e < 4; ++e) { o[4 * e4 + e] = a4[e] + b4[e]; ss += o[4 * e4 + e] * o[4 * e4 + e]; } }
            ss += shx(ss, 1); ss += shx(ss, 2); ss += shx(ss, 4); ss += shx(ss, 8);
            const float rstd = 1.f / sqrtf(ss * (1.f / 128.f) + RMS_EPS);
            float gv[8]; unpk8(gw, gv);
            const f32x4 g0 = *(const f32x4*)(gn + ek), g1 = *(const f32x4*)(gn + ek + 4);
#pragma unroll
            for (int e = 0; e < 8; ++e) { const float y = o[e] * rstd * (e < 4 ? g0[e] : g1[e - 4]); o[e] = y * (gv[e] / (1.f + __expf(-gv[e]))); }
            if (valid) *(u32x4*)(MIX + row * D + h * 128 + ek) = pk8(o);
        }
        lf0 = nlf0; lf1 = nlf1; qw = nqw; vw = nvw; gw = ngw;
    }
    { float* so = (SMP ? F.out + O_HS + (((size_t)m * SB + b) * NH + h) * 128 * 128 : F.out + O_HP + (((size_t)m * PB + b) * NH + h) * 128 * 128);
      const int l2 = opq(lane); float* sp = so + (size_t)(64 * kh + 4 * (l2 >> 5)) * 128 + 32 * nb + (l2 & 31);
#pragma unroll
      for (int kbl = 0; kbl < 2; ++kbl)
#pragma unroll
        for (int i = 0; i < 16; ++i) sp[(32 * kbl + (i & 3) + 8 * (i >> 2)) * 128] = S[kbl][i]; }
    __syncthreads();
}

constexpr int AT_KP = 272, AT_VP = 320;
constexpr int AT_KB = 64 * AT_KP, AT_VB = 64 * AT_VP;
constexpr int AT_TILE = AT_KB + AT_VB;
static_assert(4 * AT_TILE <= LDS_TAB && (8 * 66 * 64 + 64 * 64 + 8 * 64) * 4 <= LDS_TAB && 2 * AT_TILE + 8 * 2 * 32 * 144 <= LDS_TAB, "attention LDS");

__device__ __forceinline__ void attn_build_tab(Frame& F, int h) {
    const int tid = opq(F.tid);
    if (tid < 256) { const int rel = tid - 128, n = rel < 0 ? -rel : rel;
        int bk = n;
        if (n >= 8) bk = 8 + (n >= 12) + (n >= 16) + (n >= 23) + (n >= 32) + (n >= 46) + (n >= 64) + (n >= 91);
        if (rel > 0) bk += 16;
        ((LAS float*)(F.lds + LDS_TAB))[tid] = F.in[I_RB][bk * NH + h] * LOG2E; }
}
struct AttnState { f32x16 o[4]; float m, l; };
template <bool MASK_END>
__device__ __forceinline__ void attn_tile(const LAS unsigned char* Kt, const LAS unsigned char* Vt, int vh, const bf16x8 (&qf)[4], AttnState& A, int kpos0, int qpos, int qpos_min, int kv_end,
                                          const LAS float* tab, int r, int hh, int lane) {
    f32x16 st[2];
#pragma unroll
    for (int kb = 0; kb < 2; ++kb) {
#pragma unroll
        for (int i = 0; i < 16; ++i) st[kb][i] = 0.f;
#pragma unroll
        for (int s = 0; s < 4; ++s) { const bf16x8 a = *(const LAS bf16x8*)(Kt + (32 * kb + r) * AT_KP + (vh * 64 + 16 * s + 8 * hh) * 2); st[kb] = MFMA32(a, qf[s], st[kb]); }
    }
    constexpr float C2 = 0.125f * LOG2E;
    const bool far = (kpos0 + 63) <= (qpos_min - 91);
    if (far) { const float bc = tab[0]; const f32x2 c2 = {C2, C2}, b2 = {bc, bc};
#pragma unroll
        for (int kb = 0; kb < 2; ++kb)
#pragma unroll
            for (int j = 0; j < 8; ++j) { const f32x2 x = (f32x2){st[kb][2 * j], st[kb][2 * j + 1]} * c2 + b2; st[kb][2 * j] = x[0]; st[kb][2 * j + 1] = x[1]; }
    } else {
#pragma unroll
        for (int kb = 0; kb < 2; ++kb)
#pragma unroll
            for (int i = 0; i < 16; ++i) { const int kpos = kpos0 + 32 * kb + crow(i, hh); int rel = kpos - qpos; rel = rel < -128 ? -128 : (rel > 127 ? 127 : rel);
                float x = st[kb][i] * C2 + tab[rel + 128];
                if (MASK_END) x = (kpos < kv_end) ? x : -1e30f;
                st[kb][i] = x; }
    }
    float mx = st[0][0];
#pragma unroll
    for (int kb = 0; kb < 2; ++kb)
#pragma unroll
        for (int i = 0; i < 16; ++i) mx = fmaxf(mx, st[kb][i]);
    mx = fmaxf(mx, shx(mx, 32));
    if (__any(mx > A.m + 8.f)) {
        const float mnew = fmaxf(A.m, mx), alpha = __builtin_amdgcn_exp2f(A.m - mnew);
        A.m = mnew; A.l *= alpha;
#pragma unroll
        for (int mb = 0; mb < 4; ++mb)
#pragma unroll
            for (int i = 0; i < 16; ++i) A.o[mb][i] *= alpha;
    }
    { const float off = -A.m; const f32x2 off2 = {off, off};
      f32x2 ls2 = {0.f, 0.f};
#pragma unroll
      for (int kb = 0; kb < 2; ++kb)
#pragma unroll
        for (int j = 0; j < 8; ++j) { const f32x2 x = (f32x2){st[kb][2 * j], st[kb][2 * j + 1]} + off2;
            const f32x2 p = {__builtin_amdgcn_exp2f(x[0]), __builtin_amdgcn_exp2f(x[1])};
            st[kb][2 * j] = p[0]; st[kb][2 * j + 1] = p[1]; ls2 += p; }
      A.l += ls2[0] + ls2[1]; }
    const int i16 = lane & 15, tq = i16 >> 2, tp = i16 & 3, gi = (lane >> 4) & 1;
#pragma unroll
    for (int kb = 0; kb < 2; ++kb)
#pragma unroll
        for (int s2 = 0; s2 < 2; ++s2) { const bf16x8 pf = pack_step(st[kb], s2); const int key0 = 32 * kb + 16 * s2 + 4 * hh;
#pragma unroll
            for (int mb = 0; mb < 4; ++mb) {
                const s16x4 lo = vtr(Vt + (key0 + tq) * AT_VP + (32 * mb + 16 * gi + 4 * tp) * 2), hi = vtr(Vt + (key0 + 8 + tq) * AT_VP + (32 * mb + 16 * gi + 4 * tp) * 2);
                A.o[mb] = MFMA32(cat8(lo, hi), pf, A.o[mb]); } }
}
__device__ __forceinline__ void attn_store(const f32x16 (&o)[4], const float* gnorm, float post, bf16_t* dst_row  , int hh, bool active) {
    float ss = 0.f;
#pragma unroll
    for (int mb = 0; mb < 4; ++mb)
#pragma unroll
        for (int i = 0; i < 16; ++i) ss += o[mb][i] * o[mb][i];
    ss += shx(ss, 32);
    const float rstd = post / sqrtf(ss * (1.f / 128.f) + RMS_EPS);
    if (active) {
#pragma unroll
        for (int mb = 0; mb < 4; ++mb)
#pragma unroll
            for (int g4 = 0; g4 < 4; ++g4) { const int dv = 32 * mb + 8 * g4 + 4 * hh; const f32x4 gv = *(const f32x4*)(gnorm + dv);
                u32x2 w; w.x = pk2(o[mb][4 * g4] * rstd * gv[0], o[mb][4 * g4 + 1] * rstd * gv[1]); w.y = pk2(o[mb][4 * g4 + 2] * rstd * gv[2], o[mb][4 * g4 + 3] * rstd * gv[3]);
                *(u32x2*)(dst_row + dv) = w; }
    }
}

__device__ __forceinline__ void attn_prompt_unit(Frame& F, int m, int b, int h, int qb) {
    LAS unsigned char* L = F.lds; const LAS float* tab = (const LAS float*)(L + LDS_TAB);
    const bf16_t* H = (const bf16_t*)(F.ws + WS_H); bf16_t* MIX = (bf16_t*)(F.ws + WS_MIX);
    const int tid = opq(F.tid), lane = tid & 63, wave = __builtin_amdgcn_readfirstlane(tid >> 6), r = lane & 31, hh = lane >> 5, vh = wave >> 2, wq = wave & 3;
    const size_t rowb = (size_t)b * PT;
    const int q0a = qb * 256 + wq * 32, q0b = q0a + 128, qca = q0a >> 6, qcb = q0b >> 6, nkt = 4 * qb + 4;
    attn_build_tab(F, h);
    LAS unsigned char* qs = L + 2 * AT_TILE + wave * (2 * 32 * 144) + r * 144 + 16 * hh;
#pragma unroll
    for (int s = 0; s < 4; ++s) { *(LAS bf16x8*)(qs + 32 * s) = *(const bf16x8*)(H + (rowb + q0a + r) * INC + C_BQ + h * 128 + vh * 64 + 16 * s + 8 * hh);
        *(LAS bf16x8*)(qs + 32 * 144 + 32 * s) = *(const bf16x8*)(H + (rowb + q0b + r) * INC + C_BQ + h * 128 + vh * 64 + 16 * s + 8 * hh); }
    AttnState A0, A1;
#pragma unroll
    for (int mb = 0; mb < 4; ++mb)
#pragma unroll
        for (int i = 0; i < 16; ++i) { A0.o[mb][i] = 0.f; A1.o[mb][i] = 0.f; }
    A0.m = -1e30f; A0.l = 0.f; A1.m = -1e30f; A1.l = 0.f;
    u32x4 kr[2], vr[2];
#define AT_LD(kt) do { _Pragma("unroll") for (int i_ = 0; i_ < 2; ++i_) { const int c_ = tid + 512 * i_, key_ = c_ >> 4, ch_ = c_ & 15; const bf16_t* src_ = H + (rowb + 64 * (kt) + key_) * INC + h * 128 + ch_ * 8; \
        kr[i_] = *(const u32x4*)(src_ + C_BK); vr[i_] = *(const u32x4*)(src_ + C_BV); } } while (0)
#define AT_ST(buf) do { _Pragma("unroll") for (int i_ = 0; i_ < 2; ++i_) { const int c_ = tid + 512 * i_, key_ = c_ >> 4, ch_ = c_ & 15; \
        *(LAS u32x4*)(L + (buf) * AT_TILE + key_ * AT_KP + ch_ * 16) = kr[i_]; *(LAS u32x4*)(L + (buf) * AT_TILE + AT_KB + key_ * AT_VP + ch_ * 16) = vr[i_]; } } while (0)
    AT_LD(0); AT_ST(0);
    AT_LD(1);
    __syncthreads();
    for (int kt = 0; kt < nkt; ++kt) {
        if (kt <= qca) { bf16x8 qf[4];
#pragma unroll
            for (int s = 0; s < 4; ++s) qf[s] = *(const LAS bf16x8*)(qs + 32 * s);
            attn_tile<false>(L + (kt & 1) * AT_TILE, L + (kt & 1) * AT_TILE + AT_KB, vh, qf, A0, 64 * kt, q0a + r, q0a, 0, tab, r, hh, lane); }
        if (kt <= qcb) { bf16x8 qf[4];
#pragma unroll
            for (int s = 0; s < 4; ++s) qf[s] = *(const LAS bf16x8*)(qs + 32 * 144 + 32 * s);
            attn_tile<false>(L + (kt & 1) * AT_TILE, L + (kt & 1) * AT_TILE + AT_KB, vh, qf, A1, 64 * kt, q0b + r, q0b, 0, tab, r, hh, lane); }
        if (kt + 1 < nkt) AT_ST((kt + 1) & 1);
        if (kt + 2 < nkt) AT_LD(kt + 2);
        __syncthreads();
    }
#undef AT_LD
#undef AT_ST
    { const float l0 = A0.l + shx(A0.l, 32), i0 = 1.f / l0, l1 = A1.l + shx(A1.l, 32), i1 = 1.f / l1;
#pragma unroll
        for (int mb = 0; mb < 4; ++mb)
#pragma unroll
            for (int i = 0; i < 16; ++i) { A0.o[mb][i] *= i0; A1.o[mb][i] *= i1; } }
    LAS float* X = (LAS float*)L;
    if (vh == 1) {
#pragma unroll
        for (int mb = 0; mb < 4; ++mb)
#pragma unroll
            for (int i = 0; i < 16; ++i) { X[(wq * 64 + mb * 16 + i) * 64 + lane] = A0.o[mb][i]; X[((4 + wq) * 64 + mb * 16 + i) * 64 + lane] = A1.o[mb][i]; }
    }
    __syncthreads();
    if (vh == 0) {
        const float lam = ((const float*)(F.ws + WS_TAB))[TB_LAM + m];
        const float lam_init = (m == 0) ? 0.2f : 0.47071302f;
#pragma unroll
        for (int mb = 0; mb < 4; ++mb)
#pragma unroll
            for (int i = 0; i < 16; ++i) A0.o[mb][i] -= lam * X[(wq * 64 + mb * 16 + i) * 64 + lane];
        attn_store(A0.o, F.in[I_DNG] + (size_t)m * 128, 1.f - lam_init, MIX + (rowb + q0a + r) * D + 512 + h * 128, hh, true);
#pragma unroll
        for (int mb = 0; mb < 4; ++mb)
#pragma unroll
            for (int i = 0; i < 16; ++i) A1.o[mb][i] -= lam * X[((4 + wq) * 64 + mb * 16 + i) * 64 + lane];
        attn_store(A1.o, F.in[I_DNG] + (size_t)m * 128, 1.f - lam_init, MIX + (rowb + q0b + r) * D + 512 + h * 128, hh, true);
    }
    __syncthreads();
}

__device__ __forceinline__ void attn_sample_unit(Frame& F, int m, int b, int h) {
    LAS unsigned char* L = F.lds; const LAS float* tab = (const LAS float*)(L + LDS_TAB);
    const bf16_t* H = (const bf16_t*)(F.ws + WS_H); bf16_t* MIX = (bf16_t*)(F.ws + WS_MIX);
    const float* ck = F.in[I_CK] + (((size_t)m * SB + b) * PAST) * 512 + h * 128; const float* cv = F.in[I_CV] + (((size_t)m * SB + b) * PAST) * 512 + h * 128;
    const int tid = opq(F.tid), lane = tid & 63, wave = __builtin_amdgcn_readfirstlane(tid >> 6), r = lane & 31, hh = lane >> 5, vh = wave >> 2, ks = wave & 3;
    const size_t rows = (size_t)MP + (size_t)b * ST;
    attn_build_tab(F, h);
    bf16x8 qf[4];
#pragma unroll
    for (int s = 0; s < 4; ++s) qf[s] = *(const bf16x8*)(H + (rows + (r & 15)) * INC + C_BQ + h * 128 + vh * 64 + 16 * s + 8 * hh);
    AttnState A;
#pragma unroll
    for (int mb = 0; mb < 4; ++mb)
#pragma unroll
        for (int i = 0; i < 16; ++i) A.o[mb][i] = 0.f;
    A.m = -1e30f; A.l = 0.f;
    constexpr int NT = PAST / 64 + 1;
    for (int it = 0; it < (NT + 3) / 4; ++it) {
#pragma unroll 1
        for (int j = 0; j < 4; ++j) { const int T = 4 * it + j;
#pragma unroll
            for (int i = 0; i < 2; ++i) { const int c = tid + 512 * i, key = c >> 4, ch = c & 15;
                u32x4 kw = {0u, 0u, 0u, 0u}, vw = {0u, 0u, 0u, 0u};
                if (T < PAST / 64) { const float* pk = ck + (size_t)(64 * T + key) * 512 + ch * 8; const float* pv = cv + (size_t)(64 * T + key) * 512 + ch * 8;
                    const f32x4 k0 = *(const f32x4*)pk, k1 = *(const f32x4*)(pk + 4), v0 = *(const f32x4*)pv, v1 = *(const f32x4*)(pv + 4);
                    kw.x = pk2(k0[0], k0[1]); kw.y = pk2(k0[2], k0[3]); kw.z = pk2(k1[0], k1[1]); kw.w = pk2(k1[2], k1[3]);
                    vw.x = pk2(v0[0], v0[1]); vw.y = pk2(v0[2], v0[3]); vw.z = pk2(v1[0], v1[1]); vw.w = pk2(v1[2], v1[3]); }
                else if (T == PAST / 64 && key < ST) { const bf16_t* src = H + (rows + key) * INC + h * 128 + ch * 8; kw = *(const u32x4*)(src + C_BK); vw = *(const u32x4*)(src + C_BV); }
                *(LAS u32x4*)(L + j * AT_TILE + key * AT_KP + ch * 16) = kw; *(LAS u32x4*)(L + j * AT_TILE + AT_KB + key * AT_VP + ch * 16) = vw; } }
        __syncthreads();
        { const int T = 4 * it + ks;
            if (T < NT - 1) attn_tile<false>(L + ks * AT_TILE, L + ks * AT_TILE + AT_KB, vh, qf, A, 64 * T, PAST + (r & 15), PAST, 0, tab, r, hh, lane);
            else if (T == NT - 1) attn_tile<true>(L + ks * AT_TILE, L + ks * AT_TILE + AT_KB, vh, qf, A, 64 * T, PAST + (r & 15), PAST, PAST + ST, tab, r, hh, lane); }
        __syncthreads();
    }
    const float lt = A.l + shx(A.l, 32);
    LAS float* X = (LAS float*)L;
#pragma unroll
    for (int mb = 0; mb < 4; ++mb)
#pragma unroll
        for (int i = 0; i < 16; ++i) X[(wave * 66 + mb * 16 + i) * 64 + lane] = A.o[mb][i];
    X[(wave * 66 + 64) * 64 + lane] = A.m; X[(wave * 66 + 65) * 64 + lane] = lt;
    LAS float* Y = X + 8 * 66 * 64;
    LAS float* SS = Y + 64 * 64;
    __syncthreads();
    {
        const float lam = ((const float*)(F.ws + WS_TAB))[TB_LAM + m];
        float coef[8];
#pragma unroll
        for (int v2 = 0; v2 < 2; ++v2) {
            float M = -1e30f;
#pragma unroll
            for (int k = 0; k < 4; ++k) M = fmaxf(M, X[((v2 * 4 + k) * 66 + 64) * 64 + lane]);
            float Ls = 0.f;
#pragma unroll
            for (int k = 0; k < 4; ++k) { coef[v2 * 4 + k] = __builtin_amdgcn_exp2f(X[((v2 * 4 + k) * 66 + 64) * 64 + lane] - M); Ls += coef[v2 * 4 + k] * X[((v2 * 4 + k) * 66 + 65) * 64 + lane]; }
            const float sc = (v2 == 0 ? 1.f : -lam) / Ls;
#pragma unroll
            for (int k = 0; k < 4; ++k) coef[v2 * 4 + k] *= sc;
        }
        float ss = 0.f;
#pragma unroll
        for (int i8 = 0; i8 < 8; ++i8) { const int row = 8 * wave + i8; float y = 0.f;
#pragma unroll
            for (int p = 0; p < 8; ++p) y += coef[p] * X[(p * 66 + row) * 64 + lane];
            Y[row * 64 + lane] = y; ss += y * y; }
        SS[wave * 64 + lane] = ss;
    }
    __syncthreads();
    if (wave == 0) {
        float ss = 0.f;
#pragma unroll
        for (int w = 0; w < 8; ++w) ss += SS[w * 64 + lane];
        ss += shx(ss, 32);
        const float lam_init = (m == 0) ? 0.2f : 0.47071302f;
        const float rstd = (1.f - lam_init) / sqrtf(ss * (1.f / 128.f) + RMS_EPS);
        const float* gnorm = F.in[I_DNG] + (size_t)m * 128;
        bf16_t* dst_row = MIX + (rows + (r & 15)) * D + 512 + h * 128;
        if (r < ST) {
#pragma unroll
            for (int mb = 0; mb < 4; ++mb)
#pragma unroll
                for (int g4 = 0; g4 < 4; ++g4) { const int dv = 32 * mb + 8 * g4 + 4 * hh; const f32x4 gv = *(const f32x4*)(gnorm + dv); const LAS float* yp = Y + (mb * 16 + 4 * g4) * 64 + lane;
                    u32x2 w; w.x = pk2(yp[0] * rstd * gv[0], yp[64] * rstd * gv[1]); w.y = pk2(yp[128] * rstd * gv[2], yp[192] * rstd * gv[3]);
                    *(u32x2*)(dst_row + dv) = w; }
        }
    }
    __syncthreads();
}

__device__ __forceinline__ void phase_mixer(Frame& F, int m, int qsel = 0) {
    const int G = F.G, bid = F.bid;
    if (PHM & 0x1000) for (int u = bid; u < PB * NH; u += G) hgrn_unit<false>(F, m, u >> 2, u & 3);
#if PROBE_HG
    for (int u = bid; u < PB * NH; u += G) hgrn_unit<false>(F, m, u >> 2, u & 3);
#endif
    if (PHM & 0x2000) for (int u = (G >= 256 ? (bid >= 128 ? bid - 128 : bid + G - 128) : bid); u < SB * NH; u += G) attn_sample_unit(F, m, u >> 2, u & 3);
#if PROBE_SA
    for (int u = (G >= 256 ? (bid >= 128 ? bid - 128 : bid + G - 128) : bid); u < SB * NH; u += G) attn_sample_unit(F, m, u >> 2, u & 3);
#endif
    if (PHM & 0x4000) {
        gu32* head = (gu32*)(F.ws + WS_CTL) + CW_QUEUE + 64 * m + 128 * qsel;
        volatile LAS int* slot = (volatile LAS int*)(F.lds + LDS_CTRL + 64);
        for (;;) {
            if (F.tid == 0) *slot = (int)__hip_atomic_fetch_add(head, 1u, __ATOMIC_RELAXED, __HIP_MEMORY_SCOPE_AGENT);
            __syncthreads();
            const int u = *slot;
            __syncthreads();
            if (u >= PB * NH * 8) break;
            const int qb = 7 - (u >> 7), bh = u & 127;
            attn_prompt_unit(F, m, bh >> 2, bh & 3, qb);
        }
    }
    if (PHM & 0x8000) for (int u = bid; u < SB * NH; u += G) hgrn_unit<true>(F, m, u >> 2, u & 3);
}

__global__ void __launch_bounds__(NTHREADS, 2) mega_fwd(Args args) {
    extern __shared__ __attribute__((aligned(16))) unsigned char lds_raw[];
    Frame F;
    F.lds = (LAS unsigned char*)lds_raw;
    F.tid = threadIdx.x; F.lane = F.tid & 63; F.wave = __builtin_amdgcn_readfirstlane(F.tid >> 6);
    const int wave_s = F.wave;
    F.bid = blockIdx.x; F.G = gridDim.x; F.in = (kin_t)__builtin_amdgcn_kernarg_segment_ptr(); F.out = (float*)F.in[24]; F.ws = (unsigned char*)F.in[25];
    if (F.tid < 128) ((LAS unsigned*)(F.lds + LDS_CTRL))[F.tid] = 0u;
    __syncthreads();
    unsigned* barw = (unsigned*)(F.ws + WS_CTL) + CW_BAR;
    XcdBarrier bar; bar.bar = barw; bar.x = 0; bar.st = nullptr;
    const bool single = args.single != 0;
    if (single) bar = xcd_barrier_post(barw, (volatile LAS unsigned*)(F.lds + LDS_CTRL + 32));
    const int lo = args.ph_lo, hi = args.ph_hi;
#define RUN(p) (lo <= (p) && (p) < hi)
#define SEAM() do { if (single) { XcdBarrier b2_ = bar; asm volatile("" : "+s"(b2_.bar)); xcd_barrier(b2_); } } while (0)
#define REFRESH() do { { int b_ = (int)blockIdx.x, g_ = (int)gridDim.x; asm volatile("" : "+s"(b_), "+s"(g_)); F.bid = b_; F.G = g_; } { kin_t kp_ = (kin_t)__builtin_amdgcn_kernarg_segment_ptr(); asm volatile("" : "+s"(kp_)); F.in = kp_; F.out = (float*)kp_[24]; F.ws = (unsigned char*)kp_[25]; } { int l_; asm volatile("v_mbcnt_lo_u32_b32 %0, -1, 0\n\tv_mbcnt_hi_u32_b32 %0, -1, %0" : "=v"(l_)); F.lane = l_; } F.wave = wave_s; F.tid = wave_s * 64 + F.lane; } while (0)
    int ph = 0;
    if ((PHM & 1) && RUN(ph)) { REFRESH(); phase_prologue(F); SEAM();
#if PROBE_PRO
        REFRESH(); phase_prologue(F); SEAM();
#endif
    } ++ph;
    for (int l = 0; l < 4; ++l) {
#define WSB(off) ((bf16_t*)(F.ws + (off)))
#define STATS(k) ((float*)(F.ws + WS_CTL) + CW_STATS + (size_t)(k) * MT * 2)
#define LN1REF(ll) LnRef{WSB(WS_Z), STATS(2 * (ll)), F.in[I_L1G] + (size_t)(ll) * D, F.in[I_L1B] + (size_t)(ll) * D, 0}
#define LN2REF(ll) LnRef{WSB(WS_ZB), STATS(2 * (ll) + 1), F.in[I_L2G] + (size_t)(ll) * D, F.in[I_L2B] + (size_t)(ll) * D, 0}
        if ((l & 1) == 0) {
            const int m = l >> 1;
            if ((PHM & 2) && RUN(ph)) {
                REFRESH();
                const float* ctlf = (const float*)(F.ws + WS_CTL);
                pg8::Gemm g{l == 0 ? WSB(WS_XB) : WSB(WS_ZB), (const bf16_t*)(F.ws + WS_WIN) + (size_t)m * INC * D, MP, INC, D, D, 0, l == 0 ? nullptr : STATS(2 * (l - 1) + 1)}; pg8::StaticOrder S; S.init(MP, INC, F.G, F.bid);
                EpiIn E{(bf16_t*)(F.ws + WS_H), (float*)(F.ws + WS_LF), (const float*)(F.ws + WS_TAB) + TB_LB + m * 512,
                        F.out + O_KP + (size_t)m * MP * 512, F.out + O_VP + (size_t)m * MP * 512, F.out + O_KS + (size_t)m * MS * 512, F.out + O_VS + (size_t)m * MS * 512,
                        STATS(l == 0 ? 0 : 2 * (l - 1) + 1), ctlf + (l == 0 ? UC_ZERO : UC_UIN), ctlf + (l == 0 ? UC_ZERO : UC_CIN), l == 0 ? 1 : 0};
                pg8::gemm_phase<EpiIn>(F.lds, g, S, E, F.tid);
                REFRESH(); sgemm_in_phase(F.lds, g.A + (size_t)MP * D, g.Bt, F.bid, F.G, F.tid, E);
                SEAM(); } ++ph;
            if ((PHM & 4) && RUN(ph)) { REFRESH(); phase_mixer(F, m); SEAM();
#if PROBE_MIXER
                REFRESH(); phase_mixer(F, m, 1); SEAM();
#endif
            } ++ph;
            if ((PHM & 8) && RUN(ph)) {
                REFRESH();
                pg8::Gemm g{(const bf16_t*)(F.ws + WS_MIX), (const bf16_t*)(F.ws + WS_WOUT) + (size_t)m * D * D, MP, D, D, D, 0, l == 0 ? nullptr : STATS(2 * (l - 1) + 1)}; pg8::StaticOrder S; S.init(MP, D, F.G, F.bid);
                LnRef P = LN2REF(l == 0 ? 0 : l - 1); if (l == 0) { P.Z = WSB(WS_XB); P.ident = 1; }
                EpiRes E{P, WSB(WS_Z), STATS(2 * l), nullptr};
                if (F.bid & 1) { sgemm_res_phase<128>(F.lds, g.A + (size_t)MP * D, D, 0, g.Bt, D, F.bid, F.G, F.tid, P, WSB(WS_Z), STATS(2 * l), nullptr); REFRESH(); }
                pg8::gemm_phase<EpiRes>(F.lds, g, S, E, F.tid);
                REFRESH(); if (!(F.bid & 1)) sgemm_res_phase<128>(F.lds, g.A + (size_t)MP * D, D, 0, g.Bt, D, F.bid, F.G, F.tid, P, WSB(WS_Z), STATS(2 * l), nullptr);
                SEAM(); } ++ph;
        } else {
            const int p = l >> 1;
            if ((PHM & 16) && RUN(ph)) { REFRESH(); const LnRef R = LN2REF(l - 1); phase_pool_prep(F, R, p); SEAM(); } ++ph;
            ++ph;
            if ((PHM & 32) && RUN(ph)) {
                REFRESH();
                pg8::Gemm g{(const bf16_t*)(F.ws + WS_MIX), (const bf16_t*)(F.ws + WS_WPOOL) + (size_t)p * D * 256, MP, D, 256, D, 256, STATS(2 * (l - 1) + 1)}; pg8::StaticOrder S; S.init(MP, D, F.G, F.bid);
                EpiRes E{LN2REF(l - 1), WSB(WS_Z), STATS(2 * l), F.in[I_PSC] + (size_t)p * D};
                if (F.bid & 1) { const LnRef P2 = LN2REF(l - 1); sgemm_res_phase<32>(F.lds, g.A + (size_t)MP * D, D, 256, g.Bt, 256, F.bid, F.G, F.tid, P2, WSB(WS_Z), STATS(2 * l), E.scale); REFRESH(); }
                pg8::gemm_phase<EpiRes>(F.lds, g, S, E, F.tid);
                REFRESH(); if (!(F.bid & 1)) { const LnRef P2 = LN2REF(l - 1); sgemm_res_phase<32>(F.lds, g.A + (size_t)MP * D, D, 256, g.Bt, 256, F.bid, F.G, F.tid, P2, WSB(WS_Z), STATS(2 * l), E.scale); }
                SEAM(); } ++ph;
        }
        ++ph;
        if ((PHM & 128) && RUN(ph)) {
            REFRESH();
            const float* ctlf = (const float*)(F.ws + WS_CTL);
            pg8::Gemm g{WSB(WS_Z), (const bf16_t*)(F.ws + WS_WUP) + (size_t)l * UPN * D, MT, UPN, D, D, 0, STATS(2 * l)}; pg8::StaticOrder S; S.init(MT, UPN, F.G, F.bid);
            EpiUpConv E{(bf16_t*)(F.ws + WS_G), F.in[I_CW] + (size_t)l * 3 * DFF, F.in[I_CB] + (size_t)l * DFF, F.in[I_SC] + (size_t)l * SB * 2 * DFF,
                        (float*)(F.ws + WS_AHEAD), (float*)(F.ws + WS_BHEAD), (float*)(F.ws + WS_ATAIL), F.out + O_CP + (size_t)l * PB * 2 * DFF, F.out + O_CS + (size_t)l * SB * 2 * DFF, (LAS float*)(F.lds + LDS_EX),
                        STATS(2 * l), ctlf + UC_UUP + (size_t)l * UPN, ctlf + UC_CUP + (size_t)l * UPN};
            pg8::gemm_phase<EpiUpConv>(F.lds, g, S, E, F.tid); SEAM();
#if PROBE_UP
            REFRESH(); pg8::gemm_phase<EpiUpConv>(F.lds, g, S, E, F.tid); SEAM();
#endif
            } ++ph;
        ++ph;
        if ((PHM & 512) && RUN(ph)) {
            REFRESH();
            pg8::Gemm g{(const bf16_t*)(F.ws + WS_G), (const bf16_t*)(F.ws + WS_WDN) + (size_t)l * D * DFF, MP, D, DFF, DFF, 0, STATS(2 * l)}; pg8::StaticOrder S; S.init(MP, D, F.G, F.bid);
            conv_fix_local(F, l, S); REFRESH();
            EpiRes E{LN1REF(l), WSB(WS_ZB), STATS(2 * l + 1), nullptr};
            if (F.bid & 1) { const LnRef P1 = LN1REF(l); sgemm_res_phase<352>(F.lds, g.A + (size_t)MP * DFF, DFF, 0, g.Bt, DFF, F.bid, F.G, F.tid, P1, WSB(WS_ZB), STATS(2 * l + 1), nullptr); REFRESH(); }
            pg8::gemm_phase<EpiRes>(F.lds, g, S, E, F.tid);
            REFRESH(); if (!(F.bid & 1)) { const LnRef P1 = LN1REF(l); sgemm_res_phase<352>(F.lds, g.A + (size_t)MP * DFF, DFF, 0, g.Bt, DFF, F.bid, F.G, F.tid, P1, WSB(WS_ZB), STATS(2 * l + 1), nullptr); }
            SEAM(); } ++ph;
        if ((PHM & 1024) && RUN(ph) && l == 3) { REFRESH(); phase_ln_final(F, WSB(WS_ZB), F.in[I_L2G] + (size_t)3 * D, F.in[I_L2B] + (size_t)3 * D); } ++ph;
    }
#undef RUN
#undef SEAM
}
constexpr int N_PHASES = 1 + 4 * 8;

extern "C" void kernel_launch(void* const* d_in, const int* in_sizes, int n_in, void* d_out, int out_size, void* d_ws, size_t ws_size, hipStream_t stream) {
    static int grid = 0;
    if (grid == 0) {
        if (n_in != 24 || (size_t)out_size != O_END || ws_size < WS_END2) { fprintf(stderr, "kernel_launch: unexpected problem (n_in %d out %d ws %zu)\n", n_in, out_size, ws_size); grid = -1; return; }
        int dev = 0, cus = 0;
        if (hipGetDevice(&dev) != hipSuccess || hipDeviceGetAttribute(&cus, hipDeviceAttributeMultiprocessorCount, dev) != hipSuccess) { grid = -1; return; }
        if (hipFuncSetAttribute((const void*)mega_fwd, hipFuncAttributeMaxDynamicSharedMemorySize, LDS_BYTES) != hipSuccess) { fprintf(stderr, "kernel_launch: hipFuncSetAttribute failed\n"); grid = -1; return; }
        int per_cu = 0;
        if (hipOccupancyMaxActiveBlocksPerMultiprocessor(&per_cu, (const void*)mega_fwd, NTHREADS, LDS_BYTES) != hipSuccess || per_cu < 1) fprintf(stderr, "kernel_launch: occupancy query reports %d\n", per_cu);
        (void)hipGetLastError();
        grid = cus;
    }
    if (grid < 0) return;
    (void)hipMemsetAsync((char*)d_ws + WS_CTL, 0, CTL_ZERO_BYTES, stream);
    Args a{};
    for (int i = 0; i < 24; ++i) a.in[i] = (const float*)d_in[i];
    a.out = (float*)d_out; a.ws = (unsigned char*)d_ws; a.pad = 0;
#if MK_SINGLE
    a.ph_lo = 0; a.ph_hi = N_PHASES; a.single = 1;
    hipLaunchKernelGGL(mega_fwd, dim3(grid), dim3(NTHREADS), LDS_BYTES, stream, a);
#else
    for (int p = 0; p < N_PHASES; ++p) {
        const int k = (p - 1) % 8, l = (p - 1) / 8;
        if (p > 0 && (l & 1) == 1 && k == 1) continue;
        a.ph_lo = p; a.ph_hi = p + 1; a.single = 0;
        hipLaunchKernelGGL(mega_fwd, dim3(grid), dim3(NTHREADS), LDS_BYTES, stream, a);
    }
#endif
}
```

```cpp
#include <hip/hip_runtime.h>
#include <cstdio>
#include <cstdint>

#ifndef PHM
#define PHM 0xffff
#endif
#ifndef PROBE_MIXER
#define PROBE_MIXER 0
#endif
#ifndef EMU_BF16
#define EMU_BF16 0
#endif
#ifndef PROBE_LN
#define PROBE_LN 0
#endif
#ifndef PROBE_PRO
#define PROBE_PRO 0
#endif
#ifndef PROBE_HG
#define PROBE_HG 0
#endif
#ifndef PROBE_SA
#define PROBE_SA 0
#endif
#ifndef PROBE_UP
#define PROBE_UP 0
#endif
#ifndef MK_SINGLE
#define MK_SINGLE 1
#endif

#define LAS __attribute__((address_space(3)))
#define GAS __attribute__((address_space(1)))
typedef unsigned short bf16_t;
typedef short bf16x8 __attribute__((ext_vector_type(8)));
typedef short s16x4 __attribute__((ext_vector_type(4)));
typedef float f32x2 __attribute__((ext_vector_type(2)));
typedef float f32x4 __attribute__((ext_vector_type(4)));
typedef float f32x16 __attribute__((ext_vector_type(16)));
typedef unsigned u32x2 __attribute__((ext_vector_type(2)));
typedef unsigned u32x4 __attribute__((ext_vector_type(4)));
typedef __bf16 bf16x2_t __attribute__((ext_vector_type(2)));
typedef GAS unsigned gu32;

constexpr int D = 1024, PB = 32, PT = 2048, SB = 32, ST = 16, PAST = 4096;
constexpr int MP = PB * PT, MS = SB * ST, MT = MP + MS;
constexpr int INC = 3584, DFF = 2816, UPN = 2 * DFF, NH = 4;
constexpr int C_AQ = 0, C_AF = 512, C_AI = 1024, C_AG = 1536, C_BQ = 2048, C_BK = 2560, C_BV = 3072;
constexpr float DN_ALPHA = 1.681792830507429f;
constexpr float LN_EPS = 1e-5f, RMS_EPS = 1e-6f;
constexpr float LOG2E = 1.4426950408889634f;
constexpr int NWAVES = 8, NTHREADS = 512;

constexpr size_t O_YP = 0;
constexpr size_t O_YS = O_YP + (size_t)MP * D;
constexpr size_t O_KP = O_YS + (size_t)MS * D;
constexpr size_t O_VP = O_KP + (size_t)2 * MP * 512;
constexpr size_t O_HP = O_VP + (size_t)2 * MP * 512;
constexpr size_t O_PP = O_HP + (size_t)2 * PB * NH * 128 * 128;
constexpr size_t O_CP = O_PP + (size_t)2 * PB * 15 * D;
constexpr size_t O_KS = O_CP + (size_t)4 * PB * 2 * DFF;
constexpr size_t O_VS = O_KS + (size_t)2 * MS * 512;
constexpr size_t O_HS = O_VS + (size_t)2 * MS * 512;
constexpr size_t O_PS = O_HS + (size_t)2 * SB * NH * 128 * 128;
constexpr size_t O_CS = O_PS + (size_t)2 * SB * 15 * D;
constexpr size_t O_END = O_CS + (size_t)4 * SB * 2 * DFF;
static_assert(O_END == 214695936ull, "d_out size");

constexpr size_t WS_CTL = 0, CTL_ZERO_BYTES = 8u << 20;
constexpr size_t WS_WIN = CTL_ZERO_BYTES;
constexpr size_t WS_WOUT = WS_WIN + (size_t)2 * INC * D * 2;
constexpr size_t WS_WPOOL = WS_WOUT + (size_t)2 * D * D * 2;
constexpr size_t WS_WUP = WS_WPOOL + (size_t)2 * D * 256 * 2;
constexpr size_t WS_WDN = WS_WUP + (size_t)4 * UPN * D * 2;
constexpr size_t WS_TAB = WS_WDN + (size_t)4 * D * DFF * 2;
constexpr size_t WS_XB = WS_TAB + 65536;
constexpr size_t WS_Z = WS_XB + (size_t)MT * D * 2;
constexpr size_t WS_ZB = WS_Z + (size_t)MT * D * 2;
constexpr size_t WS_MIX = WS_Z + (size_t)MT * D * 4;
constexpr size_t WS_G = WS_MIX + (size_t)MT * D * 2;
constexpr size_t WS_A = WS_G + (size_t)MT * DFF * 2;
constexpr size_t WS_H = WS_A;
constexpr size_t WS_LF = WS_H + (size_t)MT * INC * 2;
constexpr size_t WS_AB = WS_A;
constexpr size_t WS_END = WS_A + (size_t)MT * UPN * 2;
static_assert(WS_LF + (size_t)MT * 512 * 4 <= WS_END, "H|LF inside region A");
constexpr size_t SIDE_BYTES = (size_t)(MT / 256) * 2 * DFF * 4;
constexpr size_t WS_AHEAD = WS_END, WS_BHEAD = WS_AHEAD + SIDE_BYTES, WS_ATAIL = WS_BHEAD + SIDE_BYTES, WS_END2 = WS_ATAIL + SIDE_BYTES;
static_assert(WS_END2 <= 2147483648ull, "workspace");
constexpr int CW_TMO = 0;
constexpr int CW_BAR = 4096;
constexpr int CW_QUEUE = 16384;
constexpr int CW_STATS = 262144;
constexpr int CW_UC = CW_STATS + 8 * MT * 2;
constexpr int UC_UUP = CW_UC, UC_CUP = UC_UUP + 4 * UPN, UC_UIN = UC_CUP + 4 * UPN, UC_CIN = UC_UIN + INC, UC_ZERO = UC_CIN + INC, UC_END = UC_ZERO + INC;
static_assert((size_t)UC_END * 4 <= CTL_ZERO_BYTES, "zeroed region");
constexpr int TB_LB = 0;
constexpr int TB_LAM = 1024;

constexpr int LDS_BYTES = 163840;
constexpr int LDS_CTRL = LDS_BYTES - 512;
constexpr int LDS_TAB = LDS_CTRL - 1024;
constexpr int LDS_STT = 131072 + 4096;
constexpr int LDS_CT = 131072 + 8192;
constexpr int LDS_EX = 131072;

__device__ __forceinline__ unsigned pk2(float lo, float hi) { f32x2 v = {lo, hi}; bf16x2_t b = __builtin_convertvector(v, bf16x2_t); return __builtin_bit_cast(unsigned, b); }
__device__ __forceinline__ float bflo(unsigned u) { return __builtin_bit_cast(float, u << 16); }
__device__ __forceinline__ float bfhi(unsigned u) { return __builtin_bit_cast(float, u & 0xffff0000u); }
__device__ __forceinline__ u32x4 pk8(const float* v) { u32x4 w; w.x = pk2(v[0], v[1]); w.y = pk2(v[2], v[3]); w.z = pk2(v[4], v[5]); w.w = pk2(v[6], v[7]); return w; }
__device__ __forceinline__ void unpk8(u32x4 w, float* v) { v[0] = bflo(w.x); v[1] = bfhi(w.x); v[2] = bflo(w.y); v[3] = bfhi(w.y); v[4] = bflo(w.z); v[5] = bfhi(w.z); v[6] = bflo(w.w); v[7] = bfhi(w.w); }
__device__ __forceinline__ int opq(int x) { asm volatile("" : "+v"(x)); return x; }
__device__ __forceinline__ int lane_id_v() { int l_; asm volatile("v_mbcnt_lo_u32_b32 %0, -1, 0\n\tv_mbcnt_hi_u32_b32 %0, -1, %0" : "=v"(l_)); return l_; }
__device__ __forceinline__ float shx_lb(float v, int lb4, int m) { return __builtin_bit_cast(float, __builtin_amdgcn_ds_bpermute(lb4 ^ (m << 2), __builtin_bit_cast(int, v))); }
__device__ __forceinline__ float shx(float v, int m) { return shx_lb(v, lane_id_v() << 2, m); }
__device__ __forceinline__ float wave_sum(float v) { const int lb = lane_id_v() << 2;
#pragma unroll
    for (int o = 1; o < 64; o <<= 1) v += shx_lb(v, lb, o);
    return v; }
__device__ __forceinline__ float silu_mul(float c, float b) { return c * __builtin_amdgcn_rcpf(1.f + __builtin_amdgcn_exp2f(-LOG2E * c)) * b; }
__device__ __forceinline__ int crow(int reg, int h) { return (reg & 3) + 8 * (reg >> 2) + 4 * h; }
__device__ __forceinline__ s16x4 vtr(const LAS unsigned char* p) { return __builtin_bit_cast(s16x4, __builtin_amdgcn_ds_read_tr16_b64_v4i16((LAS s16x4*)p)); }
__device__ __forceinline__ bf16x8 cat8(s16x4 lo, s16x4 hi) { return (bf16x8){lo[0], lo[1], lo[2], lo[3], hi[0], hi[1], hi[2], hi[3]}; }
#define MFMA32(a, b, c) __builtin_amdgcn_mfma_f32_32x32x16_bf16((a), (b), (c), 0, 0, 0)
__device__ __forceinline__ bf16x8 pack_step(const f32x16& x, int s) {
    u32x4 p; p.x = pk2(x[8 * s], x[8 * s + 1]); p.y = pk2(x[8 * s + 2], x[8 * s + 3]); p.z = pk2(x[8 * s + 4], x[8 * s + 5]); p.w = pk2(x[8 * s + 6], x[8 * s + 7]);
    return __builtin_bit_cast(bf16x8, p);
}

namespace pg8 {
constexpr int BM = 256, BK = 64, HALF = 128, HTB = HALF * BK * 2, STAGE_BYTES = 8 * HTB, NXCD = 8, WGM = 8;
__host__ __device__ __forceinline__ int lds_byte(int r, int c) { const int st = (r >> 4) * 2 + (c >> 5), rr = r & 15, cc = c & 31, ob = rr * 64 + cc * 2; return st * 1024 + (ob ^ (((ob >> 9) & 1) << 5)); }
__host__ __device__ __forceinline__ void stage_rc(int b, int& R, int& C) { const int st = b / 1024, sb = b % 1024, swz = sb ^ (((sb >> 9) & 1) << 5); R = (st >> 1) * 16 + swz / 64; C = (st & 1) * 32 + (swz % 64) / 2; }
__host__ __device__ __forceinline__ int perm32(int rho) { const int n = rho >> 4, i = rho & 15; return 8 * (i >> 2) + 4 * n + (i & 3); }
struct Unit { int pm, pn; };
struct Gemm { const bf16_t* A; const bf16_t* Bt; int M, N, K, lda, a_pn_step; const float* st; };
template <int N> __device__ __forceinline__ void wait_v() { asm volatile("s_waitcnt vmcnt(%0)" :: "n"(N) : "memory"); }
struct StaticOrder {
    int nM, nN, nwg, G, c;
    __device__ void init(int M, int N, int G_, int c_) { nM = M / BM; nN = N / BM; nwg = nM * nN; G = G_; c = c_; }
    __device__ bool next(int i, Unit& u) const {
        const long L = (long)i * G + c; if (L >= nwg) return false;
        int wgid = (int)L; { const int q = nwg / NXCD, r = nwg % NXCD, xcd = wgid % NXCD, off = wgid / NXCD; wgid = (xcd < r ? xcd * (q + 1) : r * (q + 1) + (xcd - r) * q) + off; }
        const int nig = WGM * nN, gid = wgid / nig, fm = gid * WGM, gsz = (nM - fm) < WGM ? (nM - fm) : WGM;
        u.pm = fm + ((wgid % nig) % gsz); u.pn = (wgid % nig) / gsz; return true;
    }
};
template <class Epi>
__device__ __forceinline__ void gemm_phase(LAS unsigned char* lds, const Gemm g, const StaticOrder& S, const Epi& E, int tid_in) {
    const int tid = tid_in, wid = __builtin_amdgcn_readfirstlane(tid >> 6), lane = tid & 63, wr = wid >> 2, wc = wid & 3, fr = lane & 15, fq = lane >> 4;
    const int K = g.K, nt = K / BK, lda = g.lda;
    unsigned voffA[2], voffB[2];
#define PG8_VOFF() do { const int t_ = wid * 64 + lane_id_v(); _Pragma("unroll") for (int i = 0; i < 2; ++i) { int R, C; stage_rc(t_ * 16 + i * 8192, R, C); const int Rb = (R & ~31) + perm32(R & 31); \
        voffA[i] = (unsigned)(R * lda + C) * 2u; voffB[i] = (unsigned)(Rb * K + C) * 2u; } } while (0)
    PG8_VOFF();
    const size_t kstep = (size_t)(BK * 2);
    const size_t hstepA = (size_t)HALF * lda * 2, hstepB = (size_t)HALF * K * 2;
    const size_t tstepA = 2 * hstepA, tstepB = 2 * hstepB;
    const size_t pnA = (size_t)g.a_pn_step * 2;
    const unsigned ldsw = (unsigned)wid * 1024u;
    const int aoff = lds_byte(wr * 64 + fr, fq * 8), boff = lds_byte(wc * 32 + fr, fq * 8);
#define PG8_SA(b, h) (((b) * 2 + (h)) * HTB)
#define PG8_SB(b, h) ((4 + (b) * 2 + (h)) * HTB)
#define PG8_STAGE(bufoff, gbase, voff) do { _Pragma("unroll") for (int _i = 0; _i < 2; ++_i) \
        __builtin_amdgcn_global_load_lds((const unsigned*)((const char*)(gbase) + (voff)[_i]), (LAS unsigned*)(lds + (bufoff) + ldsw + _i * 8192), 16, 0, 0); } while (0)
#define PG8_LDA(dst, b, h) do { _Pragma("unroll") for (int m = 0; m < 4; ++m) _Pragma("unroll") for (int k = 0; k < 2; ++k) dst[m][k] = *(const LAS bf16x8*)(lds + PG8_SA(b, h) + aoff + m * 2048 + k * 1024); } while (0)
#define PG8_LDB(dst, b, h) do { _Pragma("unroll") for (int n = 0; n < 2; ++n) _Pragma("unroll") for (int k = 0; k < 2; ++k) dst[n][k] = *(const LAS bf16x8*)(lds + PG8_SB(b, h) + boff + n * 2048 + k * 1024); } while (0)
#define PG8_MMA(ai, bj, At, Bt) do { __builtin_amdgcn_s_setprio(1); _Pragma("unroll") for (int m = 0; m < 4; ++m) _Pragma("unroll") for (int n = 0; n < 2; ++n) _Pragma("unroll") for (int k = 0; k < 2; ++k) \
        acc[ai][bj][m][n] = __builtin_amdgcn_mfma_f32_16x16x32_bf16(Bt[n][k], At[m][k], acc[ai][bj][m][n], 0, 0, 0); __builtin_amdgcn_s_setprio(0); } while (0)
#define PG8_WAIT_V(n) asm volatile("s_waitcnt vmcnt(" #n ")" ::: "memory")
#define PG8_WAIT_L(n) asm volatile("s_waitcnt lgkmcnt(" #n ")" ::: "memory")
#define PG8_BAR __builtin_amdgcn_s_barrier()
#define PG8_SCHED __builtin_amdgcn_sched_barrier(0)
    Unit cur, nxt; int ui = 0; bool pre = false;
    if (!S.next(0, cur)) return;
#define PG8_STATS(pm_, par_) do { if (g.st) __builtin_amdgcn_global_load_lds((const unsigned*)(g.st + (size_t)(pm_) * 512 + 64 * wid + lane_id_v()), (LAS unsigned*)(lds + LDS_STT + (par_) * 2048 + wid * 256), 4, 0, 0); } while (0)
    PG8_STATS(cur.pm, 0); __builtin_amdgcn_sched_barrier(0); E.prefetch(cur, 0, wid, lds);
    f32x4 acc[2][2][4][2];
#pragma unroll
    for (int a = 0; a < 2; ++a)
#pragma unroll
        for (int b = 0; b < 2; ++b)
#pragma unroll
            for (int m = 0; m < 4; ++m)
#pragma unroll
                for (int n = 0; n < 2; ++n) acc[a][b][m][n] = (f32x4){0.f, 0.f, 0.f, 0.f};
    bf16x8 At[4][2], B0[2][2], B1[2][2];
    const char* cA = (const char*)g.A + (size_t)cur.pm * tstepA + (size_t)cur.pn * pnA; const char* cB = (const char*)g.Bt + (size_t)cur.pn * tstepB;
    PG8_STAGE(PG8_SB(0, 0), cB, voffB); PG8_STAGE(PG8_SB(0, 1), cB + hstepB, voffB); PG8_STAGE(PG8_SA(0, 0), cA, voffA); PG8_STAGE(PG8_SA(0, 1), cA + hstepA, voffA);
    if (wr == 1) PG8_BAR;
    PG8_WAIT_V(2); PG8_BAR;
    PG8_STAGE(PG8_SB(1, 0), cB + kstep, voffB); PG8_STAGE(PG8_SA(1, 0), cA + kstep, voffA); PG8_STAGE(PG8_SB(1, 1), cB + hstepB + kstep, voffB);
    PG8_WAIT_V(6); PG8_BAR;
    for (;;) {
        const bool has_next = S.next(ui + 1, nxt);
        const char* nA = has_next ? (const char*)g.A + (size_t)nxt.pm * tstepA + (size_t)nxt.pn * pnA : cA; const char* nB = has_next ? (const char*)g.Bt + (size_t)nxt.pn * tstepB : cB;
#define PG8_ITER(t, W12) do { \
            const bool last = ((t) == nt - 2); \
            const char* a1 = cA + (size_t)((t) + 1) * kstep; \
            const char* a2 = last ? nA : cA + (size_t)((t) + 2) * kstep; const char* b2 = last ? nB : cB + (size_t)((t) + 2) * kstep; \
            const char* a3 = a2 + kstep; const char* b3 = b2 + kstep; \
            PG8_LDB(B0, 0, 0); PG8_LDB(B1, 0, 1); PG8_SCHED; PG8_LDA(At, 0, 0); PG8_STAGE(PG8_SA(1, 1), a1 + hstepA, voffA); \
            W12; PG8_WAIT_L(0); PG8_BAR; PG8_MMA(0, 0, At, B0); PG8_MMA(0, 1, At, B1); PG8_BAR; PG8_SCHED; \
            PG8_LDA(At, 0, 1); PG8_STAGE(PG8_SB(0, 0), b2, voffB); PG8_STAGE(PG8_SB(0, 1), b2 + hstepB, voffB); PG8_STAGE(PG8_SA(0, 0), a2, voffA); \
            W12; PG8_WAIT_L(0); PG8_BAR; PG8_MMA(1, 0, At, B0); PG8_MMA(1, 1, At, B1); PG8_BAR; PG8_SCHED; \
            PG8_LDB(B0, 1, 0); PG8_LDB(B1, 1, 1); PG8_SCHED; PG8_LDA(At, 1, 0); PG8_STAGE(PG8_SA(0, 1), a2 + hstepA, voffA); \
            PG8_WAIT_V(8); PG8_WAIT_L(0); PG8_BAR; PG8_MMA(0, 0, At, B0); PG8_MMA(0, 1, At, B1); PG8_BAR; PG8_SCHED; \
            PG8_LDA(At, 1, 1); PG8_STAGE(PG8_SB(1, 0), b3, voffB); PG8_STAGE(PG8_SB(1, 1), b3 + hstepB, voffB); PG8_STAGE(PG8_SA(1, 0), a3, voffA); \
            PG8_WAIT_V(8); PG8_WAIT_L(0); PG8_BAR; PG8_MMA(1, 0, At, B0); PG8_MMA(1, 1, At, B1); PG8_BAR; PG8_SCHED; \
        } while (0)
        int t0 = 0;
        if (pre) { PG8_ITER(0, wait_v<8 + Epi::VM_MIN>()); t0 = 2; }
        for (int t = t0; t < nt; t += 2) PG8_ITER(t, PG8_WAIT_V(8));
#undef PG8_ITER
        if (wr == 0) PG8_BAR;
        pre = has_next;
        { const int le = lane_id_v(); int wr_ = wr, wc_ = wc; asm volatile("" : "+s"(wr_), "+s"(wc_));
          E(acc, cur, wr_, wc_, le & 15, le >> 4, (const LAS float*)(lds + LDS_STT + (ui & 1) * 2048), (const LAS float*)(lds + LDS_CT + (ui & 1) * 4096)); }
        if (!has_next) break;
#pragma unroll
        for (int a = 0; a < 2; ++a)
#pragma unroll
            for (int b = 0; b < 2; ++b)
#pragma unroll
                for (int m = 0; m < 4; ++m)
#pragma unroll
                    for (int n = 0; n < 2; ++n) acc[a][b][m][n] = (f32x4){0.f, 0.f, 0.f, 0.f};
        cur = nxt; cA = nA; cB = nB; ++ui;
        PG8_VOFF();
        PG8_STATS(cur.pm, ui & 1); E.prefetch(cur, ui & 1, wid, lds);
        if (wr == 1) PG8_BAR;
    }
    PG8_WAIT_V(0);
    PG8_BAR;
#undef PG8_STATS
#undef PG8_VOFF
#undef PG8_SA
#undef PG8_SB
#undef PG8_STAGE
#undef PG8_LDA
#undef PG8_LDB
#undef PG8_MMA
#undef PG8_WAIT_V
#undef PG8_WAIT_L
#undef PG8_BAR
#undef PG8_SCHED
}
}

struct LnRef { const bf16_t* Z; const float* st; const float* g; const float* b; int ident; };
__device__ __forceinline__ void ln_row(const float* st, size_t row, int ident, float& mu, float& rstd) {
    mu = 0.f; rstd = 1.f;
    if (!ident) { const f32x2 s = *(const f32x2*)(st + row * 2); mu = s[0] * (1.f / D); rstd = 1.f / sqrtf(fmaxf(s[1] * (1.f / D) - mu * mu, 0.f) + LN_EPS); }
}
__device__ __forceinline__ void ln_row_lds(const LAS float* stt, int rl, int ident, float& mu, float& rstd) {
    mu = 0.f; rstd = 1.f;
    if (!ident) { const f32x2 s = *(const LAS f32x2*)(stt + 2 * rl); mu = s[0] * (1.f / D); rstd = __builtin_amdgcn_rsqf(fmaxf(s[1] * (1.f / D) - mu * mu, 0.f) + LN_EPS); }
}
struct EpiBf16 {
    __device__ __forceinline__ void prefetch(const pg8::Unit&, int, int, LAS unsigned char*) const {}
    bf16_t* O; int ldc;
    __device__ __forceinline__ void operator()(const f32x4 (&acc)[2][2][4][2], const pg8::Unit& u, int wr, int wc, int fr, int fq, const LAS float* stt, const LAS float* ct) const {
        const int row0 = u.pm * 256 + wr * 64 + fr, col0 = u.pn * 256 + wc * 32 + 8 * fq;
#pragma unroll
        for (int ai = 0; ai < 2; ++ai)
#pragma unroll
            for (int m = 0; m < 4; ++m) { bf16_t* rowp = O + (size_t)(row0 + ai * 128 + m * 16) * ldc + col0;
#pragma unroll
                for (int bj = 0; bj < 2; ++bj) { const f32x4 v0 = acc[ai][bj][m][0], v1 = acc[ai][bj][m][1];
                    u32x4 w; w.x = pk2(v0[0], v0[1]); w.y = pk2(v0[2], v0[3]); w.z = pk2(v1[0], v1[1]); w.w = pk2(v1[2], v1[3]);
                    *(u32x4*)(rowp + bj * 128) = w; } }
    }
};
struct EpiIn {
    static constexpr int VM_MIN = 24;
    __device__ __forceinline__ void prefetch(const pg8::Unit&, int, int, LAS unsigned char*) const {}
    bf16_t* H; float* LF; const float* lbv; float* kP; float* vP; float* kS; float* vS; const float* st; const float* uu; const float* cc; int ident;
    __device__ __forceinline__ void operator()(const f32x4 (&acc_in)[2][2][4][2], const pg8::Unit& u, int wr, int wc, int fr, int fq, const LAS float* stt, const LAS float* ct) const {
        f32x4 acc[2][2][4][2];
        { const int r0 = u.pm * 256 + wr * 64 + fr, c0 = u.pn * 256 + wc * 32 + 8 * fq;
#pragma unroll
          for (int bj = 0; bj < 2; ++bj) { const f32x4 u0 = *(const f32x4*)(uu + c0 + bj * 128), u1 = *(const f32x4*)(uu + c0 + bj * 128 + 4), k0 = *(const f32x4*)(cc + c0 + bj * 128), k1 = *(const f32x4*)(cc + c0 + bj * 128 + 4);
#pragma unroll
            for (int ai = 0; ai < 2; ++ai)
#pragma unroll
                for (int m = 0; m < 4; ++m) { float mu, rstd; ln_row_lds(stt, wr * 64 + fr + ai * 128 + m * 16, ident, mu, rstd);
                    const float nb = -mu * rstd; acc[ai][bj][m][0] = acc_in[ai][bj][m][0] * rstd + (u0 * nb + k0); acc[ai][bj][m][1] = acc_in[ai][bj][m][1] * rstd + (u1 * nb + k1); } } }
        const int row0 = u.pm * 256 + wr * 64 + fr, col0 = u.pn * 256 + wc * 32 + 8 * fq;
        const int kind = u.pn >> 1;
        if (kind == 1) {
#pragma unroll
            for (int bj = 0; bj < 2; ++bj) { const int c = col0 + bj * 128 - C_AF;
                const f32x4 l0 = *(const f32x4*)(lbv + c), l1 = *(const f32x4*)(lbv + c + 4);
#pragma unroll
                for (int ai = 0; ai < 2; ++ai)
#pragma unroll
                    for (int m = 0; m < 4; ++m) { const int row = row0 + ai * 128 + m * 16;
                        f32x4 o0, o1;
#pragma unroll
                        for (int e = 0; e < 4; ++e) {
                            { const float z = acc[ai][bj][m][0][e], ez = __builtin_amdgcn_exp2f(-LOG2E * fabsf(z)), sg = (z >= 0.f ? 1.f : ez) * __builtin_amdgcn_rcpf(1.f + ez), f = l0[e] + (1.f - l0[e]) * sg; o0[e] = fmaxf(__builtin_amdgcn_logf(f) * 0.6931471805599453f, -60.f); }
                            { const float z = acc[ai][bj][m][1][e], ez = __builtin_amdgcn_exp2f(-LOG2E * fabsf(z)), sg = (z >= 0.f ? 1.f : ez) * __builtin_amdgcn_rcpf(1.f + ez), f = l1[e] + (1.f - l1[e]) * sg; o1[e] = fmaxf(__builtin_amdgcn_logf(f) * 0.6931471805599453f, -60.f); }
                        }
                        float* dst = LF + (size_t)row * 512 + c; *(f32x4*)dst = o0; *(f32x4*)(dst + 4) = o1; } }
            return;
        }
#pragma unroll
        for (int ai = 0; ai < 2; ++ai)
#pragma unroll
            for (int m = 0; m < 4; ++m) { const int row = row0 + ai * 128 + m * 16; bf16_t* rowp = H + (size_t)row * INC + col0;
#pragma unroll
                for (int bj = 0; bj < 2; ++bj) { const f32x4 v0 = acc[ai][bj][m][0], v1 = acc[ai][bj][m][1];
                    u32x4 w; w.x = pk2(v0[0], v0[1]); w.y = pk2(v0[2], v0[3]); w.z = pk2(v1[0], v1[1]); w.w = pk2(v1[2], v1[3]);
                    *(u32x4*)(rowp + bj * 128) = w;
                    if (kind >= 5) { const int c = col0 + bj * 128 - (kind == 5 ? C_BK : C_BV);
                        float* dst = (row < MP) ? ((kind == 5 ? kP : vP) + (size_t)row * 512 + c) : ((kind == 5 ? kS : vS) + (size_t)(row - MP) * 512 + c);
                        *(f32x4*)dst = v0; *(f32x4*)(dst + 4) = v1; } } }
    }
};
struct EpiRes {
    static constexpr int VM_MIN = 32;
    __device__ __forceinline__ void prefetch(const pg8::Unit&, int, int, LAS unsigned char*) const {}
    LnRef P; bf16_t* Z; float* st_out; const float* scale;
    __device__ __forceinline__ void operator()(const f32x4 (&acc)[2][2][4][2], const pg8::Unit& u, int wr, int wc, int fr, int fq, const LAS float* stt, const LAS float* ct) const {
        const int row0 = u.pm * 256 + wr * 64 + fr, col0 = u.pn * 256 + wc * 32 + 8 * fq;
        const unsigned rb = (unsigned)(row0 * D + col0) * 2u;
        const char* zin = (const char*)P.Z; char* zout = (char*)Z;
        float s1[8], s2[8];
#pragma unroll
        for (int i = 0; i < 8; ++i) { s1[i] = 0.f; s2[i] = 0.f; }
#pragma unroll
        for (int bj = 0; bj < 2; ++bj) { const int c = col0 + bj * 128;
            u32x4 xr[2][4];
#pragma unroll
            for (int ai = 0; ai < 2; ++ai)
#pragma unroll
                for (int m = 0; m < 4; ++m) xr[ai][m] = *(const u32x4*)(zin + (rb + (unsigned)(((ai * 128 + m * 16) * D + bj * 128) * 2)));
            float sc[8], gg[8], bb[8];
#pragma unroll
            for (int e = 0; e < 8; ++e) { sc[e] = 1.f; gg[e] = 1.f; bb[e] = 0.f; }
            if (scale) { const f32x4 a0 = *(const f32x4*)(scale + c), a1 = *(const f32x4*)(scale + c + 4);
#pragma unroll
                for (int e = 0; e < 4; ++e) { sc[e] = a0[e]; sc[4 + e] = a1[e]; } }
            if (!P.ident) { const f32x4 a0 = *(const f32x4*)(P.g + c), a1 = *(const f32x4*)(P.g + c + 4), b0 = *(const f32x4*)(P.b + c), b1 = *(const f32x4*)(P.b + c + 4);
#pragma unroll
                for (int e = 0; e < 4; ++e) { gg[e] = a0[e]; gg[4 + e] = a1[e]; bb[e] = b0[e]; bb[4 + e] = b1[e]; } }
#pragma unroll
            for (int ai = 0; ai < 2; ++ai)
#pragma unroll
                for (int m = 0; m < 4; ++m) {
                    float mu, rstd; ln_row_lds(stt, wr * 64 + fr + ai * 128 + m * 16, P.ident, mu, rstd);
                    const u32x4 xw = xr[ai][m]; float xv[8]; unpk8(xw, xv);
                    float o[8];
#pragma unroll
                    for (int e = 0; e < 8; ++e) { const float t = rstd * gg[e], x = fmaf(xv[e], t, fmaf(-mu, t, bb[e])); o[e] = fmaf(DN_ALPHA, x, (e < 4 ? acc[ai][bj][m][0][e] : acc[ai][bj][m][1][e - 4]) * sc[e]); }
                    const u32x4 w = pk8(o); *(u32x4*)(zout + (rb + (unsigned)(((ai * 128 + m * 16) * D + bj * 128) * 2))) = w;
                    float ov[8]; unpk8(w, ov);
#pragma unroll
                    for (int e = 0; e < 8; ++e) { s1[ai * 4 + m] += ov[e]; s2[ai * 4 + m] += ov[e] * ov[e]; } } }
        const int lb4 = lane_id_v() << 2;
#pragma unroll
        for (int i = 0; i < 8; ++i) { s1[i] += shx_lb(s1[i], lb4, 16); s1[i] += shx_lb(s1[i], lb4, 32); s2[i] += shx_lb(s2[i], lb4, 16); s2[i] += shx_lb(s2[i], lb4, 32); }
        if (fq == 0) { char* sp = (char*)st_out; const unsigned sb = (unsigned)row0 * 8u;
#pragma unroll
            for (int i = 0; i < 8; ++i) { float* p = (float*)(sp + (sb + (unsigned)(((i >> 2) * 128 + (i & 3) * 16) * 8))); atomicAdd(p, s1[i]); atomicAdd(p + 1, s2[i]); } }
    }
};

template <int CTRL> __device__ __forceinline__ float dpp_f(float v) { return __builtin_bit_cast(float, __builtin_amdgcn_update_dpp(0, __builtin_bit_cast(int, v), CTRL, 0xf, 0xf, false)); }
struct EpiUpConv {
    static constexpr int VM_MIN = 16;
    bf16_t* G; const float* cw; const float* cb; const float* hist; float* ahead; float* bhead; float* atail; float* outP; float* outS; LAS float* ex; const float* st; const float* uu; const float* cc;
    __device__ __forceinline__ void prefetch(const pg8::Unit& u, int par, int wid, LAS unsigned char* lds) const {
        const int l = lane_id_v();
#pragma unroll
        for (int j = 0; j < 2; ++j) { const int arr = j * 4 + (wid >> 1), off = (wid & 1) * 64 + l;
            const float* src = (arr < 3) ? cw + (size_t)arr * DFF + 128 * u.pn : (arr == 3) ? cb + 128 * u.pn : (arr == 4) ? uu + 256 * u.pn : (arr == 5) ? cc + 256 * u.pn : (arr == 6) ? uu + 256 * u.pn + 128 : cc + 256 * u.pn + 128;
            __builtin_amdgcn_global_load_lds((const unsigned*)(src + off), (LAS unsigned*)(lds + LDS_CT + par * 4096 + (j * 512 + wid * 64) * 4), 4, 0, 0); __builtin_amdgcn_sched_barrier(0); }
    }
    __device__ __forceinline__ void corr2(const f32x4& a0, const f32x4& a1, const LAS float* up, const LAS float* kp, float mu, float rstd, f32x2 (&o)[4]) const {
        const f32x4 u0 = *(const LAS f32x4*)up, u1 = *(const LAS f32x4*)(up + 4), k0 = *(const LAS f32x4*)kp, k1 = *(const LAS f32x4*)(kp + 4);
        const float nb = -mu * rstd; const f32x2 r2 = {rstd, rstd}, n2 = {nb, nb};
        o[0] = (f32x2){a0[0], a0[1]} * r2 + ((f32x2){u0[0], u0[1]} * n2 + (f32x2){k0[0], k0[1]});
        o[1] = (f32x2){a0[2], a0[3]} * r2 + ((f32x2){u0[2], u0[3]} * n2 + (f32x2){k0[2], k0[3]});
        o[2] = (f32x2){a1[0], a1[1]} * r2 + ((f32x2){u1[0], u1[1]} * n2 + (f32x2){k1[0], k1[1]});
        o[3] = (f32x2){a1[2], a1[3]} * r2 + ((f32x2){u1[2], u1[3]} * n2 + (f32x2){k1[2], k1[3]});
    }
    template <bool SMP>
    __device__ __forceinline__ void body(const f32x4 (&acc)[2][2][4][2], const pg8::Unit& u, int wr, int fr, int chl, int ch, const LAS float* stt, const LAS float* T) const {
        const int seq_first = (u.pm & 7) == 0;
#pragma unroll
        for (int ai = 0; ai < 2; ++ai) {
            f32x2 h1[4], h2[4];
#pragma unroll
            for (int e = 0; e < 4; ++e) { h1[e] = (f32x2){0.f, 0.f}; h2[e] = (f32x2){0.f, 0.f}; }
            bool top_missing = false;
            if (!SMP) {
                if (wr == 1 || ai == 1) { const int sa = (wr == 1) ? ai : 0, sw = (wr == 1) ? 0 : 1; const LAS float* p = ex + ((sa * 2 + sw) * 2) * 128 + chl;
                    const f32x4 a0 = *(const LAS f32x4*)p, a1 = *(const LAS f32x4*)(p + 4), b0 = *(const LAS f32x4*)(p + 128), b1 = *(const LAS f32x4*)(p + 132);
                    h2[0] = (f32x2){a0[0], a0[1]}; h2[1] = (f32x2){a0[2], a0[3]}; h2[2] = (f32x2){a1[0], a1[1]}; h2[3] = (f32x2){a1[2], a1[3]};
                    h1[0] = (f32x2){b0[0], b0[1]}; h1[1] = (f32x2){b0[2], b0[3]}; h1[2] = (f32x2){b1[0], b1[1]}; h1[3] = (f32x2){b1[2], b1[3]}; }
                else top_missing = !seq_first;
            }
            f32x2 r1p[4], r2p[4];
#pragma unroll
            for (int e = 0; e < 4; ++e) { r1p[e] = (f32x2){0.f, 0.f}; r2p[e] = (f32x2){0.f, 0.f}; }
#pragma unroll
            for (int m = 0; m < 4; ++m) {
                const int rloc = 128 * ai + 64 * wr + 16 * m + fr;
                f32x2 cur[4], bb[4], r1[4], r2[4], p1[4], p2[4], o[4];
                const LAS float* Tm = T; asm volatile("" : "+v"(Tm));
                { float mu, rstd; ln_row_lds(stt, rloc, 0, mu, rstd);
                  corr2(acc[ai][0][m][0], acc[ai][0][m][1], Tm + 4 * 128, Tm + 5 * 128, mu, rstd, cur); corr2(acc[ai][1][m][0], acc[ai][1][m][1], Tm + 6 * 128, Tm + 7 * 128, mu, rstd, bb); }
#pragma unroll
                for (int e = 0; e < 4; ++e) { r1[e] = (f32x2){dpp_f<0x121>(cur[e][0]), dpp_f<0x121>(cur[e][1])}; r2[e] = (f32x2){dpp_f<0x122>(cur[e][0]), dpp_f<0x122>(cur[e][1])}; }
                if (SMP) { const int sb = ((u.pm - MP / 256) * 256 + 128 * ai + 64 * wr + 16 * m) >> 4; const float* hp = hist + (size_t)sb * 2 * DFF + ch;
                    const f32x4 a0 = *(const f32x4*)hp, a1 = *(const f32x4*)(hp + 4), b0 = *(const f32x4*)(hp + DFF), b1 = *(const f32x4*)(hp + DFF + 4);
                    const f32x2 hh0[4] = {{a0[0], a0[1]}, {a0[2], a0[3]}, {a1[0], a1[1]}, {a1[2], a1[3]}}, hh1[4] = {{b0[0], b0[1]}, {b0[2], b0[3]}, {b1[0], b1[1]}, {b1[2], b1[3]}};
#pragma unroll
                    for (int e = 0; e < 4; ++e) { p1[e] = fr >= 1 ? r1[e] : hh1[e]; p2[e] = fr >= 2 ? r2[e] : (fr == 1 ? hh1[e] : hh0[e]); } }
                else if (m == 0) {
#pragma unroll
                    for (int e = 0; e < 4; ++e) { p1[e] = fr >= 1 ? r1[e] : h1[e]; p2[e] = fr >= 2 ? r2[e] : (fr == 1 ? h1[e] : h2[e]); } }
                else {
#pragma unroll
                    for (int e = 0; e < 4; ++e) { p1[e] = fr >= 1 ? r1[e] : r1p[e]; p2[e] = fr >= 2 ? r2[e] : r2p[e]; } }
                { const f32x4 x0a = *(const LAS f32x4*)(Tm + 0 * 128), x0b = *(const LAS f32x4*)(Tm + 0 * 128 + 4), x1a = *(const LAS f32x4*)(Tm + 1 * 128), x1b = *(const LAS f32x4*)(Tm + 1 * 128 + 4);
                  const f32x4 x2a = *(const LAS f32x4*)(Tm + 2 * 128), x2b = *(const LAS f32x4*)(Tm + 2 * 128 + 4), xba = *(const LAS f32x4*)(Tm + 3 * 128), xbb = *(const LAS f32x4*)(Tm + 3 * 128 + 4);
                  const f32x2 w0[4] = {{x0a[0], x0a[1]}, {x0a[2], x0a[3]}, {x0b[0], x0b[1]}, {x0b[2], x0b[3]}}, w1[4] = {{x1a[0], x1a[1]}, {x1a[2], x1a[3]}, {x1b[0], x1b[1]}, {x1b[2], x1b[3]}};
                  const f32x2 w2[4] = {{x2a[0], x2a[1]}, {x2a[2], x2a[3]}, {x2b[0], x2b[1]}, {x2b[2], x2b[3]}}, wb[4] = {{xba[0], xba[1]}, {xba[2], xba[3]}, {xbb[0], xbb[1]}, {xbb[2], xbb[3]}};
#pragma unroll
                  for (int e = 0; e < 4; ++e) { const f32x2 c = cur[e] * w2[e] + (p1[e] * w1[e] + (p2[e] * w0[e] + wb[e]));
                      const f32x2 t = c * (f32x2){-LOG2E, -LOG2E}; const f32x2 d = (f32x2){__builtin_amdgcn_exp2f(t[0]), __builtin_amdgcn_exp2f(t[1])} + (f32x2){1.f, 1.f};
                      o[e] = (c * bb[e]) * (f32x2){__builtin_amdgcn_rcpf(d[0]), __builtin_amdgcn_rcpf(d[1])}; r1p[e] = r1[e]; r2p[e] = r2[e]; } }
                if (!(top_missing && m == 0 && fr < 2)) { u32x4 w; w.x = pk2(o[0][0], o[0][1]); w.y = pk2(o[1][0], o[1][1]); w.z = pk2(o[2][0], o[2][1]); w.w = pk2(o[3][0], o[3][1]);
                    *(u32x4*)(G + (size_t)(u.pm * 256 + rloc) * DFF + ch) = w; }
                const f32x4 ca0 = {cur[0][0], cur[0][1], cur[1][0], cur[1][1]}, ca1 = {cur[2][0], cur[2][1], cur[3][0], cur[3][1]};
                if (ai == 0 && m == 0 && wr == 0 && fr < 2) { float* pa = ahead + ((size_t)u.pm * 2 + fr) * DFF + ch; float* pb = bhead + ((size_t)u.pm * 2 + fr) * DFF + ch;
                    *(f32x4*)pa = ca0; *(f32x4*)(pa + 4) = ca1; *(f32x4*)pb = (f32x4){bb[0][0], bb[0][1], bb[1][0], bb[1][1]}; *(f32x4*)(pb + 4) = (f32x4){bb[2][0], bb[2][1], bb[3][0], bb[3][1]}; }
                if (ai == 1 && m == 3 && wr == 1 && fr >= 14) { float* pt = atail + ((size_t)u.pm * 2 + (fr - 14)) * DFF + ch; *(f32x4*)pt = ca0; *(f32x4*)(pt + 4) = ca1;
                    if (!SMP && (u.pm & 7) == 7) { float* po = outP + ((size_t)(u.pm >> 3) * 2 + (fr - 14)) * DFF + ch; *(f32x4*)po = ca0; *(f32x4*)(po + 4) = ca1; } }
                if (SMP && fr >= 14) { const int sb = ((u.pm - MP / 256) * 256 + 128 * ai + 64 * wr + 16 * m) >> 4; float* po = outS + ((size_t)sb * 2 + (fr - 14)) * DFF + ch;
                    *(f32x4*)po = ca0; *(f32x4*)(po + 4) = ca1; }
            }
        }
    }
    __device__ __forceinline__ void operator()(const f32x4 (&acc)[2][2][4][2], const pg8::Unit& u, int wr, int wc, int fr, int fq, const LAS float* stt, const LAS float* ct) const {
        const int chl = 32 * wc + 8 * fq, ch = 128 * u.pn + chl;
        const LAS float* T = ct + chl;
        if (fr >= 14) {
#pragma unroll
            for (int ai = 0; ai < 2; ++ai) { float mu, rstd; f32x2 t[4]; ln_row_lds(stt, wr * 64 + fr + ai * 128 + 48, 0, mu, rstd); corr2(acc[ai][0][3][0], acc[ai][0][3][1], T + 4 * 128, T + 5 * 128, mu, rstd, t);
                LAS float* p = ex + ((ai * 2 + wr) * 2 + (fr - 14)) * 128 + chl; *(LAS f32x4*)p = (f32x4){t[0][0], t[0][1], t[1][0], t[1][1]}; *(LAS f32x4*)(p + 4) = (f32x4){t[2][0], t[2][1], t[3][0], t[3][1]}; }
        }
        asm volatile("s_waitcnt lgkmcnt(0)" ::: "memory"); __builtin_amdgcn_s_barrier(); asm volatile("" ::: "memory");
        if (u.pm >= MP / 256) body<true>(acc, u, wr, fr, chl, ch, stt, T); else body<false>(acc, u, wr, fr, chl, ch, stt, T);
    }
};


template <int KW  >
__device__ __forceinline__ void sgemm_res_phase(LAS unsigned char* lds, const bf16_t* A, int lda, int a_grp_step, const bf16_t* Bt, int K, int bid, int G, int tid, const LnRef& P, bf16_t* Z, float* st_out, const float* scale) {
    const int lane = tid & 63, wave = __builtin_amdgcn_readfirstlane(tid >> 6), fr = lane & 15, fq = lane >> 4;
    LAS f32x4* red = (LAS f32x4*)lds;
    for (int t = bid; t < 256; t += G) {
        const int rt = t >> 5, ct = t & 31;
        const GAS bf16_t* ap = (const GAS bf16_t*)(A + (size_t)(rt * 64 + fr) * lda + (size_t)((ct * 32) >> 8) * a_grp_step + wave * KW + 8 * fq);
        const GAS bf16_t* bp = (const GAS bf16_t*)(Bt + (size_t)(ct * 32 + fr) * K + wave * KW + 8 * fq);
        f32x4 acc[4][2];
#pragma unroll
        for (int i = 0; i < 4; ++i) { acc[i][0] = (f32x4){0.f, 0.f, 0.f, 0.f}; acc[i][1] = (f32x4){0.f, 0.f, 0.f, 0.f}; }
#pragma unroll
        for (int k0 = 0; k0 < KW; k0 += 32) {
            bf16x8 af[4], bf[2];
#pragma unroll
            for (int i = 0; i < 4; ++i) af[i] = *(const GAS bf16x8*)(ap + (size_t)(16 * i) * lda + k0);
#pragma unroll
            for (int j = 0; j < 2; ++j) bf[j] = *(const GAS bf16x8*)(bp + (size_t)(16 * j) * K + k0);
#pragma unroll
            for (int i = 0; i < 4; ++i)
#pragma unroll
                for (int j = 0; j < 2; ++j) acc[i][j] = __builtin_amdgcn_mfma_f32_16x16x32_bf16(bf[j], af[i], acc[i][j], 0, 0, 0);
        }
#pragma unroll
        for (int i = 0; i < 4; ++i)
#pragma unroll
            for (int j = 0; j < 2; ++j) red[(wave * 8 + i * 2 + j) * 64 + lane] = acc[i][j];
        __syncthreads();
        f32x4 v = red[(0 * 8 + wave) * 64 + lane];
#pragma unroll
        for (int w = 1; w < 8; ++w) v += red[(w * 8 + wave) * 64 + lane];
        __syncthreads();
        const int row = rt * 64 + 16 * (wave >> 1) + fr, n = ct * 32 + 16 * (wave & 1) + 4 * fq; const size_t grow = (size_t)MP + row, off = grow * D + n;
        float mu, rstd; ln_row(P.st, grow, P.ident, mu, rstd);
        f32x4 gg = {1.f, 1.f, 1.f, 1.f}, bb = {0.f, 0.f, 0.f, 0.f}, sc = {1.f, 1.f, 1.f, 1.f};
        if (!P.ident) { gg = *(const f32x4*)(P.g + n); bb = *(const f32x4*)(P.b + n); }
        if (scale) sc = *(const f32x4*)(scale + n);
        const u32x2 xw = *(const u32x2*)(P.Z + off); const float xv[4] = {bflo(xw.x), bfhi(xw.x), bflo(xw.y), bfhi(xw.y)};
        float o[4];
#pragma unroll
        for (int e = 0; e < 4; ++e) { const float tt = rstd * gg[e], x = fmaf(xv[e], tt, fmaf(-mu, tt, bb[e])); o[e] = fmaf(DN_ALPHA, x, v[e] * sc[e]); }
        u32x2 w; w.x = pk2(o[0], o[1]); w.y = pk2(o[2], o[3]); *(u32x2*)(Z + off) = w;
        float s1 = (bflo(w.x) + bfhi(w.x)) + (bflo(w.y) + bfhi(w.y)), s2 = (bflo(w.x) * bflo(w.x) + bfhi(w.x) * bfhi(w.x)) + (bflo(w.y) * bflo(w.y) + bfhi(w.y) * bfhi(w.y));
        s1 += shx(s1, 16); s1 += shx(s1, 32); s2 += shx(s2, 16); s2 += shx(s2, 32);
        if (fq == 0) { atomicAdd(st_out + grow * 2, s1); atomicAdd(st_out + grow * 2 + 1, s2); }
    }
}

__device__ __forceinline__ void sgemm_in_phase(LAS unsigned char* lds, const bf16_t* A, const bf16_t* Bt, int bid, int G, int tid, const EpiIn& E) {
    constexpr int K = D, KW = K / 8;
    const int lane = tid & 63, wave = __builtin_amdgcn_readfirstlane(tid >> 6), fr = lane & 15, fq = lane >> 4;
    LAS f32x4* red = (LAS f32x4*)lds;
    for (int t = bid; t < 256; t += G) {
        const int rt = t >> 5, ct = t & 31;
        const GAS bf16_t* ap = (const GAS bf16_t*)(A + (size_t)(rt * 64 + fr) * K + wave * KW + 8 * fq);
        const GAS bf16_t* bp = (const GAS bf16_t*)(Bt + (size_t)(ct * 112 + fr) * K + wave * KW + 8 * fq);
        f32x4 acc[4][7];
#pragma unroll
        for (int i = 0; i < 4; ++i)
#pragma unroll
            for (int j = 0; j < 7; ++j) acc[i][j] = (f32x4){0.f, 0.f, 0.f, 0.f};
#pragma unroll
        for (int k0 = 0; k0 < KW; k0 += 32) {
            bf16x8 af[4], bf[7];
#pragma unroll
            for (int i = 0; i < 4; ++i) af[i] = *(const GAS bf16x8*)(ap + (size_t)(16 * i) * K + k0);
#pragma unroll
            for (int j = 0; j < 7; ++j) bf[j] = *(const GAS bf16x8*)(bp + (size_t)(16 * j) * K + k0);
#pragma unroll
            for (int i = 0; i < 4; ++i)
#pragma unroll
                for (int j = 0; j < 7; ++j) acc[i][j] = __builtin_amdgcn_mfma_f32_16x16x32_bf16(bf[j], af[i], acc[i][j], 0, 0, 0);
        }
#pragma unroll
        for (int i = 0; i < 4; ++i) {
#pragma unroll
            for (int j = 0; j < 7; ++j) red[(wave * 7 + j) * 64 + lane] = acc[i][j];
            __syncthreads();
            if (wave < 7) {
                f32x4 v = red[(0 * 7 + wave) * 64 + lane];
#pragma unroll
                for (int w = 1; w < 8; ++w) v += red[(w * 7 + wave) * 64 + lane];
                const int m = rt * 64 + 16 * i + fr, n = ct * 112 + 16 * wave + 4 * fq; const size_t row = (size_t)MP + m;
                float mu, rstd; ln_row(E.st, row, E.ident, mu, rstd);
                const f32x4 u0 = *(const f32x4*)(E.uu + n), k0v = *(const f32x4*)(E.cc + n);
                const float nb = -mu * rstd; v = v * rstd + (u0 * nb + k0v);
                const int kind = n >> 9;
                if (kind == 1) { const int c = n - C_AF; const f32x4 l0 = *(const f32x4*)(E.lbv + c); f32x4 o;
#pragma unroll
                    for (int e = 0; e < 4; ++e) { const float z = v[e], ez = __builtin_amdgcn_exp2f(-LOG2E * fabsf(z)), sg = (z >= 0.f ? 1.f : ez) * __builtin_amdgcn_rcpf(1.f + ez), f = l0[e] + (1.f - l0[e]) * sg; o[e] = fmaxf(__builtin_amdgcn_logf(f) * 0.6931471805599453f, -60.f); }
                    *(f32x4*)(E.LF + row * 512 + c) = o; }
                else { u32x2 w; w.x = pk2(v[0], v[1]); w.y = pk2(v[2], v[3]); *(u32x2*)(E.H + row * INC + n) = w;
                    if (kind == 5) *(f32x4*)(E.kS + (size_t)m * 512 + (n - C_BK)) = v;
                    if (kind == 6) *(f32x4*)(E.vS + (size_t)m * 512 + (n - C_BV)) = v; }
            }
            __syncthreads();
        }
    }
}

#define XB_TMO      128
#define XB_XCNT(j)  (256  + 64 * (j))
#define XB_XSUB(j)  (1280 + 64 * (j))
#define XB_XGEN(j)  (2304 + 64 * (j))
#define XB_TOP      3328
#define XB_TOPGEN   3392
#define XCD_BAR_WORDS 3456
#define XB_SPIN_CAP (1u << 22)
__device__ __forceinline__ unsigned xb_ld(unsigned* p)              { return __hip_atomic_load(p, __ATOMIC_RELAXED, __HIP_MEMORY_SCOPE_AGENT); }
__device__ __forceinline__ unsigned xb_add(unsigned* p, unsigned v) { return __hip_atomic_fetch_add(p, v, __ATOMIC_RELAXED, __HIP_MEMORY_SCOPE_AGENT); }
__device__ __forceinline__ unsigned xb_xcc_id() { return (unsigned)__builtin_amdgcn_s_getreg((3 << 11) | 20) & 0xFu; }
#define XB_SPIN(cond, bar) do { unsigned _sp = 0; while (cond) { __builtin_amdgcn_s_sleep(1); \
    if ((++_sp & 255u) == 0u) { if (xb_ld(&(bar)[XB_TMO])) break; if (_sp > XB_SPIN_CAP) { atomicAdd(&(bar)[XB_TMO], 1u); break; } } } } while (0)
struct XcdBarrier { unsigned* bar; unsigned x; volatile LAS unsigned* st; };
__device__ __forceinline__ XcdBarrier xcd_barrier_post(unsigned* bar, volatile LAS unsigned* st) {
    XcdBarrier b; b.bar = bar; b.x = xb_xcc_id(); b.st = st;
    if (threadIdx.x == 0) (void)xb_add(&bar[XB_XCNT(b.x)], 1u);
    return b;
}
__device__ __forceinline__ void xcd_barrier_complete(unsigned* bar, unsigned x, unsigned& nloc, unsigned& nx) {
    const unsigned G = gridDim.x * gridDim.y * gridDim.z;
    unsigned sum, cnt, mine, sp = 0u;
    for (;;) {
        sum = 0u; cnt = 0u; mine = 0u;
#pragma unroll
        for (unsigned j = 0; j < 16; ++j) { const unsigned c = xb_ld(&bar[XB_XCNT(j)]); sum += c; cnt += (c > 0u) ? 1u : 0u; mine = (j == x) ? c : mine; }
        if (sum == G) break;
        __builtin_amdgcn_s_sleep(1);
        if ((++sp & 255u) == 0u) { if (xb_ld(&bar[XB_TMO])) break; if (sp > XB_SPIN_CAP) { atomicAdd(&bar[XB_TMO], 1u); break; } }
    }
    nloc = mine > 0u ? mine : 1u; nx = cnt > 0u ? cnt : 1u;
}
__device__ __forceinline__ void xcd_barrier(const XcdBarrier& b) {
    asm volatile("s_waitcnt vmcnt(0)" ::: "memory");
    __syncthreads();
    if (threadIdx.x == 0) {
        unsigned* bar = b.bar;
        __builtin_amdgcn_s_waitcnt(0);
        unsigned nloc = b.st[0], nx = b.st[1];
        if (nloc == 0u) { xcd_barrier_complete(bar, b.x, nloc, nx); b.st[0] = nloc; b.st[1] = nx; }
        const unsigned old = xb_add(&bar[XB_XSUB(b.x)], 1u);
        const unsigned gen = old / nloc;
        if (old + 1u == (gen + 1u) * nloc) {
            __builtin_amdgcn_fence(__ATOMIC_RELEASE, "agent");
            asm volatile("s_waitcnt vmcnt(0)" ::: "memory");
            const unsigned og = xb_add(&bar[XB_TOP], 1u);
            const unsigned tg = og / nx;
            if (og + 1u == (tg + 1u) * nx) xb_add(&bar[XB_TOPGEN], 1u);
            else XB_SPIN(xb_ld(&bar[XB_TOPGEN]) == tg, bar);
            __builtin_amdgcn_fence(__ATOMIC_ACQUIRE, "agent");
            xb_add(&bar[XB_XGEN(b.x)], 1u);
            asm volatile("s_waitcnt vmcnt(0)" ::: "memory");
        } else {
            XB_SPIN(xb_ld(&bar[XB_XGEN(b.x)]) == gen, bar);
            __builtin_amdgcn_fence(__ATOMIC_ACQUIRE, "agent");
            asm volatile("s_waitcnt vmcnt(0)" ::: "memory");
        }
    }
    __syncthreads();
}

struct Args { const float* in[24]; float* out; unsigned char* ws; int ph_lo, ph_hi, single, pad; };
typedef const float* cfp_t;
typedef const __attribute__((address_space(4))) cfp_t* kin_t;
struct Frame {
    LAS unsigned char* lds;
    int tid, lane, wave, bid, G;
    kin_t in;
    float* out; unsigned char* ws;
};
enum { I_XP = 0, I_XS, I_CK, I_CV, I_SH, I_SP, I_SC, I_WIN, I_WOUT, I_LBL, I_HNG, I_DLAM, I_DNG, I_RB, I_PW, I_PSC, I_WUP, I_CW, I_CB, I_WDN, I_L1G, I_L1B, I_L2G, I_L2B };

__device__ __forceinline__ void p0_transpose_item(const float* W, int K, int N, bf16_t* WT, int dst_row0, LAS float* scr, int k0, int n0, int lane, const float* gk, const float* bk, float* uo, float* co) {
#pragma unroll 8
    for (int i = 0; i < 32; ++i) { const int kk = 2 * i + (lane >> 5); scr[kk * 33 + (lane & 31)] = W[(size_t)(k0 + kk) * N + n0 + (lane & 31)]; }
    asm volatile("s_waitcnt lgkmcnt(0)" ::: "memory");
    const int c = lane & 7;
    float gv[8], bv[8];
#pragma unroll
    for (int e = 0; e < 8; ++e) { gv[e] = 1.f; bv[e] = 0.f; }
    if (gk) {
#pragma unroll
        for (int e = 0; e < 8; ++e) { gv[e] = gk[k0 + 8 * c + e]; bv[e] = bk[k0 + 8 * c + e]; } }
#pragma unroll
    for (int j = 0; j < 4; ++j) { const int n = (lane >> 3) + 8 * j; const LAS float* sp = scr + (8 * c) * 33 + n;
        float wv[8]; float cs = 0.f;
#pragma unroll
        for (int e = 0; e < 8; ++e) { const float w = sp[e * 33]; wv[e] = w * gv[e]; cs += w * bv[e]; }
        const u32x4 o = pk8(wv);
        *(u32x4*)(WT + (size_t)(dst_row0 + n) * K + k0 + 8 * c) = o;
        if (gk) { float rv[8]; unpk8(o, rv); float us = 0.f;
#pragma unroll
            for (int e = 0; e < 8; ++e) us += rv[e];
            us += shx(us, 1); us += shx(us, 2); us += shx(us, 4); cs += shx(cs, 1); cs += shx(cs, 2); cs += shx(cs, 4);
            if (c == 0) { atomicAdd(uo + dst_row0 + n, us); atomicAdd(co + dst_row0 + n, cs); } } }
    asm volatile("s_waitcnt lgkmcnt(0)" ::: "memory");
}
__device__ __forceinline__ void phase_prologue(Frame& F) {
    LAS float* scr = (LAS float*)(F.lds + F.wave * 16384);
    const int gw = F.bid * NWAVES + F.wave, NGW = F.G * NWAVES;
    constexpr int I_IN = (D / 64) * (INC / 32), I_OUT = (D / 64) * (D / 32), I_POOL = 4 * 8, I_UP = (D / 64) * (UPN / 32), I_DN = (DFF / 64) * (D / 32);
    constexpr int NITEMS = 2 * I_IN + 2 * I_OUT + 8 * I_POOL + 4 * I_UP + 4 * I_DN;
    for (int it = gw; it < NITEMS; it += NGW) {
        int r = it;
        if (r < 2 * I_IN) { const int m = r / I_IN; r %= I_IN; const int kb = r / (INC / 32), nb = r % (INC / 32);
            float* ctlf = (float*)(F.ws + WS_CTL);
            p0_transpose_item(F.in[I_WIN] + (size_t)m * D * INC, D, INC, (bf16_t*)(F.ws + WS_WIN) + (size_t)m * INC * D, 32 * nb, scr, 64 * kb, 32 * nb, F.lane,
                              m == 1 ? F.in[I_L2G] + 1 * D : nullptr, F.in[I_L2B] + 1 * D, ctlf + UC_UIN, ctlf + UC_CIN); continue; } r -= 2 * I_IN;
        if (r < 2 * I_OUT) { const int m = r / I_OUT; r %= I_OUT; const int kb = r / (D / 32), nb = r % (D / 32);
            p0_transpose_item(F.in[I_WOUT] + (size_t)m * D * D, D, D, (bf16_t*)(F.ws + WS_WOUT) + (size_t)m * D * D, 32 * nb, scr, 64 * kb, 32 * nb, F.lane, nullptr, nullptr, nullptr, nullptr); continue; } r -= 2 * I_OUT;
        if (r < 8 * I_POOL) { const int pg = r / I_POOL; r %= I_POOL; const int kb = r / 8, nb = r % 8;
            p0_transpose_item(F.in[I_PW] + (size_t)pg * 256 * 256, 256, 256, (bf16_t*)(F.ws + WS_WPOOL) + (size_t)pg * 256 * 256, 32 * nb, scr, 64 * kb, 32 * nb, F.lane, nullptr, nullptr, nullptr, nullptr); continue; } r -= 8 * I_POOL;
        if (r < 4 * I_UP) { const int l = r / I_UP; r %= I_UP; const int kb = r / (UPN / 32), nb = r % (UPN / 32); const int n0 = 32 * nb;
            const int dst = (n0 < DFF) ? (256 * (n0 / 128) + (n0 % 128)) : (256 * ((n0 - DFF) / 128) + 128 + ((n0 - DFF) % 128));
            float* ctlf = (float*)(F.ws + WS_CTL);
            p0_transpose_item(F.in[I_WUP] + (size_t)l * D * UPN, D, UPN, (bf16_t*)(F.ws + WS_WUP) + (size_t)l * UPN * D, dst, scr, 64 * kb, n0, F.lane,
                              F.in[I_L1G] + (size_t)l * D, F.in[I_L1B] + (size_t)l * D, ctlf + UC_UUP + l * UPN, ctlf + UC_CUP + l * UPN); continue; } r -= 4 * I_UP;
        { const int l = r / I_DN; r %= I_DN; const int kb = r / (D / 32), nb = r % (D / 32);
            p0_transpose_item(F.in[I_WDN] + (size_t)l * DFF * D, DFF, D, (bf16_t*)(F.ws + WS_WDN) + (size_t)l * D * DFF, 32 * nb, scr, 64 * kb, 32 * nb, F.lane, nullptr, nullptr, nullptr, nullptr); }
    }
    bf16_t* XB = (bf16_t*)(F.ws + WS_XB);
    for (int m0 = gw; m0 < MT; m0 += 4 * NGW) {
        f32x4 v[4][4];
#pragma unroll
        for (int q = 0; q < 4; ++q) { const int m = m0 + q * NGW;
            if (m < MT) { const float* src = (m < MP) ? F.in[I_XP] + (size_t)m * D : F.in[I_XS] + (size_t)(m - MP) * D;
#pragma unroll
                for (int j = 0; j < 4; ++j) v[q][j] = *(const f32x4*)(src + 4 * F.lane + 256 * j); } }
#pragma unroll
        for (int q = 0; q < 4; ++q) { const int m = m0 + q * NGW;
            if (m < MT) {
#pragma unroll
                for (int j = 0; j < 4; ++j) { u32x2 w; w.x = pk2(v[q][j][0], v[q][j][1]); w.y = pk2(v[q][j][2], v[q][j][3]); *(u32x2*)(XB + (size_t)m * D + 4 * F.lane + 256 * j) = w; } } }
    }
    if (F.bid == 0) {
        float* tab = (float*)(F.ws + WS_TAB);
        { const int c = F.tid; const float a = F.in[I_LBL][c], b = F.in[I_LBL][512 + c], mx = fmaxf(a, b), ea = __expf(a - mx), eb = __expf(b - mx);
          tab[TB_LB + c] = 0.f; tab[TB_LB + 512 + c] = eb / (ea + eb); }
        if (F.wave < 2) { const int m = F.wave; const float* lp = F.in[I_DLAM] + (size_t)m * 4 * 64;
            const float s01 = wave_sum(lp[F.lane] * lp[64 + F.lane]), s23 = wave_sum(lp[128 + F.lane] * lp[192 + F.lane]);
            const float lam_init = (m == 0) ? 0.2f : 0.47071302f;
            if (F.lane == 0) tab[TB_LAM + m] = __expf(s01) - __expf(s23) + lam_init; }
    }
}

__device__ __forceinline__ void phase_ln_final(Frame& F, const bf16_t* Z, const float* g, const float* b) {
    const int gw = F.bid * NWAVES + F.wave, NGW = F.G * NWAVES;
    f32x4 gv[4], bv[4];
#pragma unroll
    for (int j = 0; j < 4; ++j) { const int c = 8 * F.lane + 512 * (j >> 1) + 4 * (j & 1); gv[j] = *(const f32x4*)(g + c); bv[j] = *(const f32x4*)(b + c); }
    u32x4 wq[2][2];
#pragma unroll
    for (int a = 0; a < 2; ++a) { const int mm = gw + a * NGW < MT ? gw + a * NGW : gw;
#pragma unroll
        for (int j2 = 0; j2 < 2; ++j2) wq[a][j2] = *(const u32x4*)(Z + (size_t)mm * D + 8 * F.lane + 512 * j2); }
    for (int m = gw; m < MT; m += NGW) {
        f32x4 v[4]; float s = 0.f;
#pragma unroll
        for (int j2 = 0; j2 < 2; ++j2) { const u32x4 w = wq[0][j2];
            v[2 * j2] = (f32x4){bflo(w.x), bfhi(w.x), bflo(w.y), bfhi(w.y)}; v[2 * j2 + 1] = (f32x4){bflo(w.z), bfhi(w.z), bflo(w.w), bfhi(w.w)}; }
        { const int mm = m + 2 * NGW < MT ? m + 2 * NGW : m;
#pragma unroll
          for (int j2 = 0; j2 < 2; ++j2) { wq[0][j2] = wq[1][j2]; wq[1][j2] = *(const u32x4*)(Z + (size_t)mm * D + 8 * F.lane + 512 * j2); } }
#pragma unroll
        for (int j = 0; j < 4; ++j) s += (v[j][0] + v[j][1]) + (v[j][2] + v[j][3]);
        const float mean = wave_sum(s) * (1.f / D); float s2 = 0.f;
#pragma unroll
        for (int j = 0; j < 4; ++j) { v[j] = v[j] - mean; s2 += (v[j][0] * v[j][0] + v[j][1] * v[j][1]) + (v[j][2] * v[j][2] + v[j][3] * v[j][3]); }
        const float rstd = 1.f / sqrtf(wave_sum(s2) * (1.f / D) + LN_EPS);
        float* outp = (m < MP) ? F.out + O_YP + (size_t)m * D : F.out + O_YS + (size_t)(m - MP) * D;
#pragma unroll
        for (int j2 = 0; j2 < 2; ++j2) { const f32x4 y0 = v[2 * j2] * rstd * gv[2 * j2] + bv[2 * j2], y1 = v[2 * j2 + 1] * rstd * gv[2 * j2 + 1] + bv[2 * j2 + 1];
            *(f32x4*)(outp + 8 * F.lane + 512 * j2) = y0; *(f32x4*)(outp + 8 * F.lane + 512 * j2 + 4) = y1; }
    }
}

template <int J>
__device__ __forceinline__ void pool_item(Frame& F, const LnRef& R, int p, int rb, int c) {
    constexpr int W = 2 << J;
    bf16_t* PO = (bf16_t*)(F.ws + WS_MIX);
    const f32x4 g0 = *(const f32x4*)(R.g + c), g1 = *(const f32x4*)(R.g + c + 4), b0 = *(const f32x4*)(R.b + c), b1 = *(const f32x4*)(R.b + c + 4);
    const int m0 = rb * 16; const bool smp = m0 >= MP; const int b = smp ? (m0 - MP) / ST : m0 / PT, t0 = smp ? 0 : m0 % PT;
    f32x4 ring[W][2]; f32x4 s0 = {0.f, 0.f, 0.f, 0.f}, s1 = {0.f, 0.f, 0.f, 0.f};
#pragma unroll
    for (int i = 0; i < W; ++i) {
        const int tt = t0 - W + i; f32x4 v0 = {0.f, 0.f, 0.f, 0.f}, v1 = {0.f, 0.f, 0.f, 0.f};
        if (tt >= 0) { const size_t rr = (size_t)(m0 - W + i); const u32x4 q = *(const u32x4*)(R.Z + rr * D + c); float mu, rstd; ln_row(R.st, rr, 0, mu, rstd);
            v0 = ((f32x4){bflo(q.x), bfhi(q.x), bflo(q.y), bfhi(q.y)} - mu) * rstd * g0 + b0; v1 = ((f32x4){bflo(q.z), bfhi(q.z), bflo(q.w), bfhi(q.w)} - mu) * rstd * g1 + b1; }
        else if (smp && tt >= -15) { const float* hp = F.in[I_SP] + (((size_t)p * SB + b) * 15 + (15 + tt)) * D + c; v0 = *(const f32x4*)hp; v1 = *(const f32x4*)(hp + 4); }
        ring[i][0] = v0; ring[i][1] = v1; s0 += v0; s1 += v1; }
    constexpr int NB = (J == 3) ? 2 : (J == 2) ? 4 : 8;
#pragma unroll
    for (int hb = 0; hb < 16 / NB; ++hb) {
        u32x4 qv[NB]; f32x2 sv[NB];
#pragma unroll
        for (int k = 0; k < NB; ++k) { const size_t rr = (size_t)(m0 + NB * hb + k); qv[k] = *(const u32x4*)(R.Z + rr * D + c); sv[k] = *(const f32x2*)(R.st + rr * 2); }
#pragma unroll
        for (int k = 0; k < NB; ++k) { const int i = NB * hb + k, t = t0 + i; const u32x4 q = qv[k];
            const float mu = sv[k][0] * (1.f / D), rstd = 1.f / sqrtf(fmaxf(sv[k][1] * (1.f / D) - mu * mu, 0.f) + LN_EPS);
            const f32x4 x0 = ((f32x4){bflo(q.x), bfhi(q.x), bflo(q.y), bfhi(q.y)} - mu) * rstd * g0 + b0, x1 = ((f32x4){bflo(q.z), bfhi(q.z), bflo(q.w), bfhi(q.w)} - mu) * rstd * g1 + b1;
            s0 += x0 - ring[i % W][0]; s1 += x1 - ring[i % W][1]; ring[i % W][0] = x0; ring[i % W][1] = x1;
            const float inv = 1.f / (float)(smp ? W : (t + 1 < W ? t + 1 : W));
            const f32x4 o0 = s0 * inv - x0, o1 = s1 * inv - x1;
            u32x4 w; w.x = pk2(o0[0], o0[1]); w.y = pk2(o0[2], o0[3]); w.z = pk2(o1[0], o1[1]); w.w = pk2(o1[2], o1[3]); *(u32x4*)(PO + (size_t)(m0 + i) * D + c) = w;
            if (!smp && t >= PT - 15) { float* op = F.out + O_PP + (((size_t)p * PB + b) * 15 + (t - (PT - 15))) * D + c; *(f32x4*)op = x0; *(f32x4*)(op + 4) = x1; }
            if (smp && t >= 1) { float* op = F.out + O_PS + (((size_t)p * SB + b) * 15 + (t - 1)) * D + c; *(f32x4*)op = x0; *(f32x4*)(op + 4) = x1; } } }
}
__device__ __forceinline__ void phase_pool_prep(Frame& F, const LnRef& R, int p) {
    const int gwv = F.bid * NWAVES + F.wave, NGW = F.G * NWAVES;
    for (int wi = gwv; wi < (MT / 32) * 4; wi += NGW) { const int j = wi & 3, rb = 2 * (wi >> 2) + (F.lane >> 5), c = 256 * j + 8 * (F.lane & 31);
        if (j == 0) pool_item<0>(F, R, p, rb, c); else if (j == 1) pool_item<1>(F, R, p, rb, c); else if (j == 2) pool_item<2>(F, R, p, rb, c); else pool_item<3>(F, R, p, rb, c); }
}

__device__ __forceinline__ void conv_fix_item(Frame& F, int l, int pm, int ch) {
    bf16_t* Gb = (bf16_t*)(F.ws + WS_G);
    const float* cw = F.in[I_CW] + (size_t)l * 3 * DFF; const float* cb = F.in[I_CB] + (size_t)l * DFF;
    const float* ahead = (const float*)(F.ws + WS_AHEAD); const float* bhead = (const float*)(F.ws + WS_BHEAD); const float* atail = (const float*)(F.ws + WS_ATAIL);
    float t0[8], t1[8], a0[8], a1[8], b0[8], b1[8], o[8];
#pragma unroll
    for (int h2 = 0; h2 < 2; ++h2) {
        const f32x4 x0 = *(const f32x4*)(atail + ((size_t)(pm - 1) * 2 + 0) * DFF + ch + 4 * h2), x1 = *(const f32x4*)(atail + ((size_t)(pm - 1) * 2 + 1) * DFF + ch + 4 * h2);
        const f32x4 y0 = *(const f32x4*)(ahead + ((size_t)pm * 2 + 0) * DFF + ch + 4 * h2), y1 = *(const f32x4*)(ahead + ((size_t)pm * 2 + 1) * DFF + ch + 4 * h2);
        const f32x4 z0 = *(const f32x4*)(bhead + ((size_t)pm * 2 + 0) * DFF + ch + 4 * h2), z1 = *(const f32x4*)(bhead + ((size_t)pm * 2 + 1) * DFF + ch + 4 * h2);
#pragma unroll
        for (int e = 0; e < 4; ++e) { t0[4 * h2 + e] = x0[e]; t1[4 * h2 + e] = x1[e]; a0[4 * h2 + e] = y0[e]; a1[4 * h2 + e] = y1[e]; b0[4 * h2 + e] = z0[e]; b1[4 * h2 + e] = z1[e]; } }
#pragma unroll
    for (int e = 0; e < 8; ++e) { const float c = cb[ch + e] + t0[e] * cw[ch + e] + t1[e] * cw[DFF + ch + e] + a0[e] * cw[2 * DFF + ch + e]; o[e] = silu_mul(c, b0[e]); }
    *(u32x4*)(Gb + (size_t)(pm * 256) * DFF + ch) = pk8(o);
#pragma unroll
    for (int e = 0; e < 8; ++e) { const float c = cb[ch + e] + t1[e] * cw[ch + e] + a0[e] * cw[DFF + ch + e] + a1[e] * cw[2 * DFF + ch + e]; o[e] = silu_mul(c, b1[e]); }
    *(u32x4*)(Gb + (size_t)(pm * 256 + 1) * DFF + ch) = pk8(o);
}
__device__ __forceinline__ void conv_fix_local(Frame& F, int l, const pg8::StaticOrder& S) {
    pg8::Unit u;
    for (int i = 0; S.next(i, u); ++i)
        if (u.pm < MP / 256 && (u.pm & 7) != 0)
            for (int it = F.tid; it < DFF / 8; it += NTHREADS) conv_fix_item(F, l, u.pm, 8 * it);
    asm volatile("s_waitcnt vmcnt(0)" ::: "memory");
    __syncthreads();
}

constexpr int HG_LF = 0;
constexpr int HG_TOT = HG_LF + 16384;
constexpr int HG_G = HG_TOT + 2048;
constexpr int HG_QT = HG_G + 512;
constexpr int HG_KS = HG_QT + 32 * 272;
constexpr int HG_V = HG_KS + 32 * 320;
constexpr int HG_PF = HG_V + 32 * 320;
constexpr int HG_OX = HG_PF + 2048;
constexpr int HG_OXP = 132;
constexpr int HG_END = HG_OX + 2 * 32 * HG_OXP * 4;
static_assert(HG_END <= LDS_TAB, "HGRN LDS");

template <bool SMP>
__device__ __forceinline__ void hgrn_unit(Frame& F, int m, int b, int h) {
    LAS unsigned char* L = F.lds;
    const bf16_t* H = (const bf16_t*)(F.ws + WS_H); const float* LFg = (const float*)(F.ws + WS_LF); bf16_t* MIX = (bf16_t*)(F.ws + WS_MIX);
    const float* gn = F.in[I_HNG] + (size_t)m * 512 + h * 128;
    const int tid = opq(F.tid), lane = tid & 63, wave = __builtin_amdgcn_readfirstlane(tid >> 6), r = lane & 31, hh = lane >> 5;
    const int nb = wave & 3, kh = wave >> 2;
    const size_t row0 = SMP ? (size_t)MP + (size_t)b * ST : (size_t)b * PT;
    const int nsteps = SMP ? 1 : PT / 32;
    f32x16 S[2];
    if (SMP) { const float* s0 = F.in[I_SH] + (((size_t)m * SB + b) * NH + h) * 128 * 128 + (size_t)(64 * kh + 4 * hh) * 128 + 32 * nb + r;
#pragma unroll
        for (int kbl = 0; kbl < 2; ++kbl)
#pragma unroll
            for (int i = 0; i < 16; ++i) S[kbl][i] = s0[(32 * kbl + (i & 3) + 8 * (i >> 2)) * 128];
    } else {
#pragma unroll
        for (int kbl = 0; kbl < 2; ++kbl)
#pragma unroll
            for (int i = 0; i < 16; ++i) S[kbl][i] = 0.f;
    }
    const int et = tid >> 4, ek = (tid & 15) * 8;
    const bool valid = !SMP || et < ST;
    f32x4 lf0 = {0.f, 0.f, 0.f, 0.f}, lf1 = {0.f, 0.f, 0.f, 0.f}; u32x4 qw = {0u, 0u, 0u, 0u}, vw = {0u, 0u, 0u, 0u}, gw = {0u, 0u, 0u, 0u};
    if (valid) { const size_t row = row0 + et;
        lf0 = *(const f32x4*)(LFg + row * 512 + h * 128 + ek); lf1 = *(const f32x4*)(LFg + row * 512 + h * 128 + ek + 4);
        qw = *(const u32x4*)(H + row * INC + C_AQ + h * 128 + ek); vw = *(const u32x4*)(H + row * INC + C_AI + h * 128 + ek); gw = *(const u32x4*)(H + row * INC + C_AG + h * 128 + ek); }
    for (int step = 0; step < nsteps; ++step) {
        const size_t row = row0 + (size_t)step * 32 + et;
        *(LAS f32x4*)(L + HG_LF + (et * 128 + ek) * 4) = lf0; *(LAS f32x4*)(L + HG_LF + (et * 128 + ek + 4) * 4) = lf1;
        f32x4 nlf0 = lf0, nlf1 = lf1; u32x4 nqw = qw, nvw = vw, ngw = gw;
        if (!SMP && step + 1 < nsteps) { const size_t rn = row + 32;
            nlf0 = *(const f32x4*)(LFg + rn * 512 + h * 128 + ek); nlf1 = *(const f32x4*)(LFg + rn * 512 + h * 128 + ek + 4);
            nqw = *(const u32x4*)(H + rn * INC + C_AQ + h * 128 + ek); nvw = *(const u32x4*)(H + rn * INC + C_AI + h * 128 + ek); ngw = *(const u32x4*)(H + rn * INC + C_AG + h * 128 + ek); }
        __syncthreads();
        { const int k = tid & 127, tq = tid >> 7; LAS float* p = (LAS float*)(L + HG_LF) + (8 * tq) * 128 + k; float vs[8];
#pragma unroll
            for (int i = 0; i < 8; ++i) vs[i] = p[i * 128];
#pragma unroll
            for (int i = 1; i < 8; ++i) vs[i] += vs[i - 1];
#pragma unroll
            for (int i = 0; i < 8; ++i) p[i * 128] = vs[i];
            ((LAS float*)(L + HG_TOT))[tq * 128 + k] = vs[7]; }
        __syncthreads();
        { float bcum[8];
            { const f32x4 c0 = *(LAS f32x4*)(L + HG_LF + (et * 128 + ek) * 4), c1 = *(LAS f32x4*)(L + HG_LF + (et * 128 + ek + 4) * 4);
#pragma unroll
              for (int e = 0; e < 4; ++e) { bcum[e] = c0[e]; bcum[4 + e] = c1[e]; } }
            for (int gq = 0; gq < (et >> 3); ++gq) { const f32x4 c0 = *(LAS f32x4*)(L + HG_TOT + (gq * 128 + ek) * 4), c1 = *(LAS f32x4*)(L + HG_TOT + (gq * 128 + ek + 4) * 4);
#pragma unroll
                for (int e = 0; e < 4; ++e) { bcum[e] += c0[e]; bcum[4 + e] += c1[e]; } }
            float qv[8]; unpk8(qw, qv);
            float qt[8], kt[8];
#pragma unroll
            for (int e = 0; e < 8; ++e) { const float lfe = e < 4 ? lf0[e] : lf1[e - 4]; const float eb = __expf(bcum[e]);
                qt[e] = qv[e] * eb; kt[e] = (1.f - __expf(lfe)) * __expf(-bcum[e]);
                if (et == 31) ((LAS float*)(L + HG_G))[ek + e] = eb; }
            const u32x4 qp = pk8(qt), kp = pk8(kt);
            *(LAS u32x4*)(L + HG_QT + et * 272 + ek * 2) = qp;
            *(LAS u32x4*)(L + HG_KS + et * 320 + ek * 2) = kp;
            *(LAS u32x4*)(L + HG_V + et * 320 + ek * 2) = vw;
        }
        __syncthreads();
        if (wave == 0) {
            f32x16 pt;
#pragma unroll
            for (int i = 0; i < 16; ++i) pt[i] = 0.f;
#pragma unroll
            for (int st = 0; st < 8; ++st) { const bf16x8 a = *(const LAS bf16x8*)(L + HG_KS + r * 320 + (16 * st + 8 * hh) * 2), bq = *(const LAS bf16x8*)(L + HG_QT + r * 272 + (16 * st + 8 * hh) * 2);
                pt = MFMA32(a, bq, pt); }
#pragma unroll
            for (int i = 0; i < 16; ++i) if (crow(i, hh) > r) pt[i] = 0.f;
            *(LAS bf16x8*)(L + HG_PF + lane * 16) = pack_step(pt, 0); *(LAS bf16x8*)(L + HG_PF + 1024 + lane * 16) = pack_step(pt, 1);
        }
        f32x16 oacc;
#pragma unroll
        for (int i = 0; i < 16; ++i) oacc[i] = 0.f;
#pragma unroll
        for (int kbl = 0; kbl < 2; ++kbl)
#pragma unroll
            for (int s2 = 0; s2 < 2; ++s2) { const int k0 = 64 * kh + 32 * kbl + 16 * s2 + 4 * hh;
                const s16x4 lo = *(const LAS s16x4*)(L + HG_QT + r * 272 + k0 * 2), hi = *(const LAS s16x4*)(L + HG_QT + r * 272 + (k0 + 8) * 2);
                oacc = MFMA32(pack_step(S[kbl], s2), cat8(lo, hi), oacc); }
        __syncthreads();
        const int i16 = lane & 15, tq = i16 >> 2, tp = i16 & 3, gi = (lane >> 4) & 1;
        if (kh == 0) {
#pragma unroll
            for (int s2 = 0; s2 < 2; ++s2) { const int key0 = 16 * s2 + 4 * hh;
                const s16x4 lo = vtr(L + HG_V + (key0 + tq) * 320 + (32 * nb + 16 * gi + 4 * tp) * 2), hi = vtr(L + HG_V + (key0 + 8 + tq) * 320 + (32 * nb + 16 * gi + 4 * tp) * 2);
                const bf16x8 pf = *(const LAS bf16x8*)(L + HG_PF + s2 * 1024 + lane * 16);
                oacc = MFMA32(cat8(lo, hi), pf, oacc); }
        }
#pragma unroll
        for (int i4 = 0; i4 < 4; ++i4) { const f32x4 o4 = {oacc[4 * i4], oacc[4 * i4 + 1], oacc[4 * i4 + 2], oacc[4 * i4 + 3]};
            *(LAS f32x4*)(L + HG_OX + ((kh * 32 + r) * HG_OXP + 32 * nb + 8 * i4 + 4 * hh) * 4) = o4; }
#pragma unroll
        for (int kbl = 0; kbl < 2; ++kbl)
#pragma unroll
            for (int s2 = 0; s2 < 2; ++s2) { const int key0 = 16 * s2 + 8 * hh;
                const s16x4 alo = vtr(L + HG_KS + (key0 + tq) * 320 + (64 * kh + 32 * kbl + 16 * gi + 4 * tp) * 2), ahi = vtr(L + HG_KS + (key0 + 4 + tq) * 320 + (64 * kh + 32 * kbl + 16 * gi + 4 * tp) * 2);
                const s16x4 lo = vtr(L + HG_V + (key0 + tq) * 320 + (32 * nb + 16 * gi + 4 * tp) * 2), hi = vtr(L + HG_V + (key0 + 4 + tq) * 320 + (32 * nb + 16 * gi + 4 * tp) * 2);
                S[kbl] = MFMA32(cat8(alo, ahi), cat8(lo, hi), S[kbl]); }
#pragma unroll
        for (int kbl = 0; kbl < 2; ++kbl)
#pragma unroll
            for (int i = 0; i < 16; ++i) S[kbl][i] *= ((LAS float*)(L + HG_G))[64 * kh + 32 * kbl + crow(i, hh)];
        __syncthreads();
        { float o[8], ss = 0.f;
#pragma unroll
            for (int e4 = 0; e4 < 2; ++e4) { const f32x4 a4 = *(LAS f32x4*)(L + HG_OX + (et * HG_OXP + ek + 4 * e4) * 4), b4 = *(LAS f32x4*)(L + HG_OX + ((32 + et) * HG_OXP + ek + 4 * e4) * 4);
#pragma unroll
                for (int e = 0; e < 4; ++e) { o[4 * e4 + e] = a4[e] + b4[e]; ss += o[4 * e4 + e] * o[4 * e4 + e]; } }
            ss += shx(ss, 1); ss += shx(ss, 2); ss += shx(ss, 4); ss += shx(ss, 8);
            const float rstd = 1.f / sqrtf(ss * (1.f / 128.f) + RMS_EPS);
            float gv[8]; unpk8(gw, gv);
            const f32x4 g0 = *(const f32x4*)(gn + ek), g1 = *(const f32x4*)(gn + ek + 4);
#pragma unroll
            for (int e = 0; e < 8; ++e) { const float y = o[e] * rstd * (e < 4 ? g0[e] : g1[e - 4]); o[e] = y * (gv[e] / (1.f + __expf(-gv[e]))); }
            if (valid) *(u32x4*)(MIX + row * D + h * 128 + ek) = pk8(o);
        }
        lf0 = nlf0; lf1 = nlf1; qw = nqw; vw = nvw; gw = ngw;
    }
    { float* so = (SMP ? F.out + O_HS + (((size_t)m * SB + b) * NH + h) * 128 * 128 : F.out + O_HP + (((size_t)m * PB + b) * NH + h) * 128 * 128);
      const int l2 = opq(lane); float* sp = so + (size_t)(64 * kh + 4 * (l2 >> 5)) * 128 + 32 * nb + (l2 & 31);
#pragma unroll
      for (int kbl = 0; kbl < 2; ++kbl)
#pragma unroll
        for (int i = 0; i < 16; ++i) sp[(32 * kbl + (i & 3) + 8 * (i >> 2)) * 128] = S[kbl][i]; }
    __syncthreads();
}

constexpr int AT_KP = 272, AT_VP = 320;
constexpr int AT_KB = 64 * AT_KP, AT_VB = 64 * AT_VP;
constexpr int AT_TILE = AT_KB + AT_VB;
static_assert(4 * AT_TILE <= LDS_TAB && (8 * 66 * 64 + 64 * 64 + 8 * 64) * 4 <= LDS_TAB && 2 * AT_TILE + 8 * 2 * 32 * 144 <= LDS_TAB, "attention LDS");

__device__ __forceinline__ void attn_build_tab(Frame& F, int h) {
    const int tid = opq(F.tid);
    if (tid < 256) { const int rel = tid - 128, n = rel < 0 ? -rel : rel;
        int bk = n;
        if (n >= 8) bk = 8 + (n >= 12) + (n >= 16) + (n >= 23) + (n >= 32) + (n >= 46) + (n >= 64) + (n >= 91);
        if (rel > 0) bk += 16;
        ((LAS float*)(F.lds + LDS_TAB))[tid] = F.in[I_RB][bk * NH + h] * LOG2E; }
}
struct AttnState { f32x16 o[4]; float m, l; };
template <bool MASK_END>
__device__ __forceinline__ void attn_tile(const LAS unsigned char* Kt, const LAS unsigned char* Vt, int vh, const bf16x8 (&qf)[4], AttnState& A, int kpos0, int qpos, int qpos_min, int kv_end,
                                          const LAS float* tab, int r, int hh, int lane) {
    f32x16 st[2];
#pragma unroll
    for (int kb = 0; kb < 2; ++kb) {
#pragma unroll
        for (int i = 0; i < 16; ++i) st[kb][i] = 0.f;
#pragma unroll
        for (int s = 0; s < 4; ++s) { const bf16x8 a = *(const LAS bf16x8*)(Kt + (32 * kb + r) * AT_KP + (vh * 64 + 16 * s + 8 * hh) * 2); st[kb] = MFMA32(a, qf[s], st[kb]); }
    }
    constexpr float C2 = 0.125f * LOG2E;
    const bool far = (kpos0 + 63) <= (qpos_min - 91);
    if (far) { const float bc = tab[0]; const f32x2 c2 = {C2, C2}, b2 = {bc, bc};
#pragma unroll
        for (int kb = 0; kb < 2; ++kb)
#pragma unroll
            for (int j = 0; j < 8; ++j) { const f32x2 x = (f32x2){st[kb][2 * j], st[kb][2 * j + 1]} * c2 + b2; st[kb][2 * j] = x[0]; st[kb][2 * j + 1] = x[1]; }
    } else {
#pragma unroll
        for (int kb = 0; kb < 2; ++kb)
#pragma unroll
            for (int i = 0; i < 16; ++i) { const int kpos = kpos0 + 32 * kb + crow(i, hh); int rel = kpos - qpos; rel = rel < -128 ? -128 : (rel > 127 ? 127 : rel);
                float x = st[kb][i] * C2 + tab[rel + 128];
                if (MASK_END) x = (kpos < kv_end) ? x : -1e30f;
                st[kb][i] = x; }
    }
    float mx = st[0][0];
#pragma unroll
    for (int kb = 0; kb < 2; ++kb)
#pragma unroll
        for (int i = 0; i < 16; ++i) mx = fmaxf(mx, st[kb][i]);
    mx = fmaxf(mx, shx(mx, 32));
    if (__any(mx > A.m + 8.f)) {
        const float mnew = fmaxf(A.m, mx), alpha = __builtin_amdgcn_exp2f(A.m - mnew);
        A.m = mnew; A.l *= alpha;
#pragma unroll
        for (int mb = 0; mb < 4; ++mb)
#pragma unroll
            for (int i = 0; i < 16; ++i) A.o[mb][i] *= alpha;
    }
    { const float off = -A.m; const f32x2 off2 = {off, off};
      f32x2 ls2 = {0.f, 0.f};
#pragma unroll
      for (int kb = 0; kb < 2; ++kb)
#pragma unroll
        for (int j = 0; j < 8; ++j) { const f32x2 x = (f32x2){st[kb][2 * j], st[kb][2 * j + 1]} + off2;
            const f32x2 p = {__builtin_amdgcn_exp2f(x[0]), __builtin_amdgcn_exp2f(x[1])};
            st[kb][2 * j] = p[0]; st[kb][2 * j + 1] = p[1]; ls2 += p; }
      A.l += ls2[0] + ls2[1]; }
    const int i16 = lane & 15, tq = i16 >> 2, tp = i16 & 3, gi = (lane >> 4) & 1;
#pragma unroll
    for (int kb = 0; kb < 2; ++kb)
#pragma unroll
        for (int s2 = 0; s2 < 2; ++s2) { const bf16x8 pf = pack_step(st[kb], s2); const int key0 = 32 * kb + 16 * s2 + 4 * hh;
#pragma unroll
            for (int mb = 0; mb < 4; ++mb) {
                const s16x4 lo = vtr(Vt + (key0 + tq) * AT_VP + (32 * mb + 16 * gi + 4 * tp) * 2), hi = vtr(Vt + (key0 + 8 + tq) * AT_VP + (32 * mb + 16 * gi + 4 * tp) * 2);
                A.o[mb] = MFMA32(cat8(lo, hi), pf, A.o[mb]); } }
}
__device__ __forceinline__ void attn_store(const f32x16 (&o)[4], const float* gnorm, float post, bf16_t* dst_row  , int hh, bool active) {
    float ss = 0.f;
#pragma unroll
    for (int mb = 0; mb < 4; ++mb)
#pragma unroll
        for (int i = 0; i < 16; ++i) ss += o[mb][i] * o[mb][i];
    ss += shx(ss, 32);
    const float rstd = post / sqrtf(ss * (1.f / 128.f) + RMS_EPS);
    if (active) {
#pragma unroll
        for (int mb = 0; mb < 4; ++mb)
#pragma unroll
            for (int g4 = 0; g4 < 4; ++g4) { const int dv = 32 * mb + 8 * g4 + 4 * hh; const f32x4 gv = *(const f32x4*)(gnorm + dv);
                u32x2 w; w.x = pk2(o[mb][4 * g4] * rstd * gv[0], o[mb][4 * g4 + 1] * rstd * gv[1]); w.y = pk2(o[mb][4 * g4 + 2] * rstd * gv[2], o[mb][4 * g4 + 3] * rstd * gv[3]);
                *(u32x2*)(dst_row + dv) = w; }
    }
}

__device__ __forceinline__ void attn_prompt_unit(Frame& F, int m, int b, int h, int qb) {
    LAS unsigned char* L = F.lds; const LAS float* tab = (const LAS float*)(L + LDS_TAB);
    const bf16_t* H = (const bf16_t*)(F.ws + WS_H); bf16_t* MIX = (bf16_t*)(F.ws + WS_MIX);
    const int tid = opq(F.tid), lane = tid & 63, wave = __builtin_amdgcn_readfirstlane(tid >> 6), r = lane & 31, hh = lane >> 5, vh = wave >> 2, wq = wave & 3;
    const size_t rowb = (size_t)b * PT;
    const int q0a = qb * 256 + wq * 32, q0b = q0a + 128, qca = q0a >> 6, qcb = q0b >> 6, nkt = 4 * qb + 4;
    attn_build_tab(F, h);
    LAS unsigned char* qs = L + 2 * AT_TILE + wave * (2 * 32 * 144) + r * 144 + 16 * hh;
#pragma unroll
    for (int s = 0; s < 4; ++s) { *(LAS bf16x8*)(qs + 32 * s) = *(const bf16x8*)(H + (rowb + q0a + r) * INC + C_BQ + h * 128 + vh * 64 + 16 * s + 8 * hh);
        *(LAS bf16x8*)(qs + 32 * 144 + 32 * s) = *(const bf16x8*)(H + (rowb + q0b + r) * INC + C_BQ + h * 128 + vh * 64 + 16 * s + 8 * hh); }
    AttnState A0, A1;
#pragma unroll
    for (int mb = 0; mb < 4; ++mb)
#pragma unroll
        for (int i = 0; i < 16; ++i) { A0.o[mb][i] = 0.f; A1.o[mb][i] = 0.f; }
    A0.m = -1e30f; A0.l = 0.f; A1.m = -1e30f; A1.l = 0.f;
    u32x4 kr[2], vr[2];
#define AT_LD(kt) do { _Pragma("unroll") for (int i_ = 0; i_ < 2; ++i_) { const int c_ = tid + 512 * i_, key_ = c_ >> 4, ch_ = c_ & 15; const bf16_t* src_ = H + (rowb + 64 * (kt) + key_) * INC + h * 128 + ch_ * 8; \
        kr[i_] = *(const u32x4*)(src_ + C_BK); vr[i_] = *(const u32x4*)(src_ + C_BV); } } while (0)
#define AT_ST(buf) do { _Pragma("unroll") for (int i_ = 0; i_ < 2; ++i_) { const int c_ = tid + 512 * i_, key_ = c_ >> 4, ch_ = c_ & 15; \
        *(LAS u32x4*)(L + (buf) * AT_TILE + key_ * AT_KP + ch_ * 16) = kr[i_]; *(LAS u32x4*)(L + (buf) * AT_TILE + AT_KB + key_ * AT_VP + ch_ * 16) = vr[i_]; } } while (0)
    AT_LD(0); AT_ST(0);
    AT_LD(1);
    __syncthreads();
    for (int kt = 0; kt < nkt; ++kt) {
        if (kt <= qca) { bf16x8 qf[4];
#pragma unroll
            for (int s = 0; s < 4; ++s) qf[s] = *(const LAS bf16x8*)(qs + 32 * s);
            attn_tile<false>(L + (kt & 1) * AT_TILE, L + (kt & 1) * AT_TILE + AT_KB, vh, qf, A0, 64 * kt, q0a + r, q0a, 0, tab, r, hh, lane); }
        if (kt <= qcb) { bf16x8 qf[4];
#pragma unroll
            for (int s = 0; s < 4; ++s) qf[s] = *(const LAS bf16x8*)(qs + 32 * 144 + 32 * s);
            attn_tile<false>(L + (kt & 1) * AT_TILE, L + (kt & 1) * AT_TILE + AT_KB, vh, qf, A1, 64 * kt, q0b + r, q0b, 0, tab, r, hh, lane); }
        if (kt + 1 < nkt) AT_ST((kt + 1) & 1);
        if (kt + 2 < nkt) AT_LD(kt + 2);
        __syncthreads();
    }
#undef AT_LD
#undef AT_ST
    { const float l0 = A0.l + shx(A0.l, 32), i0 = 1.f / l0, l1 = A1.l + shx(A1.l, 32), i1 = 1.f / l1;
#pragma unroll
        for (int mb = 0; mb < 4; ++mb)
#pragma unroll
            for (int i = 0; i < 16; ++i) { A0.o[mb][i] *= i0; A1.o[mb][i] *= i1; } }
    LAS float* X = (LAS float*)L;
    if (vh == 1) {
#pragma unroll
        for (int mb = 0; mb < 4; ++mb)
#pragma unroll
            for (int i = 0; i < 16; ++i) { X[(wq * 64 + mb * 16 + i) * 64 + lane] = A0.o[mb][i]; X[((4 + wq) * 64 + mb * 16 + i) * 64 + lane] = A1.o[mb][i]; }
    }
    __syncthreads();
    if (vh == 0) {
        const float lam = ((const float*)(F.ws + WS_TAB))[TB_LAM + m];
        const float lam_init = (m == 0) ? 0.2f : 0.47071302f;
#pragma unroll
        for (int mb = 0; mb < 4; ++mb)
#pragma unroll
            for (int i = 0; i < 16; ++i) A0.o[mb][i] -= lam * X[(wq * 64 + mb * 16 + i) * 64 + lane];
        attn_store(A0.o, F.in[I_DNG] + (size_t)m * 128, 1.f - lam_init, MIX + (rowb + q0a + r) * D + 512 + h * 128, hh, true);
#pragma unroll
        for (int mb = 0; mb < 4; ++mb)
#pragma unroll
            for (int i = 0; i < 16; ++i) A1.o[mb][i] -= lam * X[((4 + wq) * 64 + mb * 16 + i) * 64 + lane];
        attn_store(A1.o, F.in[I_DNG] + (size_t)m * 128, 1.f - lam_init, MIX + (rowb + q0b + r) * D + 512 + h * 128, hh, true);
    }
    __syncthreads();
}

__device__ __forceinline__ void attn_sample_unit(Frame& F, int m, int b, int h) {
    LAS unsigned char* L = F.lds; const LAS float* tab = (const LAS float*)(L + LDS_TAB);
    const bf16_t* H = (const bf16_t*)(F.ws + WS_H); bf16_t* MIX = (bf16_t*)(F.ws + WS_MIX);
    const float* ck = F.in[I_CK] + (((size_t)m * SB + b) * PAST) * 512 + h * 128; const float* cv = F.in[I_CV] + (((size_t)m * SB + b) * PAST) * 512 + h * 128;
    const int tid = opq(F.tid), lane = tid & 63, wave = __builtin_amdgcn_readfirstlane(tid >> 6), r = lane & 31, hh = lane >> 5, vh = wave >> 2, ks = wave & 3;
    const size_t rows = (size_t)MP + (size_t)b * ST;
    attn_build_tab(F, h);
    bf16x8 qf[4];
#pragma unroll
    for (int s = 0; s < 4; ++s) qf[s] = *(const bf16x8*)(H + (rows + (r & 15)) * INC + C_BQ + h * 128 + vh * 64 + 16 * s + 8 * hh);
    AttnState A;
#pragma unroll
    for (int mb = 0; mb < 4; ++mb)
#pragma unroll
        for (int i = 0; i < 16; ++i) A.o[mb][i] = 0.f;
    A.m = -1e30f; A.l = 0.f;
    constexpr int NT = PAST / 64 + 1;
    for (int it = 0; it < (NT + 3) / 4; ++it) {
#pragma unroll 1
        for (int j = 0; j < 4; ++j) { const int T = 4 * it + j;
#pragma unroll
            for (int i = 0; i < 2; ++i) { const int c = tid + 512 * i, key = c >> 4, ch = c & 15;
                u32x4 kw = {0u, 0u, 0u, 0u}, vw = {0u, 0u, 0u, 0u};
                if (T < PAST / 64) { const float* pk = ck + (size_t)(64 * T + key) * 512 + ch * 8; const float* pv = cv + (size_t)(64 * T + key) * 512 + ch * 8;
                    const f32x4 k0 = *(const f32x4*)pk, k1 = *(const f32x4*)(pk + 4), v0 = *(const f32x4*)pv, v1 = *(const f32x4*)(pv + 4);
                    kw.x = pk2(k0[0], k0[1]); kw.y = pk2(k0[2], k0[3]); kw.z = pk2(k1[0], k1[1]); kw.w = pk2(k1[2], k1[3]);
                    vw.x = pk2(v0[0], v0[1]); vw.y = pk2(v0[2], v0[3]); vw.z = pk2(v1[0], v1[1]); vw.w = pk2(v1[2], v1[3]); }
                else if (T == PAST / 64 && key < ST) { const bf16_t* src = H + (rows + key) * INC + h * 128 + ch * 8; kw = *(const u32x4*)(src + C_BK); vw = *(const u32x4*)(src + C_BV); }
                *(LAS u32x4*)(L + j * AT_TILE + key * AT_KP + ch * 16) = kw; *(LAS u32x4*)(L + j * AT_TILE + AT_KB + key * AT_VP + ch * 16) = vw; } }
        __syncthreads();
        { const int T = 4 * it + ks;
            if (T < NT - 1) attn_tile<false>(L + ks * AT_TILE, L + ks * AT_TILE + AT_KB, vh, qf, A, 64 * T, PAST + (r & 15), PAST, 0, tab, r, hh, lane);
            else if (T == NT - 1) attn_tile<true>(L + ks * AT_TILE, L + ks * AT_TILE + AT_KB, vh, qf, A, 64 * T, PAST + (r & 15), PAST, PAST + ST, tab, r, hh, lane); }
        __syncthreads();
    }
    const float lt = A.l + shx(A.l, 32);
    LAS float* X = (LAS float*)L;
#pragma unroll
    for (int mb = 0; mb < 4; ++mb)
#pragma unroll
        for (int i = 0; i < 16; ++i) X[(wave * 66 + mb * 16 + i) * 64 + lane] = A.o[mb][i];
    X[(wave * 66 + 64) * 64 + lane] = A.m; X[(wave * 66 + 65) * 64 + lane] = lt;
    LAS float* Y = X + 8 * 66 * 64;
    LAS float* SS = Y + 64 * 64;
    __syncthreads();
    {
        const float lam = ((const float*)(F.ws + WS_TAB))[TB_LAM + m];
        float coef[8];
#pragma unroll
        for (int v2 = 0; v2 < 2; ++v2) {
            float M = -1e30f;
#pragma unroll
            for (int k = 0; k < 4; ++k) M = fmaxf(M, X[((v2 * 4 + k) * 66 + 64) * 64 + lane]);
            float Ls = 0.f;
#pragma unroll
            for (int k = 0; k < 4; ++k) { coef[v2 * 4 + k] = __builtin_amdgcn_exp2f(X[((v2 * 4 + k) * 66 + 64) * 64 + lane] - M); Ls += coef[v2 * 4 + k] * X[((v2 * 4 + k) * 66 + 65) * 64 + lane]; }
            const float sc = (v2 == 0 ? 1.f : -lam) / Ls;
#pragma unroll
            for (int k = 0; k < 4; ++k) coef[v2 * 4 + k] *= sc;
        }
        float ss = 0.f;
#pragma unroll
        for (int i8 = 0; i8 < 8; ++i8) { const int row = 8 * wave + i8; float y = 0.f;
#pragma unroll
            for (int p = 0; p < 8; ++p) y += coef[p] * X[(p * 66 + row) * 64 + lane];
            Y[row * 64 + lane] = y; ss += y * y; }
        SS[wave * 64 + lane] = ss;
    }
    __syncthreads();
    if (wave == 0) {
        float ss = 0.f;
#pragma unroll
        for (int w = 0; w < 8; ++w) ss += SS[w * 64 + lane];
        ss += shx(ss, 32);
        const float lam_init = (m == 0) ? 0.2f : 0.47071302f;
        const float rstd = (1.f - lam_init) / sqrtf(ss * (1.f / 128.f) + RMS_EPS);
        const float* gnorm = F.in[I_DNG] + (size_t)m * 128;
        bf16_t* dst_row = MIX + (rows + (r & 15)) * D + 512 + h * 128;
        if (r < ST) {
#pragma unroll
            for (int mb = 0; mb < 4; ++mb)
#pragma unroll
                for (int g4 = 0; g4 < 4; ++g4) { const int dv = 32 * mb + 8 * g4 + 4 * hh; const f32x4 gv = *(const f32x4*)(gnorm + dv); const LAS float* yp = Y + (mb * 16 + 4 * g4) * 64 + lane;
                    u32x2 w; w.x = pk2(yp[0] * rstd * gv[0], yp[64] * rstd * gv[1]); w.y = pk2(yp[128] * rstd * gv[2], yp[192] * rstd * gv[3]);
                    *(u32x2*)(dst_row + dv) = w; }
        }
    }
    __syncthreads();
}

__device__ __forceinline__ void phase_mixer(Frame& F, int m, int qsel = 0) {
    const int G = F.G, bid = F.bid;
    if (PHM & 0x1000) for (int u = bid; u < PB * NH; u += G) hgrn_unit<false>(F, m, u >> 2, u & 3);
#if PROBE_HG
    for (int u = bid; u < PB * NH; u += G) hgrn_unit<false>(F, m, u >> 2, u & 3);
#endif
    if (PHM & 0x2000) for (int u = (G >= 256 ? (bid >= 128 ? bid - 128 : bid + G - 128) : bid); u < SB * NH; u += G) attn_sample_unit(F, m, u >> 2, u & 3);
#if PROBE_SA
    for (int u = (G >= 256 ? (bid >= 128 ? bid - 128 : bid + G - 128) : bid); u < SB * NH; u += G) attn_sample_unit(F, m, u >> 2, u & 3);
#endif
    if (PHM & 0x4000) {
        gu32* head = (gu32*)(F.ws + WS_CTL) + CW_QUEUE + 64 * m + 128 * qsel;
        volatile LAS int* slot = (volatile LAS int*)(F.lds + LDS_CTRL + 64);
        for (;;) {
            if (F.tid == 0) *slot = (int)__hip_atomic_fetch_add(head, 1u, __ATOMIC_RELAXED, __HIP_MEMORY_SCOPE_AGENT);
            __syncthreads();
            const int u = *slot;
            __syncthreads();
            if (u >= PB * NH * 8) break;
            const int qb = 7 - (u >> 7), bh = u & 127;
            attn_prompt_unit(F, m, bh >> 2, bh & 3, qb);
        }
    }
    if (PHM & 0x8000) for (int u = bid; u < SB * NH; u += G) hgrn_unit<true>(F, m, u >> 2, u & 3);
}

__global__ void __launch_bounds__(NTHREADS, 2) mega_fwd(Args args) {
    extern __shared__ __attribute__((aligned(16))) unsigned char lds_raw[];
    Frame F;
    F.lds = (LAS unsigned char*)lds_raw;
    F.tid = threadIdx.x; F.lane = F.tid & 63; F.wave = __builtin_amdgcn_readfirstlane(F.tid >> 6);
    const int wave_s = F.wave;
    F.bid = blockIdx.x; F.G = gridDim.x; F.in = (kin_t)__builtin_amdgcn_kernarg_segment_ptr(); F.out = (float*)F.in[24]; F.ws = (unsigned char*)F.in[25];
    if (F.tid < 128) ((LAS unsigned*)(F.lds + LDS_CTRL))[F.tid] = 0u;
    __syncthreads();
    unsigned* barw = (unsigned*)(F.ws + WS_CTL) + CW_BAR;
    XcdBarrier bar; bar.bar = barw; bar.x = 0; bar.st = nullptr;
    const bool single = args.single != 0;
    if (single) bar = xcd_barrier_post(barw, (volatile LAS unsigned*)(F.lds + LDS_CTRL + 32));
    const int lo = args.ph_lo, hi = args.ph_hi;
#define RUN(p) (lo <= (p) && (p) < hi)
#define SEAM() do { if (single) { XcdBarrier b2_ = bar; asm volatile("" : "+s"(b2_.bar)); xcd_barrier(b2_); } } while (0)
#define REFRESH() do { { int b_ = (int)blockIdx.x, g_ = (int)gridDim.x; asm volatile("" : "+s"(b_), "+s"(g_)); F.bid = b_; F.G = g_; } { kin_t kp_ = (kin_t)__builtin_amdgcn_kernarg_segment_ptr(); asm volatile("" : "+s"(kp_)); F.in = kp_; F.out = (float*)kp_[24]; F.ws = (unsigned char*)kp_[25]; } { int l_; asm volatile("v_mbcnt_lo_u32_b32 %0, -1, 0\n\tv_mbcnt_hi_u32_b32 %0, -1, %0" : "=v"(l_)); F.lane = l_; } F.wave = wave_s; F.tid = wave_s * 64 + F.lane; } while (0)
    int ph = 0;
    if ((PHM & 1) && RUN(ph)) { REFRESH(); phase_prologue(F); SEAM();
#if PROBE_PRO
        REFRESH(); phase_prologue(F); SEAM();
#endif
    } ++ph;
    for (int l = 0; l < 4; ++l) {
#define WSB(off) ((bf16_t*)(F.ws + (off)))
#define STATS(k) ((float*)(F.ws + WS_CTL) + CW_STATS + (size_t)(k) * MT * 2)
#define LN1REF(ll) LnRef{WSB(WS_Z), STATS(2 * (ll)), F.in[I_L1G] + (size_t)(ll) * D, F.in[I_L1B] + (size_t)(ll) * D, 0}
#define LN2REF(ll) LnRef{WSB(WS_ZB), STATS(2 * (ll) + 1), F.in[I_L2G] + (size_t)(ll) * D, F.in[I_L2B] + (size_t)(ll) * D, 0}
        if ((l & 1) == 0) {
            const int m = l >> 1;
            if ((PHM & 2) && RUN(ph)) {
                REFRESH();
                const float* ctlf = (const float*)(F.ws + WS_CTL);
                pg8::Gemm g{l == 0 ? WSB(WS_XB) : WSB(WS_ZB), (const bf16_t*)(F.ws + WS_WIN) + (size_t)m * INC * D, MP, INC, D, D, 0, l == 0 ? nullptr : STATS(2 * (l - 1) + 1)}; pg8::StaticOrder S; S.init(MP, INC, F.G, F.bid);
                EpiIn E{(bf16_t*)(F.ws + WS_H), (float*)(F.ws + WS_LF), (const float*)(F.ws + WS_TAB) + TB_LB + m * 512,
                        F.out + O_KP + (size_t)m * MP * 512, F.out + O_VP + (size_t)m * MP * 512, F.out + O_KS + (size_t)m * MS * 512, F.out + O_VS + (size_t)m * MS * 512,
                        STATS(l == 0 ? 0 : 2 * (l - 1) + 1), ctlf + (l == 0 ? UC_ZERO : UC_UIN), ctlf + (l == 0 ? UC_ZERO : UC_CIN), l == 0 ? 1 : 0};
                pg8::gemm_phase<EpiIn>(F.lds, g, S, E, F.tid);
                REFRESH(); sgemm_in_phase(F.lds, g.A + (size_t)MP * D, g.Bt, F.bid, F.G, F.tid, E);
                SEAM(); } ++ph;
            if ((PHM & 4) && RUN(ph)) { REFRESH(); phase_mixer(F, m); SEAM();
#if PROBE_MIXER
                REFRESH(); phase_mixer(F, m, 1); SEAM();
#endif
            } ++ph;
            if ((PHM & 8) && RUN(ph)) {
                REFRESH();
                pg8::Gemm g{(const bf16_t*)(F.ws + WS_MIX), (const bf16_t*)(F.ws + WS_WOUT) + (size_t)m * D * D, MP, D, D, D, 0, l == 0 ? nullptr : STATS(2 * (l - 1) + 1)}; pg8::StaticOrder S; S.init(MP, D, F.G, F.bid);
                LnRef P = LN2REF(l == 0 ? 0 : l - 1); if (l == 0) { P.Z = WSB(WS_XB); P.ident = 1; }
                EpiRes E{P, WSB(WS_Z), STATS(2 * l), nullptr};
                if (F.bid & 1) { sgemm_res_phase<128>(F.lds, g.A + (size_t)MP * D, D, 0, g.Bt, D, F.bid, F.G, F.tid, P, WSB(WS_Z), STATS(2 * l), nullptr); REFRESH(); }
                pg8::gemm_phase<EpiRes>(F.lds, g, S, E, F.tid);
                REFRESH(); if (!(F.bid & 1)) sgemm_res_phase<128>(F.lds, g.A + (size_t)MP * D, D, 0, g.Bt, D, F.bid, F.G, F.tid, P, WSB(WS_Z), STATS(2 * l), nullptr);
                SEAM(); } ++ph;
        } else {
            const int p = l >> 1;
            if ((PHM & 16) && RUN(ph)) { REFRESH(); const LnRef R = LN2REF(l - 1); phase_pool_prep(F, R, p); SEAM(); } ++ph;
            ++ph;
            if ((PHM & 32) && RUN(ph)) {
                REFRESH();
                pg8::Gemm g{(const bf16_t*)(F.ws + WS_MIX), (const bf16_t*)(F.ws + WS_WPOOL) + (size_t)p * D * 256, MP, D, 256, D, 256, STATS(2 * (l - 1) + 1)}; pg8::StaticOrder S; S.init(MP, D, F.G, F.bid);
                EpiRes E{LN2REF(l - 1), WSB(WS_Z), STATS(2 * l), F.in[I_PSC] + (size_t)p * D};
                if (F.bid & 1) { const LnRef P2 = LN2REF(l - 1); sgemm_res_phase<32>(F.lds, g.A + (size_t)MP * D, D, 256, g.Bt, 256, F.bid, F.G, F.tid, P2, WSB(WS_Z), STATS(2 * l), E.scale); REFRESH(); }
                pg8::gemm_phase<EpiRes>(F.lds, g, S, E, F.tid);
                REFRESH(); if (!(F.bid & 1)) { const LnRef P2 = LN2REF(l - 1); sgemm_res_phase<32>(F.lds, g.A + (size_t)MP * D, D, 256, g.Bt, 256, F.bid, F.G, F.tid, P2, WSB(WS_Z), STATS(2 * l), E.scale); }
                SEAM(); } ++ph;
        }
        ++ph;
        if ((PHM & 128) && RUN(ph)) {
            REFRESH();
            const float* ctlf = (const float*)(F.ws + WS_CTL);
            pg8::Gemm g{WSB(WS_Z), (const bf16_t*)(F.ws + WS_WUP) + (size_t)l * UPN * D, MT, UPN, D, D, 0, STATS(2 * l)}; pg8::StaticOrder S; S.init(MT, UPN, F.G, F.bid);
            EpiUpConv E{(bf16_t*)(F.ws + WS_G), F.in[I_CW] + (size_t)l * 3 * DFF, F.in[I_CB] + (size_t)l * DFF, F.in[I_SC] + (size_t)l * SB * 2 * DFF,
                        (float*)(F.ws + WS_AHEAD), (float*)(F.ws + WS_BHEAD), (float*)(F.ws + WS_ATAIL), F.out + O_CP + (size_t)l * PB * 2 * DFF, F.out + O_CS + (size_t)l * SB * 2 * DFF, (LAS float*)(F.lds + LDS_EX),
                        STATS(2 * l), ctlf + UC_UUP + (size_t)l * UPN, ctlf + UC_CUP + (size_t)l * UPN};
            pg8::gemm_phase<EpiUpConv>(F.lds, g, S, E, F.tid); SEAM();
#if PROBE_UP
            REFRESH(); pg8::gemm_phase<EpiUpConv>(F.lds, g, S, E, F.tid); SEAM();
#endif
            } ++ph;
        ++ph;
        if ((PHM & 512) && RUN(ph)) {
            REFRESH();
            pg8::Gemm g{(const bf16_t*)(F.ws + WS_G), (const bf16_t*)(F.ws + WS_WDN) + (size_t)l * D * DFF, MP, D, DFF, DFF, 0, STATS(2 * l)}; pg8::StaticOrder S; S.init(MP, D, F.G, F.bid);
            conv_fix_local(F, l, S); REFRESH();
            EpiRes E{LN1REF(l), WSB(WS_ZB), STATS(2 * l + 1), nullptr};
            if (F.bid & 1) { const LnRef P1 = LN1REF(l); sgemm_res_phase<352>(F.lds, g.A + (size_t)MP * DFF, DFF, 0, g.Bt, DFF, F.bid, F.G, F.tid, P1, WSB(WS_ZB), STATS(2 * l + 1), nullptr); REFRESH(); }
            pg8::gemm_phase<EpiRes>(F.lds, g, S, E, F.tid);
            REFRESH(); if (!(F.bid & 1)) { const LnRef P1 = LN1REF(l); sgemm_res_phase<352>(F.lds, g.A + (size_t)MP * DFF, DFF, 0, g.Bt, DFF, F.bid, F.G, F.tid, P1, WSB(WS_ZB), STATS(2 * l + 1), nullptr); }
            SEAM(); } ++ph;
        if ((PHM & 1024) && RUN(ph) && l == 3) { REFRESH(); phase_ln_final(F, WSB(WS_ZB), F.in[I_L2G] + (size_t)3 * D, F.in[I_L2B] + (size_t)3 * D); } ++ph;
    }
#undef RUN
#undef SEAM
}
constexpr int N_PHASES = 1 + 4 * 8;

extern "C" void kernel_launch(void* const* d_in, const int* in_sizes, int n_in, void* d_out, int out_size, void* d_ws, size_t ws_size, hipStream_t stream) {
    static int grid = 0;
    if (grid == 0) {
        if (n_in != 24 || (size_t)out_size != O_END || ws_size < WS_END2) { fprintf(stderr, "kernel_launch: unexpected problem (n_in %d out %d ws %zu)\n", n_in, out_size, ws_size); grid = -1; return; }
        int dev = 0, cus = 0;
        if (hipGetDevice(&dev) != hipSuccess || hipDeviceGetAttribute(&cus, hipDeviceAttributeMultiprocessorCount, dev) != hipSuccess) { grid = -1; return; }
        if (hipFuncSetAttribute((const void*)mega_fwd, hipFuncAttributeMaxDynamicSharedMemorySize, LDS_BYTES) != hipSuccess) { fprintf(stderr, "kernel_launch: hipFuncSetAttribute failed\n"); grid = -1; return; }
        int per_cu = 0;
        if (hipOccupancyMaxActiveBlocksPerMultiprocessor(&per_cu, (const void*)mega_fwd, NTHREADS, LDS_BYTES) != hipSuccess || per_cu < 1) fprintf(stderr, "kernel_launch: occupancy query reports %d\n", per_cu);
        (void)hipGetLastError();
        grid = cus;
    }
    if (grid < 0) return;
    (void)hipMemsetAsync((char*)d_ws + WS_CTL, 0, CTL_ZERO_BYTES, stream);
    Args a{};
    for (int i = 0; i < 24; ++i) a.in[i] = (const float*)d_in[i];
    a.out = (float*)d_out; a.ws = (unsigned char*)d_ws; a.pad = 0;
#if MK_SINGLE
    a.ph_lo = 0; a.ph_hi = N_PHASES; a.single = 1;
    hipLaunchKernelGGL(mega_fwd, dim3(grid), dim3(NTHREADS), LDS_BYTES, stream, a);
#else
    for (int p = 0; p < N_PHASES; ++p) {
        const int k = (p - 1) % 8, l = (p - 1) / 8;
        if (p > 0 && (l & 1) == 1 && k == 1) continue;
        a.ph_lo = p; a.ph_hi = p + 1; a.single = 0;
        hipLaunchKernelGGL(mega_fwd, dim3(grid), dim3(NTHREADS), LDS_BYTES, stream, a);
    }
#endif
}
```
